# Optimizing an MI355X kernel written in HIP

```python
import math
import jax, jax.numpy as jnp
from jax import lax
import numpy as np

D_MODEL = 1024
BATCH = 8
SEQ = 8192
DEPTH = 4
DEC_BATCH = 16
DEC_SEQ = 64
PAST_LEN = 2048

CHUNK = 64
N_MIXERS = 2
N_HGRN_LAYERS = (DEPTH + N_MIXERS - 1) // N_MIXERS
N_GLA_LAYERS = DEPTH // N_MIXERS
HGRN_HEAD_DIM = 128
HGRN_HEADS = D_MODEL // HGRN_HEAD_DIM
HGRN_WIDTH = HGRN_HEADS * HGRN_HEAD_DIM
GLA_HEADS = 4
GLA_KEY_DIM = D_MODEL // (2 * GLA_HEADS)
GLA_VAL_DIM = D_MODEL // GLA_HEADS
GLA_GATE_RANK = 16
GLA_TAU = 16.0
MEM_TOKENS = 256
MEM_HEADS = 4
MEM_HEAD_DIM = 128
MEM_WIDTH = MEM_HEADS * MEM_HEAD_DIM
D_FF = 2816
ALPHA = (2.0 * DEPTH) ** 0.25
BETA = (8.0 * DEPTH) ** -0.25
LN_EPS = 1e-5
RMS_EPS = 1e-6
GATE_CLAMP = 1.0 - 1e-6
HGRN_SPLITS = (HGRN_WIDTH, 2 * HGRN_WIDTH, 3 * HGRN_WIDTH, 4 * HGRN_WIDTH)
HGRN_IN = 4 * HGRN_WIDTH + MEM_WIDTH
HGRN_MIX_WIDTH = HGRN_WIDTH + MEM_WIDTH
GLA_QK = GLA_HEADS * GLA_KEY_DIM
GLA_V = GLA_HEADS * GLA_VAL_DIM
GLA_SPLITS = (GLA_QK, 2 * GLA_QK, 2 * GLA_QK + GLA_V, 2 * GLA_QK + 2 * GLA_V, 2 * GLA_QK + 2 * GLA_V + GLA_GATE_RANK)
GLA_IN = 2 * GLA_QK + 2 * GLA_V + GLA_GATE_RANK + MEM_WIDTH
GLA_MIX_WIDTH = GLA_V + MEM_WIDTH

kernel_name = 'hybrid_hgrn2_gla_streaming_step'


def layer_norm(x, gain, bias):
    xf = x.astype(jnp.float32)
    mu = jnp.mean(xf, axis=-1, keepdims=True)
    var = jnp.mean(jnp.square(xf - mu), axis=-1, keepdims=True)
    return ((xf - mu) * lax.rsqrt(var + LN_EPS) * gain + bias).astype(x.dtype)


def swiglu(x, w_gate, w_up, w_down):
    return (jax.nn.silu(x @ w_gate) * (x @ w_up)) @ w_down


def gated_linear_attention(q, k, v, log_a, s0):
    B, L, H, K = q.shape
    V = v.shape[-1]
    C = min(CHUNK, L)
    N = L // C
    f32 = jnp.float32

    def chunks(t):
        return t.astype(f32).reshape(B, N, C, H, t.shape[-1]).swapaxes(0, 1)

    causal = jnp.tril(jnp.ones((C, C), dtype=bool))[None, :, :, None, None]

    def step(s, blk):
        qc, kc, vc, gc = blk
        b = jnp.cumsum(gc, axis=1)
        diff = b[:, :, None] - b[:, None]
        decay = jnp.where(causal, jnp.exp(jnp.minimum(diff, 0.0)), 0.0)
        scores = jnp.einsum('bthk,btshk,bshk->bhts', qc, decay, kc)
        o = (jnp.einsum('bhts,bshv->bthv', scores, vc)
             + jnp.einsum('bthk,bhkv->bthv', qc * jnp.exp(b), s))
        b_last = b[:, -1]
        s = (jnp.exp(b_last)[..., None] * s
             + jnp.einsum('bshk,bshv->bhkv', kc * jnp.exp(b_last[:, None] - b), vc))
        return s, o

    s_final, o = lax.scan(step, s0.astype(f32), (chunks(q), chunks(k), chunks(v), chunks(log_a)))
    return o.swapaxes(0, 1).reshape(B, L, H, V), s_final.astype(s0.dtype)


def head_rmsnorm_gate(o, gain, gate, dtype):
    B, L, H, V = o.shape
    o = o * lax.rsqrt(jnp.mean(o * o, axis=-1, keepdims=True) + RMS_EPS)
    return (o.reshape(B, L, H * V) * gain * jax.nn.silu(gate.astype(jnp.float32))).astype(dtype)


def hgrn2_mixer(x, w_in, lower_bound, norm_gain, s0):
    B, L, _ = x.shape
    q, f, i, g, xq = jnp.split(x @ w_in, HGRN_SPLITS, axis=-1)
    heads = lambda t: t.reshape(B, L, HGRN_HEADS, HGRN_HEAD_DIM)
    f32 = f.astype(jnp.float32)
    k = (1.0 - lower_bound) * jax.nn.sigmoid(-f32)
    log_f = jnp.log1p(-jnp.minimum(k, GATE_CLAMP))
    q = jax.nn.silu(q) * HGRN_HEAD_DIM ** -0.5
    o, s = gated_linear_attention(heads(q), heads(k), heads(i), heads(log_f), s0)
    return head_rmsnorm_gate(o, norm_gain, g, x.dtype), xq, s


def gla_mixer(x, w_in, w_gate2, b_gate, norm_gain, s0):
    B, L, _ = x.shape
    q, k, v, r, ga, xq = jnp.split(x @ w_in, GLA_SPLITS, axis=-1)
    heads_k = lambda t: t.reshape(B, L, GLA_HEADS, GLA_KEY_DIM)
    log_a = jax.nn.log_sigmoid((ga @ w_gate2 + b_gate).astype(jnp.float32)) / GLA_TAU
    o, s = gated_linear_attention(heads_k(q) * GLA_KEY_DIM ** -0.5, heads_k(k),
                                  v.reshape(B, L, GLA_HEADS, GLA_VAL_DIM), heads_k(log_a), s0)
    return head_rmsnorm_gate(o, norm_gain, r, x.dtype), xq, s


def memory_attention(xq, mem_k, mem_v):
    B, L, _ = xq.shape
    q = xq.reshape(B, L, MEM_HEADS, MEM_HEAD_DIM)
    s = jnp.einsum('blhd,bmhd->bhlm', q, mem_k).astype(jnp.float32) * MEM_HEAD_DIM ** -0.5
    p = jax.nn.softmax(s, axis=-1).astype(mem_v.dtype)
    return jnp.einsum('bhlm,bmhd->blhd', p, mem_v).reshape(B, L, MEM_WIDTH)


def run_trunk(x, mem_k, mem_v, s_hgrn, s_gla, ffn_w_gate, ffn_w_up, ffn_w_down, ln_gain, ln_bias,
              hgrn_w_in, hgrn_lb_logits, hgrn_norm, hgrn_w_out,
              gla_w_in, gla_w_gate2, gla_b_gate, gla_norm, gla_w_out):
    sm = jax.nn.softmax(hgrn_lb_logits.astype(jnp.float32), axis=0)
    lower_bounds = jnp.cumsum(sm, axis=0) - sm[0]
    new_h, new_g = [], []
    for layer in range(DEPTH):
        x = layer_norm(ALPHA * x + 0.5 * swiglu(x, ffn_w_gate[layer, 0], ffn_w_up[layer, 0], ffn_w_down[layer, 0]),
                       ln_gain[layer, 0], ln_bias[layer, 0])
        j = layer // N_MIXERS
        if layer % N_MIXERS == 0:
            mix, xq, s = hgrn2_mixer(x, hgrn_w_in[j], lower_bounds[j], hgrn_norm[j], s_hgrn[j])
            w_out = hgrn_w_out[j]
            new_h.append(s)
        else:
            mix, xq, s = gla_mixer(x, gla_w_in[j], gla_w_gate2[j], gla_b_gate[j], gla_norm[j], s_gla[j])
            w_out = gla_w_out[j]
            new_g.append(s)
        xo = memory_attention(xq, mem_k[layer], mem_v[layer])
        x = layer_norm(ALPHA * x + jnp.concatenate([mix, xo], axis=-1) @ w_out,
                       ln_gain[layer, 1], ln_bias[layer, 1])
        x = layer_norm(ALPHA * x + 0.5 * swiglu(x, ffn_w_gate[layer, 1], ffn_w_up[layer, 1], ffn_w_down[layer, 1]),
                       ln_gain[layer, 2], ln_bias[layer, 2])
    return x, jnp.stack(new_h), jnp.stack(new_g)


def setup_inputs(seed: int = 0) -> dict:
    key = jax.random.key(seed)
    ks = jax.random.split(key, 26)
    nrm = lambda k, shape, scale: jax.random.normal(k, shape, jnp.float32) * scale
    d = D_MODEL
    hgrn_col_scale = jnp.concatenate([jnp.ones((2 * HGRN_WIDTH,)), BETA * jnp.ones((HGRN_WIDTH,)),
                                      jnp.ones((HGRN_WIDTH + MEM_WIDTH,))])
    gla_col_scale = jnp.concatenate([jnp.ones((2 * GLA_QK,)), BETA * jnp.ones((GLA_V,)),
                                     jnp.ones((GLA_V + GLA_GATE_RANK + MEM_WIDTH,))])
    return {
        'x_prompt': nrm(ks[0], (BATCH, SEQ, d), 1.0),
        'x_sample': nrm(ks[1], (DEC_BATCH, DEC_SEQ, d), 1.0),
        'mem_prompt': nrm(ks[2], (BATCH, MEM_TOKENS, d), 1.0),
        'cache_mem_k': nrm(ks[3], (DEPTH, DEC_BATCH, MEM_TOKENS, MEM_HEADS, MEM_HEAD_DIM), 1.0),
        'cache_mem_v': nrm(ks[4], (DEPTH, DEC_BATCH, MEM_TOKENS, MEM_HEADS, MEM_HEAD_DIM), BETA),
        'state_hgrn': nrm(ks[5], (N_HGRN_LAYERS, DEC_BATCH, HGRN_HEADS, HGRN_HEAD_DIM, HGRN_HEAD_DIM), 0.5),
        'state_gla': nrm(ks[6], (N_GLA_LAYERS, DEC_BATCH, GLA_HEADS, GLA_KEY_DIM, GLA_VAL_DIM), 1.0),
        'ffn_w_gate': nrm(ks[7], (DEPTH, 2, d, D_FF), d ** -0.5),
        'ffn_w_up': nrm(ks[8], (DEPTH, 2, d, D_FF), d ** -0.5),
        'ffn_w_down': nrm(ks[9], (DEPTH, 2, D_FF, d), BETA * D_FF ** -0.5),
        'ln_gain': 1.0 + nrm(ks[10], (DEPTH, 3, d), 0.02),
        'ln_bias': nrm(ks[11], (DEPTH, 3, d), 0.02),
        'hgrn_w_in': nrm(ks[12], (N_HGRN_LAYERS, d, HGRN_IN), d ** -0.5) * hgrn_col_scale,
        'hgrn_lb_logits': nrm(ks[13], (N_HGRN_LAYERS, HGRN_WIDTH), 0.5),
        'hgrn_norm': 1.0 + nrm(ks[14], (N_HGRN_LAYERS, HGRN_WIDTH), 0.02),
        'hgrn_w_out': nrm(ks[15], (N_HGRN_LAYERS, HGRN_MIX_WIDTH, d), BETA * HGRN_MIX_WIDTH ** -0.5),
        'gla_w_in': nrm(ks[16], (N_GLA_LAYERS, d, GLA_IN), d ** -0.5) * gla_col_scale,
        'gla_w_gate2': nrm(ks[17], (N_GLA_LAYERS, GLA_GATE_RANK, GLA_QK), GLA_GATE_RANK ** -0.5),
        'gla_b_gate': nrm(ks[18], (N_GLA_LAYERS, GLA_QK), 0.1),
        'gla_norm': 1.0 + nrm(ks[19], (N_GLA_LAYERS, GLA_V), 0.02),
        'gla_w_out': nrm(ks[20], (N_GLA_LAYERS, GLA_MIX_WIDTH, d), BETA * GLA_MIX_WIDTH ** -0.5),
        'mem_w_k': nrm(ks[21], (DEPTH, d, MEM_WIDTH), d ** -0.5),
        'mem_w_v': nrm(ks[22], (DEPTH, d, MEM_WIDTH), BETA * d ** -0.5),
    }


def reference(x_prompt, x_sample, mem_prompt, cache_mem_k, cache_mem_v, state_hgrn, state_gla,
              ffn_w_gate, ffn_w_up, ffn_w_down, ln_gain, ln_bias,
              hgrn_w_in, hgrn_lb_logits, hgrn_norm, hgrn_w_out,
              gla_w_in, gla_w_gate2, gla_b_gate, gla_norm, gla_w_out, mem_w_k, mem_w_v):
    weights = (ffn_w_gate, ffn_w_up, ffn_w_down, ln_gain, ln_bias,
               hgrn_w_in, hgrn_lb_logits, hgrn_norm, hgrn_w_out,
               gla_w_in, gla_w_gate2, gla_b_gate, gla_norm, gla_w_out)
    b = x_prompt.shape[0]
    mem_k_prompt = jnp.einsum('bmd,ldc->lbmc', mem_prompt, mem_w_k).reshape(DEPTH, b, MEM_TOKENS, MEM_HEADS, MEM_HEAD_DIM)
    mem_v_prompt = jnp.einsum('bmd,ldc->lbmc', mem_prompt, mem_w_v).reshape(DEPTH, b, MEM_TOKENS, MEM_HEADS, MEM_HEAD_DIM)
    zeros_h = jnp.zeros((N_HGRN_LAYERS, b, HGRN_HEADS, HGRN_HEAD_DIM, HGRN_HEAD_DIM), x_prompt.dtype)
    zeros_g = jnp.zeros((N_GLA_LAYERS, b, GLA_HEADS, GLA_KEY_DIM, GLA_VAL_DIM), x_prompt.dtype)
    y_prompt, state_hgrn_prompt, state_gla_prompt = run_trunk(
        x_prompt, mem_k_prompt, mem_v_prompt, zeros_h, zeros_g, *weights)
    y_sample, state_hgrn_sample, state_gla_sample = run_trunk(
        x_sample, cache_mem_k, cache_mem_v, state_hgrn, state_gla, *weights)
    return (y_prompt, y_sample, state_hgrn_prompt, state_gla_prompt, mem_k_prompt, mem_v_prompt,
            state_hgrn_sample, state_gla_sample)
```

```cpp
#include <hip/hip_runtime.h>
#include <hip/hip_cooperative_groups.h>
#include <cstdio>
namespace cg = cooperative_groups;

#ifndef ONE_LAUNCH
#define ONE_LAUNCH 0
#endif

#define LAS __attribute__((address_space(3)))
typedef unsigned short bf16_t;
typedef short bf16x8 __attribute__((ext_vector_type(8)));
typedef float f32x4 __attribute__((ext_vector_type(4)));
typedef float f32x2 __attribute__((ext_vector_type(2)));
typedef unsigned u32x4 __attribute__((ext_vector_type(4)));
typedef unsigned u32x2 __attribute__((ext_vector_type(2)));
typedef __bf16 nbf2 __attribute__((ext_vector_type(2)));

constexpr int D = 1024, MP = 65536, MS = 1024, MROWS = MP + MS, FF = 2816;
constexpr int HG_LD = 4608, GL_LD = 4096;
constexpr float ALPHA = 1.6817928305074292f;
constexpr int NTHR = 512;
constexpr int LDS_BYTES = 132 * 1024;

constexpr size_t O_Y = 0;
constexpr size_t O_SHP = (size_t)MROWS * D;
constexpr size_t O_SGP = O_SHP + 2u * 8 * 8 * 128 * 128;
constexpr size_t O_MK = O_SGP + 2u * 8 * 4 * 128 * 256;
constexpr size_t O_MV = O_MK + 4u * 2048 * 512;
constexpr size_t O_SHS = O_MV + 4u * 2048 * 512;
constexpr size_t O_SGS = O_SHS + 2u * 16 * 8 * 128 * 128;

constexpr size_t WS_WGU = 0;
constexpr size_t WS_WD = WS_WGU + 8ull * 5632 * 1024 * 2;
constexpr size_t WS_HWIN = WS_WD + 8ull * 1024 * 2816 * 2;
constexpr size_t WS_GWIN = WS_HWIN + 2ull * 4608 * 1024 * 2;
constexpr size_t WS_WOUT = WS_GWIN + 2ull * 4096 * 1024 * 2;
constexpr size_t WS_MEMW = WS_WOUT + 4ull * 1024 * 1536 * 2;
constexpr size_t WS_MEMP = WS_MEMW + 4096ull * 1024 * 2;
constexpr size_t WS_MKB = WS_MEMP + 2048ull * 1024 * 2;
constexpr size_t WS_MVB = WS_MKB + 4ull * 2048 * 512 * 2;
constexpr size_t WS_CKB = WS_MVB + 4ull * 2048 * 512 * 2;
constexpr size_t WS_CVB = WS_CKB + 4ull * 4096 * 512 * 2;
constexpr size_t WS_XN = WS_CVB + 4ull * 4096 * 512 * 2;
constexpr size_t WS_PROJ = WS_XN + (size_t)MROWS * 1024 * 2;
constexpr size_t WS_END = WS_PROJ + (size_t)MROWS * 4608 * 2;

struct Params {
    const float* in[23];
    float* out;
    unsigned char* ws;
    int ph_lo, ph_hi;
};

__device__ __forceinline__ unsigned pk2(float lo, float hi) { f32x2 v = {lo, hi}; nbf2 b = __builtin_convertvector(v, nbf2); return __builtin_bit_cast(unsigned, b); }
__device__ __forceinline__ float bflo(unsigned u) { return __uint_as_float(u << 16); }
__device__ __forceinline__ float bfhi(unsigned u) { return __uint_as_float(u & 0xffff0000u); }
__device__ __forceinline__ bf16_t f2bf(float f) { unsigned u = pk2(f, 0.f); return (bf16_t)(u & 0xffffu); }
__device__ __forceinline__ float sigmoidf_(float x) { return 1.0f / (1.0f + __expf(-x)); }
#define MFMA16(a, b, c) __builtin_amdgcn_mfma_f32_16x16x32_bf16((a), (b), (c), 0, 0, 0)

constexpr int BM = 256, BK = 64, HALF = 128, HTB = HALF * BK * 2, NXCD = 8, WGM = 8;
__device__ __forceinline__ int lds_byte(int r, int c) { const int st = (r >> 4) * 2 + (c >> 5), rr = r & 15, cc = c & 31, ob = rr * 64 + cc * 2; return st * 1024 + (ob ^ (((ob >> 9) & 1) << 5)); }
__device__ __forceinline__ void stage_rc(int b, int& R, int& C) { const int st = b / 1024, sb = b % 1024, swz = sb ^ (((sb >> 9) & 1) << 5); R = (st >> 1) * 16 + swz / 64; C = (st & 1) * 32 + (swz % 64) / 2; }
__device__ __forceinline__ int perm32(int rho) { const int n = rho >> 4, i = rho & 15; return 8 * (i >> 2) + 4 * n + (i & 3); }

struct Unit { int pm, pn; };
struct StaticOrder {
    int nM, nN, nwg, G, c;
    __device__ __forceinline__ void init(int M, int N, int G_, int c_) { nM = M / BM; nN = N / BM; nwg = nM * nN; G = G_; c = c_; }
    __device__ __forceinline__ bool next(int i, Unit& u) const {
        const long L = (long)i * G + c; if (L >= nwg) return false;
        int wgid = (int)L; { const int q = nwg / NXCD, r = nwg % NXCD, xcd = wgid % NXCD, off = wgid / NXCD; wgid = (xcd < r ? xcd * (q + 1) : r * (q + 1) + (xcd - r) * q) + off; }
        const int nig = WGM * nN, gid = wgid / nig, fm = gid * WGM, gsz = (nM - fm) < WGM ? (nM - fm) : WGM;
        u.pm = fm + ((wgid % nig) % gsz); u.pn = (wgid % nig) / gsz; return true;
    }
};

enum { EPI_SWIGLU = 0, EPI_BF16 = 1, EPI_RES = 2, EPI_MEMKV = 3 };
struct Epi { int mode; bf16_t* ob; int ldo; float* xf; float scale; float* mk_out; float* mv_out; bf16_t* mkb; bf16_t* mvb; };

template <int MODE> __device__ __forceinline__ void gemm_epilogue(const f32x4 (&acc)[2][2][4][2], const Unit& u, int wr, int wc, int fr, int fq, const Epi& E) {
    const int row0 = u.pm * BM + wr * 64 + fr;
    if constexpr (MODE == EPI_SWIGLU) {
        const int col0 = u.pn * 128 + wc * 32 + 8 * fq;
#pragma unroll
        for (int ai = 0; ai < 2; ++ai)
#pragma unroll
            for (int m = 0; m < 4; ++m) {
                bf16_t* rowp = E.ob + (size_t)(row0 + ai * HALF + m * 16) * E.ldo + col0;
                float h[8];
#pragma unroll
                for (int n = 0; n < 2; ++n)
#pragma unroll
                    for (int j = 0; j < 4; ++j) { const float g = acc[ai][0][m][n][j], up = acc[ai][1][m][n][j]; h[n * 4 + j] = g * up * __builtin_amdgcn_rcpf(1.0f + __expf(-g)); }
                u32x4 w; w.x = pk2(h[0], h[1]); w.y = pk2(h[2], h[3]); w.z = pk2(h[4], h[5]); w.w = pk2(h[6], h[7]);
                *(u32x4*)rowp = w;
            }
    } else if constexpr (MODE == EPI_BF16) {
        const int col0 = u.pn * BM + wc * 32 + 8 * fq;
#pragma unroll
        for (int ai = 0; ai < 2; ++ai)
#pragma unroll
            for (int m = 0; m < 4; ++m) {
                bf16_t* rowp = E.ob + (size_t)(row0 + ai * HALF + m * 16) * E.ldo + col0;
#pragma unroll
                for (int bj = 0; bj < 2; ++bj) {
                    const f32x4 v0 = acc[ai][bj][m][0], v1 = acc[ai][bj][m][1];
                    u32x4 w; w.x = pk2(v0[0], v0[1]); w.y = pk2(v0[2], v0[3]); w.z = pk2(v1[0], v1[1]); w.w = pk2(v1[2], v1[3]);
                    *(u32x4*)(rowp + bj * HALF) = w;
                }
            }
    } else if constexpr (MODE == EPI_RES) {
        const int col0 = u.pn * BM + wc * 32 + 4 * fq;
#pragma unroll
        for (int ai = 0; ai < 2; ++ai)
#pragma unroll
            for (int m = 0; m < 4; ++m) {
                float* rowp = E.xf + (size_t)(row0 + ai * HALF + m * 16) * D + col0;
#pragma unroll
                for (int bj = 0; bj < 2; ++bj)
#pragma unroll
                    for (int n = 0; n < 2; ++n) { f32x4 x = *(const f32x4*)(rowp + bj * HALF + n * 16); x = x * ALPHA + acc[ai][bj][m][n] * E.scale; *(f32x4*)(rowp + bj * HALF + n * 16) = x; }
                asm volatile("" ::: "memory");
            }
    } else {
        const int colt = u.pn * BM; const int l = colt >> 10, kv = (colt >> 9) & 1, cc0 = (colt & 511) + wc * 32 + 4 * fq;
        float* of = (kv ? E.mv_out : E.mk_out) + (size_t)l * 2048 * 512;
        bf16_t* ob = (kv ? E.mvb : E.mkb) + (size_t)l * 2048 * 512;
#pragma unroll
        for (int ai = 0; ai < 2; ++ai)
#pragma unroll
            for (int m = 0; m < 4; ++m) {
                const size_t ro = (size_t)(row0 + ai * HALF + m * 16) * 512 + cc0;
#pragma unroll
                for (int bj = 0; bj < 2; ++bj)
#pragma unroll
                    for (int n = 0; n < 2; ++n) { const f32x4 v = acc[ai][bj][m][n]; *(f32x4*)(of + ro + bj * HALF + n * 16) = v; u32x2 w; w.x = pk2(v[0], v[1]); w.y = pk2(v[2], v[3]); *(u32x2*)(ob + ro + bj * HALF + n * 16) = w; }
            }
    }
}

template <int MODE> __device__ __forceinline__ void gemm_phase(LAS unsigned char* lds, const bf16_t* Ag, int lda, const bf16_t* Btg, int M, int N, int K, const Epi& E) {
    int tid_ = threadIdx.x; asm volatile("" : "+v"(tid_));
    const int tid = tid_, wid = __builtin_amdgcn_readfirstlane(tid >> 6), lane = tid & 63, wr = wid >> 2, wc = wid & 3, fr = lane & 15, fq = lane >> 4;
    const int nt = K / BK;
    constexpr bool PERM = (MODE == EPI_SWIGLU || MODE == EPI_BF16);
    StaticOrder S; S.init(M, N, (int)gridDim.x, (int)blockIdx.x);
    unsigned voffA[2], voffB[2];
#pragma unroll
    for (int i = 0; i < 2; ++i) { int R, C; stage_rc(tid * 16 + i * 8192, R, C); const int Rb = PERM ? ((R & ~31) + perm32(R & 31)) : R;
        voffA[i] = (unsigned)(R * lda + C) * 2u; voffB[i] = (unsigned)(Rb * K + C) * 2u; }
    const size_t kstep = (size_t)(BK * 2);
    const size_t hstepA = (size_t)HALF * lda * 2, hstepB = (size_t)HALF * K * 2;
    const size_t tstepA = 2 * hstepA, tstepB = 2 * hstepB;
    const unsigned ldsw = (unsigned)wid * 1024u;
    const int aoff = lds_byte(wr * 64 + fr, fq * 8), boff = lds_byte(wc * 32 + fr, fq * 8);
#define PG8_SA(b, h) (((b) * 2 + (h)) * HTB)
#define PG8_SB(b, h) ((4 + (b) * 2 + (h)) * HTB)
#define PG8_STAGE(bufoff, gbase, voff) do { _Pragma("unroll") for (int _i = 0; _i < 2; ++_i) \
        __builtin_amdgcn_global_load_lds((const unsigned*)((const char*)(gbase) + (voff)[_i]), (LAS unsigned*)(lds + (bufoff) + ldsw + _i * 8192), 16, 0, 0); } while (0)
#define PG8_LDA(dst, b, h) do { _Pragma("unroll") for (int m = 0; m < 4; ++m) _Pragma("unroll") for (int k = 0; k < 2; ++k) dst[m][k] = *(const LAS bf16x8*)(lds + PG8_SA(b, h) + aoff + m * 2048 + k * 1024); } while (0)
#define PG8_LDB(dst, b, h) do { _Pragma("unroll") for (int n = 0; n < 2; ++n) _Pragma("unroll") for (int k = 0; k < 2; ++k) dst[n][k] = *(const LAS bf16x8*)(lds + PG8_SB(b, h) + boff + n * 2048 + k * 1024); } while (0)
#define PG8_MMA(ai, bj, At, Bt) do { __builtin_amdgcn_s_setprio(1); _Pragma("unroll") for (int m = 0; m < 4; ++m) _Pragma("unroll") for (int n = 0; n < 2; ++n) _Pragma("unroll") for (int k = 0; k < 2; ++k) \
        acc[ai][bj][m][n] = __builtin_amdgcn_mfma_f32_16x16x32_bf16(Bt[n][k], At[m][k], acc[ai][bj][m][n], 0, 0, 0); __builtin_amdgcn_s_setprio(0); } while (0)
#define PG8_WAIT_V(n) asm volatile("s_waitcnt vmcnt(" #n ")" ::: "memory")
#define PG8_WAIT_L(n) asm volatile("s_waitcnt lgkmcnt(" #n ")" ::: "memory")
#define PG8_BAR __builtin_amdgcn_s_barrier()
#define PG8_SCHED __builtin_amdgcn_sched_barrier(0)
    Unit cur, nxt; int ui = 0;
    if (!S.next(0, cur)) return;
    f32x4 acc[2][2][4][2];
#pragma unroll
    for (int a = 0; a < 2; ++a)
#pragma unroll
        for (int b = 0; b < 2; ++b)
#pragma unroll
            for (int m = 0; m < 4; ++m)
#pragma unroll
                for (int n = 0; n < 2; ++n) acc[a][b][m][n] = (f32x4){0.f, 0.f, 0.f, 0.f};
    bf16x8 At[4][2], B0[2][2], B1[2][2];
    const char* cA = (const char*)Ag + (size_t)cur.pm * tstepA; const char* cB = (const char*)Btg + (size_t)cur.pn * tstepB;
    PG8_STAGE(PG8_SB(0, 0), cB, voffB); PG8_STAGE(PG8_SA(0, 0), cA, voffA); PG8_STAGE(PG8_SB(0, 1), cB + hstepB, voffB); PG8_STAGE(PG8_SA(0, 1), cA + hstepA, voffA);
    if (wr == 1) PG8_BAR;
    PG8_WAIT_V(4); PG8_BAR;
    PG8_STAGE(PG8_SB(1, 0), cB + kstep, voffB); PG8_STAGE(PG8_SA(1, 0), cA + kstep, voffA); PG8_STAGE(PG8_SB(1, 1), cB + hstepB + kstep, voffB);
    PG8_WAIT_V(6); PG8_BAR;
    for (;;) {
        const bool has_next = S.next(ui + 1, nxt);
        const char* nA = has_next ? (const char*)Ag + (size_t)nxt.pm * tstepA : cA; const char* nB = has_next ? (const char*)Btg + (size_t)nxt.pn * tstepB : cB;
        for (int t = 0; t < nt; t += 2) {
            const bool last = (t == nt - 2);
            const char* a1 = cA + (size_t)(t + 1) * kstep;
            const char* a2 = last ? nA : cA + (size_t)(t + 2) * kstep; const char* b2 = last ? nB : cB + (size_t)(t + 2) * kstep;
            const char* a3 = a2 + kstep; const char* b3 = b2 + kstep;
            PG8_LDB(B0, 0, 0); PG8_SCHED; PG8_LDA(At, 0, 0); PG8_STAGE(PG8_SA(1, 1), a1 + hstepA, voffA);
            PG8_WAIT_L(8); PG8_BAR; PG8_WAIT_L(0); PG8_MMA(0, 0, At, B0); PG8_BAR; PG8_SCHED;
            PG8_LDB(B1, 0, 1); PG8_STAGE(PG8_SB(0, 0), b2, voffB);
            PG8_BAR; PG8_WAIT_L(0); PG8_MMA(0, 1, At, B1); PG8_BAR;
            PG8_LDA(At, 0, 1); PG8_STAGE(PG8_SA(0, 0), a2, voffA);
            PG8_BAR; PG8_WAIT_L(0); PG8_MMA(1, 0, At, B0); PG8_BAR; PG8_SCHED;
            PG8_STAGE(PG8_SB(0, 1), b2 + hstepB, voffB);
            PG8_WAIT_V(6); PG8_BAR; PG8_MMA(1, 1, At, B1); PG8_BAR;
            PG8_LDB(B0, 1, 0); PG8_SCHED; PG8_LDA(At, 1, 0); PG8_STAGE(PG8_SA(0, 1), a2 + hstepA, voffA);
            PG8_WAIT_L(8); PG8_BAR; PG8_WAIT_L(0); PG8_MMA(0, 0, At, B0); PG8_BAR; PG8_SCHED;
            PG8_LDB(B1, 1, 1); PG8_STAGE(PG8_SB(1, 0), b3, voffB);
            PG8_BAR; PG8_WAIT_L(0); PG8_MMA(0, 1, At, B1); PG8_BAR;
            PG8_LDA(At, 1, 1); PG8_STAGE(PG8_SA(1, 0), a3, voffA);
            PG8_BAR; PG8_WAIT_L(0); PG8_MMA(1, 0, At, B0); PG8_BAR; PG8_SCHED;
            PG8_STAGE(PG8_SB(1, 1), b3 + hstepB, voffB);
            PG8_WAIT_V(6); PG8_BAR; PG8_MMA(1, 1, At, B1); PG8_BAR;
        }
        gemm_epilogue<MODE>(acc, cur, wr, wc, fr, fq, E);
        if (!has_next) break;
#pragma unroll
        for (int a = 0; a < 2; ++a)
#pragma unroll
            for (int b = 0; b < 2; ++b)
#pragma unroll
                for (int m = 0; m < 4; ++m)
#pragma unroll
                    for (int n = 0; n < 2; ++n) acc[a][b][m][n] = (f32x4){0.f, 0.f, 0.f, 0.f};
        cur = nxt; cA = nA; cB = nB; ++ui;
    }
    PG8_WAIT_V(0);
    if (wr == 0) PG8_BAR;
    PG8_BAR;
#undef PG8_SA
#undef PG8_SB
#undef PG8_STAGE
#undef PG8_LDA
#undef PG8_LDB
#undef PG8_MMA
#undef PG8_WAIT_V
#undef PG8_WAIT_L
#undef PG8_BAR
#undef PG8_SCHED
}

__device__ __forceinline__ void transpose_job(LAS unsigned char* lds, const float* src, int ld, int K, int c0, int ncols, bf16_t* dst, int rowmode, int drow0) {
    LAS float* tile = (LAS float*)lds;
    int tid_ = threadIdx.x; asm volatile("" : "+v"(tid_)); const int tid = tid_;
    const int nkt = K / 64, nct = ncols / 64, ntiles = nkt * nct;
    for (int t = blockIdx.x; t < ntiles; t += gridDim.x) {
        const int kt = t % nkt, ct = t / nkt;
        const int k0 = kt * 64, n0 = ct * 64;
        { const int kr = tid >> 4, c4 = (tid & 15) * 4;
#pragma unroll
          for (int rr = 0; rr < 64; rr += 32) { const f32x4 v = *(const f32x4*)(src + (size_t)(k0 + kr + rr) * ld + c0 + n0 + c4);
              tile[(kr + rr) * 65 + c4 + 0] = v[0]; tile[(kr + rr) * 65 + c4 + 1] = v[1]; tile[(kr + rr) * 65 + c4 + 2] = v[2]; tile[(kr + rr) * 65 + c4 + 3] = v[3]; } }
        __syncthreads();
        { const int n = tid >> 3, k8 = (tid & 7) * 8; float v[8];
#pragma unroll
          for (int i = 0; i < 8; ++i) v[i] = tile[(k8 + i) * 65 + n];
          const int c = c0 + n0 + n; int drow;
          if (rowmode == 0) drow = drow0 + c; else drow = 256 * (c >> 7) + (c & 127) + (rowmode == 2 ? 128 : 0);
          u32x4 w; w.x = pk2(v[0], v[1]); w.y = pk2(v[2], v[3]); w.z = pk2(v[4], v[5]); w.w = pk2(v[6], v[7]);
          *(u32x4*)(dst + (size_t)drow * K + k0 + k8) = w; }
        __syncthreads();
    }
}
__device__ __forceinline__ void convert_job(const float* src, bf16_t* dst, float* dstf, size_t n) {
    const size_t nv = n / 8;
    for (size_t i = (size_t)blockIdx.x * NTHR + threadIdx.x; i < nv; i += (size_t)gridDim.x * NTHR) {
        const f32x4 a = *(const f32x4*)(src + i * 8), b = *(const f32x4*)(src + i * 8 + 4);
        u32x4 w; w.x = pk2(a[0], a[1]); w.y = pk2(a[2], a[3]); w.z = pk2(b[0], b[1]); w.w = pk2(b[2], b[3]);
        *(u32x4*)(dst + i * 8) = w;
        if (dstf) { *(f32x4*)(dstf + i * 8) = a; *(f32x4*)(dstf + i * 8 + 4) = b; }
    }
}
__device__ __forceinline__ void prep_phase(LAS unsigned char* lds, const Params& p) {
    unsigned char* ws = p.ws;
    for (int jb = 0; jb < 52; ++jb) {
        const float* src; int ld, K, c0, ncols, rowmode, drow0; bf16_t* dst;
        if (jb < 24) { const int lf = jb / 3, t = jb % 3;
            if (t < 2) { src = p.in[7 + t] + (size_t)lf * 1024 * FF; ld = FF; K = 1024; c0 = 0; ncols = FF; dst = (bf16_t*)(ws + WS_WGU) + (size_t)lf * 5632 * 1024; rowmode = 1 + t; drow0 = 0; }
            else { src = p.in[9] + (size_t)lf * FF * 1024; ld = 1024; K = FF; c0 = 0; ncols = 1024; dst = (bf16_t*)(ws + WS_WD) + (size_t)lf * 1024 * FF; rowmode = 0; drow0 = 0; }
        } else if (jb < 44) { const int j = (jb - 24) / 10, t = (jb - 24) % 10; rowmode = 0; K = 1024;
            if (t < 4) {
                src = p.in[12] + (size_t)j * 1024 * 4608; ld = 4608; dst = (bf16_t*)(ws + WS_HWIN) + (size_t)j * 4608 * 1024;
                c0 = t == 0 ? 0 : (t == 1 ? 3072 : (t == 2 ? 2048 : 4096)); ncols = t == 0 ? 2048 : (t == 3 ? 512 : 1024); drow0 = (t == 0 ? 0 : (t == 1 ? 2048 : (t == 2 ? 3072 : 4096))) - c0;
            } else if (t < 8) {
                src = p.in[16] + (size_t)j * 1024 * 3600; ld = 3600; dst = (bf16_t*)(ws + WS_GWIN) + (size_t)j * 4096 * 1024; const int u = t - 4;
                c0 = u == 0 ? 0 : (u == 1 ? 2048 : (u == 2 ? 1024 : 3088)); ncols = u == 3 ? 512 : 1024; drow0 = (u == 0 ? 0 : (u == 1 ? 1536 : (u == 2 ? 2560 : 3584))) - c0;
            } else { src = p.in[t == 8 ? 15 : 20] + (size_t)j * 1536 * 1024; ld = 1024; K = 1536; c0 = 0; ncols = 1024; dst = (bf16_t*)(ws + WS_WOUT) + (size_t)(2 * j + (t - 8)) * 1024 * 1536; drow0 = 0; }
        } else { const int l = (jb - 44) >> 1, kv = (jb - 44) & 1; src = p.in[21 + kv] + (size_t)l * 1024 * 512; ld = 512; K = 1024; c0 = 0; ncols = 512; dst = (bf16_t*)(ws + WS_MEMW); rowmode = 0; drow0 = l * 1024 + kv * 512; }
        transpose_job(lds, src, ld, K, c0, ncols, dst, rowmode, drow0);
    }
    for (int j = 0; j < 2; ++j) {
        const float* gs = p.in[16] + (size_t)j * 1024 * 3600; bf16_t* gd = (bf16_t*)(ws + WS_GWIN) + (size_t)j * 4096 * 1024;
        const float* w2 = p.in[17] + (size_t)j * 16 * 512;
        for (int i = blockIdx.x * NTHR + threadIdx.x; i < 512 * 1024; i += gridDim.x * NTHR) {
            const int c = i >> 10, kk = i & 1023; float sacc = 0.f;
#pragma unroll
            for (int r = 0; r < 16; ++r) sacc += gs[(size_t)kk * 3600 + 3072 + r] * w2[r * 512 + c];
            gd[(size_t)(1024 + c) * 1024 + kk] = f2bf(sacc);
        }
    }
    for (int jb = 0; jb < 5; ++jb) {
        const float* src; bf16_t* dst; float* dstf = nullptr; size_t n;
        if (jb == 0) { src = p.in[0]; dst = (bf16_t*)(ws + WS_XN); dstf = p.out + O_Y; n = (size_t)MP * D; }
        else if (jb == 1) { src = p.in[1]; dst = (bf16_t*)(ws + WS_XN) + (size_t)MP * D; dstf = p.out + O_Y + (size_t)MP * D; n = (size_t)MS * D; }
        else if (jb == 2) { src = p.in[2]; dst = (bf16_t*)(ws + WS_MEMP); n = (size_t)2048 * 1024; }
        else if (jb == 3) { src = p.in[3]; dst = (bf16_t*)(ws + WS_CKB); n = (size_t)4 * 4096 * 512; }
        else { src = p.in[4]; dst = (bf16_t*)(ws + WS_CVB); n = (size_t)4 * 4096 * 512; }
        convert_job(src, dst, dstf, n);
    }
}

__device__ __forceinline__ void ln_phase(float* x, bf16_t* xn, const float* gain, const float* bias) {
    int tid_ = threadIdx.x; asm volatile("" : "+v"(tid_));
    const int lane = tid_ & 63, wv = tid_ >> 6;
    f32x4 g[4], b[4];
#pragma unroll
    for (int i = 0; i < 4; ++i) { g[i] = *(const f32x4*)(gain + 4 * lane + 256 * i); b[i] = *(const f32x4*)(bias + 4 * lane + 256 * i); }
    for (int row = blockIdx.x * 8 + wv; row < MROWS; row += gridDim.x * 8) {
        float* xr = x + (size_t)row * D; f32x4 v[4]; float s = 0.f;
#pragma unroll
        for (int i = 0; i < 4; ++i) { v[i] = *(const f32x4*)(xr + 4 * lane + 256 * i); s += (v[i][0] + v[i][1]) + (v[i][2] + v[i][3]); }
#pragma unroll
        for (int o = 32; o >= 1; o >>= 1) s += __shfl_xor(s, o);
        const float mu = s * (1.0f / 1024.0f); float q = 0.f;
#pragma unroll
        for (int i = 0; i < 4; ++i) { const f32x4 d = v[i] - mu; q += (d[0] * d[0] + d[1] * d[1]) + (d[2] * d[2] + d[3] * d[3]); }
#pragma unroll
        for (int o = 32; o >= 1; o >>= 1) q += __shfl_xor(q, o);
        const float rs = 1.0f / sqrtf(q * (1.0f / 1024.0f) + 1e-5f);
#pragma unroll
        for (int i = 0; i < 4; ++i) { const f32x4 o = (v[i] - mu) * rs * g[i] + b[i]; *(f32x4*)(xr + 4 * lane + 256 * i) = o;
            u32x2 w; w.x = pk2(o[0], o[1]); w.y = pk2(o[2], o[3]); *(u32x2*)(xn + (size_t)row * D + 4 * lane + 256 * i) = w; }
    }
}

__device__ __forceinline__ void headnorm_phase(bf16_t* proj, int ld, int ocol, int gcol, int lanes_per_head  , const float* gain) {
    int tid_ = threadIdx.x; asm volatile("" : "+v"(tid_));
    const int lane = tid_ & 63, wv = tid_ >> 6;
    float gn[2][8];
#pragma unroll
    for (int hh = 0; hh < 2; ++hh)
#pragma unroll
        for (int i = 0; i < 8; ++i) gn[hh][i] = gain[hh * 512 + 8 * lane + i];
    const float invn = lanes_per_head == 16 ? (1.0f / 128.0f) : (1.0f / 256.0f);
    for (int row = blockIdx.x * 8 + wv; row < MROWS; row += gridDim.x * 8) {
        bf16_t* pr = proj + (size_t)row * ld;
#pragma unroll
        for (int hh = 0; hh < 2; ++hh) {
            const u32x4 ov = *(const u32x4*)(pr + ocol + hh * 512 + 8 * lane), gv = *(const u32x4*)(pr + gcol + hh * 512 + 8 * lane);
            float o[8], g[8];
#pragma unroll
            for (int i = 0; i < 4; ++i) { o[2 * i] = bflo(ov[i]); o[2 * i + 1] = bfhi(ov[i]); g[2 * i] = bflo(gv[i]); g[2 * i + 1] = bfhi(gv[i]); }
            float s = 0.f;
#pragma unroll
            for (int i = 0; i < 8; ++i) s += o[i] * o[i];
            s += __shfl_xor(s, 1); s += __shfl_xor(s, 2); s += __shfl_xor(s, 4); s += __shfl_xor(s, 8);
            if (lanes_per_head == 32) s += __shfl_xor(s, 16);
            const float rs = 1.0f / sqrtf(s * invn + 1e-6f);
            float r[8];
#pragma unroll
            for (int i = 0; i < 8; ++i) r[i] = o[i] * rs * gn[hh][i] * g[i] * sigmoidf_(g[i]);
            u32x4 w; w.x = pk2(r[0], r[1]); w.y = pk2(r[2], r[3]); w.z = pk2(r[4], r[5]); w.w = pk2(r[6], r[7]);
            *(u32x4*)(pr + ocol + hh * 512 + 8 * lane) = w;
        }
    }
}

constexpr int MX_G = 0, MX_T = 32768, MX_BL = 34816, MX_QT = 35328, MX_KT = MX_QT + 17408, MX_QH = MX_KT + 17408, MX_KHT = MX_QH + 17408,
              MX_VT = MX_KHT + 18432, MX_PP = MX_VT + 4608, MX_ST = MX_PP + 9216, MX_END = MX_ST + 8704;
static_assert(MX_END <= LDS_BYTES, "mixer LDS");

struct ChainArgs {
    bf16_t* proj; int ld; size_t row0; int nchunks;
    int qcol, kcol, gcol, vcol;
    int gla;
    const float* lb0; const float* lb1; int lbj;
    const float* bgate;
    const float* s0; float* sout; int sstride;
};

__device__ __forceinline__ void mixer_chain(LAS unsigned char* lds, const ChainArgs& a) {
    int tid_ = threadIdx.x; asm volatile("" : "+v"(tid_));
    const int tid = tid_, wid = __builtin_amdgcn_readfirstlane(tid >> 6), lane = tid & 63, fr = lane & 15, fq = lane >> 4;
    LAS float* G = (LAS float*)(lds + MX_G); LAS float* T = (LAS float*)(lds + MX_T); LAS float* BL = (LAS float*)(lds + MX_BL);
    LAS bf16_t* QT = (LAS bf16_t*)(lds + MX_QT); LAS bf16_t* KT = (LAS bf16_t*)(lds + MX_KT); LAS bf16_t* QH = (LAS bf16_t*)(lds + MX_QH);
    LAS bf16_t* KHT = (LAS bf16_t*)(lds + MX_KHT); LAS bf16_t* VT = (LAS bf16_t*)(lds + MX_VT); LAS bf16_t* PP = (LAS bf16_t*)(lds + MX_PP); LAS bf16_t* ST = (LAS bf16_t*)(lds + MX_ST);
    const int t0 = tid >> 4, cv = tid & 15, c8 = cv * 8;
    float cA[8], cB[8];
#pragma unroll
    for (int i = 0; i < 8; ++i) {
        if (a.gla) { cA[i] = a.bgate[c8 + i]; cB[i] = 0.f; }
        else { float lb = 0.f; if (a.lbj == 1) lb = sigmoidf_(a.lb1[c8 + i] - a.lb0[c8 + i]); cA[i] = lb; cB[i] = 1.0f - lb; }
    }
    f32x4 Sacc[2];
#pragma unroll
    for (int vi = 0; vi < 2; ++vi)
#pragma unroll
        for (int j = 0; j < 4; ++j) Sacc[vi][j] = a.s0 ? a.s0[(size_t)(16 * wid + 4 * fq + j) * a.sstride + 16 * vi + fr] : 0.f;
#pragma unroll
    for (int vi = 0; vi < 2; ++vi) { u32x2 w; w.x = pk2(Sacc[vi][0], Sacc[vi][1]); w.y = pk2(Sacc[vi][2], Sacc[vi][3]); *(LAS u32x2*)(ST + (16 * vi + fr) * 136 + 16 * wid + 4 * fq) = w; }

    u32x4 rq[2], rk[2], rg[2], rv;
    rg[0] = rg[1] = (u32x4){0u, 0u, 0u, 0u}; rv = (u32x4){0u, 0u, 0u, 0u};
    auto issue_loads = [&](int c) {
        const bf16_t* base = a.proj + (a.row0 + (size_t)c * 64) * a.ld;
#pragma unroll
        for (int rr = 0; rr < 2; ++rr) { const bf16_t* rp = base + (size_t)(t0 + 32 * rr) * a.ld + c8;
            rq[rr] = *(const u32x4*)(rp + a.qcol); rk[rr] = *(const u32x4*)(rp + a.kcol); if (a.gla) rg[rr] = *(const u32x4*)(rp + a.gcol); }
        if (tid < 256) rv = *(const u32x4*)(base + (size_t)(tid >> 2) * a.ld + a.vcol + 8 * (tid & 3));
    };
    issue_loads(0);
    const float qscale = 0.08838834764831845f;
    for (int c = 0; c < a.nchunks; ++c) {
        float qv[2][8], kv[2][8];
#pragma unroll
        for (int rr = 0; rr < 2; ++rr) {
            float gvv[8];
#pragma unroll
            for (int i = 0; i < 8; ++i) {
                const unsigned uq = rq[rr][i >> 1], uk = rk[rr][i >> 1], ug = rg[rr][i >> 1];
                const float q = (i & 1) ? bfhi(uq) : bflo(uq), k = (i & 1) ? bfhi(uk) : bflo(uk);
                if (a.gla) {
                    const float g = ((i & 1) ? bfhi(ug) : bflo(ug)) + cA[i];
                    qv[rr][i] = q * qscale; kv[rr][i] = k;
                    gvv[i] = (fminf(g, 0.f) - __logf(1.0f + __expf(-fabsf(g)))) * (1.0f / 16.0f);
                } else {
                    qv[rr][i] = q * sigmoidf_(q) * qscale;
                    const float e = __expf(-k), r = 1.0f / (1.0f + e);
                    kv[rr][i] = cB[i] * e * r;
                    gvv[i] = __logf(fmaxf(cA[i] + cB[i] * r, 1e-6f));
                }
            }
            LAS float* gp = G + (t0 + 32 * rr) * 128 + c8;
            *(LAS f32x4*)gp = (f32x4){gvv[0], gvv[1], gvv[2], gvv[3]}; *(LAS f32x4*)(gp + 4) = (f32x4){gvv[4], gvv[5], gvv[6], gvv[7]};
        }
        if (tid < 256) { const int tv = tid >> 2, v8 = (tid & 3) * 8;
#pragma unroll
            for (int i = 0; i < 8; ++i) VT[(v8 + i) * 72 + tv] = (bf16_t)((i & 1) ? (rv[i >> 1] >> 16) : (rv[i >> 1] & 0xffffu)); }
        if (c + 1 < a.nchunks) issue_loads(c + 1);
        __syncthreads();
        { const int k = tid & 127, sg = tid >> 7; float run = 0.f;
#pragma unroll
          for (int i = 0; i < 16; ++i) { run += G[(16 * sg + i) * 128 + k]; G[(16 * sg + i) * 128 + k] = run; }
          T[sg * 128 + k] = run; }
        __syncthreads();
        {
            float tA[8], tB[8], tC[8], bmid[8], blast[8];
            { const f32x4 x0 = *(const LAS f32x4*)(T + c8), x1 = *(const LAS f32x4*)(T + c8 + 4), y0 = *(const LAS f32x4*)(T + 128 + c8), y1 = *(const LAS f32x4*)(T + 128 + c8 + 4),
                  z0 = *(const LAS f32x4*)(T + 256 + c8), z1 = *(const LAS f32x4*)(T + 256 + c8 + 4);
              const f32x4 m0 = *(const LAS f32x4*)(G + 31 * 128 + c8), m1 = *(const LAS f32x4*)(G + 31 * 128 + c8 + 4), l0 = *(const LAS f32x4*)(G + 63 * 128 + c8), l1 = *(const LAS f32x4*)(G + 63 * 128 + c8 + 4);
#pragma unroll
              for (int i = 0; i < 4; ++i) { tA[i] = x0[i]; tA[4 + i] = x1[i]; tB[i] = x0[i] + y0[i]; tB[4 + i] = x1[i] + y1[i]; tC[i] = tB[i] + z0[i]; tC[4 + i] = tB[4 + i] + z1[i];
                  bmid[i] = m0[i] + tA[i]; bmid[4 + i] = m1[i] + tA[4 + i]; blast[i] = l0[i] + tC[i]; blast[4 + i] = l1[i] + tC[4 + i]; } }
#pragma unroll
            for (int rr = 0; rr < 2; ++rr) {
                const int t = t0 + 32 * rr, sg = t >> 4;
                const f32x4 g0 = *(const LAS f32x4*)(G + t * 128 + c8), g1 = *(const LAS f32x4*)(G + t * 128 + c8 + 4);
                float qh[8], qt[8], kt[8], kh[8];
#pragma unroll
                for (int i = 0; i < 8; ++i) {
                    const float off = sg == 0 ? 0.f : (sg == 1 ? tA[i] : (sg == 2 ? tB[i] : tC[i]));
                    const float b = (i < 4 ? g0[i & 3] : g1[i & 3]) + off;
                    qh[i] = qv[rr][i] * __expf(b);
                    qt[i] = qv[rr][i] * __expf(fminf(b - bmid[i], 80.f));
                    kt[i] = kv[rr][i] * __expf(fminf(bmid[i] - b, 80.f));
                    kh[i] = kv[rr][i] * __expf(blast[i] - b);
                }
                u32x4 w;
                w.x = pk2(qt[0], qt[1]); w.y = pk2(qt[2], qt[3]); w.z = pk2(qt[4], qt[5]); w.w = pk2(qt[6], qt[7]); *(LAS u32x4*)(QT + t * 136 + c8) = w;
                w.x = pk2(kt[0], kt[1]); w.y = pk2(kt[2], kt[3]); w.z = pk2(kt[4], kt[5]); w.w = pk2(kt[6], kt[7]); *(LAS u32x4*)(KT + t * 136 + c8) = w;
                w.x = pk2(qh[0], qh[1]); w.y = pk2(qh[2], qh[3]); w.z = pk2(qh[4], qh[5]); w.w = pk2(qh[6], qh[7]); *(LAS u32x4*)(QH + t * 136 + c8) = w;
#pragma unroll
                for (int i = 0; i < 8; ++i) KHT[(c8 + i) * 72 + t] = f2bf(kh[i]);
            }
            if (t0 == 0) {
#pragma unroll
                for (int i = 0; i < 8; ++i) BL[c8 + i] = blast[i]; }
        }
        __syncthreads();
        { const int ti = wid >> 1;
#pragma unroll
          for (int sh = 0; sh < 2; ++sh) { const int si = 2 * (wid & 1) + sh; f32x4 pa = {0.f, 0.f, 0.f, 0.f};
              if (si <= ti) {
#pragma unroll
                  for (int kk = 0; kk < 4; ++kk) { const bf16x8 A = *(const LAS bf16x8*)(KT + (16 * si + fr) * 136 + 32 * kk + 8 * fq), B = *(const LAS bf16x8*)(QT + (16 * ti + fr) * 136 + 32 * kk + 8 * fq); pa = MFMA16(A, B, pa); }
                  if (si == ti) {
#pragma unroll
                      for (int j = 0; j < 4; ++j) if (4 * fq + j > fr) pa[j] = 0.f; }
              }
              u32x2 w; w.x = pk2(pa[0], pa[1]); w.y = pk2(pa[2], pa[3]); *(LAS u32x2*)(PP + (16 * ti + fr) * 72 + 16 * si + 4 * fq) = w; } }
        __syncthreads();
        { const int ti = wid >> 1, vi = wid & 1; f32x4 o = {0.f, 0.f, 0.f, 0.f};
#pragma unroll
          for (int kk = 0; kk < 2; ++kk) { const bf16x8 A = *(const LAS bf16x8*)(VT + (16 * vi + fr) * 72 + 32 * kk + 8 * fq), B = *(const LAS bf16x8*)(PP + (16 * ti + fr) * 72 + 32 * kk + 8 * fq); o = MFMA16(A, B, o); }
#pragma unroll
          for (int kk = 0; kk < 4; ++kk) { const bf16x8 A = *(const LAS bf16x8*)(ST + (16 * vi + fr) * 136 + 32 * kk + 8 * fq), B = *(const LAS bf16x8*)(QH + (16 * ti + fr) * 136 + 32 * kk + 8 * fq); o = MFMA16(A, B, o); }
          u32x2 w; w.x = pk2(o[0], o[1]); w.y = pk2(o[2], o[3]);
          *(u32x2*)(a.proj + (a.row0 + (size_t)c * 64 + 16 * ti + fr) * a.ld + a.vcol + 16 * vi + 4 * fq) = w; }
        { float dj[4];
#pragma unroll
          for (int j = 0; j < 4; ++j) dj[j] = __expf(BL[16 * wid + 4 * fq + j]);
#pragma unroll
          for (int vi = 0; vi < 2; ++vi) {
#pragma unroll
              for (int j = 0; j < 4; ++j) Sacc[vi][j] *= dj[j];
#pragma unroll
              for (int kk = 0; kk < 2; ++kk) { const bf16x8 A = *(const LAS bf16x8*)(KHT + (16 * wid + fr) * 72 + 32 * kk + 8 * fq), B = *(const LAS bf16x8*)(VT + (16 * vi + fr) * 72 + 32 * kk + 8 * fq); Sacc[vi] = MFMA16(A, B, Sacc[vi]); } } }
        __syncthreads();
#pragma unroll
        for (int vi = 0; vi < 2; ++vi) { u32x2 w; w.x = pk2(Sacc[vi][0], Sacc[vi][1]); w.y = pk2(Sacc[vi][2], Sacc[vi][3]); *(LAS u32x2*)(ST + (16 * vi + fr) * 136 + 16 * wid + 4 * fq) = w; }
    }
#pragma unroll
    for (int vi = 0; vi < 2; ++vi)
#pragma unroll
        for (int j = 0; j < 4; ++j) a.sout[(size_t)(16 * wid + 4 * fq + j) * a.sstride + 16 * vi + fr] = Sacc[vi][j];
    __syncthreads();
}

constexpr int AT_PITCH = 264;
__device__ __forceinline__ void mem_attn(LAS unsigned char* lds, const bf16_t* Kb, const bf16_t* Vb, bf16_t* Q, int ld, int nrows) {
    int tid_ = threadIdx.x; asm volatile("" : "+v"(tid_));
    const int tid = tid_, wid = __builtin_amdgcn_readfirstlane(tid >> 6), lane = tid & 63, fr = lane & 15, fq = lane >> 4;
    LAS bf16_t* VT = (LAS bf16_t*)lds;
#pragma unroll
    for (int it = 0; it < 8; ++it) { const int idx = tid + NTHR * it, key = idx >> 4, v8 = (idx & 15) * 8; const u32x4 v = *(const u32x4*)(Vb + (size_t)key * 512 + v8);
#pragma unroll
        for (int i = 0; i < 8; ++i) VT[(v8 + i) * AT_PITCH + key] = (bf16_t)((i & 1) ? (v[i >> 1] >> 16) : (v[i >> 1] & 0xffffu)); }
    __syncthreads();
    const float sc = 0.08838834764831845f;
    for (int q0 = wid * 16; q0 < nrows; q0 += 128) {
        bf16x8 Qf0, Qf1, Qf2, Qf3;
        { const bf16_t* qp = Q + (size_t)(q0 + fr) * ld + 8 * fq; Qf0 = *(const bf16x8*)(qp); Qf1 = *(const bf16x8*)(qp + 32); Qf2 = *(const bf16x8*)(qp + 64); Qf3 = *(const bf16x8*)(qp + 96); }
        f32x4 s[16];
#pragma unroll
        for (int a = 0; a < 16; ++a) {
            const bf16_t* kp = Kb + (size_t)(16 * a + fr) * 512 + 8 * fq;
            f32x4 t = {0.f, 0.f, 0.f, 0.f};
            t = MFMA16(*(const bf16x8*)(kp), Qf0, t); t = MFMA16(*(const bf16x8*)(kp + 32), Qf1, t); t = MFMA16(*(const bf16x8*)(kp + 64), Qf2, t); t = MFMA16(*(const bf16x8*)(kp + 96), Qf3, t);
            s[a] = t;
            if ((a & 1) == 1) asm volatile("" ::: "memory");
        }
        float mx = -3.0e38f;
#pragma unroll
        for (int a = 0; a < 16; ++a) mx = fmaxf(fmaxf(mx, fmaxf(s[a][0], s[a][1])), fmaxf(s[a][2], s[a][3]));
        mx = fmaxf(mx, __shfl_xor(mx, 16)); mx = fmaxf(mx, __shfl_xor(mx, 32));
        float sum = 0.f; u32x2 pk[16];
#pragma unroll
        for (int a = 0; a < 16; ++a) { const float e0 = __expf((s[a][0] - mx) * sc), e1 = __expf((s[a][1] - mx) * sc), e2 = __expf((s[a][2] - mx) * sc), e3 = __expf((s[a][3] - mx) * sc);
            sum += (e0 + e1) + (e2 + e3); pk[a].x = pk2(e0, e1); pk[a].y = pk2(e2, e3); }
        sum += __shfl_xor(sum, 16); sum += __shfl_xor(sum, 32);
        const float inv = 1.0f / sum;
        f32x4 o[8];
#pragma unroll
        for (int dt = 0; dt < 8; ++dt) o[dt] = (f32x4){0.f, 0.f, 0.f, 0.f};
#pragma unroll
        for (int ap = 0; ap < 8; ++ap) {
            const u32x4 bv = {pk[2 * ap].x, pk[2 * ap].y, pk[2 * ap + 1].x, pk[2 * ap + 1].y};
            const bf16x8 B = __builtin_bit_cast(bf16x8, bv);
#pragma unroll
            for (int dt = 0; dt < 8; ++dt) {
                const u32x2 lo = *(const LAS u32x2*)(VT + (16 * dt + fr) * AT_PITCH + 32 * ap + 4 * fq), hi = *(const LAS u32x2*)(VT + (16 * dt + fr) * AT_PITCH + 32 * ap + 16 + 4 * fq);
                const u32x4 av = {lo.x, lo.y, hi.x, hi.y};
                o[dt] = MFMA16(__builtin_bit_cast(bf16x8, av), B, o[dt]);
            }
        }
#pragma unroll
        for (int dt = 0; dt < 8; ++dt) { u32x2 w; w.x = pk2(o[dt][0] * inv, o[dt][1] * inv); w.y = pk2(o[dt][2] * inv, o[dt][3] * inv);
            *(u32x2*)(Q + (size_t)(q0 + fr) * ld + 16 * dt + 4 * fq) = w; }
    }
    __syncthreads();
}

__device__ __forceinline__ void mixer_phase(LAS unsigned char* lds, const Params& p, int layer) {
    const int j = layer >> 1, gla = layer & 1, w = blockIdx.x, G = gridDim.x;
    bf16_t* proj = (bf16_t*)(p.ws + WS_PROJ);
    const int ld = gla ? GL_LD : HG_LD;
    const int nvs = gla ? 8 : 4, nh = gla ? 4 : 8, vdim = gla ? 256 : 128;
    const int n_prompt = 8 * nh * nvs  , n_sample = 16 * nh * nvs  ;
    for (int it = w; it < n_prompt + n_sample; it += G) {
        const bool smp = it >= n_prompt; const int id = smp ? it - n_prompt : it;
        const int lo = id & 7, rest = id >> 3, vs = rest % nvs, hi = rest / nvs, bh = lo + 8 * hi, b = bh / nh, h = bh % nh;
        ChainArgs a;
        a.proj = proj; a.ld = ld; a.gla = gla; a.lbj = j;
        a.row0 = smp ? (size_t)MP + (size_t)b * 64 : (size_t)b * 8192; a.nchunks = smp ? 1 : 128;
        if (gla) { a.qcol = h * 128; a.kcol = 512 + h * 128; a.gcol = 1024 + h * 128; a.vcol = 2560 + h * 256 + 32 * vs; a.bgate = p.in[18] + j * 512 + h * 128; a.lb0 = a.lb1 = nullptr; }
        else { a.qcol = h * 128; a.kcol = 1024 + h * 128; a.gcol = 0; a.vcol = 3072 + h * 128 + 32 * vs; a.bgate = nullptr; a.lb0 = p.in[13] + h * 128; a.lb1 = p.in[13] + 1024 + h * 128; }
        const size_t per_b = (size_t)nh * 128 * vdim, so = ((size_t)b * nh + h) * 128 * vdim + 32 * vs;
        if (smp) { a.s0 = (gla ? p.in[6] : p.in[5]) + (size_t)j * 16 * per_b + so; a.sout = p.out + (gla ? O_SGS : O_SHS) + (size_t)j * 16 * per_b + so; }
        else { a.s0 = nullptr; a.sout = p.out + (gla ? O_SGP : O_SHP) + (size_t)j * 8 * per_b + so; }
        a.sstride = vdim;
        mixer_chain(lds, a);
    }
    const int xq = gla ? 3584 : 4096;
    for (int it = w; it < 256 + 64; it += G) {
        const bf16_t* Kb; const bf16_t* Vb; bf16_t* Qp; int nrows;
        if (it < 256) { const int bh = it >> 3, grp = it & 7, b = bh >> 2, h = bh & 3;
            Kb = (const bf16_t*)(p.ws + WS_MKB) + ((size_t)layer * 2048 + b * 256) * 512 + h * 128;
            Vb = (const bf16_t*)(p.ws + WS_MVB) + ((size_t)layer * 2048 + b * 256) * 512 + h * 128;
            Qp = proj + ((size_t)b * 8192 + grp * 1024) * ld + xq + h * 128; nrows = 1024;
        } else { const int bh = it - 256, b = bh >> 2, h = bh & 3;
            Kb = (const bf16_t*)(p.ws + WS_CKB) + ((size_t)layer * 4096 + b * 256) * 512 + h * 128;
            Vb = (const bf16_t*)(p.ws + WS_CVB) + ((size_t)layer * 4096 + b * 256) * 512 + h * 128;
            Qp = proj + ((size_t)MP + b * 64) * ld + xq + h * 128; nrows = 64;
        }
        mem_attn(lds, Kb, Vb, Qp, ld, nrows);
    }
}

constexpr int NPHASE = 2 + 4 * 11;
__global__ void __launch_bounds__(NTHR, 2) trunk_fwd(Params p) {
    extern __shared__ __attribute__((aligned(16))) unsigned char lds_raw[];
    LAS unsigned char* lds = (LAS unsigned char*)lds_raw;
    unsigned char* ws = p.ws;
    float* xf = p.out + O_Y;
    bf16_t* xn = (bf16_t*)(ws + WS_XN);
    bf16_t* proj = (bf16_t*)(ws + WS_PROJ);
    for (int ph = p.ph_lo; ph < p.ph_hi; ++ph) {
        if (ph == 0) prep_phase(lds, p);
        else if (ph == 1) { Epi E{EPI_MEMKV, nullptr, 0, nullptr, 0.f, p.out + O_MK, p.out + O_MV, (bf16_t*)(ws + WS_MKB), (bf16_t*)(ws + WS_MVB)};
            gemm_phase<EPI_MEMKV>(lds, (const bf16_t*)(ws + WS_MEMP), 1024, (const bf16_t*)(ws + WS_MEMW), 2048, 4096, 1024, E); }
        else {
            const int layer = (ph - 2) / 11, s = (ph - 2) % 11, gla = layer & 1, j = layer >> 1;
            if (s == 0 || s == 8) { const int lf = layer * 2 + (s == 8);
                Epi E{EPI_SWIGLU, proj, FF, nullptr, 0.f, nullptr, nullptr, nullptr, nullptr};
                gemm_phase<EPI_SWIGLU>(lds, xn, 1024, (const bf16_t*)(ws + WS_WGU) + (size_t)lf * 5632 * 1024, MROWS, 5632, 1024, E); }
            else if (s == 1 || s == 9) { const int lf = layer * 2 + (s == 9);
                Epi E{EPI_RES, nullptr, 0, xf, 0.5f, nullptr, nullptr, nullptr, nullptr};
                gemm_phase<EPI_RES>(lds, proj, FF, (const bf16_t*)(ws + WS_WD) + (size_t)lf * 1024 * FF, MROWS, 1024, FF, E); }
            else if (s == 2 || s == 7 || s == 10) { const int li = layer * 3 + (s == 2 ? 0 : (s == 7 ? 1 : 2));
                ln_phase(xf, xn, p.in[10] + li * 1024, p.in[11] + li * 1024); }
            else if (s == 3) {
                Epi E{EPI_BF16, proj, gla ? GL_LD : HG_LD, nullptr, 0.f, nullptr, nullptr, nullptr, nullptr};
                if (gla) gemm_phase<EPI_BF16>(lds, xn, 1024, (const bf16_t*)(ws + WS_GWIN) + (size_t)j * 4096 * 1024, MROWS, 4096, 1024, E);
                else gemm_phase<EPI_BF16>(lds, xn, 1024, (const bf16_t*)(ws + WS_HWIN) + (size_t)j * 4608 * 1024, MROWS, 4608, 1024, E); }
            else if (s == 4) mixer_phase(lds, p, layer);
            else if (s == 5) { if (gla) headnorm_phase(proj, GL_LD, 2560, 1536, 32, p.in[19] + j * 1024); else headnorm_phase(proj, HG_LD, 3072, 2048, 16, p.in[14] + j * 1024); }
            else if (s == 6) {
                Epi E{EPI_RES, nullptr, 0, xf, 1.0f, nullptr, nullptr, nullptr, nullptr};
                gemm_phase<EPI_RES>(lds, proj + (gla ? 2560 : 3072), gla ? GL_LD : HG_LD, (const bf16_t*)(ws + WS_WOUT) + (size_t)layer * 1024 * 1536, MROWS, 1024, 1536, E); }
        }
        if (ph + 1 < p.ph_hi) { __threadfence(); cg::this_grid().sync(); }
    }
}

extern "C" void kernel_launch(void* const* d_in, const int* in_sizes, int n_in, void* d_out, int out_size, void* d_ws, size_t ws_size, hipStream_t stream) {
    static int grid = 0;
    if (grid == 0) {
        if (n_in != 23 || ws_size < WS_END) { fprintf(stderr, "kernel_launch: need 23 inputs and %zu bytes of workspace; got %d, %zu\n", (size_t)WS_END, n_in, ws_size); grid = -1; return; }
        if (hipFuncSetAttribute((const void*)trunk_fwd, hipFuncAttributeMaxDynamicSharedMemorySize, LDS_BYTES) != hipSuccess) { fprintf(stderr, "kernel_launch: hipFuncSetAttribute failed\n"); grid = -1; return; }
        int dev = 0, cus = 0, per_cu = 0;
        (void)hipGetDevice(&dev); (void)hipDeviceGetAttribute(&cus, hipDeviceAttributeMultiprocessorCount, dev);
        (void)hipOccupancyMaxActiveBlocksPerMultiprocessor(&per_cu, (const void*)trunk_fwd, NTHR, LDS_BYTES);
        if (per_cu < 1) { fprintf(stderr, "kernel_launch: occupancy query says %d blocks per CU\n", per_cu); per_cu = 1; }
        (void)hipGetLastError();
        grid = cus;
    }
    if (grid < 0) return;
    Params p{};
    for (int i = 0; i < 23; ++i) p.in[i] = (const float*)d_in[i];
    p.out = (float*)d_out; p.ws = (unsigned char*)d_ws;
#if ONE_LAUNCH
    p.ph_lo = 0; p.ph_hi = NPHASE;
    void* args[] = {&p};
    hipError_t e = hipLaunchCooperativeKernel((const void*)trunk_fwd, dim3(grid), dim3(NTHR), args, LDS_BYTES, stream);
    if (e != hipSuccess) fprintf(stderr, "cooperative launch failed: %s (grid %d)\n", hipGetErrorString(e), grid);
#else
    for (int ph = 0; ph < NPHASE; ++ph) {
        p.ph_lo = ph; p.ph_hi = ph + 1;
        hipLaunchKernelGGL(trunk_fwd, dim3(grid), dim3(NTHR), LDS_BYTES, stream, p);
    }
#endif
}
```

```cpp
#include <hip/hip_runtime.h>
#include <hip/hip_cooperative_groups.h>
#include <cstdio>
namespace cg = cooperative_groups;

#ifndef ONE_LAUNCH
#define ONE_LAUNCH 1
#endif

#define LAS __attribute__((address_space(3)))
typedef unsigned short bf16_t;
typedef short bf16x8 __attribute__((ext_vector_type(8)));
typedef float f32x4 __attribute__((ext_vector_type(4)));
typedef float f32x2 __attribute__((ext_vector_type(2)));
typedef unsigned u32x4 __attribute__((ext_vector_type(4)));
typedef unsigned u32x2 __attribute__((ext_vector_type(2)));
typedef __bf16 nbf2 __attribute__((ext_vector_type(2)));

constexpr int D = 1024, MP = 65536, MS = 1024, MROWS = MP + MS, FF = 2816;
constexpr int HG_LD = 4608, GL_LD = 4096;
constexpr float ALPHA = 1.6817928305074292f;
constexpr int NTHR = 512;
constexpr int LDS_BYTES = 132 * 1024;

constexpr size_t O_Y = 0;
constexpr size_t O_SHP = (size_t)MROWS * D;
constexpr size_t O_SGP = O_SHP + 2u * 8 * 8 * 128 * 128;
constexpr size_t O_MK = O_SGP + 2u * 8 * 4 * 128 * 256;
constexpr size_t O_MV = O_MK + 4u * 2048 * 512;
constexpr size_t O_SHS = O_MV + 4u * 2048 * 512;
constexpr size_t O_SGS = O_SHS + 2u * 16 * 8 * 128 * 128;

constexpr size_t WS_WGU = 0;
constexpr size_t WS_WD = WS_WGU + 8ull * 5632 * 1024 * 2;
constexpr size_t WS_HWIN = WS_WD + 8ull * 1024 * 2816 * 2;
constexpr size_t WS_GWIN = WS_HWIN + 2ull * 4608 * 1024 * 2;
constexpr size_t WS_WOUT = WS_GWIN + 2ull * 4096 * 1024 * 2;
constexpr size_t WS_MEMW = WS_WOUT + 4ull * 1024 * 1536 * 2;
constexpr size_t WS_MEMP = WS_MEMW + 4096ull * 1024 * 2;
constexpr size_t WS_MKB = WS_MEMP + 2048ull * 1024 * 2;
constexpr size_t WS_MVB = WS_MKB + 4ull * 2048 * 512 * 2;
constexpr size_t WS_CKB = WS_MVB + 4ull * 2048 * 512 * 2;
constexpr size_t WS_CVB = WS_CKB + 4ull * 4096 * 512 * 2;
constexpr size_t WS_XN = WS_CVB + 4ull * 4096 * 512 * 2;
constexpr size_t WS_PROJ = WS_XN + (size_t)MROWS * 1024 * 2;
constexpr size_t WS_END = WS_PROJ + (size_t)MROWS * 4608 * 2;

struct Params {
    const float* in[23];
    float* out;
    unsigned char* ws;
    int ph_lo, ph_hi;
};

__device__ __forceinline__ unsigned pk2(float lo, float hi) { f32x2 v = {lo, hi}; nbf2 b = __builtin_convertvector(v, nbf2); return __builtin_bit_cast(unsigned, b); }
__device__ __forceinline__ float bflo(unsigned u) { return __uint_as_float(u << 16); }
__device__ __forceinline__ float bfhi(unsigned u) { return __uint_as_float(u & 0xffff0000u); }
__device__ __forceinline__ bf16_t f2bf(float f) { unsigned u = pk2(f, 0.f); return (bf16_t)(u & 0xffffu); }
__device__ __forceinline__ float sigmoidf_(float x) { return 1.0f / (1.0f + __expf(-x)); }
#define MFMA16(a, b, c) __builtin_amdgcn_mfma_f32_16x16x32_bf16((a), (b), (c), 0, 0, 0)

constexpr int BM = 256, BK = 64, HALF = 128, HTB = HALF * BK * 2, NXCD = 8, WGM = 8;
__device__ __forceinline__ int lds_byte(int r, int c) { const int st = (r >> 4) * 2 + (c >> 5), rr = r & 15, cc = c & 31, ob = rr * 64 + cc * 2; return st * 1024 + (ob ^ (((ob >> 9) & 1) << 5)); }
__device__ __forceinline__ void stage_rc(int b, int& R, int& C) { const int st = b / 1024, sb = b % 1024, swz = sb ^ (((sb >> 9) & 1) << 5); R = (st >> 1) * 16 + swz / 64; C = (st & 1) * 32 + (swz % 64) / 2; }
__device__ __forceinline__ int perm32(int rho) { const int n = rho >> 4, i = rho & 15; return 8 * (i >> 2) + 4 * n + (i & 3); }

struct Unit { int pm, pn; };
struct StaticOrder {
    int nM, nN, nwg, G, c;
    __device__ __forceinline__ void init(int M, int N, int G_, int c_) { nM = M / BM; nN = N / BM; nwg = nM * nN; G = G_; c = c_; }
    __device__ __forceinline__ bool next(int i, Unit& u) const {
        const long L = (long)i * G + c; if (L >= nwg) return false;
        int wgid = (int)L; { const int q = nwg / NXCD, r = nwg % NXCD, xcd = wgid % NXCD, off = wgid / NXCD; wgid = (xcd < r ? xcd * (q + 1) : r * (q + 1) + (xcd - r) * q) + off; }
        const int nig = WGM * nN, gid = wgid / nig, fm = gid * WGM, gsz = (nM - fm) < WGM ? (nM - fm) : WGM;
        u.pm = fm + ((wgid % nig) % gsz); u.pn = (wgid % nig) / gsz; return true;
    }
};

enum { EPI_SWIGLU = 0, EPI_BF16 = 1, EPI_RES = 2, EPI_MEMKV = 3 };
struct Epi { int mode; bf16_t* ob; int ldo; float* xf; float scale; float* mk_out; float* mv_out; bf16_t* mkb; bf16_t* mvb; };

template <int MODE> __device__ __forceinline__ void gemm_epilogue(const f32x4 (&acc)[2][2][4][2], const Unit& u, int wr, int wc, int fr, int fq, const Epi& E) {
    const int row0 = u.pm * BM + wr * 64 + fr;
    if constexpr (MODE == EPI_SWIGLU) {
        const int col0 = u.pn * 128 + wc * 32 + 8 * fq;
#pragma unroll
        for (int ai = 0; ai < 2; ++ai)
#pragma unroll
            for (int m = 0; m < 4; ++m) {
                bf16_t* rowp = E.ob + (size_t)(row0 + ai * HALF + m * 16) * E.ldo + col0;
                float h[8];
#pragma unroll
                for (int n = 0; n < 2; ++n)
#pragma unroll
                    for (int j = 0; j < 4; ++j) { const float g = acc[ai][0][m][n][j], up = acc[ai][1][m][n][j]; h[n * 4 + j] = g * up * __builtin_amdgcn_rcpf(1.0f + __expf(-g)); }
                u32x4 w; w.x = pk2(h[0], h[1]); w.y = pk2(h[2], h[3]); w.z = pk2(h[4], h[5]); w.w = pk2(h[6], h[7]);
                *(u32x4*)rowp = w;
            }
    } else if constexpr (MODE == EPI_BF16) {
        const int col0 = u.pn * BM + wc * 32 + 8 * fq;
#pragma unroll
        for (int ai = 0; ai < 2; ++ai)
#pragma unroll
            for (int m = 0; m < 4; ++m) {
                bf16_t* rowp = E.ob + (size_t)(row0 + ai * HALF + m * 16) * E.ldo + col0;
#pragma unroll
                for (int bj = 0; bj < 2; ++bj) {
                    const f32x4 v0 = acc[ai][bj][m][0], v1 = acc[ai][bj][m][1];
                    u32x4 w; w.x = pk2(v0[0], v0[1]); w.y = pk2(v0[2], v0[3]); w.z = pk2(v1[0], v1[1]); w.w = pk2(v1[2], v1[3]);
                    *(u32x4*)(rowp + bj * HALF) = w;
                }
            }
    } else if constexpr (MODE == EPI_RES) {
        const int col0 = u.pn * BM + wc * 32 + 4 * fq;
#pragma unroll
        for (int ai = 0; ai < 2; ++ai)
#pragma unroll
            for (int m = 0; m < 4; ++m) {
                float* rowp = E.xf + (size_t)(row0 + ai * HALF + m * 16) * D + col0;
#pragma unroll
                for (int bj = 0; bj < 2; ++bj)
#pragma unroll
                    for (int n = 0; n < 2; ++n) { f32x4 x = *(const f32x4*)(rowp + bj * HALF + n * 16); x = x * ALPHA + acc[ai][bj][m][n] * E.scale; *(f32x4*)(rowp + bj * HALF + n * 16) = x; }
                asm volatile("" ::: "memory");
            }
    } else {
        const int colt = u.pn * BM; const int l = colt >> 10, kv = (colt >> 9) & 1, cc0 = (colt & 511) + wc * 32 + 4 * fq;
        float* of = (kv ? E.mv_out : E.mk_out) + (size_t)l * 2048 * 512;
        bf16_t* ob = (kv ? E.mvb : E.mkb) + (size_t)l * 2048 * 512;
#pragma unroll
        for (int ai = 0; ai < 2; ++ai)
#pragma unroll
            for (int m = 0; m < 4; ++m) {
                const size_t ro = (size_t)(row0 + ai * HALF + m * 16) * 512 + cc0;
#pragma unroll
                for (int bj = 0; bj < 2; ++bj)
#pragma unroll
                    for (int n = 0; n < 2; ++n) { const f32x4 v = acc[ai][bj][m][n]; *(f32x4*)(of + ro + bj * HALF + n * 16) = v; u32x2 w; w.x = pk2(v[0], v[1]); w.y = pk2(v[2], v[3]); *(u32x2*)(ob + ro + bj * HALF + n * 16) = w; }
            }
    }
}

template <int MODE> __device__ __forceinline__ void gemm_phase(LAS unsigned char* lds, const bf16_t* Ag, int lda, const bf16_t* Btg, int M, int N, int K, const Epi& E) {
    int tid_ = threadIdx.x; asm volatile("" : "+v"(tid_));
    const int tid = tid_, wid = __builtin_amdgcn_readfirstlane(tid >> 6), lane = tid & 63, wr = wid >> 2, wc = wid & 3, fr = lane & 15, fq = lane >> 4;
    const int nt = K / BK;
    constexpr bool PERM = (MODE == EPI_SWIGLU || MODE == EPI_BF16);
    StaticOrder S; S.init(M, N, (int)gridDim.x, (int)blockIdx.x);
    unsigned voffA[2], voffB[2];
#pragma unroll
    for (int i = 0; i < 2; ++i) { int R, C; stage_rc(tid * 16 + i * 8192, R, C); const int Rb = PERM ? ((R & ~31) + perm32(R & 31)) : R;
        voffA[i] = (unsigned)(R * lda + C) * 2u; voffB[i] = (unsigned)(Rb * K + C) * 2u; }
    const size_t kstep = (size_t)(BK * 2);
    const size_t hstepA = (size_t)HALF * lda * 2, hstepB = (size_t)HALF * K * 2;
    const size_t tstepA = 2 * hstepA, tstepB = 2 * hstepB;
    const unsigned ldsw = (unsigned)wid * 1024u;
    const int aoff = lds_byte(wr * 64 + fr, fq * 8), boff = lds_byte(wc * 32 + fr, fq * 8);
#define PG8_SA(b, h) (((b) * 2 + (h)) * HTB)
#define PG8_SB(b, h) ((4 + (b) * 2 + (h)) * HTB)
#define PG8_STAGE(bufoff, gbase, voff) do { _Pragma("unroll") for (int _i = 0; _i < 2; ++_i) \
        __builtin_amdgcn_global_load_lds((const unsigned*)((const char*)(gbase) + (voff)[_i]), (LAS unsigned*)(lds + (bufoff) + ldsw + _i * 8192), 16, 0, 0); } while (0)
#define PG8_LDA(dst, b, h) do { _Pragma("unroll") for (int m = 0; m < 4; ++m) _Pragma("unroll") for (int k = 0; k < 2; ++k) dst[m][k] = *(const LAS bf16x8*)(lds + PG8_SA(b, h) + aoff + m * 2048 + k * 1024); } while (0)
#define PG8_LDB(dst, b, h) do { _Pragma("unroll") for (int n = 0; n < 2; ++n) _Pragma("unroll") for (int k = 0; k < 2; ++k) dst[n][k] = *(const LAS bf16x8*)(lds + PG8_SB(b, h) + boff + n * 2048 + k * 1024); } while (0)
#define PG8_MMA(ai, bj, At, Bt) do { __builtin_amdgcn_s_setprio(1); _Pragma("unroll") for (int m = 0; m < 4; ++m) _Pragma("unroll") for (int n = 0; n < 2; ++n) _Pragma("unroll") for (int k = 0; k < 2; ++k) \
        acc[ai][bj][m][n] = __builtin_amdgcn_mfma_f32_16x16x32_bf16(Bt[n][k], At[m][k], acc[ai][bj][m][n], 0, 0, 0); __builtin_amdgcn_s_setprio(0); } while (0)
#define PG8_WAIT_V(n) asm volatile("s_waitcnt vmcnt(" #n ")" ::: "memory")
#define PG8_WAIT_L(n) asm volatile("s_waitcnt lgkmcnt(" #n ")" ::: "memory")
#define PG8_BAR __builtin_amdgcn_s_barrier()
#define PG8_SCHED __builtin_amdgcn_sched_barrier(0)
    Unit cur, nxt; int ui = 0;
    if (!S.next(0, cur)) return;
    f32x4 acc[2][2][4][2];
#pragma unroll
    for (int a = 0; a < 2; ++a)
#pragma unroll
        for (int b = 0; b < 2; ++b)
#pragma unroll
            for (int m = 0; m < 4; ++m)
#pragma unroll
                for (int n = 0; n < 2; ++n) acc[a][b][m][n] = (f32x4){0.f, 0.f, 0.f, 0.f};
    bf16x8 At[4][2], B0[2][2], B1[2][2];
    const char* cA = (const char*)Ag + (size_t)cur.pm * tstepA; const char* cB = (const char*)Btg + (size_t)cur.pn * tstepB;
    PG8_STAGE(PG8_SB(0, 0), cB, voffB); PG8_STAGE(PG8_SA(0, 0), cA, voffA); PG8_STAGE(PG8_SB(0, 1), cB + hstepB, voffB); PG8_STAGE(PG8_SA(0, 1), cA + hstepA, voffA);
    if (wr == 1) PG8_BAR;
    PG8_WAIT_V(4); PG8_BAR;
    PG8_STAGE(PG8_SB(1, 0), cB + kstep, voffB); PG8_STAGE(PG8_SA(1, 0), cA + kstep, voffA); PG8_STAGE(PG8_SB(1, 1), cB + hstepB + kstep, voffB);
    PG8_WAIT_V(6); PG8_BAR;
    for (;;) {
        const bool has_next = S.next(ui + 1, nxt);
        const char* nA = has_next ? (const char*)Ag + (size_t)nxt.pm * tstepA : cA; const char* nB = has_next ? (const char*)Btg + (size_t)nxt.pn * tstepB : cB;
        for (int t = 0; t < nt; t += 2) {
            const bool last = (t == nt - 2);
            const char* a1 = cA + (size_t)(t + 1) * kstep;
            const char* a2 = last ? nA : cA + (size_t)(t + 2) * kstep; const char* b2 = last ? nB : cB + (size_t)(t + 2) * kstep;
            const char* a3 = a2 + kstep; const char* b3 = b2 + kstep;
            PG8_LDB(B0, 0, 0); PG8_SCHED; PG8_LDA(At, 0, 0); PG8_STAGE(PG8_SA(1, 1), a1 + hstepA, voffA);
            PG8_WAIT_L(8); PG8_BAR; PG8_WAIT_L(0); PG8_MMA(0, 0, At, B0); PG8_BAR; PG8_SCHED;
            PG8_LDB(B1, 0, 1); PG8_STAGE(PG8_SB(0, 0), b2, voffB);
            PG8_BAR; PG8_WAIT_L(0); PG8_MMA(0, 1, At, B1); PG8_BAR;
            PG8_LDA(At, 0, 1); PG8_STAGE(PG8_SA(0, 0), a2, voffA);
            PG8_BAR; PG8_WAIT_L(0); PG8_MMA(1, 0, At, B0); PG8_BAR; PG8_SCHED;
            PG8_STAGE(PG8_SB(0, 1), b2 + hstepB, voffB);
            PG8_WAIT_V(6); PG8_BAR; PG8_MMA(1, 1, At, B1); PG8_BAR;
            PG8_LDB(B0, 1, 0); PG8_SCHED; PG8_LDA(At, 1, 0); PG8_STAGE(PG8_SA(0, 1), a2 + hstepA, voffA);
            PG8_WAIT_L(8); PG8_BAR; PG8_WAIT_L(0); PG8_MMA(0, 0, At, B0); PG8_BAR; PG8_SCHED;
            PG8_LDB(B1, 1, 1); PG8_STAGE(PG8_SB(1, 0), b3, voffB);
            PG8_BAR; PG8_WAIT_L(0); PG8_MMA(0, 1, At, B1); PG8_BAR;
            PG8_LDA(At, 1, 1); PG8_STAGE(PG8_SA(1, 0), a3, voffA);
            PG8_BAR; PG8_WAIT_L(0); PG8_MMA(1, 0, At, B0); PG8_BAR; PG8_SCHED;
            PG8_STAGE(PG8_SB(1, 1), b3 + hstepB, voffB);
            PG8_WAIT_V(6); PG8_BAR; PG8_MMA(1, 1, At, B1); PG8_BAR;
        }
        gemm_epilogue<MODE>(acc, cur, wr, wc, fr, fq, E);
        if (!has_next) break;
#pragma unroll
        for (int a = 0; a < 2; ++a)
#pragma unroll
            for (int b = 0; b < 2; ++b)
#pragma unroll
                for (int m = 0; m < 4; ++m)
#pragma unroll
                    for (int n = 0; n < 2; ++n) acc[a][b][m][n] = (f32x4){0.f, 0.f, 0.f, 0.f};
        cur = nxt; cA = nA; cB = nB; ++ui;
    }
    PG8_WAIT_V(0);
    if (wr == 0) PG8_BAR;
    PG8_BAR;
#undef PG8_SA
#undef PG8_SB
#undef PG8_STAGE
#undef PG8_LDA
#undef PG8_LDB
#undef PG8_MMA
#undef PG8_WAIT_V
#undef PG8_WAIT_L
#undef PG8_BAR
#undef PG8_SCHED
}

__device__ __forceinline__ void transpose_job(LAS unsigned char* lds, const float* src, int ld, int K, int c0, int ncols, bf16_t* dst, int rowmode, int drow0) {
    LAS float* tile = (LAS float*)lds;
    int tid_ = threadIdx.x; asm volatile("" : "+v"(tid_)); const int tid = tid_;
    const int nkt = K / 64, nct = ncols / 64, ntiles = nkt * nct;
    for (int t = blockIdx.x; t < ntiles; t += gridDim.x) {
        const int kt = t % nkt, ct = t / nkt;
        const int k0 = kt * 64, n0 = ct * 64;
        { const int kr = tid >> 4, c4 = (tid & 15) * 4;
#pragma unroll
          for (int rr = 0; rr < 64; rr += 32) { const f32x4 v = *(const f32x4*)(src + (size_t)(k0 + kr + rr) * ld + c0 + n0 + c4);
              tile[(kr + rr) * 65 + c4 + 0] = v[0]; tile[(kr + rr) * 65 + c4 + 1] = v[1]; tile[(kr + rr) * 65 + c4 + 2] = v[2]; tile[(kr + rr) * 65 + c4 + 3] = v[3]; } }
        __syncthreads();
        { const int n = tid >> 3, k8 = (tid & 7) * 8; float v[8];
#pragma unroll
          for (int i = 0; i < 8; ++i) v[i] = tile[(k8 + i) * 65 + n];
          const int c = c0 + n0 + n; int drow;
          if (rowmode == 0) drow = drow0 + c; else drow = 256 * (c >> 7) + (c & 127) + (rowmode == 2 ? 128 : 0);
          u32x4 w; w.x = pk2(v[0], v[1]); w.y = pk2(v[2], v[3]); w.z = pk2(v[4], v[5]); w.w = pk2(v[6], v[7]);
          *(u32x4*)(dst + (size_t)drow * K + k0 + k8) = w; }
        __syncthreads();
    }
}
__device__ __forceinline__ void convert_job(const float* src, bf16_t* dst, float* dstf, size_t n) {
    const size_t nv = n / 8;
    for (size_t i = (size_t)blockIdx.x * NTHR + threadIdx.x; i < nv; i += (size_t)gridDim.x * NTHR) {
        const f32x4 a = *(const f32x4*)(src + i * 8), b = *(const f32x4*)(src + i * 8 + 4);
        u32x4 w; w.x = pk2(a[0], a[1]); w.y = pk2(a[2], a[3]); w.z = pk2(b[0], b[1]); w.w = pk2(b[2], b[3]);
        *(u32x4*)(dst + i * 8) = w;
        if (dstf) { *(f32x4*)(dstf + i * 8) = a; *(f32x4*)(dstf + i * 8 + 4) = b; }
    }
}
__device__ __forceinline__ void prep_phase(LAS unsigned char* lds, const Params& p) {
    unsigned char* ws = p.ws;
    for (int jb = 0; jb < 52; ++jb) {
        const float* src; int ld, K, c0, ncols, rowmode, drow0; bf16_t* dst;
        if (jb < 24) { const int lf = jb / 3, t = jb % 3;
            if (t < 2) { src = p.in[7 + t] + (size_t)lf * 1024 * FF; ld = FF; K = 1024; c0 = 0; ncols = FF; dst = (bf16_t*)(ws + WS_WGU) + (size_t)lf * 5632 * 1024; rowmode = 1 + t; drow0 = 0; }
            else { src = p.in[9] + (size_t)lf * FF * 1024; ld = 1024; K = FF; c0 = 0; ncols = 1024; dst = (bf16_t*)(ws + WS_WD) + (size_t)lf * 1024 * FF; rowmode = 0; drow0 = 0; }
        } else if (jb < 44) { const int j = (jb - 24) / 10, t = (jb - 24) % 10; rowmode = 0; K = 1024;
            if (t < 4) {
                src = p.in[12] + (size_t)j * 1024 * 4608; ld = 4608; dst = (bf16_t*)(ws + WS_HWIN) + (size_t)j * 4608 * 1024;
                c0 = t == 0 ? 0 : (t == 1 ? 3072 : (t == 2 ? 2048 : 4096)); ncols = t == 0 ? 2048 : (t == 3 ? 512 : 1024); drow0 = (t == 0 ? 0 : (t == 1 ? 2048 : (t == 2 ? 3072 : 4096))) - c0;
            } else if (t < 8) {
                src = p.in[16] + (size_t)j * 1024 * 3600; ld = 3600; dst = (bf16_t*)(ws + WS_GWIN) + (size_t)j * 4096 * 1024; const int u = t - 4;
                c0 = u == 0 ? 0 : (u == 1 ? 2048 : (u == 2 ? 1024 : 3088)); ncols = u == 3 ? 512 : 1024; drow0 = (u == 0 ? 0 : (u == 1 ? 1536 : (u == 2 ? 2560 : 3584))) - c0;
            } else { src = p.in[t == 8 ? 15 : 20] + (size_t)j * 1536 * 1024; ld = 1024; K = 1536; c0 = 0; ncols = 1024; dst = (bf16_t*)(ws + WS_WOUT) + (size_t)(2 * j + (t - 8)) * 1024 * 1536; drow0 = 0; }
        } else { const int l = (jb - 44) >> 1, kv = (jb - 44) & 1; src = p.in[21 + kv] + (size_t)l * 1024 * 512; ld = 512; K = 1024; c0 = 0; ncols = 512; dst = (bf16_t*)(ws + WS_MEMW); rowmode = 0; drow0 = l * 1024 + kv * 512; }
        transpose_job(lds, src, ld, K, c0, ncols, dst, rowmode, drow0);
    }
    for (int j = 0; j < 2; ++j) {
        const float* gs = p.in[16] + (size_t)j * 1024 * 3600; bf16_t* gd = (bf16_t*)(ws + WS_GWIN) + (size_t)j * 4096 * 1024;
        const float* w2 = p.in[17] + (size_t)j * 16 * 512;
        for (int i = blockIdx.x * NTHR + threadIdx.x; i < 512 * 1024; i += gridDim.x * NTHR) {
            const int c = i >> 10, kk = i & 1023; float sacc = 0.f;
#pragma unroll
            for (int r = 0; r < 16; ++r) sacc += gs[(size_t)kk * 3600 + 3072 + r] * w2[r * 512 + c];
            gd[(size_t)(1024 + c) * 1024 + kk] = f2bf(sacc);
        }
    }
    for (int jb = 0; jb < 5; ++jb) {
        const float* src; bf16_t* dst; float* dstf = nullptr; size_t n;
        if (jb == 0) { src = p.in[0]; dst = (bf16_t*)(ws + WS_XN); dstf = p.out + O_Y; n = (size_t)MP * D; }
        else if (jb == 1) { src = p.in[1]; dst = (bf16_t*)(ws + WS_XN) + (size_t)MP * D; dstf = p.out + O_Y + (size_t)MP * D; n = (size_t)MS * D; }
        else if (jb == 2) { src = p.in[2]; dst = (bf16_t*)(ws + WS_MEMP); n = (size_t)2048 * 1024; }
        else if (jb == 3) { src = p.in[3]; dst = (bf16_t*)(ws + WS_CKB); n = (size_t)4 * 4096 * 512; }
        else { src = p.in[4]; dst = (bf16_t*)(ws + WS_CVB); n = (size_t)4 * 4096 * 512; }
        convert_job(src, dst, dstf, n);
    }
}

__device__ __forceinline__ void ln_phase(float* x, bf16_t* xn, const float* gain, const float* bias) {
    int tid_ = threadIdx.x; asm volatile("" : "+v"(tid_));
    const int lane = tid_ & 63, wv = tid_ >> 6;
    f32x4 g[4], b[4];
#pragma unroll
    for (int i = 0; i < 4; ++i) { g[i] = *(const f32x4*)(gain + 4 * lane + 256 * i); b[i] = *(const f32x4*)(bias + 4 * lane + 256 * i); }
    for (int row = blockIdx.x * 8 + wv; row < MROWS; row += gridDim.x * 8) {
        float* xr = x + (size_t)row * D; f32x4 v[4]; float s = 0.f;
#pragma unroll
        for (int i = 0; i < 4; ++i) { v[i] = *(const f32x4*)(xr + 4 * lane + 256 * i); s += (v[i][0] + v[i][1]) + (v[i][2] + v[i][3]); }
#pragma unroll
        for (int o = 32; o >= 1; o >>= 1) s += __shfl_xor(s, o);
        const float mu = s * (1.0f / 1024.0f); float q = 0.f;
#pragma unroll
        for (int i = 0; i < 4; ++i) { const f32x4 d = v[i] - mu; q += (d[0] * d[0] + d[1] * d[1]) + (d[2] * d[2] + d[3] * d[3]); }
#pragma unroll
        for (int o = 32; o >= 1; o >>= 1) q += __shfl_xor(q, o);
        const float rs = 1.0f / sqrtf(q * (1.0f / 1024.0f) + 1e-5f);
#pragma unroll
        for (int i = 0; i < 4; ++i) { const f32x4 o = (v[i] - mu) * rs * g[i] + b[i]; *(f32x4*)(xr + 4 * lane + 256 * i) = o;
            u32x2 w; w.x = pk2(o[0], o[1]); w.y = pk2(o[2], o[3]); *(u32x2*)(xn + (size_t)row * D + 4 * lane + 256 * i) = w; }
    }
}

__device__ __forceinline__ void headnorm_phase(bf16_t* proj, int ld, int ocol, int gcol, int lanes_per_head  , const float* gain) {
    int tid_ = threadIdx.x; asm volatile("" : "+v"(tid_));
    const int lane = tid_ & 63, wv = tid_ >> 6;
    float gn[2][8];
#pragma unroll
    for (int hh = 0; hh < 2; ++hh)
#pragma unroll
        for (int i = 0; i < 8; ++i) gn[hh][i] = gain[hh * 512 + 8 * lane + i];
    const float invn = lanes_per_head == 16 ? (1.0f / 128.0f) : (1.0f / 256.0f);
    for (int row = blockIdx.x * 8 + wv; row < MROWS; row += gridDim.x * 8) {
        bf16_t* pr = proj + (size_t)row * ld;
#pragma unroll
        for (int hh = 0; hh < 2; ++hh) {
            const u32x4 ov = *(const u32x4*)(pr + ocol + hh * 512 + 8 * lane), gv = *(const u32x4*)(pr + gcol + hh * 512 + 8 * lane);
            float o[8], g[8];
#pragma unroll
            for (int i = 0; i < 4; ++i) { o[2 * i] = bflo(ov[i]); o[2 * i + 1] = bfhi(ov[i]); g[2 * i] = bflo(gv[i]); g[2 * i + 1] = bfhi(gv[i]); }
            float s = 0.f;
#pragma unroll
            for (int i = 0; i < 8; ++i) s += o[i] * o[i];
            s += __shfl_xor(s, 1); s += __shfl_xor(s, 2); s += __shfl_xor(s, 4); s += __shfl_xor(s, 8);
            if (lanes_per_head == 32) s += __shfl_xor(s, 16);
            const float rs = 1.0f / sqrtf(s * invn + 1e-6f);
            float r[8];
#pragma unroll
            for (int i = 0; i < 8; ++i) r[i] = o[i] * rs * gn[hh][i] * g[i] * sigmoidf_(g[i]);
            u32x4 w; w.x = pk2(r[0], r[1]); w.y = pk2(r[2], r[3]); w.z = pk2(r[4], r[5]); w.w = pk2(r[6], r[7]);
            *(u32x4*)(pr + ocol + hh * 512 + 8 * lane) = w;
        }
    }
}

constexpr int MX_G = 0, MX_T = 32768, MX_BL = 34816, MX_QT = 35328, MX_KT = MX_QT + 17408, MX_QH = MX_KT + 17408, MX_KHT = MX_QH + 17408,
              MX_VT = MX_KHT + 18432, MX_PP = MX_VT + 4608, MX_ST = MX_PP + 9216, MX_END = MX_ST + 8704;
static_assert(MX_END <= LDS_BYTES, "mixer LDS");

struct ChainArgs {
    bf16_t* proj; int ld; size_t row0; int nchunks;
    int qcol, kcol, gcol, vcol;
    int gla;
    const float* lb0; const float* lb1; int lbj;
    const float* bgate;
    const float* s0; float* sout; int sstride;
};

__device__ __forceinline__ void mixer_chain(LAS unsigned char* lds, const ChainArgs& a) {
    int tid_ = threadIdx.x; asm volatile("" : "+v"(tid_));
    const int tid = tid_, wid = __builtin_amdgcn_readfirstlane(tid >> 6), lane = tid & 63, fr = lane & 15, fq = lane >> 4;
    LAS float* G = (LAS float*)(lds + MX_G); LAS float* T = (LAS float*)(lds + MX_T); LAS float* BL = (LAS float*)(lds + MX_BL);
    LAS bf16_t* QT = (LAS bf16_t*)(lds + MX_QT); LAS bf16_t* KT = (LAS bf16_t*)(lds + MX_KT); LAS bf16_t* QH = (LAS bf16_t*)(lds + MX_QH);
    LAS bf16_t* KHT = (LAS bf16_t*)(lds + MX_KHT); LAS bf16_t* VT = (LAS bf16_t*)(lds + MX_VT); LAS bf16_t* PP = (LAS bf16_t*)(lds + MX_PP); LAS bf16_t* ST = (LAS bf16_t*)(lds + MX_ST);
    const int t0 = tid >> 4, cv = tid & 15, c8 = cv * 8;
    float cA[8], cB[8];
#pragma unroll
    for (int i = 0; i < 8; ++i) {
        if (a.gla) { cA[i] = a.bgate[c8 + i]; cB[i] = 0.f; }
        else { float lb = 0.f; if (a.lbj == 1) lb = sigmoidf_(a.lb1[c8 + i] - a.lb0[c8 + i]); cA[i] = lb; cB[i] = 1.0f - lb; }
    }
    f32x4 Sacc[2];
#pragma unroll
    for (int vi = 0; vi < 2; ++vi)
#pragma unroll
        for (int j = 0; j < 4; ++j) Sacc[vi][j] = a.s0 ? a.s0[(size_t)(16 * wid + 4 * fq + j) * a.sstride + 16 * vi + fr] : 0.f;
#pragma unroll
    for (int vi = 0; vi < 2; ++vi) { u32x2 w; w.x = pk2(Sacc[vi][0], Sacc[vi][1]); w.y = pk2(Sacc[vi][2], Sacc[vi][3]); *(LAS u32x2*)(ST + (16 * vi + fr) * 136 + 16 * wid + 4 * fq) = w; }

    u32x4 rq[2], rk[2], rg[2], rv;
    rg[0] = rg[1] = (u32x4){0u, 0u, 0u, 0u}; rv = (u32x4){0u, 0u, 0u, 0u};
    auto issue_loads = [&](int c) {
        const bf16_t* base = a.proj + (a.row0 + (size_t)c * 64) * a.ld;
#pragma unroll
        for (int rr = 0; rr < 2; ++rr) { const bf16_t* rp = base + (size_t)(t0 + 32 * rr) * a.ld + c8;
            rq[rr] = *(const u32x4*)(rp + a.qcol); rk[rr] = *(const u32x4*)(rp + a.kcol); if (a.gla) rg[rr] = *(const u32x4*)(rp + a.gcol); }
        if (tid < 256) rv = *(const u32x4*)(base + (size_t)(tid >> 2) * a.ld + a.vcol + 8 * (tid & 3));
    };
    issue_loads(0);
    const float qscale = 0.08838834764831845f;
    for (int c = 0; c < a.nchunks; ++c) {
        float qv[2][8], kv[2][8];
#pragma unroll
        for (int rr = 0; rr < 2; ++rr) {
            float gvv[8];
#pragma unroll
            for (int i = 0; i < 8; ++i) {
                const unsigned uq = rq[rr][i >> 1], uk = rk[rr][i >> 1], ug = rg[rr][i >> 1];
                const float q = (i & 1) ? bfhi(uq) : bflo(uq), k = (i & 1) ? bfhi(uk) : bflo(uk);
                if (a.gla) {
                    const float g = ((i & 1) ? bfhi(ug) : bflo(ug)) + cA[i];
                    qv[rr][i] = q * qscale; kv[rr][i] = k;
                    gvv[i] = (fminf(g, 0.f) - __logf(1.0f + __expf(-fabsf(g)))) * (1.0f / 16.0f);
                } else {
                    qv[rr][i] = q * sigmoidf_(q) * qscale;
                    const float e = __expf(-k), r = 1.0f / (1.0f + e);
                    kv[rr][i] = cB[i] * e * r;
                    gvv[i] = __logf(fmaxf(cA[i] + cB[i] * r, 1e-6f));
                }
            }
            LAS float* gp = G + (t0 + 32 * rr) * 128 + c8;
            *(LAS f32x4*)gp = (f32x4){gvv[0], gvv[1], gvv[2], gvv[3]}; *(LAS f32x4*)(gp + 4) = (f32x4){gvv[4], gvv[5], gvv[6], gvv[7]};
        }
        if (tid < 256) { const int tv = tid >> 2, v8 = (tid & 3) * 8;
#pragma unroll
            for (int i = 0; i < 8; ++i) VT[(v8 + i) * 72 + tv] = (bf16_t)((i & 1) ? (rv[i >> 1] >> 16) : (rv[i >> 1] & 0xffffu)); }
        if (c + 1 < a.nchunks) issue_loads(c + 1);
        __syncthreads();
        { const int k = tid & 127, sg = tid >> 7; float run = 0.f;
#pragma unroll
          for (int i = 0; i < 16; ++i) { run += G[(16 * sg + i) * 128 + k]; G[(16 * sg + i) * 128 + k] = run; }
          T[sg * 128 + k] = run; }
        __syncthreads();
        {
            float tA[8], tB[8], tC[8], bmid[8], blast[8];
            { const f32x4 x0 = *(const LAS f32x4*)(T + c8), x1 = *(const LAS f32x4*)(T + c8 + 4), y0 = *(const LAS f32x4*)(T + 128 + c8), y1 = *(const LAS f32x4*)(T + 128 + c8 + 4),
                  z0 = *(const LAS f32x4*)(T + 256 + c8), z1 = *(const LAS f32x4*)(T + 256 + c8 + 4);
              const f32x4 m0 = *(const LAS f32x4*)(G + 31 * 128 + c8), m1 = *(const LAS f32x4*)(G + 31 * 128 + c8 + 4), l0 = *(const LAS f32x4*)(G + 63 * 128 + c8), l1 = *(const LAS f32x4*)(G + 63 * 128 + c8 + 4);
#pragma unroll
              for (int i = 0; i < 4; ++i) { tA[i] = x0[i]; tA[4 + i] = x1[i]; tB[i] = x0[i] + y0[i]; tB[4 + i] = x1[i] + y1[i]; tC[i] = tB[i] + z0[i]; tC[4 + i] = tB[4 + i] + z1[i];
                  bmid[i] = m0[i] + tA[i]; bmid[4 + i] = m1[i] + tA[4 + i]; blast[i] = l0[i] + tC[i]; blast[4 + i] = l1[i] + tC[4 + i]; } }
#pragma unroll
            for (int rr = 0; rr < 2; ++rr) {
                const int t = t0 + 32 * rr, sg = t >> 4;
                const f32x4 g0 = *(const LAS f32x4*)(G + t * 128 + c8), g1 = *(const LAS f32x4*)(G + t * 128 + c8 + 4);
                float qh[8], qt[8], kt[8], kh[8];
#pragma unroll
                for (int i = 0; i < 8; ++i) {
                    const float off = sg == 0 ? 0.f : (sg == 1 ? tA[i] : (sg == 2 ? tB[i] : tC[i]));
                    const float b = (i < 4 ? g0[i & 3] : g1[i & 3]) + off;
                    qh[i] = qv[rr][i] * __expf(b);
                    qt[i] = qv[rr][i] * __expf(fminf(b - bmid[i], 80.f));
                    kt[i] = kv[rr][i] * __expf(fminf(bmid[i] - b, 80.f));
                    kh[i] = kv[rr][i] * __expf(blast[i] - b);
                }
                u32x4 w;
                w.x = pk2(qt[0], qt[1]); w.y = pk2(qt[2], qt[3]); w.z = pk2(qt[4], qt[5]); w.w = pk2(qt[6], qt[7]); *(LAS u32x4*)(QT + t * 136 + c8) = w;
                w.x = pk2(kt[0], kt[1]); w.y = pk2(kt[2], kt[3]); w.z = pk2(kt[4], kt[5]); w.w = pk2(kt[6], kt[7]); *(LAS u32x4*)(KT + t * 136 + c8) = w;
                w.x = pk2(qh[0], qh[1]); w.y = pk2(qh[2], qh[3]); w.z = pk2(qh[4], qh[5]); w.w = pk2(qh[6], qh[7]); *(LAS u32x4*)(QH + t * 136 + c8) = w;
#pragma unroll
                for (int i = 0; i < 8; ++i) KHT[(c8 + i) * 72 + t] = f2bf(kh[i]);
            }
            if (t0 == 0) {
#pragma unroll
                for (int i = 0; i < 8; ++i) BL[c8 + i] = blast[i]; }
        }
        __syncthreads();
        { const int ti = wid >> 1;
#pragma unroll
          for (int sh = 0; sh < 2; ++sh) { const int si = 2 * (wid & 1) + sh; f32x4 pa = {0.f, 0.f, 0.f, 0.f};
              if (si <= ti) {
#pragma unroll
                  for (int kk = 0; kk < 4; ++kk) { const bf16x8 A = *(const LAS bf16x8*)(KT + (16 * si + fr) * 136 + 32 * kk + 8 * fq), B = *(const LAS bf16x8*)(QT + (16 * ti + fr) * 136 + 32 * kk + 8 * fq); pa = MFMA16(A, B, pa); }
                  if (si == ti) {
#pragma unroll
                      for (int j = 0; j < 4; ++j) if (4 * fq + j > fr) pa[j] = 0.f; }
              }
              u32x2 w; w.x = pk2(pa[0], pa[1]); w.y = pk2(pa[2], pa[3]); *(LAS u32x2*)(PP + (16 * ti + fr) * 72 + 16 * si + 4 * fq) = w; } }
        __syncthreads();
        { const int ti = wid >> 1, vi = wid & 1; f32x4 o = {0.f, 0.f, 0.f, 0.f};
#pragma unroll
          for (int kk = 0; kk < 2; ++kk) { const bf16x8 A = *(const LAS bf16x8*)(VT + (16 * vi + fr) * 72 + 32 * kk + 8 * fq), B = *(const LAS bf16x8*)(PP + (16 * ti + fr) * 72 + 32 * kk + 8 * fq); o = MFMA16(A, B, o); }
#pragma unroll
          for (int kk = 0; kk < 4; ++kk) { const bf16x8 A = *(const LAS bf16x8*)(ST + (16 * vi + fr) * 136 + 32 * kk + 8 * fq), B = *(const LAS bf16x8*)(QH + (16 * ti + fr) * 136 + 32 * kk + 8 * fq); o = MFMA16(A, B, o); }
          u32x2 w; w.x = pk2(o[0], o[1]); w.y = pk2(o[2], o[3]);
          *(u32x2*)(a.proj + (a.row0 + (size_t)c * 64 + 16 * ti + fr) * a.ld + a.vcol + 16 * vi + 4 * fq) = w; }
        { float dj[4];
#pragma unroll
          for (int j = 0; j < 4; ++j) dj[j] = __expf(BL[16 * wid + 4 * fq + j]);
#pragma unroll
          for (int vi = 0; vi < 2; ++vi) {
#pragma unroll
              for (int j = 0; j < 4; ++j) Sacc[vi][j] *= dj[j];
#pragma unroll
              for (int kk = 0; kk < 2; ++kk) { const bf16x8 A = *(const LAS bf16x8*)(KHT + (16 * wid + fr) * 72 + 32 * kk + 8 * fq), B = *(const LAS bf16x8*)(VT + (16 * vi + fr) * 72 + 32 * kk + 8 * fq); Sacc[vi] = MFMA16(A, B, Sacc[vi]); } } }
        __syncthreads();
#pragma unroll
        for (int vi = 0; vi < 2; ++vi) { u32x2 w; w.x = pk2(Sacc[vi][0], Sacc[vi][1]); w.y = pk2(Sacc[vi][2], Sacc[vi][3]); *(LAS u32x2*)(ST + (16 * vi + fr) * 136 + 16 * wid + 4 * fq) = w; }
    }
#pragma unroll
    for (int vi = 0; vi < 2; ++vi)
#pragma unroll
        for (int j = 0; j < 4; ++j) a.sout[(size_t)(16 * wid + 4 * fq + j) * a.sstride + 16 * vi + fr] = Sacc[vi][j];
    __syncthreads();
}

constexpr int AT_PITCH = 264;
__device__ __forceinline__ void mem_attn(LAS unsigned char* lds, const bf16_t* Kb, const bf16_t* Vb, bf16_t* Q, int ld, int nrows) {
    int tid_ = threadIdx.x; asm volatile("" : "+v"(tid_));
    const int tid = tid_, wid = __builtin_amdgcn_readfirstlane(tid >> 6), lane = tid & 63, fr = lane & 15, fq = lane >> 4;
    LAS bf16_t* VT = (LAS bf16_t*)lds;
#pragma unroll
    for (int it = 0; it < 8; ++it) { const int idx = tid + NTHR * it, key = idx >> 4, v8 = (idx & 15) * 8; const u32x4 v = *(const u32x4*)(Vb + (size_t)key * 512 + v8);
#pragma unroll
        for (int i = 0; i < 8; ++i) VT[(v8 + i) * AT_PITCH + key] = (bf16_t)((i & 1) ? (v[i >> 1] >> 16) : (v[i >> 1] & 0xffffu)); }
    __syncthreads();
    const float sc = 0.08838834764831845f;
    for (int q0 = wid * 16; q0 < nrows; q0 += 128) {
        bf16x8 Qf0, Qf1, Qf2, Qf3;
        { const bf16_t* qp = Q + (size_t)(q0 + fr) * ld + 8 * fq; Qf0 = *(const bf16x8*)(qp); Qf1 = *(const bf16x8*)(qp + 32); Qf2 = *(const bf16x8*)(qp + 64); Qf3 = *(const bf16x8*)(qp + 96); }
        f32x4 s[16];
#pragma unroll
        for (int a = 0; a < 16; ++a) {
            const bf16_t* kp = Kb + (size_t)(16 * a + fr) * 512 + 8 * fq;
            f32x4 t = {0.f, 0.f, 0.f, 0.f};
            t = MFMA16(*(const bf16x8*)(kp), Qf0, t); t = MFMA16(*(const bf16x8*)(kp + 32), Qf1, t); t = MFMA16(*(const bf16x8*)(kp + 64), Qf2, t); t = MFMA16(*(const bf16x8*)(kp + 96), Qf3, t);
            s[a] = t;
            if ((a & 1) == 1) asm volatile("" ::: "memory");
        }
        float mx = -3.0e38f;
#pragma unroll
        for (int a = 0; a < 16; ++a) mx = fmaxf(fmaxf(mx, fmaxf(s[a][0], s[a][1])), fmaxf(s[a][2], s[a][3]));
        mx = fmaxf(mx, __shfl_xor(mx, 16)); mx = fmaxf(mx, __shfl_xor(mx, 32));
        float sum = 0.f; u32x2 pk[16];
#pragma unroll
        for (int a = 0; a < 16; ++a) { const float e0 = __expf((s[a][0] - mx) * sc), e1 = __expf((s[a][1] - mx) * sc), e2 = __expf((s[a][2] - mx) * sc), e3 = __expf((s[a][3] - mx) * sc);
            sum += (e0 + e1) + (e2 + e3); pk[a].x = pk2(e0, e1); pk[a].y = pk2(e2, e3); }
        sum += __shfl_xor(sum, 16); sum += __shfl_xor(sum, 32);
        const float inv = 1.0f / sum;
        f32x4 o[8];
#pragma unroll
        for (int dt = 0; dt < 8; ++dt) o[dt] = (f32x4){0.f, 0.f, 0.f, 0.f};
#pragma unroll
        for (int ap = 0; ap < 8; ++ap) {
            const u32x4 bv = {pk[2 * ap].x, pk[2 * ap].y, pk[2 * ap + 1].x, pk[2 * ap + 1].y};
            const bf16x8 B = __builtin_bit_cast(bf16x8, bv);
#pragma unroll
            for (int dt = 0; dt < 8; ++dt) {
                const u32x2 lo = *(const LAS u32x2*)(VT + (16 * dt + fr) * AT_PITCH + 32 * ap + 4 * fq), hi = *(const LAS u32x2*)(VT + (16 * dt + fr) * AT_PITCH + 32 * ap + 16 + 4 * fq);
                const u32x4 av = {lo.x, lo.y, hi.x, hi.y};
                o[dt] = MFMA16(__builtin_bit_cast(bf16x8, av), B, o[dt]);
            }
        }
#pragma unroll
        for (int dt = 0; dt < 8; ++dt) { u32x2 w; w.x = pk2(o[dt][0] * inv, o[dt][1] * inv); w.y = pk2(o[dt][2] * inv, o[dt][3] * inv);
            *(u32x2*)(Q + (size_t)(q0 + fr) * ld + 16 * dt + 4 * fq) = w; }
    }
    __syncthreads();
}

__device__ __forceinline__ void mixer_phase(LAS unsigned char* lds, const Params& p, int layer) {
    const int j = layer >> 1, gla = layer & 1, w = blockIdx.x, G = gridDim.x;
    bf16_t* proj = (bf16_t*)(p.ws + WS_PROJ);
    const int ld = gla ? GL_LD : HG_LD;
    const int nvs = gla ? 8 : 4, nh = gla ? 4 : 8, vdim = gla ? 256 : 128;
    const int n_prompt = 8 * nh * nvs  , n_sample = 16 * nh * nvs  ;
    for (int it = w; it < n_prompt + n_sample; it += G) {
        const bool smp = it >= n_prompt; const int id = smp ? it - n_prompt : it;
        const int lo = id & 7, rest = id >> 3, vs = rest % nvs, hi = rest / nvs, bh = lo + 8 * hi, b = bh / nh, h = bh % nh;
        ChainArgs a;
        a.proj = proj; a.ld = ld; a.gla = gla; a.lbj = j;
        a.row0 = smp ? (size_t)MP + (size_t)b * 64 : (size_t)b * 8192; a.nchunks = smp ? 1 : 128;
        if (gla) { a.qcol = h * 128; a.kcol = 512 + h * 128; a.gcol = 1024 + h * 128; a.vcol = 2560 + h * 256 + 32 * vs; a.bgate = p.in[18] + j * 512 + h * 128; a.lb0 = a.lb1 = nullptr; }
        else { a.qcol = h * 128; a.kcol = 1024 + h * 128; a.gcol = 0; a.vcol = 3072 + h * 128 + 32 * vs; a.bgate = nullptr; a.lb0 = p.in[13] + h * 128; a.lb1 = p.in[13] + 1024 + h * 128; }
        const size_t per_b = (size_t)nh * 128 * vdim, so = ((size_t)b * nh + h) * 128 * vdim + 32 * vs;
        if (smp) { a.s0 = (gla ? p.in[6] : p.in[5]) + (size_t)j * 16 * per_b + so; a.sout = p.out + (gla ? O_SGS : O_SHS) + (size_t)j * 16 * per_b + so; }
        else { a.s0 = nullptr; a.sout = p.out + (gla ? O_SGP : O_SHP) + (size_t)j * 8 * per_b + so; }
        a.sstride = vdim;
        mixer_chain(lds, a);
    }
    const int xq = gla ? 3584 : 4096;
    for (int it = w; it < 256 + 64; it += G) {
        const bf16_t* Kb; const bf16_t* Vb; bf16_t* Qp; int nrows;
        if (it < 256) { const int bh = it >> 3, grp = it & 7, b = bh >> 2, h = bh & 3;
            Kb = (const bf16_t*)(p.ws + WS_MKB) + ((size_t)layer * 2048 + b * 256) * 512 + h * 128;
            Vb = (const bf16_t*)(p.ws + WS_MVB) + ((size_t)layer * 2048 + b * 256) * 512 + h * 128;
            Qp = proj + ((size_t)b * 8192 + grp * 1024) * ld + xq + h * 128; nrows = 1024;
        } else { const int bh = it - 256, b = bh >> 2, h = bh & 3;
            Kb = (const bf16_t*)(p.ws + WS_CKB) + ((size_t)layer * 4096 + b * 256) * 512 + h * 128;
            Vb = (const bf16_t*)(p.ws + WS_CVB) + ((size_t)layer * 4096 + b * 256) * 512 + h * 128;
            Qp = proj + ((size_t)MP + b * 64) * ld + xq + h * 128; nrows = 64;
        }
        mem_attn(lds, Kb, Vb, Qp, ld, nrows);
    }
}

constexpr int NPHASE = 2 + 4 * 11;
__global__ void __launch_bounds__(NTHR, 2) trunk_fwd(Params p) {
    extern __shared__ __attribute__((aligned(16))) unsigned char lds_raw[];
    LAS unsigned char* lds = (LAS unsigned char*)lds_raw;
    unsigned char* ws = p.ws;
    float* xf = p.out + O_Y;
    bf16_t* xn = (bf16_t*)(ws + WS_XN);
    bf16_t* proj = (bf16_t*)(ws + WS_PROJ);
    for (int ph = p.ph_lo; ph < p.ph_hi; ++ph) {
        if (ph == 0) prep_phase(lds, p);
        else if (ph == 1) { Epi E{EPI_MEMKV, nullptr, 0, nullptr, 0.f, p.out + O_MK, p.out + O_MV, (bf16_t*)(ws + WS_MKB), (bf16_t*)(ws + WS_MVB)};
            gemm_phase<EPI_MEMKV>(lds, (const bf16_t*)(ws + WS_MEMP), 1024, (const bf16_t*)(ws + WS_MEMW), 2048, 4096, 1024, E); }
        else {
            const int layer = (ph - 2) / 11, s = (ph - 2) % 11, gla = layer & 1, j = layer >> 1;
            if (s == 0 || s == 8) { const int lf = layer * 2 + (s == 8);
                Epi E{EPI_SWIGLU, proj, FF, nullptr, 0.f, nullptr, nullptr, nullptr, nullptr};
                gemm_phase<EPI_SWIGLU>(lds, xn, 1024, (const bf16_t*)(ws + WS_WGU) + (size_t)lf * 5632 * 1024, MROWS, 5632, 1024, E); }
            else if (s == 1 || s == 9) { const int lf = layer * 2 + (s == 9);
                Epi E{EPI_RES, nullptr, 0, xf, 0.5f, nullptr, nullptr, nullptr, nullptr};
                gemm_phase<EPI_RES>(lds, proj, FF, (const bf16_t*)(ws + WS_WD) + (size_t)lf * 1024 * FF, MROWS, 1024, FF, E); }
            else if (s == 2 || s == 7 || s == 10) { const int li = layer * 3 + (s == 2 ? 0 : (s == 7 ? 1 : 2));
                ln_phase(xf, xn, p.in[10] + li * 1024, p.in[11] + li * 1024); }
            else if (s == 3) {
                Epi E{EPI_BF16, proj, gla ? GL_LD : HG_LD, nullptr, 0.f, nullptr, nullptr, nullptr, nullptr};
                if (gla) gemm_phase<EPI_BF16>(lds, xn, 1024, (const bf16_t*)(ws + WS_GWIN) + (size_t)j * 4096 * 1024, MROWS, 4096, 1024, E);
                else gemm_phase<EPI_BF16>(lds, xn, 1024, (const bf16_t*)(ws + WS_HWIN) + (size_t)j * 4608 * 1024, MROWS, 4608, 1024, E); }
            else if (s == 4) mixer_phase(lds, p, layer);
            else if (s == 5) { if (gla) headnorm_phase(proj, GL_LD, 2560, 1536, 32, p.in[19] + j * 1024); else headnorm_phase(proj, HG_LD, 3072, 2048, 16, p.in[14] + j * 1024); }
            else if (s == 6) {
                Epi E{EPI_RES, nullptr, 0, xf, 1.0f, nullptr, nullptr, nullptr, nullptr};
                gemm_phase<EPI_RES>(lds, proj + (gla ? 2560 : 3072), gla ? GL_LD : HG_LD, (const bf16_t*)(ws + WS_WOUT) + (size_t)layer * 1024 * 1536, MROWS, 1024, 1536, E); }
        }
        if (ph + 1 < p.ph_hi) { __threadfence(); cg::this_grid().sync(); }
    }
}

extern "C" void kernel_launch(void* const* d_in, const int* in_sizes, int n_in, void* d_out, int out_size, void* d_ws, size_t ws_size, hipStream_t stream) {
    static int grid = 0;
    if (grid == 0) {
        if (n_in != 23 || ws_size < WS_END) { fprintf(stderr, "kernel_launch: need 23 inputs and %zu bytes of workspace; got %d, %zu\n", (size_t)WS_END, n_in, ws_size); grid = -1; return; }
        if (hipFuncSetAttribute((const void*)trunk_fwd, hipFuncAttributeMaxDynamicSharedMemorySize, LDS_BYTES) != hipSuccess) { fprintf(stderr, "kernel_launch: hipFuncSetAttribute failed\n"); grid = -1; return; }
        int dev = 0, cus = 0, per_cu = 0;
        (void)hipGetDevice(&dev); (void)hipDeviceGetAttribute(&cus, hipDeviceAttributeMultiprocessorCount, dev);
        (void)hipOccupancyMaxActiveBlocksPerMultiprocessor(&per_cu, (const void*)trunk_fwd, NTHR, LDS_BYTES);
        if (per_cu < 1) { fprintf(stderr, "kernel_launch: occupancy query says %d blocks per CU\n", per_cu); per_cu = 1; }
        (void)hipGetLastError();
        grid = cus;
    }
    if (grid < 0) return;
    Params p{};
    for (int i = 0; i < 23; ++i) p.in[i] = (const float*)d_in[i];
    p.out = (float*)d_out; p.ws = (unsigned char*)d_ws;
#if ONE_LAUNCH
    p.ph_lo = 0; p.ph_hi = NPHASE;
    void* args[] = {&p};
    hipError_t e = hipLaunchCooperativeKernel((const void*)trunk_fwd, dim3(grid), dim3(NTHR), args, LDS_BYTES, stream);
    if (e != hipSuccess) fprintf(stderr, "cooperative launch failed: %s (grid %d)\n", hipGetErrorString(e), grid);
#else
    for (int ph = 0; ph < NPHASE; ++ph) {
        p.ph_lo = ph; p.ph_hi = ph + 1;
        hipLaunchKernelGGL(trunk_fwd, dim3(grid), dim3(NTHR), LDS_BYTES, stream, p);
    }
#endif
}
```

```cpp
#include <hip/hip_runtime.h>
#include <hip/hip_cooperative_groups.h>
#include <cstdio>
namespace cg = cooperative_groups;

#ifndef ONE_LAUNCH
#define ONE_LAUNCH 1
#endif

#define LAS __attribute__((address_space(3)))
typedef unsigned short bf16_t;
typedef short bf16x8 __attribute__((ext_vector_type(8)));
typedef float f32x4 __attribute__((ext_vector_type(4)));
typedef float f32x2 __attribute__((ext_vector_type(2)));
typedef unsigned u32x4 __attribute__((ext_vector_type(4)));
typedef unsigned u32x2 __attribute__((ext_vector_type(2)));
typedef __bf16 nbf2 __attribute__((ext_vector_type(2)));

constexpr int D = 1024, MP = 65536, MS = 1024, MROWS = MP + MS, FF = 2816;
constexpr int HG_LD = 4608, GL_LD = 4096;
constexpr float ALPHA = 1.6817928305074292f;
constexpr int NTHR = 512;
constexpr int LDS_BYTES = 132 * 1024;

constexpr size_t O_Y = 0;
constexpr size_t O_SHP = (size_t)MROWS * D;
constexpr size_t O_SGP = O_SHP + 2u * 8 * 8 * 128 * 128;
constexpr size_t O_MK = O_SGP + 2u * 8 * 4 * 128 * 256;
constexpr size_t O_MV = O_MK + 4u * 2048 * 512;
constexpr size_t O_SHS = O_MV + 4u * 2048 * 512;
constexpr size_t O_SGS = O_SHS + 2u * 16 * 8 * 128 * 128;

constexpr size_t WS_WGU = 0;
constexpr size_t WS_WD = WS_WGU + 8ull * 5632 * 1024 * 2;
constexpr size_t WS_HWIN = WS_WD + 8ull * 1024 * 2816 * 2;
constexpr size_t WS_GWIN = WS_HWIN + 2ull * 4608 * 1024 * 2;
constexpr size_t WS_WOUT = WS_GWIN + 2ull * 4096 * 1024 * 2;
constexpr size_t WS_MEMW = WS_WOUT + 4ull * 1024 * 1536 * 2;
constexpr size_t WS_MEMP = WS_MEMW + 4096ull * 1024 * 2;
constexpr size_t WS_MKB = WS_MEMP + 2048ull * 1024 * 2;
constexpr size_t WS_MVB = WS_MKB + 4ull * 2048 * 512 * 2;
constexpr size_t WS_CKB = WS_MVB + 4ull * 2048 * 512 * 2;
constexpr size_t WS_CVB = WS_CKB + 4ull * 4096 * 512 * 2;
constexpr size_t WS_XN = WS_CVB + 4ull * 4096 * 512 * 2;
constexpr size_t WS_PROJ = WS_XN + (size_t)MROWS * 1024 * 2;
constexpr size_t WS_VEC = WS_PROJ + (size_t)MROWS * 4608 * 2;
constexpr size_t WS_BAR = WS_VEC + 3ull * (MROWS / 64) * 1024 * 4;
constexpr size_t WS_END = WS_BAR + 16384;

struct Params {
    const float* in[23];
    float* out;
    unsigned char* ws;
    int ph_lo, ph_hi;
};

__device__ __forceinline__ unsigned pk2(float lo, float hi) { f32x2 v = {lo, hi}; nbf2 b = __builtin_convertvector(v, nbf2); return __builtin_bit_cast(unsigned, b); }
__device__ __forceinline__ float bflo(unsigned u) { return __uint_as_float(u << 16); }
__device__ __forceinline__ float bfhi(unsigned u) { return __uint_as_float(u & 0xffff0000u); }
__device__ __forceinline__ bf16_t f2bf(float f) { unsigned u = pk2(f, 0.f); return (bf16_t)(u & 0xffffu); }
__device__ __forceinline__ float sigmoidf_(float x) { return 1.0f / (1.0f + __expf(-x)); }
__device__ __forceinline__ int ltid() { int t = threadIdx.x; asm volatile("" : "+v"(t)); return t; }
__device__ __forceinline__ int lbid() { int t = blockIdx.x; asm volatile("" : "+s"(t)); return t; }
#define MFMA16(a, b, c) __builtin_amdgcn_mfma_f32_16x16x32_bf16((a), (b), (c), 0, 0, 0)

constexpr int BM = 256, BK = 64, HALF = 128, HTB = HALF * BK * 2, NXCD = 8, WGM = 8;
__device__ __forceinline__ int lds_byte(int r, int c) { const int st = (r >> 4) * 2 + (c >> 5), rr = r & 15, cc = c & 31, ob = rr * 64 + cc * 2; return st * 1024 + (ob ^ (((ob >> 9) & 1) << 5)); }
__device__ __forceinline__ void stage_rc(int b, int& R, int& C) { const int st = b / 1024, sb = b % 1024, swz = sb ^ (((sb >> 9) & 1) << 5); R = (st >> 1) * 16 + swz / 64; C = (st & 1) * 32 + (swz % 64) / 2; }
__device__ __forceinline__ int perm32(int rho) { const int n = rho >> 4, i = rho & 15; return 8 * (i >> 2) + 4 * n + (i & 3); }

struct Unit { int pm, pn; };
struct StaticOrder {
    int nM, nN, nwg, G, c;
    __device__ __forceinline__ void init(int M, int N, int G_, int c_) { nM = M / BM; nN = N / BM; nwg = nM * nN; G = G_; c = c_; }
    __device__ __forceinline__ bool next(int i, Unit& u) const {
        const long L = (long)i * G + c; if (L >= nwg) return false;
        int wgid = (int)L; { const int q = nwg / NXCD, r = nwg % NXCD, xcd = wgid % NXCD, off = wgid / NXCD; wgid = (xcd < r ? xcd * (q + 1) : r * (q + 1) + (xcd - r) * q) + off; }
        const int nig = WGM * nN, gid = wgid / nig, fm = gid * WGM, gsz = (nM - fm) < WGM ? (nM - fm) : WGM;
        u.pm = fm + ((wgid % nig) % gsz); u.pn = (wgid % nig) / gsz; return true;
    }
};

enum { EPI_SWIGLU = 0, EPI_BF16 = 1, EPI_RES = 2, EPI_MEMKV = 3 };
struct Epi { int mode; bf16_t* ob; int ldo; float* xf; float scale; float* mk_out; float* mv_out; bf16_t* mkb; bf16_t* mvb; };

template <int MODE> __device__ __forceinline__ void gemm_epilogue(const f32x4 (&acc)[2][2][4][2], const Unit& u, int wr, int wc, int fr, int fq, const Epi& E) {
    const int row0 = u.pm * BM + wr * 64 + fr;
    if constexpr (MODE == EPI_SWIGLU) {
        const int col0 = u.pn * 128 + wc * 32 + 8 * fq;
#pragma unroll
        for (int ai = 0; ai < 2; ++ai)
#pragma unroll
            for (int m = 0; m < 4; ++m) {
                bf16_t* rowp = E.ob + (size_t)(row0 + ai * HALF + m * 16) * E.ldo + col0;
                float h[8];
#pragma unroll
                for (int n = 0; n < 2; ++n)
#pragma unroll
                    for (int j = 0; j < 4; ++j) { const float g = acc[ai][0][m][n][j], up = acc[ai][1][m][n][j]; h[n * 4 + j] = g * up * __builtin_amdgcn_rcpf(1.0f + __expf(-g)); }
                u32x4 w; w.x = pk2(h[0], h[1]); w.y = pk2(h[2], h[3]); w.z = pk2(h[4], h[5]); w.w = pk2(h[6], h[7]);
                *(u32x4*)rowp = w;
            }
    } else if constexpr (MODE == EPI_BF16) {
        const int col0 = u.pn * BM + wc * 32 + 8 * fq;
#pragma unroll
        for (int ai = 0; ai < 2; ++ai)
#pragma unroll
            for (int m = 0; m < 4; ++m) {
                bf16_t* rowp = E.ob + (size_t)(row0 + ai * HALF + m * 16) * E.ldo + col0;
#pragma unroll
                for (int bj = 0; bj < 2; ++bj) {
                    const f32x4 v0 = acc[ai][bj][m][0], v1 = acc[ai][bj][m][1];
                    u32x4 w; w.x = pk2(v0[0], v0[1]); w.y = pk2(v0[2], v0[3]); w.z = pk2(v1[0], v1[1]); w.w = pk2(v1[2], v1[3]);
                    *(u32x4*)(rowp + bj * HALF) = w;
                }
            }
    } else if constexpr (MODE == EPI_RES) {
        const int col0 = u.pn * BM + wc * 32 + 4 * fq;
#pragma unroll
        for (int ai = 0; ai < 2; ++ai)
#pragma unroll
            for (int m = 0; m < 4; ++m) {
                float* rowp = E.xf + (size_t)(row0 + ai * HALF + m * 16) * D + col0;
#pragma unroll
                for (int bj = 0; bj < 2; ++bj)
#pragma unroll
                    for (int n = 0; n < 2; ++n) { f32x4 x = *(const f32x4*)(rowp + bj * HALF + n * 16); x = x * ALPHA + acc[ai][bj][m][n] * E.scale; *(f32x4*)(rowp + bj * HALF + n * 16) = x; }
                asm volatile("" ::: "memory");
            }
    } else {
        const int colt = u.pn * BM; const int l = colt >> 10, kv = (colt >> 9) & 1, cc0 = (colt & 511) + wc * 32 + 4 * fq;
        float* of = (kv ? E.mv_out : E.mk_out) + (size_t)l * 2048 * 512;
        bf16_t* ob = (kv ? E.mvb : E.mkb) + (size_t)l * 2048 * 512;
#pragma unroll
        for (int ai = 0; ai < 2; ++ai)
#pragma unroll
            for (int m = 0; m < 4; ++m) {
                const size_t ro = (size_t)(row0 + ai * HALF + m * 16) * 512 + cc0;
#pragma unroll
                for (int bj = 0; bj < 2; ++bj)
#pragma unroll
                    for (int n = 0; n < 2; ++n) { const f32x4 v = acc[ai][bj][m][n]; *(f32x4*)(of + ro + bj * HALF + n * 16) = v; u32x2 w; w.x = pk2(v[0], v[1]); w.y = pk2(v[2], v[3]); *(u32x2*)(ob + ro + bj * HALF + n * 16) = w; }
            }
    }
}

template <int MODE> __device__ __forceinline__ void gemm_phase(LAS unsigned char* lds, const bf16_t* Ag, int lda, const bf16_t* Btg, int M, int N, int K, const Epi& E) {
    int tid_ = threadIdx.x; asm volatile("" : "+v"(tid_));
    const int tid = tid_, wid = __builtin_amdgcn_readfirstlane(tid >> 6), lane = tid & 63, wr = wid >> 2, wc = wid & 3, fr = lane & 15, fq = lane >> 4;
    const int nt = K / BK;
    constexpr bool PERM = (MODE == EPI_SWIGLU || MODE == EPI_BF16);
    StaticOrder S; S.init(M, N, (int)gridDim.x, lbid());
    unsigned voffA[2], voffB[2];
#pragma unroll
    for (int i = 0; i < 2; ++i) { int R, C; stage_rc(tid * 16 + i * 8192, R, C); const int Rb = PERM ? ((R & ~31) + perm32(R & 31)) : R;
        voffA[i] = (unsigned)(R * lda + C) * 2u; voffB[i] = (unsigned)(Rb * K + C) * 2u; }
    const size_t kstep = (size_t)(BK * 2);
    const size_t hstepA = (size_t)HALF * lda * 2, hstepB = (size_t)HALF * K * 2;
    const size_t tstepA = 2 * hstepA, tstepB = 2 * hstepB;
    const unsigned ldsw = (unsigned)wid * 1024u;
    const int aoff = lds_byte(wr * 64 + fr, fq * 8), boff = lds_byte(wc * 32 + fr, fq * 8);
#define PG8_SA(b, h) (((b) * 2 + (h)) * HTB)
#define PG8_SB(b, h) ((4 + (b) * 2 + (h)) * HTB)
#define PG8_STAGE(bufoff, gbase, voff) do { _Pragma("unroll") for (int _i = 0; _i < 2; ++_i) \
        __builtin_amdgcn_global_load_lds((const unsigned*)((const char*)(gbase) + (voff)[_i]), (LAS unsigned*)(lds + (bufoff) + ldsw + _i * 8192), 16, 0, 0); } while (0)
#define PG8_LDA(dst, b, h) do { _Pragma("unroll") for (int m = 0; m < 4; ++m) _Pragma("unroll") for (int k = 0; k < 2; ++k) dst[m][k] = *(const LAS bf16x8*)(lds + PG8_SA(b, h) + aoff + m * 2048 + k * 1024); } while (0)
#define PG8_LDB(dst, b, h) do { _Pragma("unroll") for (int n = 0; n < 2; ++n) _Pragma("unroll") for (int k = 0; k < 2; ++k) dst[n][k] = *(const LAS bf16x8*)(lds + PG8_SB(b, h) + boff + n * 2048 + k * 1024); } while (0)
#define PG8_MMA(ai, bj, At, Bt) do { __builtin_amdgcn_s_setprio(1); _Pragma("unroll") for (int m = 0; m < 4; ++m) _Pragma("unroll") for (int n = 0; n < 2; ++n) _Pragma("unroll") for (int k = 0; k < 2; ++k) \
        acc[ai][bj][m][n] = __builtin_amdgcn_mfma_f32_16x16x32_bf16(Bt[n][k], At[m][k], acc[ai][bj][m][n], 0, 0, 0); __builtin_amdgcn_s_setprio(0); } while (0)
#define PG8_WAIT_V(n) asm volatile("s_waitcnt vmcnt(" #n ")" ::: "memory")
#define PG8_WAIT_L(n) asm volatile("s_waitcnt lgkmcnt(" #n ")" ::: "memory")
#define PG8_BAR __builtin_amdgcn_s_barrier()
#define PG8_SCHED __builtin_amdgcn_sched_barrier(0)
    Unit cur, nxt; int ui = 0;
    if (!S.next(0, cur)) return;
    f32x4 acc[2][2][4][2];
#pragma unroll
    for (int a = 0; a < 2; ++a)
#pragma unroll
        for (int b = 0; b < 2; ++b)
#pragma unroll
            for (int m = 0; m < 4; ++m)
#pragma unroll
                for (int n = 0; n < 2; ++n) acc[a][b][m][n] = (f32x4){0.f, 0.f, 0.f, 0.f};
    bf16x8 At[4][2], B0[2][2], B1[2][2];
    const char* cA = (const char*)Ag + (size_t)cur.pm * tstepA; const char* cB = (const char*)Btg + (size_t)cur.pn * tstepB;
    PG8_STAGE(PG8_SB(0, 0), cB, voffB); PG8_STAGE(PG8_SA(0, 0), cA, voffA); PG8_STAGE(PG8_SB(0, 1), cB + hstepB, voffB); PG8_STAGE(PG8_SA(0, 1), cA + hstepA, voffA);
    if (wr == 1) PG8_BAR;
    PG8_WAIT_V(4); PG8_BAR;
    PG8_STAGE(PG8_SB(1, 0), cB + kstep, voffB); PG8_STAGE(PG8_SA(1, 0), cA + kstep, voffA); PG8_STAGE(PG8_SB(1, 1), cB + hstepB + kstep, voffB);
    PG8_WAIT_V(6); PG8_BAR;
    for (;;) {
        const bool has_next = S.next(ui + 1, nxt);
        const char* nA = has_next ? (const char*)Ag + (size_t)nxt.pm * tstepA : cA; const char* nB = has_next ? (const char*)Btg + (size_t)nxt.pn * tstepB : cB;
        for (int t = 0; t < nt; t += 2) {
            const bool last = (t == nt - 2);
            const char* a1 = cA + (size_t)(t + 1) * kstep;
            const char* a2 = last ? nA : cA + (size_t)(t + 2) * kstep; const char* b2 = last ? nB : cB + (size_t)(t + 2) * kstep;
            const char* a3 = a2 + kstep; const char* b3 = b2 + kstep;
            PG8_LDB(B0, 0, 0); PG8_SCHED; PG8_LDA(At, 0, 0); PG8_STAGE(PG8_SA(1, 1), a1 + hstepA, voffA);
            PG8_WAIT_L(8); PG8_BAR; PG8_WAIT_L(0); PG8_MMA(0, 0, At, B0); PG8_BAR; PG8_SCHED;
            PG8_LDB(B1, 0, 1); PG8_STAGE(PG8_SB(0, 0), b2, voffB);
            PG8_BAR; PG8_WAIT_L(0); PG8_MMA(0, 1, At, B1); PG8_BAR;
            PG8_LDA(At, 0, 1); PG8_STAGE(PG8_SA(0, 0), a2, voffA);
            PG8_BAR; PG8_WAIT_L(0); PG8_MMA(1, 0, At, B0); PG8_BAR; PG8_SCHED;
            PG8_STAGE(PG8_SB(0, 1), b2 + hstepB, voffB);
            PG8_WAIT_V(6); PG8_BAR; PG8_MMA(1, 1, At, B1); PG8_BAR;
            PG8_LDB(B0, 1, 0); PG8_SCHED; PG8_LDA(At, 1, 0); PG8_STAGE(PG8_SA(0, 1), a2 + hstepA, voffA);
            PG8_WAIT_L(8); PG8_BAR; PG8_WAIT_L(0); PG8_MMA(0, 0, At, B0); PG8_BAR; PG8_SCHED;
            PG8_LDB(B1, 1, 1); PG8_STAGE(PG8_SB(1, 0), b3, voffB);
            PG8_BAR; PG8_WAIT_L(0); PG8_MMA(0, 1, At, B1); PG8_BAR;
            PG8_LDA(At, 1, 1); PG8_STAGE(PG8_SA(1, 0), a3, voffA);
            PG8_BAR; PG8_WAIT_L(0); PG8_MMA(1, 0, At, B0); PG8_BAR; PG8_SCHED;
            PG8_STAGE(PG8_SB(1, 1), b3 + hstepB, voffB);
            PG8_WAIT_V(6); PG8_BAR; PG8_MMA(1, 1, At, B1); PG8_BAR;
        }
        gemm_epilogue<MODE>(acc, cur, wr, wc, fr, fq, E);
        if (!has_next) break;
#pragma unroll
        for (int a = 0; a < 2; ++a)
#pragma unroll
            for (int b = 0; b < 2; ++b)
#pragma unroll
                for (int m = 0; m < 4; ++m)
#pragma unroll
                    for (int n = 0; n < 2; ++n) acc[a][b][m][n] = (f32x4){0.f, 0.f, 0.f, 0.f};
        cur = nxt; cA = nA; cB = nB; ++ui;
    }
    PG8_WAIT_V(0);
    if (wr == 0) PG8_BAR;
    PG8_BAR;
#undef PG8_SA
#undef PG8_SB
#undef PG8_STAGE
#undef PG8_LDA
#undef PG8_LDB
#undef PG8_MMA
#undef PG8_WAIT_V
#undef PG8_WAIT_L
#undef PG8_BAR
#undef PG8_SCHED
}

__device__ __forceinline__ void transpose_job(LAS unsigned char* lds, const float* src, int ld, int K, int c0, int ncols, bf16_t* dst, int rowmode, int drow0) {
    LAS float* tile = (LAS float*)lds;
    int tid_ = threadIdx.x; asm volatile("" : "+v"(tid_)); const int tid = tid_;
    const int nkt = K / 64, nct = ncols / 64, ntiles = nkt * nct;
    for (int t = lbid(); t < ntiles; t += gridDim.x) {
        const int kt = t % nkt, ct = t / nkt;
        const int k0 = kt * 64, n0 = ct * 64;
        { const int kr = tid >> 4, c4 = (tid & 15) * 4;
#pragma unroll
          for (int rr = 0; rr < 64; rr += 32) { const f32x4 v = *(const f32x4*)(src + (size_t)(k0 + kr + rr) * ld + c0 + n0 + c4);
              tile[(kr + rr) * 65 + c4 + 0] = v[0]; tile[(kr + rr) * 65 + c4 + 1] = v[1]; tile[(kr + rr) * 65 + c4 + 2] = v[2]; tile[(kr + rr) * 65 + c4 + 3] = v[3]; } }
        __syncthreads();
        { const int n = tid >> 3, k8 = (tid & 7) * 8; float v[8];
#pragma unroll
          for (int i = 0; i < 8; ++i) v[i] = tile[(k8 + i) * 65 + n];
          const int c = c0 + n0 + n; int drow;
          if (rowmode == 0) drow = drow0 + c; else drow = 256 * (c >> 7) + (c & 127) + (rowmode == 2 ? 128 : 0);
          u32x4 w; w.x = pk2(v[0], v[1]); w.y = pk2(v[2], v[3]); w.z = pk2(v[4], v[5]); w.w = pk2(v[6], v[7]);
          *(u32x4*)(dst + (size_t)drow * K + k0 + k8) = w; }
        __syncthreads();
    }
}
__device__ __forceinline__ void convert_job(const float* src, bf16_t* dst, float* dstf, size_t n) {
    const size_t nv = n / 8;
    for (size_t i = (size_t)lbid() * NTHR + ltid(); i < nv; i += (size_t)gridDim.x * NTHR) {
        const f32x4 a = *(const f32x4*)(src + i * 8), b = *(const f32x4*)(src + i * 8 + 4);
        u32x4 w; w.x = pk2(a[0], a[1]); w.y = pk2(a[2], a[3]); w.z = pk2(b[0], b[1]); w.w = pk2(b[2], b[3]);
        *(u32x4*)(dst + i * 8) = w;
        if (dstf) { *(f32x4*)(dstf + i * 8) = a; *(f32x4*)(dstf + i * 8 + 4) = b; }
    }
}
__device__ __forceinline__ void prep_phase(LAS unsigned char* lds, const Params& p) {
    unsigned char* ws = p.ws;
    for (int jb = 0; jb < 52; ++jb) {
        const float* src; int ld, K, c0, ncols, rowmode, drow0; bf16_t* dst;
        if (jb < 24) { const int lf = jb / 3, t = jb % 3;
            if (t < 2) { src = (t == 0 ? p.in[7] : p.in[8]) + (size_t)lf * 1024 * FF; ld = FF; K = 1024; c0 = 0; ncols = FF; dst = (bf16_t*)(ws + WS_WGU) + (size_t)lf * 5632 * 1024; rowmode = 1 + t; drow0 = 0; }
            else { src = p.in[9] + (size_t)lf * FF * 1024; ld = 1024; K = FF; c0 = 0; ncols = 1024; dst = (bf16_t*)(ws + WS_WD) + (size_t)lf * 1024 * FF; rowmode = 0; drow0 = 0; }
        } else if (jb < 44) { const int j = (jb - 24) / 10, t = (jb - 24) % 10; rowmode = 0; K = 1024;
            if (t < 4) {
                src = p.in[12] + (size_t)j * 1024 * 4608; ld = 4608; dst = (bf16_t*)(ws + WS_HWIN) + (size_t)j * 4608 * 1024;
                c0 = t == 0 ? 0 : (t == 1 ? 3072 : (t == 2 ? 2048 : 4096)); ncols = t == 0 ? 2048 : (t == 3 ? 512 : 1024); drow0 = (t == 0 ? 0 : (t == 1 ? 2048 : (t == 2 ? 3072 : 4096))) - c0;
            } else if (t < 8) {
                src = p.in[16] + (size_t)j * 1024 * 3600; ld = 3600; dst = (bf16_t*)(ws + WS_GWIN) + (size_t)j * 4096 * 1024; const int u = t - 4;
                c0 = u == 0 ? 0 : (u == 1 ? 2048 : (u == 2 ? 1024 : 3088)); ncols = u == 3 ? 512 : 1024; drow0 = (u == 0 ? 0 : (u == 1 ? 1536 : (u == 2 ? 2560 : 3584))) - c0;
            } else { src = (t == 8 ? p.in[15] : p.in[20]) + (size_t)j * 1536 * 1024; ld = 1024; K = 1536; c0 = 0; ncols = 1024; dst = (bf16_t*)(ws + WS_WOUT) + (size_t)(2 * j + (t - 8)) * 1024 * 1536; drow0 = 0; }
        } else { const int l = (jb - 44) >> 1, kv = (jb - 44) & 1; src = (kv ? p.in[22] : p.in[21]) + (size_t)l * 1024 * 512; ld = 512; K = 1024; c0 = 0; ncols = 512; dst = (bf16_t*)(ws + WS_MEMW); rowmode = 0; drow0 = l * 1024 + kv * 512; }
        transpose_job(lds, src, ld, K, c0, ncols, dst, rowmode, drow0);
    }
    for (int j = 0; j < 2; ++j) {
        const float* gs = p.in[16] + (size_t)j * 1024 * 3600; bf16_t* gd = (bf16_t*)(ws + WS_GWIN) + (size_t)j * 4096 * 1024;
        const float* w2 = p.in[17] + (size_t)j * 16 * 512;
        for (int i = lbid() * NTHR + ltid(); i < 512 * 1024; i += gridDim.x * NTHR) {
            const int c = i >> 10, kk = i & 1023; float sacc = 0.f;
#pragma unroll
            for (int r = 0; r < 16; ++r) sacc += gs[(size_t)kk * 3600 + 3072 + r] * w2[r * 512 + c];
            gd[(size_t)(1024 + c) * 1024 + kk] = f2bf(sacc);
        }
    }
    for (int jb = 0; jb < 5; ++jb) {
        const float* src; bf16_t* dst; float* dstf = nullptr; size_t n;
        if (jb == 0) { src = p.in[0]; dst = (bf16_t*)(ws + WS_XN); dstf = p.out + O_Y; n = (size_t)MP * D; }
        else if (jb == 1) { src = p.in[1]; dst = (bf16_t*)(ws + WS_XN) + (size_t)MP * D; dstf = p.out + O_Y + (size_t)MP * D; n = (size_t)MS * D; }
        else if (jb == 2) { src = p.in[2]; dst = (bf16_t*)(ws + WS_MEMP); n = (size_t)2048 * 1024; }
        else if (jb == 3) { src = p.in[3]; dst = (bf16_t*)(ws + WS_CKB); n = (size_t)4 * 4096 * 512; }
        else { src = p.in[4]; dst = (bf16_t*)(ws + WS_CVB); n = (size_t)4 * 4096 * 512; }
        convert_job(src, dst, dstf, n);
    }
}

__device__ __forceinline__ void ln_phase(float* x, bf16_t* xn, const float* gain, const float* bias) {
    int tid_ = threadIdx.x; asm volatile("" : "+v"(tid_));
    const int lane = tid_ & 63, wv = tid_ >> 6;
    f32x4 g[4], b[4];
#pragma unroll
    for (int i = 0; i < 4; ++i) { g[i] = *(const f32x4*)(gain + 4 * lane + 256 * i); b[i] = *(const f32x4*)(bias + 4 * lane + 256 * i); }
    for (int row = lbid() * 8 + wv; row < MROWS; row += gridDim.x * 8) {
        float* xr = x + (size_t)row * D; f32x4 v[4]; float s = 0.f;
#pragma unroll
        for (int i = 0; i < 4; ++i) { v[i] = *(const f32x4*)(xr + 4 * lane + 256 * i); s += (v[i][0] + v[i][1]) + (v[i][2] + v[i][3]); }
#pragma unroll
        for (int o = 32; o >= 1; o >>= 1) s += __shfl_xor(s, o);
        const float mu = s * (1.0f / 1024.0f); float q = 0.f;
#pragma unroll
        for (int i = 0; i < 4; ++i) { const f32x4 d = v[i] - mu; q += (d[0] * d[0] + d[1] * d[1]) + (d[2] * d[2] + d[3] * d[3]); }
#pragma unroll
        for (int o = 32; o >= 1; o >>= 1) q += __shfl_xor(q, o);
        const float rs = 1.0f / sqrtf(q * (1.0f / 1024.0f) + 1e-5f);
#pragma unroll
        for (int i = 0; i < 4; ++i) { const f32x4 o = (v[i] - mu) * rs * g[i] + b[i]; *(f32x4*)(xr + 4 * lane + 256 * i) = o;
            u32x2 w; w.x = pk2(o[0], o[1]); w.y = pk2(o[2], o[3]); *(u32x2*)(xn + (size_t)row * D + 4 * lane + 256 * i) = w; }
    }
}

__device__ __forceinline__ void headnorm_phase(bf16_t* proj, int ld, int ocol, int gcol, int lanes_per_head  , const float* gain) {
    int tid_ = threadIdx.x; asm volatile("" : "+v"(tid_));
    const int lane = tid_ & 63, wv = tid_ >> 6;
    float gn[2][8];
#pragma unroll
    for (int hh = 0; hh < 2; ++hh)
#pragma unroll
        for (int i = 0; i < 8; ++i) gn[hh][i] = gain[hh * 512 + 8 * lane + i];
    const float invn = lanes_per_head == 16 ? (1.0f / 128.0f) : (1.0f / 256.0f);
    for (int row = lbid() * 8 + wv; row < MROWS; row += gridDim.x * 8) {
        bf16_t* pr = proj + (size_t)row * ld;
#pragma unroll
        for (int hh = 0; hh < 2; ++hh) {
            const u32x4 ov = *(const u32x4*)(pr + ocol + hh * 512 + 8 * lane), gv = *(const u32x4*)(pr + gcol + hh * 512 + 8 * lane);
            float o[8], g[8];
#pragma unroll
            for (int i = 0; i < 4; ++i) { o[2 * i] = bflo(ov[i]); o[2 * i + 1] = bfhi(ov[i]); g[2 * i] = bflo(gv[i]); g[2 * i + 1] = bfhi(gv[i]); }
            float s = 0.f;
#pragma unroll
            for (int i = 0; i < 8; ++i) s += o[i] * o[i];
            s += __shfl_xor(s, 1); s += __shfl_xor(s, 2); s += __shfl_xor(s, 4); s += __shfl_xor(s, 8);
            if (lanes_per_head == 32) s += __shfl_xor(s, 16);
            const float rs = 1.0f / sqrtf(s * invn + 1e-6f);
            float r[8];
#pragma unroll
            for (int i = 0; i < 8; ++i) r[i] = o[i] * rs * gn[hh][i] * g[i] * sigmoidf_(g[i]);
            u32x4 w; w.x = pk2(r[0], r[1]); w.y = pk2(r[2], r[3]); w.z = pk2(r[4], r[5]); w.w = pk2(r[6], r[7]);
            *(u32x4*)(pr + ocol + hh * 512 + 8 * lane) = w;
        }
    }
}

constexpr int MP_G = 0, MP_T = 32768, MP_KTT = 34816, MP_END = MP_KTT + 128 * 72 * 2;
static_assert(MP_END <= 131072, "prepass LDS");

struct PrepArgs {
    bf16_t* proj; int ld; size_t row0; int qcol, kcol, gcol; int gla;
    const float* lb0; const float* lb1; int lbj; const float* bgate;
    bf16_t* ktb;
    float* em; float* el; float* elm;
};

__device__ __forceinline__ void mixprep_item(LAS unsigned char* lds, const PrepArgs& a) {
    int tid_ = threadIdx.x; asm volatile("" : "+v"(tid_));
    const int tid = tid_;
    LAS float* G = (LAS float*)(lds + MP_G); LAS float* T = (LAS float*)(lds + MP_T); LAS bf16_t* KTT = (LAS bf16_t*)(lds + MP_KTT);
    const int t0 = tid >> 4, cv = tid & 15, c8 = cv * 8;
    float cA[8], cB[8];
#pragma unroll
    for (int i = 0; i < 8; ++i) {
        if (a.gla) { cA[i] = a.bgate[c8 + i]; cB[i] = 0.f; }
        else { float lb = 0.f; if (a.lbj == 1) lb = sigmoidf_(a.lb1[c8 + i] - a.lb0[c8 + i]); cA[i] = lb; cB[i] = 1.0f - lb; }
    }
    const float qscale = 0.08838834764831845f;
    bf16_t* base = a.proj + a.row0 * a.ld;
    float qv[2][8], kv[2][8];
#pragma unroll
    for (int rr = 0; rr < 2; ++rr) {
        const bf16_t* rp = base + (size_t)(t0 + 32 * rr) * a.ld + c8;
        const u32x4 rq = *(const u32x4*)(rp + a.qcol), rk = *(const u32x4*)(rp + a.kcol);
        u32x4 rg = {0u, 0u, 0u, 0u}; if (a.gla) rg = *(const u32x4*)(rp + a.gcol);
        float gvv[8];
#pragma unroll
        for (int i = 0; i < 8; ++i) {
            const unsigned uq = rq[i >> 1], uk = rk[i >> 1], ug = rg[i >> 1];
            const float q = (i & 1) ? bfhi(uq) : bflo(uq), k = (i & 1) ? bfhi(uk) : bflo(uk);
            if (a.gla) {
                const float g = ((i & 1) ? bfhi(ug) : bflo(ug)) + cA[i];
                qv[rr][i] = q * qscale; kv[rr][i] = k;
                gvv[i] = (fminf(g, 0.f) - __logf(1.0f + __expf(-fabsf(g)))) * (1.0f / 16.0f);
            } else {
                qv[rr][i] = q * sigmoidf_(q) * qscale;
                const float e = __expf(-k), r = 1.0f / (1.0f + e);
                kv[rr][i] = cB[i] * e * r;
                gvv[i] = __logf(fmaxf(cA[i] + cB[i] * r, 1e-6f));
            }
        }
        LAS float* gp = G + (t0 + 32 * rr) * 128 + c8;
        *(LAS f32x4*)gp = (f32x4){gvv[0], gvv[1], gvv[2], gvv[3]}; *(LAS f32x4*)(gp + 4) = (f32x4){gvv[4], gvv[5], gvv[6], gvv[7]};
    }
    __syncthreads();
    { const int k = tid & 127, sg = tid >> 7; float run = 0.f;
#pragma unroll
      for (int i = 0; i < 16; ++i) { run += G[(16 * sg + i) * 128 + k]; G[(16 * sg + i) * 128 + k] = run; }
      T[sg * 128 + k] = run; }
    __syncthreads();
    {
        float tA[8], tB[8], tC[8], bmid[8], blast[8];
        { const f32x4 x0 = *(const LAS f32x4*)(T + c8), x1 = *(const LAS f32x4*)(T + c8 + 4), y0 = *(const LAS f32x4*)(T + 128 + c8), y1 = *(const LAS f32x4*)(T + 128 + c8 + 4),
              z0 = *(const LAS f32x4*)(T + 256 + c8), z1 = *(const LAS f32x4*)(T + 256 + c8 + 4);
          const f32x4 m0 = *(const LAS f32x4*)(G + 31 * 128 + c8), m1 = *(const LAS f32x4*)(G + 31 * 128 + c8 + 4), l0 = *(const LAS f32x4*)(G + 63 * 128 + c8), l1 = *(const LAS f32x4*)(G + 63 * 128 + c8 + 4);
#pragma unroll
          for (int i = 0; i < 4; ++i) { tA[i] = x0[i]; tA[4 + i] = x1[i]; tB[i] = x0[i] + y0[i]; tB[4 + i] = x1[i] + y1[i]; tC[i] = tB[i] + z0[i]; tC[4 + i] = tB[4 + i] + z1[i];
              bmid[i] = m0[i] + tA[i]; bmid[4 + i] = m1[i] + tA[4 + i]; blast[i] = l0[i] + tC[i]; blast[4 + i] = l1[i] + tC[4 + i]; } }
#pragma unroll
        for (int rr = 0; rr < 2; ++rr) {
            const int t = t0 + 32 * rr, sg = t >> 4;
            const f32x4 g0 = *(const LAS f32x4*)(G + t * 128 + c8), g1 = *(const LAS f32x4*)(G + t * 128 + c8 + 4);
            float qt[8], kt[8];
#pragma unroll
            for (int i = 0; i < 8; ++i) {
                const float off = sg == 0 ? 0.f : (sg == 1 ? tA[i] : (sg == 2 ? tB[i] : tC[i]));
                const float b = (i < 4 ? g0[i & 3] : g1[i & 3]) + off;
                qt[i] = qv[rr][i] * __expf(fminf(b - bmid[i], 80.f));
                kt[i] = kv[rr][i] * __expf(fminf(bmid[i] - b, 80.f));
            }
            bf16_t* rp = base + (size_t)t * a.ld + c8;
            u32x4 w;
            w.x = pk2(qt[0], qt[1]); w.y = pk2(qt[2], qt[3]); w.z = pk2(qt[4], qt[5]); w.w = pk2(qt[6], qt[7]); *(u32x4*)(rp + a.qcol) = w;
            w.x = pk2(kt[0], kt[1]); w.y = pk2(kt[2], kt[3]); w.z = pk2(kt[4], kt[5]); w.w = pk2(kt[6], kt[7]); *(u32x4*)(rp + a.kcol) = w;
#pragma unroll
            for (int i = 0; i < 4; ++i) { KTT[(c8 + 2 * i) * 72 + t] = (bf16_t)(w[i] & 0xffffu); KTT[(c8 + 2 * i + 1) * 72 + t] = (bf16_t)(w[i] >> 16); }
        }
        if (t0 == 0) {
            f32x4 v0, v1;
#pragma unroll
            for (int i = 0; i < 4; ++i) { v0[i] = __expf(bmid[i]); v1[i] = __expf(bmid[4 + i]); }
            *(f32x4*)(a.em + c8) = v0; *(f32x4*)(a.em + c8 + 4) = v1;
#pragma unroll
            for (int i = 0; i < 4; ++i) { v0[i] = __expf(blast[i]); v1[i] = __expf(blast[4 + i]); }
            *(f32x4*)(a.el + c8) = v0; *(f32x4*)(a.el + c8 + 4) = v1;
#pragma unroll
            for (int i = 0; i < 4; ++i) { v0[i] = __expf(blast[i] - bmid[i]); v1[i] = __expf(blast[4 + i] - bmid[4 + i]); }
            *(f32x4*)(a.elm + c8) = v0; *(f32x4*)(a.elm + c8 + 4) = v1;
        }
    }
    __syncthreads();
    { const int k = tid >> 2, j = tid & 3;
      const u32x4 w0 = *(const LAS u32x4*)(KTT + k * 72 + 16 * j), w1 = *(const LAS u32x4*)(KTT + k * 72 + 16 * j + 8);
      *(u32x4*)(a.ktb + k * 64 + 16 * j) = w0; *(u32x4*)(a.ktb + k * 64 + 16 * j + 8) = w1; }
    __syncthreads();
}

constexpr int MX_QT = 0, MX_KT = MX_QT + 17408, MX_KTT = MX_KT + 17408, MX_VT = MX_KTT + 18432, MX_PP = MX_VT + 4608, MX_ST = MX_PP + 9216, MX_END = MX_ST + 8704;
static_assert(MX_END <= 131072, "mixer LDS");

struct ChainArgs {
    bf16_t* proj; int ld; size_t row0; int nchunks;
    int qcol, kcol, vcol;
    const bf16_t* ktb;
    size_t ktb_stride;
    const float* em; const float* el; const float* elm; int vec_stride;
    const float* s0; float* sout; int sstride;
};

__device__ __forceinline__ void mixer_chain(LAS unsigned char* lds, const ChainArgs& a) {
    int tid_ = threadIdx.x; asm volatile("" : "+v"(tid_));
    const int tid = tid_, wid = __builtin_amdgcn_readfirstlane(tid >> 6), lane = tid & 63, fr = lane & 15, fq = lane >> 4;
    LAS bf16_t* QT = (LAS bf16_t*)(lds + MX_QT); LAS bf16_t* KT = (LAS bf16_t*)(lds + MX_KT); LAS bf16_t* KTT = (LAS bf16_t*)(lds + MX_KTT);
    LAS bf16_t* VT = (LAS bf16_t*)(lds + MX_VT); LAS bf16_t* PP = (LAS bf16_t*)(lds + MX_PP); LAS bf16_t* ST = (LAS bf16_t*)(lds + MX_ST);
    const int t0 = tid >> 4, c8 = (tid & 15) * 8;
    f32x4 Sacc[2];
#pragma unroll
    for (int vi = 0; vi < 2; ++vi)
#pragma unroll
        for (int j = 0; j < 4; ++j) Sacc[vi][j] = a.s0 ? a.s0[(size_t)(16 * wid + 4 * fq + j) * a.sstride + 16 * vi + fr] : 0.f;
    u32x4 rq[2], rk[2], rkt[2], rv; f32x4 vem, vel, velm;
    rv = (u32x4){0u, 0u, 0u, 0u};
    auto issue_loads = [&](int c) {
        const bf16_t* base = a.proj + (a.row0 + (size_t)c * 64) * a.ld;
#pragma unroll
        for (int rr = 0; rr < 2; ++rr) { const bf16_t* rp = base + (size_t)(t0 + 32 * rr) * a.ld + c8; rq[rr] = *(const u32x4*)(rp + a.qcol); rk[rr] = *(const u32x4*)(rp + a.kcol); }
        const bf16_t* kp = a.ktb + (size_t)c * a.ktb_stride + (tid >> 2) * 64 + 16 * (tid & 3);
        rkt[0] = *(const u32x4*)kp; rkt[1] = *(const u32x4*)(kp + 8);
        if (tid < 256) rv = *(const u32x4*)(base + (size_t)(tid >> 2) * a.ld + a.vcol + 8 * (tid & 3));
        const size_t vo = (size_t)c * a.vec_stride + 16 * wid + 4 * fq;
        vem = *(const f32x4*)(a.em + vo); vel = *(const f32x4*)(a.el + vo); velm = *(const f32x4*)(a.elm + vo);
    };
    issue_loads(0);
    for (int c = 0; c < a.nchunks; ++c) {
#pragma unroll
        for (int rr = 0; rr < 2; ++rr) { *(LAS u32x4*)(QT + (t0 + 32 * rr) * 136 + c8) = rq[rr]; *(LAS u32x4*)(KT + (t0 + 32 * rr) * 136 + c8) = rk[rr]; }
        { LAS bf16_t* kp = KTT + (tid >> 2) * 72 + 16 * (tid & 3); *(LAS u32x4*)kp = rkt[0]; *(LAS u32x4*)(kp + 8) = rkt[1]; }
        if (tid < 256) { const int tv = tid >> 2, v8 = (tid & 3) * 8;
#pragma unroll
            for (int i = 0; i < 8; ++i) VT[(v8 + i) * 72 + tv] = (bf16_t)((i & 1) ? (rv[i >> 1] >> 16) : (rv[i >> 1] & 0xffffu)); }
#pragma unroll
        for (int vi = 0; vi < 2; ++vi) { u32x2 w; w.x = pk2(Sacc[vi][0] * vem[0], Sacc[vi][1] * vem[1]); w.y = pk2(Sacc[vi][2] * vem[2], Sacc[vi][3] * vem[3]); *(LAS u32x2*)(ST + (16 * vi + fr) * 136 + 16 * wid + 4 * fq) = w; }
        const f32x4 cel = vel, celm = velm;
        if (c + 1 < a.nchunks) issue_loads(c + 1);
        __syncthreads();
        { const int ti = wid >> 1;
#pragma unroll
          for (int sh = 0; sh < 2; ++sh) { const int si = 2 * (wid & 1) + sh; f32x4 pa = {0.f, 0.f, 0.f, 0.f};
              if (si <= ti) {
#pragma unroll
                  for (int kk = 0; kk < 4; ++kk) { const bf16x8 A = *(const LAS bf16x8*)(KT + (16 * si + fr) * 136 + 32 * kk + 8 * fq), B = *(const LAS bf16x8*)(QT + (16 * ti + fr) * 136 + 32 * kk + 8 * fq); pa = MFMA16(A, B, pa); }
                  if (si == ti) {
#pragma unroll
                      for (int j = 0; j < 4; ++j) if (4 * fq + j > fr) pa[j] = 0.f; }
              }
              u32x2 w; w.x = pk2(pa[0], pa[1]); w.y = pk2(pa[2], pa[3]); *(LAS u32x2*)(PP + (16 * ti + fr) * 72 + 16 * si + 4 * fq) = w; } }
        __syncthreads();
        { const int ti = wid >> 1, vi = wid & 1; f32x4 o = {0.f, 0.f, 0.f, 0.f};
#pragma unroll
          for (int kk = 0; kk < 2; ++kk) { const bf16x8 A = *(const LAS bf16x8*)(VT + (16 * vi + fr) * 72 + 32 * kk + 8 * fq), B = *(const LAS bf16x8*)(PP + (16 * ti + fr) * 72 + 32 * kk + 8 * fq); o = MFMA16(A, B, o); }
#pragma unroll
          for (int kk = 0; kk < 4; ++kk) { const bf16x8 A = *(const LAS bf16x8*)(ST + (16 * vi + fr) * 136 + 32 * kk + 8 * fq), B = *(const LAS bf16x8*)(QT + (16 * ti + fr) * 136 + 32 * kk + 8 * fq); o = MFMA16(A, B, o); }
          u32x2 w; w.x = pk2(o[0], o[1]); w.y = pk2(o[2], o[3]);
          *(u32x2*)(a.proj + (a.row0 + (size_t)c * 64 + 16 * ti + fr) * a.ld + a.vcol + 16 * vi + 4 * fq) = w; }
#pragma unroll
        for (int vi = 0; vi < 2; ++vi) { f32x4 u = {0.f, 0.f, 0.f, 0.f};
#pragma unroll
            for (int kk = 0; kk < 2; ++kk) { const bf16x8 A = *(const LAS bf16x8*)(KTT + (16 * wid + fr) * 72 + 32 * kk + 8 * fq), B = *(const LAS bf16x8*)(VT + (16 * vi + fr) * 72 + 32 * kk + 8 * fq); u = MFMA16(A, B, u); }
            Sacc[vi] = Sacc[vi] * cel + u * celm; }
        __syncthreads();
    }
#pragma unroll
    for (int vi = 0; vi < 2; ++vi)
#pragma unroll
        for (int j = 0; j < 4; ++j) a.sout[(size_t)(16 * wid + 4 * fq + j) * a.sstride + 16 * vi + fr] = Sacc[vi][j];
}

constexpr int AT_PITCH = 264;
__device__ __forceinline__ void mem_attn(LAS unsigned char* lds, const bf16_t* Kb, const bf16_t* Vb, bf16_t* Q, int ld, int nrows) {
    int tid_ = threadIdx.x; asm volatile("" : "+v"(tid_));
    const int tid = tid_, wid = __builtin_amdgcn_readfirstlane(tid >> 6), lane = tid & 63, fr = lane & 15, fq = lane >> 4;
    LAS bf16_t* VT = (LAS bf16_t*)lds;
#pragma unroll
    for (int it = 0; it < 8; ++it) { const int idx = tid + NTHR * it, key = idx >> 4, v8 = (idx & 15) * 8; const u32x4 v = *(const u32x4*)(Vb + (size_t)key * 512 + v8);
#pragma unroll
        for (int i = 0; i < 8; ++i) VT[(v8 + i) * AT_PITCH + key] = (bf16_t)((i & 1) ? (v[i >> 1] >> 16) : (v[i >> 1] & 0xffffu)); }
    __syncthreads();
    const float sc = 0.08838834764831845f;
    for (int q0 = wid * 16; q0 < nrows; q0 += 128) {
        bf16x8 Qf0, Qf1, Qf2, Qf3;
        { const bf16_t* qp = Q + (size_t)(q0 + fr) * ld + 8 * fq; Qf0 = *(const bf16x8*)(qp); Qf1 = *(const bf16x8*)(qp + 32); Qf2 = *(const bf16x8*)(qp + 64); Qf3 = *(const bf16x8*)(qp + 96); }
        f32x4 s[16];
#pragma unroll
        for (int a = 0; a < 16; ++a) {
            const bf16_t* kp = Kb + (size_t)(16 * a + fr) * 512 + 8 * fq;
            f32x4 t = {0.f, 0.f, 0.f, 0.f};
            t = MFMA16(*(const bf16x8*)(kp), Qf0, t); t = MFMA16(*(const bf16x8*)(kp + 32), Qf1, t); t = MFMA16(*(const bf16x8*)(kp + 64), Qf2, t); t = MFMA16(*(const bf16x8*)(kp + 96), Qf3, t);
            s[a] = t;
            if ((a & 1) == 1) asm volatile("" ::: "memory");
        }
        float mx = -3.0e38f;
#pragma unroll
        for (int a = 0; a < 16; ++a) mx = fmaxf(fmaxf(mx, fmaxf(s[a][0], s[a][1])), fmaxf(s[a][2], s[a][3]));
        mx = fmaxf(mx, __shfl_xor(mx, 16)); mx = fmaxf(mx, __shfl_xor(mx, 32));
        float sum = 0.f; u32x2 pk[16];
#pragma unroll
        for (int a = 0; a < 16; ++a) { const float e0 = __expf((s[a][0] - mx) * sc), e1 = __expf((s[a][1] - mx) * sc), e2 = __expf((s[a][2] - mx) * sc), e3 = __expf((s[a][3] - mx) * sc);
            sum += (e0 + e1) + (e2 + e3); pk[a].x = pk2(e0, e1); pk[a].y = pk2(e2, e3); }
        sum += __shfl_xor(sum, 16); sum += __shfl_xor(sum, 32);
        const float inv = 1.0f / sum;
        f32x4 o[8];
#pragma unroll
        for (int dt = 0; dt < 8; ++dt) o[dt] = (f32x4){0.f, 0.f, 0.f, 0.f};
#pragma unroll
        for (int ap = 0; ap < 8; ++ap) {
            const u32x4 bv = {pk[2 * ap].x, pk[2 * ap].y, pk[2 * ap + 1].x, pk[2 * ap + 1].y};
            const bf16x8 B = __builtin_bit_cast(bf16x8, bv);
#pragma unroll
            for (int dt = 0; dt < 8; ++dt) {
                const u32x2 lo = *(const LAS u32x2*)(VT + (16 * dt + fr) * AT_PITCH + 32 * ap + 4 * fq), hi = *(const LAS u32x2*)(VT + (16 * dt + fr) * AT_PITCH + 32 * ap + 16 + 4 * fq);
                const u32x4 av = {lo.x, lo.y, hi.x, hi.y};
                o[dt] = MFMA16(__builtin_bit_cast(bf16x8, av), B, o[dt]);
            }
        }
#pragma unroll
        for (int dt = 0; dt < 8; ++dt) { u32x2 w; w.x = pk2(o[dt][0] * inv, o[dt][1] * inv); w.y = pk2(o[dt][2] * inv, o[dt][3] * inv);
            *(u32x2*)(Q + (size_t)(q0 + fr) * ld + 16 * dt + 4 * fq) = w; }
    }
    __syncthreads();
}

constexpr int NCHUNK = MROWS / 64;
__device__ __forceinline__ void mixprep_phase(LAS unsigned char* lds, const Params& p, int layer) {
    const int j = layer >> 1, gla = layer & 1, w = lbid(), G = gridDim.x;
    bf16_t* proj = (bf16_t*)(p.ws + WS_PROJ);
    const int ld = gla ? GL_LD : HG_LD, nh = gla ? 4 : 8;
    bf16_t* ktb = (bf16_t*)(p.ws + WS_XN);
    float* vec = (float*)(p.ws + WS_VEC);
    const int xq = gla ? 3584 : 4096;
    for (int it = w; it < 256 + 64; it += G) {
        const bf16_t* Kb; const bf16_t* Vb; bf16_t* Qp; int nrows;
        if (it < 256) { const int bh = it >> 3, grp = it & 7, b = bh >> 2, h = bh & 3;
            Kb = (const bf16_t*)(p.ws + WS_MKB) + ((size_t)layer * 2048 + b * 256) * 512 + h * 128;
            Vb = (const bf16_t*)(p.ws + WS_MVB) + ((size_t)layer * 2048 + b * 256) * 512 + h * 128;
            Qp = proj + ((size_t)b * 8192 + grp * 1024) * ld + xq + h * 128; nrows = 1024;
        } else { const int bh = it - 256, b = bh >> 2, h = bh & 3;
            Kb = (const bf16_t*)(p.ws + WS_CKB) + ((size_t)layer * 4096 + b * 256) * 512 + h * 128;
            Vb = (const bf16_t*)(p.ws + WS_CVB) + ((size_t)layer * 4096 + b * 256) * 512 + h * 128;
            Qp = proj + ((size_t)MP + b * 64) * ld + xq + h * 128; nrows = 64;
        }
        mem_attn(lds, Kb, Vb, Qp, ld, nrows);
    }
    for (int it = w; it < NCHUNK * nh; it += G) {
        const int ci = it / nh, h = it % nh;
        PrepArgs a;
        a.proj = proj; a.ld = ld; a.row0 = (size_t)ci * 64; a.gla = gla; a.lbj = j;
        if (gla) { a.qcol = h * 128; a.kcol = 512 + h * 128; a.gcol = 1024 + h * 128; a.bgate = p.in[18] + j * 512 + h * 128; a.lb0 = a.lb1 = nullptr; }
        else { a.qcol = h * 128; a.kcol = 1024 + h * 128; a.gcol = 0; a.bgate = nullptr; a.lb0 = p.in[13] + h * 128; a.lb1 = p.in[13] + 1024 + h * 128; }
        a.ktb = ktb + ((size_t)ci * nh + h) * 8192;
        a.em = vec + (size_t)ci * 1024 + h * 128; a.el = a.em + (size_t)NCHUNK * 1024; a.elm = a.el + (size_t)NCHUNK * 1024;
        mixprep_item(lds, a);
    }
}
__device__ __forceinline__ void chain_phase(LAS unsigned char* lds, const Params& p, int layer) {
    const int j = layer >> 1, gla = layer & 1, w = lbid(), G = gridDim.x;
    bf16_t* proj = (bf16_t*)(p.ws + WS_PROJ);
    const int ld = gla ? GL_LD : HG_LD;
    const int nvs = gla ? 8 : 4, nh = gla ? 4 : 8, vdim = gla ? 256 : 128;
    const bf16_t* ktb = (const bf16_t*)(p.ws + WS_XN);
    const float* vec = (const float*)(p.ws + WS_VEC);
    const int n_prompt = 8 * nh * nvs  , n_sample = 16 * nh * nvs  ;
    for (int it = w; it < n_prompt + n_sample; it += G) {
        const bool smp = it >= n_prompt; const int id = smp ? it - n_prompt : it;
        const int lo = id & 7, rest = id >> 3, vs = rest % nvs, hi = rest / nvs, bh = lo + 8 * hi, b = bh / nh, h = bh % nh;
        ChainArgs a;
        a.proj = proj; a.ld = ld;
        a.row0 = smp ? (size_t)MP + (size_t)b * 64 : (size_t)b * 8192; a.nchunks = smp ? 1 : 128;
        const int ci0 = smp ? 1024 + b : b * 128;
        if (gla) { a.qcol = h * 128; a.kcol = 512 + h * 128; a.vcol = 2560 + h * 256 + 32 * vs; }
        else { a.qcol = h * 128; a.kcol = 1024 + h * 128; a.vcol = 3072 + h * 128 + 32 * vs; }
        a.ktb = ktb + ((size_t)ci0 * nh + h) * 8192; a.ktb_stride = (size_t)nh * 8192;
        a.em = vec + (size_t)ci0 * 1024 + h * 128; a.el = a.em + (size_t)NCHUNK * 1024; a.elm = a.el + (size_t)NCHUNK * 1024; a.vec_stride = 1024;
        const size_t per_b = (size_t)nh * 128 * vdim, so = ((size_t)b * nh + h) * 128 * vdim + 32 * vs;
        if (smp) { a.s0 = (gla ? p.in[6] : p.in[5]) + (size_t)j * 16 * per_b + so; a.sout = p.out + (gla ? O_SGS : O_SHS) + (size_t)j * 16 * per_b + so; }
        else { a.s0 = nullptr; a.sout = p.out + (gla ? O_SGP : O_SHP) + (size_t)j * 8 * per_b + so; }
        a.sstride = vdim;
        mixer_chain(lds, a);
    }
}

#define XB_TMO      128
#define XB_XCNT(j)  (256  + 64 * (j))
#define XB_XSUB(j)  (1280 + 64 * (j))
#define XB_XGEN(j)  (2304 + 64 * (j))
#define XB_TOP      3328
#define XB_TOPGEN   3392
#define XCD_BAR_WORDS 3456
#define XB_SPIN_CAP (1u << 22)
__device__ __forceinline__ unsigned xb_ld(unsigned* p)              { return __hip_atomic_load(p, __ATOMIC_RELAXED, __HIP_MEMORY_SCOPE_AGENT); }
__device__ __forceinline__ unsigned xb_add(unsigned* p, unsigned v) { return __hip_atomic_fetch_add(p, v, __ATOMIC_RELAXED, __HIP_MEMORY_SCOPE_AGENT); }
__device__ __forceinline__ unsigned xb_xcc_id() { return (unsigned)__builtin_amdgcn_s_getreg((3 << 11) | 20) & 0xFu; }
#define XB_SPIN(cond, bar) do { unsigned _sp = 0; while (cond) { __builtin_amdgcn_s_sleep(1); \
    if ((++_sp & 255u) == 0u) { if (xb_ld(&(bar)[XB_TMO])) break; if (_sp > XB_SPIN_CAP) { atomicAdd(&(bar)[XB_TMO], 1u); break; } } } } while (0)
struct XcdBarrier { unsigned* bar; unsigned x; volatile LAS unsigned* st; };
__device__ __forceinline__ XcdBarrier xcd_barrier_post(unsigned* bar, volatile LAS unsigned* st) {
    XcdBarrier b; b.bar = bar; b.x = xb_xcc_id(); b.st = st;
    if (threadIdx.x == 0) (void)xb_add(&bar[XB_XCNT(b.x)], 1u);
    return b;
}
__device__ __forceinline__ void xcd_barrier_complete(unsigned* bar, unsigned x, unsigned& nloc, unsigned& nx) {
    const unsigned G = gridDim.x * gridDim.y * gridDim.z;
    unsigned sum, cnt, mine, sp = 0u;
    for (;;) {
        sum = 0u; cnt = 0u; mine = 0u;
#pragma unroll
        for (unsigned j = 0; j < 16; ++j) { const unsigned c = xb_ld(&bar[XB_XCNT(j)]); sum += c; cnt += (c > 0u) ? 1u : 0u; mine = (j == x) ? c : mine; }
        if (sum == G) break;
        __builtin_amdgcn_s_sleep(1);
        if ((++sp & 255u) == 0u) { if (xb_ld(&bar[XB_TMO])) break; if (sp > XB_SPIN_CAP) { atomicAdd(&bar[XB_TMO], 1u); break; } }
    }
    nloc = mine > 0u ? mine : 1u; nx = cnt > 0u ? cnt : 1u;
}
__device__ __forceinline__ void xcd_barrier(const XcdBarrier& b) {
    asm volatile("s_waitcnt vmcnt(0)" ::: "memory");
    __syncthreads();
    if (threadIdx.x == 0) {
        unsigned* bar = b.bar;
        __builtin_amdgcn_s_waitcnt(0);
        unsigned nloc = b.st[0], nx = b.st[1];
        if (nloc == 0u) { xcd_barrier_complete(bar, b.x, nloc, nx); b.st[0] = nloc; b.st[1] = nx; }
        const unsigned old = xb_add(&bar[XB_XSUB(b.x)], 1u);
        const unsigned gen = old / nloc;
        if (old + 1u == (gen + 1u) * nloc) {
            __builtin_amdgcn_fence(__ATOMIC_RELEASE, "agent");
            asm volatile("s_waitcnt vmcnt(0)" ::: "memory");
            const unsigned og = xb_add(&bar[XB_TOP], 1u);
            const unsigned tg = og / nx;
            if (og + 1u == (tg + 1u) * nx) xb_add(&bar[XB_TOPGEN], 1u);
            else XB_SPIN(xb_ld(&bar[XB_TOPGEN]) == tg, bar);
            __builtin_amdgcn_fence(__ATOMIC_ACQUIRE, "agent");
            xb_add(&bar[XB_XGEN(b.x)], 1u);
            asm volatile("s_waitcnt vmcnt(0)" ::: "memory");
        } else {
            XB_SPIN(xb_ld(&bar[XB_XGEN(b.x)]) == gen, bar);
            __builtin_amdgcn_fence(__ATOMIC_ACQUIRE, "agent");
            asm volatile("s_waitcnt vmcnt(0)" ::: "memory");
        }
    }
    __syncthreads();
}

constexpr int PPL = 12;
constexpr int NPHASE = 2 + 4 * PPL;
constexpr int LDS_ST_OFF = 131072;
__global__ void __launch_bounds__(NTHR, 2) trunk_fwd(Params p) {
    extern __shared__ __attribute__((aligned(16))) unsigned char lds_raw[];
    LAS unsigned char* lds = (LAS unsigned char*)lds_raw;
    if (p.ph_hi - p.ph_lo > 1) {
        if (threadIdx.x < 4) ((LAS unsigned*)(lds + LDS_ST_OFF))[threadIdx.x] = 0u;
        __syncthreads();
        (void)xcd_barrier_post((unsigned*)(p.ws + WS_BAR), (volatile LAS unsigned*)(lds + LDS_ST_OFF));
    }
    for (int ph = p.ph_lo; ph < p.ph_hi; ++ph) {
        if (ph == 0) prep_phase(lds, p);
        else if (ph == 1) { Epi E{EPI_MEMKV, nullptr, 0, nullptr, 0.f, p.out + O_MK, p.out + O_MV, (bf16_t*)(p.ws + WS_MKB), (bf16_t*)(p.ws + WS_MVB)};
            gemm_phase<EPI_MEMKV>(lds, (const bf16_t*)(p.ws + WS_MEMP), 1024, (const bf16_t*)(p.ws + WS_MEMW), 2048, 4096, 1024, E); }
        else {
            const int layer = (ph - 2) / PPL, s = (ph - 2) % PPL, gla = layer & 1, j = layer >> 1;
            if (s == 0 || s == 9) { const int lf = layer * 2 + (s == 9);
                Epi E{EPI_SWIGLU, ((bf16_t*)(p.ws + WS_PROJ)), FF, nullptr, 0.f, nullptr, nullptr, nullptr, nullptr};
                gemm_phase<EPI_SWIGLU>(lds, ((bf16_t*)(p.ws + WS_XN)), 1024, (const bf16_t*)(p.ws + WS_WGU) + (size_t)lf * 5632 * 1024, MROWS, 5632, 1024, E); }
            else if (s == 1 || s == 10) { const int lf = layer * 2 + (s == 10);
                Epi E{EPI_RES, nullptr, 0, (p.out + O_Y), 0.5f, nullptr, nullptr, nullptr, nullptr};
                gemm_phase<EPI_RES>(lds, ((bf16_t*)(p.ws + WS_PROJ)), FF, (const bf16_t*)(p.ws + WS_WD) + (size_t)lf * 1024 * FF, MROWS, 1024, FF, E); }
            else if (s == 2 || s == 8 || s == 11) { const int li = layer * 3 + (s == 2 ? 0 : (s == 8 ? 1 : 2));
                ln_phase((p.out + O_Y), ((bf16_t*)(p.ws + WS_XN)), p.in[10] + li * 1024, p.in[11] + li * 1024); }
            else if (s == 3) {
                Epi E{EPI_BF16, ((bf16_t*)(p.ws + WS_PROJ)), gla ? GL_LD : HG_LD, nullptr, 0.f, nullptr, nullptr, nullptr, nullptr};
                if (gla) gemm_phase<EPI_BF16>(lds, ((bf16_t*)(p.ws + WS_XN)), 1024, (const bf16_t*)(p.ws + WS_GWIN) + (size_t)j * 4096 * 1024, MROWS, 4096, 1024, E);
                else gemm_phase<EPI_BF16>(lds, ((bf16_t*)(p.ws + WS_XN)), 1024, (const bf16_t*)(p.ws + WS_HWIN) + (size_t)j * 4608 * 1024, MROWS, 4608, 1024, E); }
            else if (s == 4) mixprep_phase(lds, p, layer);
            else if (s == 5) chain_phase(lds, p, layer);
            else if (s == 6) { if (gla) headnorm_phase(((bf16_t*)(p.ws + WS_PROJ)), GL_LD, 2560, 1536, 32, p.in[19] + j * 1024); else headnorm_phase(((bf16_t*)(p.ws + WS_PROJ)), HG_LD, 3072, 2048, 16, p.in[14] + j * 1024); }
            else if (s == 7) {
                Epi E{EPI_RES, nullptr, 0, (p.out + O_Y), 1.0f, nullptr, nullptr, nullptr, nullptr};
                gemm_phase<EPI_RES>(lds, ((bf16_t*)(p.ws + WS_PROJ)) + (gla ? 2560 : 3072), gla ? GL_LD : HG_LD, (const bf16_t*)(p.ws + WS_WOUT) + (size_t)layer * 1024 * 1536, MROWS, 1024, 1536, E); }
        }
        if (ph + 1 < p.ph_hi) {
            if (ph == 0) cg::this_grid().sync();
            else { XcdBarrier bar; bar.bar = (unsigned*)(p.ws + WS_BAR); bar.x = xb_xcc_id(); bar.st = (volatile LAS unsigned*)(lds + LDS_ST_OFF); xcd_barrier(bar); }
        }
    }
}

extern "C" void kernel_launch(void* const* d_in, const int* in_sizes, int n_in, void* d_out, int out_size, void* d_ws, size_t ws_size, hipStream_t stream) {
    static int grid = 0;
    if (grid == 0) {
        if (n_in != 23 || ws_size < WS_END) { fprintf(stderr, "kernel_launch: need 23 inputs and %zu bytes of workspace; got %d, %zu\n", (size_t)WS_END, n_in, ws_size); grid = -1; return; }
        if (hipFuncSetAttribute((const void*)trunk_fwd, hipFuncAttributeMaxDynamicSharedMemorySize, LDS_BYTES) != hipSuccess) { fprintf(stderr, "kernel_launch: hipFuncSetAttribute failed\n"); grid = -1; return; }
        int dev = 0, cus = 0, per_cu = 0;
        (void)hipGetDevice(&dev); (void)hipDeviceGetAttribute(&cus, hipDeviceAttributeMultiprocessorCount, dev);
        (void)hipOccupancyMaxActiveBlocksPerMultiprocessor(&per_cu, (const void*)trunk_fwd, NTHR, LDS_BYTES);
        if (per_cu < 1) { fprintf(stderr, "kernel_launch: occupancy query says %d blocks per CU\n", per_cu); per_cu = 1; }
        (void)hipGetLastError();
        grid = cus;
    }
    if (grid < 0) return;
    Params p{};
    for (int i = 0; i < 23; ++i) p.in[i] = (const float*)d_in[i];
    p.out = (float*)d_out; p.ws = (unsigned char*)d_ws;
#if ONE_LAUNCH
    (void)hipMemsetAsync((unsigned char*)d_ws + WS_BAR, 0, 16384, stream);
    p.ph_lo = 0; p.ph_hi = NPHASE;
    void* args[] = {&p};
    hipError_t e = hipLaunchCooperativeKernel((const void*)trunk_fwd, dim3(grid), dim3(NTHR), args, LDS_BYTES, stream);
    if (e != hipSuccess) fprintf(stderr, "cooperative launch failed: %s (grid %d)\n", hipGetErrorString(e), grid);
#else
    for (int ph = 0; ph < NPHASE; ++ph) {
        p.ph_lo = ph; p.ph_hi = ph + 1;
        hipLaunchKernelGGL(trunk_fwd, dim3(grid), dim3(NTHR), LDS_BYTES, stream, p);
    }
#endif
}
```

```cpp
#include <hip/hip_runtime.h>
#include <hip/hip_cooperative_groups.h>
#include <cstdio>
namespace cg = cooperative_groups;

#ifndef ONE_LAUNCH
#define ONE_LAUNCH 1
#endif

#define LAS __attribute__((address_space(3)))
typedef unsigned short bf16_t;
typedef short bf16x8 __attribute__((ext_vector_type(8)));
typedef float f32x4 __attribute__((ext_vector_type(4)));
typedef float f32x2 __attribute__((ext_vector_type(2)));
typedef unsigned u32x4 __attribute__((ext_vector_type(4)));
typedef unsigned u32x2 __attribute__((ext_vector_type(2)));
typedef __bf16 nbf2 __attribute__((ext_vector_type(2)));

constexpr int D = 1024, MP = 65536, MS = 1024, MROWS = MP + MS, FF = 2816;
constexpr int HG_LD = 4608, GL_LD = 4096;
constexpr float ALPHA = 1.6817928305074292f;
constexpr int NTHR = 512;
constexpr int LDS_BYTES = 136 * 1024;
constexpr int LDS_X = 131072;

constexpr size_t O_Y = 0;
constexpr size_t O_SHP = (size_t)MROWS * D;
constexpr size_t O_SGP = O_SHP + 2u * 8 * 8 * 128 * 128;
constexpr size_t O_MK = O_SGP + 2u * 8 * 4 * 128 * 256;
constexpr size_t O_MV = O_MK + 4u * 2048 * 512;
constexpr size_t O_SHS = O_MV + 4u * 2048 * 512;
constexpr size_t O_SGS = O_SHS + 2u * 16 * 8 * 128 * 128;

constexpr size_t WS_WGU = 0;
constexpr size_t WS_WD = WS_WGU + 8ull * 5632 * 1024 * 2;
constexpr size_t WS_HWIN = WS_WD + 8ull * 1024 * 2816 * 2;
constexpr size_t WS_GWIN = WS_HWIN + 2ull * 4608 * 1024 * 2;
constexpr size_t WS_WOUT = WS_GWIN + 2ull * 4096 * 1024 * 2;
constexpr size_t WS_MEMW = WS_WOUT + 4ull * 1024 * 1536 * 2;
constexpr size_t WS_MEMP = WS_MEMW + 4096ull * 1024 * 2;
constexpr size_t WS_MKB = WS_MEMP + 2048ull * 1024 * 2;
constexpr size_t WS_MVB = WS_MKB + 4ull * 2048 * 512 * 2;
constexpr size_t WS_CKB = WS_MVB + 4ull * 2048 * 512 * 2;
constexpr size_t WS_CVB = WS_CKB + 4ull * 4096 * 512 * 2;
constexpr size_t WS_XN = WS_CVB + 4ull * 4096 * 512 * 2;
constexpr size_t WS_PROJ = WS_XN + (size_t)MROWS * 1024 * 2;
constexpr size_t WS_VEC = WS_PROJ + (size_t)MROWS * 4608 * 2;
constexpr size_t WS_BAR = WS_VEC + 3ull * (MROWS / 64) * 1024 * 4;
constexpr size_t WS_STATS = WS_BAR + 16384;
constexpr size_t WS_CV_WGU = WS_STATS + 12ull * MROWS * 8;
constexpr size_t WS_CV_HWIN = WS_CV_WGU + 8ull * 2 * 5632 * 4;
constexpr size_t WS_CV_GWIN = WS_CV_HWIN + 2ull * 2 * 4608 * 4;
constexpr size_t WS_ZERO_END = WS_CV_GWIN + 2ull * 2 * 4096 * 4;
constexpr size_t WS_END = WS_ZERO_END;

struct Params {
    const float* in[23];
    float* out;
    unsigned char* ws;
    int ph_lo, ph_hi;
};

__device__ __forceinline__ unsigned pk2(float lo, float hi) { f32x2 v = {lo, hi}; nbf2 b = __builtin_convertvector(v, nbf2); return __builtin_bit_cast(unsigned, b); }
__device__ __forceinline__ float bflo(unsigned u) { return __uint_as_float(u << 16); }
__device__ __forceinline__ float bfhi(unsigned u) { return __uint_as_float(u & 0xffff0000u); }
__device__ __forceinline__ bf16_t f2bf(float f) { unsigned u = pk2(f, 0.f); return (bf16_t)(u & 0xffffu); }
__device__ __forceinline__ float sigmoidf_(float x) { return 1.0f / (1.0f + __expf(-x)); }
__device__ __forceinline__ int ltid() { int t = threadIdx.x; asm volatile("" : "+v"(t)); return t; }
__device__ __forceinline__ int lbid() { int t = blockIdx.x; asm volatile("" : "+s"(t)); return t; }
#define MFMA16(a, b, c) __builtin_amdgcn_mfma_f32_16x16x32_bf16((a), (b), (c), 0, 0, 0)

constexpr int BM = 256, BK = 64, HALF = 128, HTB = HALF * BK * 2, NXCD = 8, WGM = 8;
__device__ __forceinline__ int lds_byte(int r, int c) { const int st = (r >> 4) * 2 + (c >> 5), rr = r & 15, cc = c & 31, ob = rr * 64 + cc * 2; return st * 1024 + (ob ^ (((ob >> 9) & 1) << 5)); }
__device__ __forceinline__ void stage_rc(int b, int& R, int& C) { const int st = b / 1024, sb = b % 1024, swz = sb ^ (((sb >> 9) & 1) << 5); R = (st >> 1) * 16 + swz / 64; C = (st & 1) * 32 + (swz % 64) / 2; }
__device__ __forceinline__ int perm32(int rho) { const int n = rho >> 4, i = rho & 15; return 8 * (i >> 2) + 4 * n + (i & 3); }

struct Unit { int pm, pn; };
struct StaticOrder {
    int nM, nN, nwg, G, c;
    __device__ __forceinline__ void init(int M, int N, int G_, int c_) { nM = M / BM; nN = N / BM; nwg = nM * nN; G = G_; c = c_; }
    __device__ __forceinline__ bool next(int i, Unit& u) const {
        const long L = (long)i * G + c; if (L >= nwg) return false;
        int wgid = (int)L; { const int q = nwg / NXCD, r = nwg % NXCD, xcd = wgid % NXCD, off = wgid / NXCD; wgid = (xcd < r ? xcd * (q + 1) : r * (q + 1) + (xcd - r) * q) + off; }
        const int nig = WGM * nN, gid = wgid / nig, fm = gid * WGM, gsz = (nM - fm) < WGM ? (nM - fm) : WGM;
        u.pm = fm + ((wgid % nig) % gsz); u.pn = (wgid % nig) / gsz; return true;
    }
};

enum { EPI_SWIGLU = 0, EPI_BF16 = 1, EPI_RES = 2, EPI_MEMKV = 3 };
struct Epi { int mode; bf16_t* ob; int ldo; float* xf; float scale; float* mk_out; float* mv_out; bf16_t* mkb; bf16_t* mvb;
             const float* st_in; const float* v1; const float* v2; float* st_out; bf16_t* ybf; };
__device__ __forceinline__ void row_mu_rstd(const LAS float* XS, bool has, int rl, float& mu, float& rstd) {
    if (has) { const f32x2 q = *(const LAS f32x2*)(XS + 2 * rl); mu = q.x * (1.0f / 1024.0f); rstd = 1.0f / sqrtf(fmaxf(q.y * (1.0f / 1024.0f) - mu * mu, 0.f) + 1e-5f); }
    else { mu = 0.f; rstd = 1.0f; }
}

template <int MODE> __device__ __forceinline__ void gemm_epilogue(const f32x4 (&acc)[2][2][4][2], const Unit& u, int wr, int wc, int fr, int fq, const Epi& E, LAS unsigned char* lds) {
    const int row0 = u.pm * BM + wr * 64 + fr;
    const LAS float* XS = (const LAS float*)(lds + LDS_X); const bool has = (E.st_in != nullptr); const int rl0 = wr * 64 + fr;
    if constexpr (MODE == EPI_SWIGLU) {
        const int col0 = u.pn * 128 + wc * 32 + 8 * fq;
        const int cl = wc * 32 + 8 * fq;
        f32x4 c1g[2], c2g[2], c1u[2], c2u[2];
#pragma unroll
        for (int n = 0; n < 2; ++n) {
            if (has) { c1g[n] = *(const LAS f32x4*)(XS + 512 + cl + 4 * n); c2g[n] = *(const LAS f32x4*)(XS + 768 + cl + 4 * n); c1u[n] = *(const LAS f32x4*)(XS + 512 + cl + 128 + 4 * n); c2u[n] = *(const LAS f32x4*)(XS + 768 + cl + 128 + 4 * n); }
            else { c1g[n] = c2g[n] = c1u[n] = c2u[n] = (f32x4){0.f, 0.f, 0.f, 0.f}; }
        }
#pragma unroll
        for (int ai = 0; ai < 2; ++ai)
#pragma unroll
            for (int m = 0; m < 4; ++m) {
                const int row = row0 + ai * HALF + m * 16;
                float mu, rstd; row_mu_rstd(XS, has, rl0 + ai * HALF + m * 16, mu, rstd);
                bf16_t* rowp = E.ob + (size_t)row * E.ldo + col0;
                float h[8];
#pragma unroll
                for (int n = 0; n < 2; ++n)
#pragma unroll
                    for (int j = 0; j < 4; ++j) { const float g = rstd * (acc[ai][0][m][n][j] - mu * c1g[n][j]) + c2g[n][j], up = rstd * (acc[ai][1][m][n][j] - mu * c1u[n][j]) + c2u[n][j];
                        h[n * 4 + j] = g * up * __builtin_amdgcn_rcpf(1.0f + __expf(-g)); }
                u32x4 w; w.x = pk2(h[0], h[1]); w.y = pk2(h[2], h[3]); w.z = pk2(h[4], h[5]); w.w = pk2(h[6], h[7]);
                *(u32x4*)rowp = w;
            }
    } else if constexpr (MODE == EPI_BF16) {
        const int col0 = u.pn * BM + wc * 32 + 8 * fq, cl = wc * 32 + 8 * fq;
        f32x4 c1[2][2], c2[2][2];
#pragma unroll
        for (int bj = 0; bj < 2; ++bj)
#pragma unroll
            for (int n = 0; n < 2; ++n) { c1[bj][n] = *(const LAS f32x4*)(XS + 512 + cl + bj * HALF + 4 * n); c2[bj][n] = *(const LAS f32x4*)(XS + 768 + cl + bj * HALF + 4 * n); }
#pragma unroll
        for (int ai = 0; ai < 2; ++ai)
#pragma unroll
            for (int m = 0; m < 4; ++m) {
                const int row = row0 + ai * HALF + m * 16;
                float mu, rstd; row_mu_rstd(XS, has, rl0 + ai * HALF + m * 16, mu, rstd);
                bf16_t* rowp = E.ob + (size_t)row * E.ldo + col0;
#pragma unroll
                for (int bj = 0; bj < 2; ++bj) {
                    const f32x4 v0 = (acc[ai][bj][m][0] - c1[bj][0] * mu) * rstd + c2[bj][0], v1 = (acc[ai][bj][m][1] - c1[bj][1] * mu) * rstd + c2[bj][1];
                    u32x4 w; w.x = pk2(v0[0], v0[1]); w.y = pk2(v0[2], v0[3]); w.z = pk2(v1[0], v1[1]); w.w = pk2(v1[2], v1[3]);
                    *(u32x4*)(rowp + bj * HALF) = w;
                }
            }
    } else if constexpr (MODE == EPI_RES) {
        const int col0 = u.pn * BM + wc * 32 + 4 * fq, cl = wc * 32 + 4 * fq;
#pragma unroll
        for (int bt = 0; bt < 3; ++bt) {
            const int g0 = bt * 3, ng = bt == 2 ? 2 : 3;
            f32x4 xv[3][2][2];
#pragma unroll
            for (int gi = 0; gi < 3; ++gi) if (gi < ng) { const int g = g0 + gi, ai = g >> 2, m = g & 3; const float* rowp = E.xf + (size_t)(row0 + ai * HALF + m * 16) * D + col0;
#pragma unroll
                for (int bj = 0; bj < 2; ++bj)
#pragma unroll
                    for (int n = 0; n < 2; ++n) xv[gi][bj][n] = *(const f32x4*)(rowp + bj * HALF + n * 16); }
#pragma unroll
            for (int gi = 0; gi < 3; ++gi) if (gi < ng) {
                const int g = g0 + gi, ai = g >> 2, m = g & 3;
                const int row = row0 + ai * HALF + m * 16;
                float mu, rstd; row_mu_rstd(XS, has, rl0 + ai * HALF + m * 16, mu, rstd);
                float* rowp = E.xf + (size_t)row * D + col0; bf16_t* rowb = E.ybf + (size_t)row * D + col0;
                float s1 = 0.f, s2 = 0.f;
#pragma unroll
                for (int bj = 0; bj < 2; ++bj)
#pragma unroll
                    for (int n = 0; n < 2; ++n) { f32x4 x = xv[gi][bj][n];
                        if (has) { const f32x4 gp = *(const LAS f32x4*)(XS + 512 + cl + bj * HALF + n * 16), bp = *(const LAS f32x4*)(XS + 768 + cl + bj * HALF + n * 16); x = (x - mu) * rstd * gp + bp; }
                        x = x * ALPHA + acc[ai][bj][m][n] * E.scale;
                        *(f32x4*)(rowp + bj * HALF + n * 16) = x;
                        u32x2 w; w.x = pk2(x[0], x[1]); w.y = pk2(x[2], x[3]); *(u32x2*)(rowb + bj * HALF + n * 16) = w;
                        s1 += (x[0] + x[1]) + (x[2] + x[3]); s2 += (x[0] * x[0] + x[1] * x[1]) + (x[2] * x[2] + x[3] * x[3]); }
                s1 += __shfl_xor(s1, 16); s1 += __shfl_xor(s1, 32); s2 += __shfl_xor(s2, 16); s2 += __shfl_xor(s2, 32);
                if (fq == 0) { atomicAdd(E.st_out + 2 * (size_t)row, s1); atomicAdd(E.st_out + 2 * (size_t)row + 1, s2); }
            }
            asm volatile("" ::: "memory");
        }
    } else {
        const int colt = u.pn * BM; const int l = colt >> 10, kv = (colt >> 9) & 1, cc0 = (colt & 511) + wc * 32 + 4 * fq;
        float* of = (kv ? E.mv_out : E.mk_out) + (size_t)l * 2048 * 512;
        bf16_t* ob = (kv ? E.mvb : E.mkb) + (size_t)l * 2048 * 512;
#pragma unroll
        for (int ai = 0; ai < 2; ++ai)
#pragma unroll
            for (int m = 0; m < 4; ++m) {
                const size_t ro = (size_t)(row0 + ai * HALF + m * 16) * 512 + cc0;
#pragma unroll
                for (int bj = 0; bj < 2; ++bj)
#pragma unroll
                    for (int n = 0; n < 2; ++n) { const f32x4 v = acc[ai][bj][m][n]; *(f32x4*)(of + ro + bj * HALF + n * 16) = v; u32x2 w; w.x = pk2(v[0], v[1]); w.y = pk2(v[2], v[3]); *(u32x2*)(ob + ro + bj * HALF + n * 16) = w; }
            }
    }
}

template <int MODE> __device__ __forceinline__ void gemm_phase(LAS unsigned char* lds, const bf16_t* Ag, int lda, const bf16_t* Btg, int M, int N, int K, const Epi& E) {
    int tid_ = threadIdx.x; asm volatile("" : "+v"(tid_));
    const int tid = tid_, wid = __builtin_amdgcn_readfirstlane(tid >> 6), lane = tid & 63, wr = wid >> 2, wc = wid & 3, fr = lane & 15, fq = lane >> 4;
    const int nt = K / BK;
    constexpr bool PERM = (MODE == EPI_SWIGLU || MODE == EPI_BF16);
    StaticOrder S; S.init(M, N, (int)gridDim.x, lbid());
    unsigned voffA[2], voffB[2];
#pragma unroll
    for (int i = 0; i < 2; ++i) { int R, C; stage_rc(tid * 16 + i * 8192, R, C); const int Rb = PERM ? ((R & ~31) + perm32(R & 31)) : R;
        voffA[i] = (unsigned)(R * lda + C) * 2u; voffB[i] = (unsigned)(Rb * K + C) * 2u; }
    const size_t kstep = (size_t)(BK * 2);
    const size_t hstepA = (size_t)HALF * lda * 2, hstepB = (size_t)HALF * K * 2;
    const size_t tstepA = 2 * hstepA, tstepB = 2 * hstepB;
    const unsigned ldsw = (unsigned)wid * 1024u;
    const int aoff = lds_byte(wr * 64 + fr, fq * 8), boff = lds_byte(wc * 32 + fr, fq * 8);
#define PG8_SA(b, h) (((b) * 2 + (h)) * HTB)
#define PG8_SB(b, h) ((4 + (b) * 2 + (h)) * HTB)
#define PG8_STAGE(bufoff, gbase, voff) do { _Pragma("unroll") for (int _i = 0; _i < 2; ++_i) \
        __builtin_amdgcn_global_load_lds((const unsigned*)((const char*)(gbase) + (voff)[_i]), (LAS unsigned*)(lds + (bufoff) + ldsw + _i * 8192), 16, 0, 0); } while (0)
#define PG8_LDA(dst, b, h) do { _Pragma("unroll") for (int m = 0; m < 4; ++m) _Pragma("unroll") for (int k = 0; k < 2; ++k) dst[m][k] = *(const LAS bf16x8*)(lds + PG8_SA(b, h) + aoff + m * 2048 + k * 1024); } while (0)
#define PG8_LDB(dst, b, h) do { _Pragma("unroll") for (int n = 0; n < 2; ++n) _Pragma("unroll") for (int k = 0; k < 2; ++k) dst[n][k] = *(const LAS bf16x8*)(lds + PG8_SB(b, h) + boff + n * 2048 + k * 1024); } while (0)
#define PG8_MMA(ai, bj, At, Bt) do { __builtin_amdgcn_s_setprio(1); _Pragma("unroll") for (int m = 0; m < 4; ++m) _Pragma("unroll") for (int n = 0; n < 2; ++n) _Pragma("unroll") for (int k = 0; k < 2; ++k) \
        acc[ai][bj][m][n] = __builtin_amdgcn_mfma_f32_16x16x32_bf16(Bt[n][k], At[m][k], acc[ai][bj][m][n], 0, 0, 0); __builtin_amdgcn_s_setprio(0); } while (0)
#define PG8_WAIT_V(n) asm volatile("s_waitcnt vmcnt(" #n ")" ::: "memory")
#define PG8_WAIT_L(n) asm volatile("s_waitcnt lgkmcnt(" #n ")" ::: "memory")
#define PG8_BAR __builtin_amdgcn_s_barrier()
#define PG8_SCHED __builtin_amdgcn_sched_barrier(0)
    Unit cur, nxt; int ui = 0;
    if (!S.next(0, cur)) return;
    f32x4 acc[2][2][4][2];
#pragma unroll
    for (int a = 0; a < 2; ++a)
#pragma unroll
        for (int b = 0; b < 2; ++b)
#pragma unroll
            for (int m = 0; m < 4; ++m)
#pragma unroll
                for (int n = 0; n < 2; ++n) acc[a][b][m][n] = (f32x4){0.f, 0.f, 0.f, 0.f};
    bf16x8 At[4][2], B0[2][2], B1[2][2];
    const char* cA = (const char*)Ag + (size_t)cur.pm * tstepA; const char* cB = (const char*)Btg + (size_t)cur.pn * tstepB;
    PG8_STAGE(PG8_SB(0, 0), cB, voffB); PG8_STAGE(PG8_SA(0, 0), cA, voffA); PG8_STAGE(PG8_SB(0, 1), cB + hstepB, voffB); PG8_STAGE(PG8_SA(0, 1), cA + hstepA, voffA);
    if (wr == 1) PG8_BAR;
    PG8_WAIT_V(4); PG8_BAR;
    PG8_STAGE(PG8_SB(1, 0), cB + kstep, voffB); PG8_STAGE(PG8_SA(1, 0), cA + kstep, voffA); PG8_STAGE(PG8_SB(1, 1), cB + hstepB + kstep, voffB);
    PG8_WAIT_V(6); PG8_BAR;
    for (;;) {
        const bool has_next = S.next(ui + 1, nxt);
        const char* nA = has_next ? (const char*)Ag + (size_t)nxt.pm * tstepA : cA; const char* nB = has_next ? (const char*)Btg + (size_t)nxt.pn * tstepB : cB;
        for (int t = 0; t < nt; t += 2) {
            const bool last = (t == nt - 2);
            if (MODE != EPI_MEMKV && t == nt - 4 && E.st_in != nullptr && wid < 4) {
                const char* gsrc = wid < 2 ? (const char*)(E.st_in + 2 * ((size_t)cur.pm * BM + wid * 128)) : (const char*)((wid == 2 ? E.v1 : E.v2) + cur.pn * BM);
                __builtin_amdgcn_global_load_lds((const unsigned*)(gsrc + lane * 16), (LAS unsigned*)(lds + LDS_X + wid * 1024), 16, 0, 0);
            }
            const char* a1 = cA + (size_t)(t + 1) * kstep;
            const char* a2 = last ? nA : cA + (size_t)(t + 2) * kstep; const char* b2 = last ? nB : cB + (size_t)(t + 2) * kstep;
            const char* a3 = a2 + kstep; const char* b3 = b2 + kstep;
            PG8_LDB(B0, 0, 0); PG8_SCHED; PG8_LDA(At, 0, 0); PG8_STAGE(PG8_SA(1, 1), a1 + hstepA, voffA);
            PG8_WAIT_L(8); PG8_BAR; PG8_WAIT_L(0); PG8_MMA(0, 0, At, B0); PG8_BAR; PG8_SCHED;
            PG8_LDB(B1, 0, 1); PG8_STAGE(PG8_SB(0, 0), b2, voffB);
            PG8_BAR; PG8_WAIT_L(0); PG8_MMA(0, 1, At, B1); PG8_BAR;
            PG8_LDA(At, 0, 1); PG8_STAGE(PG8_SA(0, 0), a2, voffA);
            PG8_BAR; PG8_WAIT_L(0); PG8_MMA(1, 0, At, B0); PG8_BAR; PG8_SCHED;
            PG8_STAGE(PG8_SB(0, 1), b2 + hstepB, voffB);
            PG8_WAIT_V(6); PG8_BAR; PG8_MMA(1, 1, At, B1); PG8_BAR;
            PG8_LDB(B0, 1, 0); PG8_SCHED; PG8_LDA(At, 1, 0); PG8_STAGE(PG8_SA(0, 1), a2 + hstepA, voffA);
            PG8_WAIT_L(8); PG8_BAR; PG8_WAIT_L(0); PG8_MMA(0, 0, At, B0); PG8_BAR; PG8_SCHED;
            PG8_LDB(B1, 1, 1); PG8_STAGE(PG8_SB(1, 0), b3, voffB);
            PG8_BAR; PG8_WAIT_L(0); PG8_MMA(0, 1, At, B1); PG8_BAR;
            PG8_LDA(At, 1, 1); PG8_STAGE(PG8_SA(1, 0), a3, voffA);
            PG8_BAR; PG8_WAIT_L(0); PG8_MMA(1, 0, At, B0); PG8_BAR; PG8_SCHED;
            PG8_STAGE(PG8_SB(1, 1), b3 + hstepB, voffB);
            PG8_WAIT_V(6); PG8_BAR; PG8_MMA(1, 1, At, B1); PG8_BAR;
        }
        gemm_epilogue<MODE>(acc, cur, wr, wc, fr, fq, E, lds);
        if (!has_next) break;
#pragma unroll
        for (int a = 0; a < 2; ++a)
#pragma unroll
            for (int b = 0; b < 2; ++b)
#pragma unroll
                for (int m = 0; m < 4; ++m)
#pragma unroll
                    for (int n = 0; n < 2; ++n) acc[a][b][m][n] = (f32x4){0.f, 0.f, 0.f, 0.f};
        cur = nxt; cA = nA; cB = nB; ++ui;
    }
    PG8_WAIT_V(0);
    if (wr == 0) PG8_BAR;
    PG8_BAR;
#undef PG8_SA
#undef PG8_SB
#undef PG8_STAGE
#undef PG8_LDA
#undef PG8_LDB
#undef PG8_MMA
#undef PG8_WAIT_V
#undef PG8_WAIT_L
#undef PG8_BAR
#undef PG8_SCHED
}

__device__ __forceinline__ void transpose_job(LAS unsigned char* lds, const float* src, int ld, int K, int c0, int ncols, bf16_t* dst, int rowmode, int drow0,
                                              const float* gk, const float* bk, float* c1, float* c2) {
    LAS float* tile = (LAS float*)lds;
    int tid_ = threadIdx.x; asm volatile("" : "+v"(tid_)); const int tid = tid_;
    const int nkt = K / 64, nct = ncols / 64, ntiles = nkt * nct;
    for (int t = lbid(); t < ntiles; t += gridDim.x) {
        const int kt = t % nkt, ct = t / nkt;
        const int k0 = kt * 64, n0 = ct * 64;
        { const int kr = tid >> 4, c4 = (tid & 15) * 4;
#pragma unroll
          for (int rr = 0; rr < 64; rr += 32) { const f32x4 v = *(const f32x4*)(src + (size_t)(k0 + kr + rr) * ld + c0 + n0 + c4);
              tile[(kr + rr) * 65 + c4 + 0] = v[0]; tile[(kr + rr) * 65 + c4 + 1] = v[1]; tile[(kr + rr) * 65 + c4 + 2] = v[2]; tile[(kr + rr) * 65 + c4 + 3] = v[3]; } }
        __syncthreads();
        { const int n = tid >> 3, k8 = (tid & 7) * 8; float v[8];
#pragma unroll
          for (int i = 0; i < 8; ++i) v[i] = tile[(k8 + i) * 65 + n];
          const int c = c0 + n0 + n; int drow;
          if (rowmode == 0) drow = drow0 + c; else drow = 256 * (c >> 7) + (c & 127) + (rowmode == 2 ? 128 : 0);
          u32x4 w;
          if (gk) {
              const f32x4 g0 = *(const f32x4*)(gk + k0 + k8), g1 = *(const f32x4*)(gk + k0 + k8 + 4), b0 = *(const f32x4*)(bk + k0 + k8), b1 = *(const f32x4*)(bk + k0 + k8 + 4);
              float s2 = 0.f;
#pragma unroll
              for (int i = 0; i < 4; ++i) { s2 += b0[i] * v[i] + b1[i] * v[4 + i]; v[i] *= g0[i]; v[4 + i] *= g1[i]; }
              w.x = pk2(v[0], v[1]); w.y = pk2(v[2], v[3]); w.z = pk2(v[4], v[5]); w.w = pk2(v[6], v[7]);
              float s1 = 0.f;
#pragma unroll
              for (int i = 0; i < 4; ++i) s1 += bflo(w[i]) + bfhi(w[i]);
              s1 += __shfl_xor(s1, 1); s1 += __shfl_xor(s1, 2); s1 += __shfl_xor(s1, 4);
              s2 += __shfl_xor(s2, 1); s2 += __shfl_xor(s2, 2); s2 += __shfl_xor(s2, 4);
              if ((tid & 7) == 0) { atomicAdd(c1 + drow, s1); atomicAdd(c2 + drow, s2); }
          } else { w.x = pk2(v[0], v[1]); w.y = pk2(v[2], v[3]); w.z = pk2(v[4], v[5]); w.w = pk2(v[6], v[7]); }
          *(u32x4*)(dst + (size_t)drow * K + k0 + k8) = w; }
        __syncthreads();
    }
}
__device__ __forceinline__ void convert_job(const float* src, bf16_t* dst, float* dstf, size_t n) {
    const size_t nv = n / 8;
    for (size_t i = (size_t)lbid() * NTHR + ltid(); i < nv; i += (size_t)gridDim.x * NTHR) {
        const f32x4 a = *(const f32x4*)(src + i * 8), b = *(const f32x4*)(src + i * 8 + 4);
        u32x4 w; w.x = pk2(a[0], a[1]); w.y = pk2(a[2], a[3]); w.z = pk2(b[0], b[1]); w.w = pk2(b[2], b[3]);
        *(u32x4*)(dst + i * 8) = w;
        if (dstf) { *(f32x4*)(dstf + i * 8) = a; *(f32x4*)(dstf + i * 8 + 4) = b; }
    }
}
__device__ __forceinline__ void prep_phase(LAS unsigned char* lds, const Params& p) {
    unsigned char* ws = p.ws;
    for (int jb = 0; jb < 52; ++jb) {
        const float* src; int ld, K, c0, ncols, rowmode, drow0; bf16_t* dst; int li = -1; float* cv = nullptr; int cvn = 0;
        if (jb < 24) { const int lf = jb / 3, t = jb % 3;
            if (t < 2) { src = (t == 0 ? p.in[7] : p.in[8]) + (size_t)lf * 1024 * FF; ld = FF; K = 1024; c0 = 0; ncols = FF; dst = (bf16_t*)(ws + WS_WGU) + (size_t)lf * 5632 * 1024; rowmode = 1 + t; drow0 = 0;
                if (lf > 0) { li = (lf & 1) ? 3 * (lf >> 1) + 1 : 3 * (lf >> 1) - 1; cv = (float*)(ws + WS_CV_WGU) + (size_t)lf * 2 * 5632; cvn = 5632; } }
            else { src = p.in[9] + (size_t)lf * FF * 1024; ld = 1024; K = FF; c0 = 0; ncols = 1024; dst = (bf16_t*)(ws + WS_WD) + (size_t)lf * 1024 * FF; rowmode = 0; drow0 = 0; }
        } else if (jb < 44) { const int j = (jb - 24) / 10, t = (jb - 24) % 10; rowmode = 0; K = 1024;
            if (t < 4) {
                src = p.in[12] + (size_t)j * 1024 * 4608; ld = 4608; dst = (bf16_t*)(ws + WS_HWIN) + (size_t)j * 4608 * 1024;
                c0 = t == 0 ? 0 : (t == 1 ? 3072 : (t == 2 ? 2048 : 4096)); ncols = t == 0 ? 2048 : (t == 3 ? 512 : 1024); drow0 = (t == 0 ? 0 : (t == 1 ? 2048 : (t == 2 ? 3072 : 4096))) - c0;
                li = 3 * (2 * j); cv = (float*)(ws + WS_CV_HWIN) + (size_t)j * 2 * 4608; cvn = 4608;
            } else if (t < 8) {
                src = p.in[16] + (size_t)j * 1024 * 3600; ld = 3600; dst = (bf16_t*)(ws + WS_GWIN) + (size_t)j * 4096 * 1024; const int u = t - 4;
                c0 = u == 0 ? 0 : (u == 1 ? 2048 : (u == 2 ? 1024 : 3088)); ncols = u == 3 ? 512 : 1024; drow0 = (u == 0 ? 0 : (u == 1 ? 1536 : (u == 2 ? 2560 : 3584))) - c0;
                li = 3 * (2 * j + 1); cv = (float*)(ws + WS_CV_GWIN) + (size_t)j * 2 * 4096; cvn = 4096;
            } else { src = (t == 8 ? p.in[15] : p.in[20]) + (size_t)j * 1536 * 1024; ld = 1024; K = 1536; c0 = 0; ncols = 1024; dst = (bf16_t*)(ws + WS_WOUT) + (size_t)(2 * j + (t - 8)) * 1024 * 1536; drow0 = 0; }
        } else { const int l = (jb - 44) >> 1, kv = (jb - 44) & 1; src = (kv ? p.in[22] : p.in[21]) + (size_t)l * 1024 * 512; ld = 512; K = 1024; c0 = 0; ncols = 512; dst = (bf16_t*)(ws + WS_MEMW); rowmode = 0; drow0 = l * 1024 + kv * 512; }
        const float* gk = li >= 0 ? p.in[10] + li * 1024 : nullptr; const float* bk = li >= 0 ? p.in[11] + li * 1024 : nullptr;
        transpose_job(lds, src, ld, K, c0, ncols, dst, rowmode, drow0, gk, bk, cv, cv + cvn);
    }
    for (int j = 0; j < 2; ++j) {
        const float* gs = p.in[16] + (size_t)j * 1024 * 3600; bf16_t* gd = (bf16_t*)(ws + WS_GWIN) + (size_t)j * 4096 * 1024;
        const float* w2 = p.in[17] + (size_t)j * 16 * 512;
        const int li = 3 * (2 * j + 1); const float* gk = p.in[10] + li * 1024; const float* bk = p.in[11] + li * 1024;
        float* c1 = (float*)(ws + WS_CV_GWIN) + (size_t)j * 2 * 4096; float* c2 = c1 + 4096;
        for (int i = lbid() * NTHR + ltid(); i < 512 * 1024; i += gridDim.x * NTHR) {
            const int c = i >> 10, kk = i & 1023; float sacc = 0.f;
#pragma unroll
            for (int r = 0; r < 16; ++r) sacc += gs[(size_t)kk * 3600 + 3072 + r] * w2[r * 512 + c];
            const bf16_t hv = f2bf(sacc * gk[kk]);
            gd[(size_t)(1024 + c) * 1024 + kk] = hv;
            float s1 = __uint_as_float(((unsigned)hv) << 16), s2 = sacc * bk[kk];
#pragma unroll
            for (int o = 32; o >= 1; o >>= 1) { s1 += __shfl_xor(s1, o); s2 += __shfl_xor(s2, o); }
            if ((kk & 63) == 0) { atomicAdd(c1 + 1024 + c, s1); atomicAdd(c2 + 1024 + c, s2); }
        }
    }
    for (int jb = 0; jb < 5; ++jb) {
        const float* src; bf16_t* dst; float* dstf = nullptr; size_t n;
        if (jb == 0) { src = p.in[0]; dst = (bf16_t*)(ws + WS_XN); dstf = p.out + O_Y; n = (size_t)MP * D; }
        else if (jb == 1) { src = p.in[1]; dst = (bf16_t*)(ws + WS_XN) + (size_t)MP * D; dstf = p.out + O_Y + (size_t)MP * D; n = (size_t)MS * D; }
        else if (jb == 2) { src = p.in[2]; dst = (bf16_t*)(ws + WS_MEMP); n = (size_t)2048 * 1024; }
        else if (jb == 3) { src = p.in[3]; dst = (bf16_t*)(ws + WS_CKB); n = (size_t)4 * 4096 * 512; }
        else { src = p.in[4]; dst = (bf16_t*)(ws + WS_CVB); n = (size_t)4 * 4096 * 512; }
        convert_job(src, dst, dstf, n);
    }
}

__device__ __forceinline__ void ln_phase(float* x, bf16_t* xn, const float* gain, const float* bias) {
    int tid_ = threadIdx.x; asm volatile("" : "+v"(tid_));
    const int lane = tid_ & 63, wv = tid_ >> 6;
    f32x4 g[4], b[4];
#pragma unroll
    for (int i = 0; i < 4; ++i) { g[i] = *(const f32x4*)(gain + 4 * lane + 256 * i); b[i] = *(const f32x4*)(bias + 4 * lane + 256 * i); }
    for (int row = lbid() * 8 + wv; row < MROWS; row += gridDim.x * 8) {
        float* xr = x + (size_t)row * D; f32x4 v[4]; float s = 0.f;
#pragma unroll
        for (int i = 0; i < 4; ++i) { v[i] = *(const f32x4*)(xr + 4 * lane + 256 * i); s += (v[i][0] + v[i][1]) + (v[i][2] + v[i][3]); }
#pragma unroll
        for (int o = 32; o >= 1; o >>= 1) s += __shfl_xor(s, o);
        const float mu = s * (1.0f / 1024.0f); float q = 0.f;
#pragma unroll
        for (int i = 0; i < 4; ++i) { const f32x4 d = v[i] - mu; q += (d[0] * d[0] + d[1] * d[1]) + (d[2] * d[2] + d[3] * d[3]); }
#pragma unroll
        for (int o = 32; o >= 1; o >>= 1) q += __shfl_xor(q, o);
        const float rs = 1.0f / sqrtf(q * (1.0f / 1024.0f) + 1e-5f);
#pragma unroll
        for (int i = 0; i < 4; ++i) { const f32x4 o = (v[i] - mu) * rs * g[i] + b[i]; *(f32x4*)(xr + 4 * lane + 256 * i) = o;
            if (xn) { u32x2 w; w.x = pk2(o[0], o[1]); w.y = pk2(o[2], o[3]); *(u32x2*)(xn + (size_t)row * D + 4 * lane + 256 * i) = w; } }
    }
}

__device__ __forceinline__ void headnorm_phase(bf16_t* proj, int ld, int ocol, int gcol, int lanes_per_head  , const float* gain) {
    int tid_ = threadIdx.x; asm volatile("" : "+v"(tid_));
    const int lane = tid_ & 63, wv = tid_ >> 6;
    float gn[2][8];
#pragma unroll
    for (int hh = 0; hh < 2; ++hh)
#pragma unroll
        for (int i = 0; i < 8; ++i) gn[hh][i] = gain[hh * 512 + 8 * lane + i];
    const float invn = lanes_per_head == 16 ? (1.0f / 128.0f) : (1.0f / 256.0f);
    for (int row = lbid() * 8 + wv; row < MROWS; row += gridDim.x * 8) {
        bf16_t* pr = proj + (size_t)row * ld;
#pragma unroll
        for (int hh = 0; hh < 2; ++hh) {
            const u32x4 ov = *(const u32x4*)(pr + ocol + hh * 512 + 8 * lane), gv = *(const u32x4*)(pr + gcol + hh * 512 + 8 * lane);
            float o[8], g[8];
#pragma unroll
            for (int i = 0; i < 4; ++i) { o[2 * i] = bflo(ov[i]); o[2 * i + 1] = bfhi(ov[i]); g[2 * i] = bflo(gv[i]); g[2 * i + 1] = bfhi(gv[i]); }
            float s = 0.f;
#pragma unroll
            for (int i = 0; i < 8; ++i) s += o[i] * o[i];
            s += __shfl_xor(s, 1); s += __shfl_xor(s, 2); s += __shfl_xor(s, 4); s += __shfl_xor(s, 8);
            if (lanes_per_head == 32) s += __shfl_xor(s, 16);
            const float rs = 1.0f / sqrtf(s * invn + 1e-6f);
            float r[8];
#pragma unroll
            for (int i = 0; i < 8; ++i) r[i] = o[i] * rs * gn[hh][i] * g[i] * sigmoidf_(g[i]);
            u32x4 w; w.x = pk2(r[0], r[1]); w.y = pk2(r[2], r[3]); w.z = pk2(r[4], r[5]); w.w = pk2(r[6], r[7]);
            *(u32x4*)(pr + ocol + hh * 512 + 8 * lane) = w;
        }
    }
}

constexpr int MP_G = 0, MP_T = 32768, MP_KTT = 34816, MP_END = MP_KTT + 128 * 72 * 2;
static_assert(MP_END <= 131072, "prepass LDS");

struct PrepArgs {
    bf16_t* proj; int ld; size_t row0; int qcol, kcol, gcol; int gla;
    const float* lb0; const float* lb1; int lbj; const float* bgate;
    bf16_t* ktb;
    float* em; float* el; float* elm;
};

__device__ __forceinline__ void mixprep_item(LAS unsigned char* lds, const PrepArgs& a) {
    int tid_ = threadIdx.x; asm volatile("" : "+v"(tid_));
    const int tid = tid_;
    LAS float* G = (LAS float*)(lds + MP_G); LAS float* T = (LAS float*)(lds + MP_T); LAS bf16_t* KTT = (LAS bf16_t*)(lds + MP_KTT);
    const int t0 = tid >> 4, cv = tid & 15, c8 = cv * 8;
    float cA[8], cB[8];
#pragma unroll
    for (int i = 0; i < 8; ++i) {
        if (a.gla) { cA[i] = a.bgate[c8 + i]; cB[i] = 0.f; }
        else { float lb = 0.f; if (a.lbj == 1) lb = sigmoidf_(a.lb1[c8 + i] - a.lb0[c8 + i]); cA[i] = lb; cB[i] = 1.0f - lb; }
    }
    const float qscale = 0.08838834764831845f;
    bf16_t* base = a.proj + a.row0 * a.ld;
    float qv[2][8], kv[2][8];
#pragma unroll
    for (int rr = 0; rr < 2; ++rr) {
        const bf16_t* rp = base + (size_t)(t0 + 32 * rr) * a.ld + c8;
        const u32x4 rq = *(const u32x4*)(rp + a.qcol), rk = *(const u32x4*)(rp + a.kcol);
        u32x4 rg = {0u, 0u, 0u, 0u}; if (a.gla) rg = *(const u32x4*)(rp + a.gcol);
        float gvv[8];
#pragma unroll
        for (int i = 0; i < 8; ++i) {
            const unsigned uq = rq[i >> 1], uk = rk[i >> 1], ug = rg[i >> 1];
            const float q = (i & 1) ? bfhi(uq) : bflo(uq), k = (i & 1) ? bfhi(uk) : bflo(uk);
            if (a.gla) {
                const float g = ((i & 1) ? bfhi(ug) : bflo(ug)) + cA[i];
                qv[rr][i] = q * qscale; kv[rr][i] = k;
                gvv[i] = (fminf(g, 0.f) - __logf(1.0f + __expf(-fabsf(g)))) * (1.0f / 16.0f);
            } else {
                qv[rr][i] = q * sigmoidf_(q) * qscale;
                const float e = __expf(-k), r = 1.0f / (1.0f + e);
                kv[rr][i] = cB[i] * e * r;
                gvv[i] = __logf(fmaxf(cA[i] + cB[i] * r, 1e-6f));
            }
        }
        LAS float* gp = G + (t0 + 32 * rr) * 128 + c8;
        *(LAS f32x4*)gp = (f32x4){gvv[0], gvv[1], gvv[2], gvv[3]}; *(LAS f32x4*)(gp + 4) = (f32x4){gvv[4], gvv[5], gvv[6], gvv[7]};
    }
    __syncthreads();
    { const int k = tid & 127, sg = tid >> 7; float run = 0.f;
#pragma unroll
      for (int i = 0; i < 16; ++i) { run += G[(16 * sg + i) * 128 + k]; G[(16 * sg + i) * 128 + k] = run; }
      T[sg * 128 + k] = run; }
    __syncthreads();
    {
        float tA[8], tB[8], tC[8], bmid[8], blast[8];
        { const f32x4 x0 = *(const LAS f32x4*)(T + c8), x1 = *(const LAS f32x4*)(T + c8 + 4), y0 = *(const LAS f32x4*)(T + 128 + c8), y1 = *(const LAS f32x4*)(T + 128 + c8 + 4),
              z0 = *(const LAS f32x4*)(T + 256 + c8), z1 = *(const LAS f32x4*)(T + 256 + c8 + 4);
          const f32x4 m0 = *(const LAS f32x4*)(G + 31 * 128 + c8), m1 = *(const LAS f32x4*)(G + 31 * 128 + c8 + 4), l0 = *(const LAS f32x4*)(G + 63 * 128 + c8), l1 = *(const LAS f32x4*)(G + 63 * 128 + c8 + 4);
#pragma unroll
          for (int i = 0; i < 4; ++i) { tA[i] = x0[i]; tA[4 + i] = x1[i]; tB[i] = x0[i] + y0[i]; tB[4 + i] = x1[i] + y1[i]; tC[i] = tB[i] + z0[i]; tC[4 + i] = tB[4 + i] + z1[i];
              bmid[i] = m0[i] + tA[i]; bmid[4 + i] = m1[i] + tA[4 + i]; blast[i] = l0[i] + tC[i]; blast[4 + i] = l1[i] + tC[4 + i]; } }
#pragma unroll
        for (int rr = 0; rr < 2; ++rr) {
            const int t = t0 + 32 * rr, sg = t >> 4;
            const f32x4 g0 = *(const LAS f32x4*)(G + t * 128 + c8), g1 = *(const LAS f32x4*)(G + t * 128 + c8 + 4);
            float qt[8], kt[8];
#pragma unroll
            for (int i = 0; i < 8; ++i) {
                const float off = sg == 0 ? 0.f : (sg == 1 ? tA[i] : (sg == 2 ? tB[i] : tC[i]));
                const float b = (i < 4 ? g0[i & 3] : g1[i & 3]) + off;
                qt[i] = qv[rr][i] * __expf(fminf(b - bmid[i], 80.f));
                kt[i] = kv[rr][i] * __expf(fminf(bmid[i] - b, 80.f));
            }
            bf16_t* rp = base + (size_t)t * a.ld + c8;
            u32x4 w;
            w.x = pk2(qt[0], qt[1]); w.y = pk2(qt[2], qt[3]); w.z = pk2(qt[4], qt[5]); w.w = pk2(qt[6], qt[7]); *(u32x4*)(rp + a.qcol) = w;
            w.x = pk2(kt[0], kt[1]); w.y = pk2(kt[2], kt[3]); w.z = pk2(kt[4], kt[5]); w.w = pk2(kt[6], kt[7]); *(u32x4*)(rp + a.kcol) = w;
#pragma unroll
            for (int i = 0; i < 4; ++i) { KTT[(c8 + 2 * i) * 72 + t] = (bf16_t)(w[i] & 0xffffu); KTT[(c8 + 2 * i + 1) * 72 + t] = (bf16_t)(w[i] >> 16); }
        }
        if (t0 == 0) {
            f32x4 v0, v1;
#pragma unroll
            for (int i = 0; i < 4; ++i) { v0[i] = __expf(bmid[i]); v1[i] = __expf(bmid[4 + i]); }
            *(f32x4*)(a.em + c8) = v0; *(f32x4*)(a.em + c8 + 4) = v1;
#pragma unroll
            for (int i = 0; i < 4; ++i) { v0[i] = __expf(blast[i]); v1[i] = __expf(blast[4 + i]); }
            *(f32x4*)(a.el + c8) = v0; *(f32x4*)(a.el + c8 + 4) = v1;
#pragma unroll
            for (int i = 0; i < 4; ++i) { v0[i] = __expf(blast[i] - bmid[i]); v1[i] = __expf(blast[4 + i] - bmid[4 + i]); }
            *(f32x4*)(a.elm + c8) = v0; *(f32x4*)(a.elm + c8 + 4) = v1;
        }
    }
    __syncthreads();
    { const int k = tid >> 2, j = tid & 3;
      const u32x4 w0 = *(const LAS u32x4*)(KTT + k * 72 + 16 * j), w1 = *(const LAS u32x4*)(KTT + k * 72 + 16 * j + 8);
      *(u32x4*)(a.ktb + k * 64 + 16 * j) = w0; *(u32x4*)(a.ktb + k * 64 + 16 * j + 8) = w1; }
    __syncthreads();
}

constexpr int MX_QT = 0, MX_KT = MX_QT + 17408, MX_KTT = MX_KT + 17408, MX_VT = MX_KTT + 18432, MX_PP = MX_VT + 4608, MX_ST = MX_PP + 9216, MX_END = MX_ST + 8704;
static_assert(MX_END <= 131072, "mixer LDS");

struct ChainArgs {
    bf16_t* proj; int ld; size_t row0; int nchunks;
    int qcol, kcol, vcol;
    const bf16_t* ktb;
    size_t ktb_stride;
    const float* em; const float* el; const float* elm; int vec_stride;
    const float* s0; float* sout; int sstride;
};

__device__ __forceinline__ void mixer_chain(LAS unsigned char* lds, const ChainArgs& a) {
    int tid_ = threadIdx.x; asm volatile("" : "+v"(tid_));
    const int tid = tid_, wid = __builtin_amdgcn_readfirstlane(tid >> 6), lane = tid & 63, fr = lane & 15, fq = lane >> 4;
    LAS bf16_t* QT = (LAS bf16_t*)(lds + MX_QT); LAS bf16_t* KT = (LAS bf16_t*)(lds + MX_KT); LAS bf16_t* KTT = (LAS bf16_t*)(lds + MX_KTT);
    LAS bf16_t* VT = (LAS bf16_t*)(lds + MX_VT); LAS bf16_t* PP = (LAS bf16_t*)(lds + MX_PP); LAS bf16_t* ST = (LAS bf16_t*)(lds + MX_ST);
    const int t0 = tid >> 4, c8 = (tid & 15) * 8;
    f32x4 Sacc[2];
#pragma unroll
    for (int vi = 0; vi < 2; ++vi)
#pragma unroll
        for (int j = 0; j < 4; ++j) Sacc[vi][j] = a.s0 ? a.s0[(size_t)(16 * wid + 4 * fq + j) * a.sstride + 16 * vi + fr] : 0.f;
    u32x4 rq[2], rk[2], rkt[2], rv; f32x4 vem, vel, velm;
    rv = (u32x4){0u, 0u, 0u, 0u};
    auto issue_loads = [&](int c) {
        const bf16_t* base = a.proj + (a.row0 + (size_t)c * 64) * a.ld;
#pragma unroll
        for (int rr = 0; rr < 2; ++rr) { const bf16_t* rp = base + (size_t)(t0 + 32 * rr) * a.ld + c8; rq[rr] = *(const u32x4*)(rp + a.qcol); rk[rr] = *(const u32x4*)(rp + a.kcol); }
        const bf16_t* kp = a.ktb + (size_t)c * a.ktb_stride + (tid >> 2) * 64 + 16 * (tid & 3);
        rkt[0] = *(const u32x4*)kp; rkt[1] = *(const u32x4*)(kp + 8);
        if (tid < 256) rv = *(const u32x4*)(base + (size_t)(tid >> 2) * a.ld + a.vcol + 8 * (tid & 3));
        const size_t vo = (size_t)c * a.vec_stride + 16 * wid + 4 * fq;
        vem = *(const f32x4*)(a.em + vo); vel = *(const f32x4*)(a.el + vo); velm = *(const f32x4*)(a.elm + vo);
    };
    issue_loads(0);
    for (int c = 0; c < a.nchunks; ++c) {
#pragma unroll
        for (int rr = 0; rr < 2; ++rr) { *(LAS u32x4*)(QT + (t0 + 32 * rr) * 136 + c8) = rq[rr]; *(LAS u32x4*)(KT + (t0 + 32 * rr) * 136 + c8) = rk[rr]; }
        { LAS bf16_t* kp = KTT + (tid >> 2) * 72 + 16 * (tid & 3); *(LAS u32x4*)kp = rkt[0]; *(LAS u32x4*)(kp + 8) = rkt[1]; }
        if (tid < 256) { const int tv = tid >> 2, v8 = (tid & 3) * 8;
#pragma unroll
            for (int i = 0; i < 8; ++i) VT[(v8 + i) * 72 + tv] = (bf16_t)((i & 1) ? (rv[i >> 1] >> 16) : (rv[i >> 1] & 0xffffu)); }
#pragma unroll
        for (int vi = 0; vi < 2; ++vi) { u32x2 w; w.x = pk2(Sacc[vi][0] * vem[0], Sacc[vi][1] * vem[1]); w.y = pk2(Sacc[vi][2] * vem[2], Sacc[vi][3] * vem[3]); *(LAS u32x2*)(ST + (16 * vi + fr) * 136 + 16 * wid + 4 * fq) = w; }
        const f32x4 cel = vel, celm = velm;
        if (c + 1 < a.nchunks) issue_loads(c + 1);
        __syncthreads();
        { const int ti = wid >> 1;
#pragma unroll
          for (int sh = 0; sh < 2; ++sh) { const int si = 2 * (wid & 1) + sh; f32x4 pa = {0.f, 0.f, 0.f, 0.f};
              if (si <= ti) {
#pragma unroll
                  for (int kk = 0; kk < 4; ++kk) { const bf16x8 A = *(const LAS bf16x8*)(KT + (16 * si + fr) * 136 + 32 * kk + 8 * fq), B = *(const LAS bf16x8*)(QT + (16 * ti + fr) * 136 + 32 * kk + 8 * fq); pa = MFMA16(A, B, pa); }
                  if (si == ti) {
#pragma unroll
                      for (int j = 0; j < 4; ++j) if (4 * fq + j > fr) pa[j] = 0.f; }
              }
              u32x2 w; w.x = pk2(pa[0], pa[1]); w.y = pk2(pa[2], pa[3]); *(LAS u32x2*)(PP + (16 * ti + fr) * 72 + 16 * si + 4 * fq) = w; } }
        __syncthreads();
        { const int ti = wid >> 1, vi = wid & 1; f32x4 o = {0.f, 0.f, 0.f, 0.f};
#pragma unroll
          for (int kk = 0; kk < 2; ++kk) { const bf16x8 A = *(const LAS bf16x8*)(VT + (16 * vi + fr) * 72 + 32 * kk + 8 * fq), B = *(const LAS bf16x8*)(PP + (16 * ti + fr) * 72 + 32 * kk + 8 * fq); o = MFMA16(A, B, o); }
#pragma unroll
          for (int kk = 0; kk < 4; ++kk) { const bf16x8 A = *(const LAS bf16x8*)(ST + (16 * vi + fr) * 136 + 32 * kk + 8 * fq), B = *(const LAS bf16x8*)(QT + (16 * ti + fr) * 136 + 32 * kk + 8 * fq); o = MFMA16(A, B, o); }
          u32x2 w; w.x = pk2(o[0], o[1]); w.y = pk2(o[2], o[3]);
          *(u32x2*)(a.proj + (a.row0 + (size_t)c * 64 + 16 * ti + fr) * a.ld + a.vcol + 16 * vi + 4 * fq) = w; }
#pragma unroll
        for (int vi = 0; vi < 2; ++vi) { f32x4 u = {0.f, 0.f, 0.f, 0.f};
#pragma unroll
            for (int kk = 0; kk < 2; ++kk) { const bf16x8 A = *(const LAS bf16x8*)(KTT + (16 * wid + fr) * 72 + 32 * kk + 8 * fq), B = *(const LAS bf16x8*)(VT + (16 * vi + fr) * 72 + 32 * kk + 8 * fq); u = MFMA16(A, B, u); }
            Sacc[vi] = Sacc[vi] * cel + u * celm; }
        __syncthreads();
    }
#pragma unroll
    for (int vi = 0; vi < 2; ++vi)
#pragma unroll
        for (int j = 0; j < 4; ++j) a.sout[(size_t)(16 * wid + 4 * fq + j) * a.sstride + 16 * vi + fr] = Sacc[vi][j];
}

constexpr int AT_PITCH = 264;
__device__ __forceinline__ void mem_attn(LAS unsigned char* lds, const bf16_t* Kb, const bf16_t* Vb, bf16_t* Q, int ld, int nrows) {
    int tid_ = threadIdx.x; asm volatile("" : "+v"(tid_));
    const int tid = tid_, wid = __builtin_amdgcn_readfirstlane(tid >> 6), lane = tid & 63, fr = lane & 15, fq = lane >> 4;
    LAS bf16_t* VT = (LAS bf16_t*)lds;
#pragma unroll
    for (int it = 0; it < 8; ++it) { const int idx = tid + NTHR * it, key = idx >> 4, v8 = (idx & 15) * 8; const u32x4 v = *(const u32x4*)(Vb + (size_t)key * 512 + v8);
#pragma unroll
        for (int i = 0; i < 8; ++i) VT[(v8 + i) * AT_PITCH + key] = (bf16_t)((i & 1) ? (v[i >> 1] >> 16) : (v[i >> 1] & 0xffffu)); }
    __syncthreads();
    const float sc = 0.08838834764831845f;
    for (int q0 = wid * 16; q0 < nrows; q0 += 128) {
        bf16x8 Qf0, Qf1, Qf2, Qf3;
        { const bf16_t* qp = Q + (size_t)(q0 + fr) * ld + 8 * fq; Qf0 = *(const bf16x8*)(qp); Qf1 = *(const bf16x8*)(qp + 32); Qf2 = *(const bf16x8*)(qp + 64); Qf3 = *(const bf16x8*)(qp + 96); }
        f32x4 s[16];
#pragma unroll
        for (int a = 0; a < 16; ++a) {
            const bf16_t* kp = Kb + (size_t)(16 * a + fr) * 512 + 8 * fq;
            f32x4 t = {0.f, 0.f, 0.f, 0.f};
            t = MFMA16(*(const bf16x8*)(kp), Qf0, t); t = MFMA16(*(const bf16x8*)(kp + 32), Qf1, t); t = MFMA16(*(const bf16x8*)(kp + 64), Qf2, t); t = MFMA16(*(const bf16x8*)(kp + 96), Qf3, t);
            s[a] = t;
            if ((a & 1) == 1) asm volatile("" ::: "memory");
        }
        float mx = -3.0e38f;
#pragma unroll
        for (int a = 0; a < 16; ++a) mx = fmaxf(fmaxf(mx, fmaxf(s[a][0], s[a][1])), fmaxf(s[a][2], s[a][3]));
        mx = fmaxf(mx, __shfl_xor(mx, 16)); mx = fmaxf(mx, __shfl_xor(mx, 32));
        float sum = 0.f; u32x2 pk[16];
#pragma unroll
        for (int a = 0; a < 16; ++a) { const float e0 = __expf((s[a][0] - mx) * sc), e1 = __expf((s[a][1] - mx) * sc), e2 = __expf((s[a][2] - mx) * sc), e3 = __expf((s[a][3] - mx) * sc);
            sum += (e0 + e1) + (e2 + e3); pk[a].x = pk2(e0, e1); pk[a].y = pk2(e2, e3); }
        sum += __shfl_xor(sum, 16); sum += __shfl_xor(sum, 32);
        const float inv = 1.0f / sum;
        f32x4 o[8];
#pragma unroll
        for (int dt = 0; dt < 8; ++dt) o[dt] = (f32x4){0.f, 0.f, 0.f, 0.f};
#pragma unroll
        for (int ap = 0; ap < 8; ++ap) {
            const u32x4 bv = {pk[2 * ap].x, pk[2 * ap].y, pk[2 * ap + 1].x, pk[2 * ap + 1].y};
            const bf16x8 B = __builtin_bit_cast(bf16x8, bv);
#pragma unroll
            for (int dt = 0; dt < 8; ++dt) {
                const u32x2 lo = *(const LAS u32x2*)(VT + (16 * dt + fr) * AT_PITCH + 32 * ap + 4 * fq), hi = *(const LAS u32x2*)(VT + (16 * dt + fr) * AT_PITCH + 32 * ap + 16 + 4 * fq);
                const u32x4 av = {lo.x, lo.y, hi.x, hi.y};
                o[dt] = MFMA16(__builtin_bit_cast(bf16x8, av), B, o[dt]);
            }
        }
#pragma unroll
        for (int dt = 0; dt < 8; ++dt) { u32x2 w; w.x = pk2(o[dt][0] * inv, o[dt][1] * inv); w.y = pk2(o[dt][2] * inv, o[dt][3] * inv);
            *(u32x2*)(Q + (size_t)(q0 + fr) * ld + 16 * dt + 4 * fq) = w; }
    }
    __syncthreads();
}

constexpr int NCHUNK = MROWS / 64;
__device__ __forceinline__ void mixprep_phase(LAS unsigned char* lds, const Params& p, int layer) {
    const int j = layer >> 1, gla = layer & 1, w = lbid(), G = gridDim.x;
    bf16_t* proj = (bf16_t*)(p.ws + WS_PROJ);
    const int ld = gla ? GL_LD : HG_LD, nh = gla ? 4 : 8;
    bf16_t* ktb = (bf16_t*)(p.ws + WS_XN);
    float* vec = (float*)(p.ws + WS_VEC);
    const int xq = gla ? 3584 : 4096;
    for (int it = w; it < 256 + 64; it += G) {
        const bf16_t* Kb; const bf16_t* Vb; bf16_t* Qp; int nrows;
        if (it < 256) { const int bh = it >> 3, grp = it & 7, b = bh >> 2, h = bh & 3;
            Kb = (const bf16_t*)(p.ws + WS_MKB) + ((size_t)layer * 2048 + b * 256) * 512 + h * 128;
            Vb = (const bf16_t*)(p.ws + WS_MVB) + ((size_t)layer * 2048 + b * 256) * 512 + h * 128;
            Qp = proj + ((size_t)b * 8192 + grp * 1024) * ld + xq + h * 128; nrows = 1024;
        } else { const int bh = it - 256, b = bh >> 2, h = bh & 3;
            Kb = (const bf16_t*)(p.ws + WS_CKB) + ((size_t)layer * 4096 + b * 256) * 512 + h * 128;
            Vb = (const bf16_t*)(p.ws + WS_CVB) + ((size_t)layer * 4096 + b * 256) * 512 + h * 128;
            Qp = proj + ((size_t)MP + b * 64) * ld + xq + h * 128; nrows = 64;
        }
        mem_attn(lds, Kb, Vb, Qp, ld, nrows);
    }
    for (int it = w; it < NCHUNK * nh; it += G) {
        const int ci = it / nh, h = it % nh;
        PrepArgs a;
        a.proj = proj; a.ld = ld; a.row0 = (size_t)ci * 64; a.gla = gla; a.lbj = j;
        if (gla) { a.qcol = h * 128; a.kcol = 512 + h * 128; a.gcol = 1024 + h * 128; a.bgate = p.in[18] + j * 512 + h * 128; a.lb0 = a.lb1 = nullptr; }
        else { a.qcol = h * 128; a.kcol = 1024 + h * 128; a.gcol = 0; a.bgate = nullptr; a.lb0 = p.in[13] + h * 128; a.lb1 = p.in[13] + 1024 + h * 128; }
        a.ktb = ktb + ((size_t)ci * nh + h) * 8192;
        a.em = vec + (size_t)ci * 1024 + h * 128; a.el = a.em + (size_t)NCHUNK * 1024; a.elm = a.el + (size_t)NCHUNK * 1024;
        mixprep_item(lds, a);
    }
}
__device__ __forceinline__ void chain_phase(LAS unsigned char* lds, const Params& p, int layer) {
    const int j = layer >> 1, gla = layer & 1, w = lbid(), G = gridDim.x;
    bf16_t* proj = (bf16_t*)(p.ws + WS_PROJ);
    const int ld = gla ? GL_LD : HG_LD;
    const int nvs = gla ? 8 : 4, nh = gla ? 4 : 8, vdim = gla ? 256 : 128;
    const bf16_t* ktb = (const bf16_t*)(p.ws + WS_XN);
    const float* vec = (const float*)(p.ws + WS_VEC);
    const int n_prompt = 8 * nh * nvs  , n_sample = 16 * nh * nvs  ;
    for (int it = w; it < n_prompt + n_sample; it += G) {
        const bool smp = it >= n_prompt; const int id = smp ? it - n_prompt : it;
        const int lo = id & 7, rest = id >> 3, vs = rest % nvs, hi = rest / nvs, bh = lo + 8 * hi, b = bh / nh, h = bh % nh;
        ChainArgs a;
        a.proj = proj; a.ld = ld;
        a.row0 = smp ? (size_t)MP + (size_t)b * 64 : (size_t)b * 8192; a.nchunks = smp ? 1 : 128;
        const int ci0 = smp ? 1024 + b : b * 128;
        if (gla) { a.qcol = h * 128; a.kcol = 512 + h * 128; a.vcol = 2560 + h * 256 + 32 * vs; }
        else { a.qcol = h * 128; a.kcol = 1024 + h * 128; a.vcol = 3072 + h * 128 + 32 * vs; }
        a.ktb = ktb + ((size_t)ci0 * nh + h) * 8192; a.ktb_stride = (size_t)nh * 8192;
        a.em = vec + (size_t)ci0 * 1024 + h * 128; a.el = a.em + (size_t)NCHUNK * 1024; a.elm = a.el + (size_t)NCHUNK * 1024; a.vec_stride = 1024;
        const size_t per_b = (size_t)nh * 128 * vdim, so = ((size_t)b * nh + h) * 128 * vdim + 32 * vs;
        if (smp) { a.s0 = (gla ? p.in[6] : p.in[5]) + (size_t)j * 16 * per_b + so; a.sout = p.out + (gla ? O_SGS : O_SHS) + (size_t)j * 16 * per_b + so; }
        else { a.s0 = nullptr; a.sout = p.out + (gla ? O_SGP : O_SHP) + (size_t)j * 8 * per_b + so; }
        a.sstride = vdim;
        mixer_chain(lds, a);
    }
}

#define XB_TMO      128
#define XB_XCNT(j)  (256  + 64 * (j))
#define XB_XSUB(j)  (1280 + 64 * (j))
#define XB_XGEN(j)  (2304 + 64 * (j))
#define XB_TOP      3328
#define XB_TOPGEN   3392
#define XCD_BAR_WORDS 3456
#define XB_SPIN_CAP (1u << 22)
__device__ __forceinline__ unsigned xb_ld(unsigned* p)              { return __hip_atomic_load(p, __ATOMIC_RELAXED, __HIP_MEMORY_SCOPE_AGENT); }
__device__ __forceinline__ unsigned xb_add(unsigned* p, unsigned v) { return __hip_atomic_fetch_add(p, v, __ATOMIC_RELAXED, __HIP_MEMORY_SCOPE_AGENT); }
__device__ __forceinline__ unsigned xb_xcc_id() { return (unsigned)__builtin_amdgcn_s_getreg((3 << 11) | 20) & 0xFu; }
#define XB_SPIN(cond, bar) do { unsigned _sp = 0; while (cond) { __builtin_amdgcn_s_sleep(1); \
    if ((++_sp & 255u) == 0u) { if (xb_ld(&(bar)[XB_TMO])) break; if (_sp > XB_SPIN_CAP) { atomicAdd(&(bar)[XB_TMO], 1u); break; } } } } while (0)
struct XcdBarrier { unsigned* bar; unsigned x; volatile LAS unsigned* st; };
__device__ __forceinline__ XcdBarrier xcd_barrier_post(unsigned* bar, volatile LAS unsigned* st) {
    XcdBarrier b; b.bar = bar; b.x = xb_xcc_id(); b.st = st;
    if (threadIdx.x == 0) (void)xb_add(&bar[XB_XCNT(b.x)], 1u);
    return b;
}
__device__ __forceinline__ void xcd_barrier_complete(unsigned* bar, unsigned x, unsigned& nloc, unsigned& nx) {
    const unsigned G = gridDim.x * gridDim.y * gridDim.z;
    unsigned sum, cnt, mine, sp = 0u;
    for (;;) {
        sum = 0u; cnt = 0u; mine = 0u;
#pragma unroll
        for (unsigned j = 0; j < 16; ++j) { const unsigned c = xb_ld(&bar[XB_XCNT(j)]); sum += c; cnt += (c > 0u) ? 1u : 0u; mine = (j == x) ? c : mine; }
        if (sum == G) break;
        __builtin_amdgcn_s_sleep(1);
        if ((++sp & 255u) == 0u) { if (xb_ld(&bar[XB_TMO])) break; if (sp > XB_SPIN_CAP) { atomicAdd(&bar[XB_TMO], 1u); break; } }
    }
    nloc = mine > 0u ? mine : 1u; nx = cnt > 0u ? cnt : 1u;
}
__device__ __forceinline__ void xcd_barrier(const XcdBarrier& b) {
    asm volatile("s_waitcnt vmcnt(0)" ::: "memory");
    __syncthreads();
    if (threadIdx.x == 0) {
        unsigned* bar = b.bar;
        __builtin_amdgcn_s_waitcnt(0);
        unsigned nloc = b.st[0], nx = b.st[1];
        if (nloc == 0u) { xcd_barrier_complete(bar, b.x, nloc, nx); b.st[0] = nloc; b.st[1] = nx; }
        const unsigned old = xb_add(&bar[XB_XSUB(b.x)], 1u);
        const unsigned gen = old / nloc;
        if (old + 1u == (gen + 1u) * nloc) {
            __builtin_amdgcn_fence(__ATOMIC_RELEASE, "agent");
            asm volatile("s_waitcnt vmcnt(0)" ::: "memory");
            const unsigned og = xb_add(&bar[XB_TOP], 1u);
            const unsigned tg = og / nx;
            if (og + 1u == (tg + 1u) * nx) xb_add(&bar[XB_TOPGEN], 1u);
            else XB_SPIN(xb_ld(&bar[XB_TOPGEN]) == tg, bar);
            __builtin_amdgcn_fence(__ATOMIC_ACQUIRE, "agent");
            xb_add(&bar[XB_XGEN(b.x)], 1u);
            asm volatile("s_waitcnt vmcnt(0)" ::: "memory");
        } else {
            XB_SPIN(xb_ld(&bar[XB_XGEN(b.x)]) == gen, bar);
            __builtin_amdgcn_fence(__ATOMIC_ACQUIRE, "agent");
            asm volatile("s_waitcnt vmcnt(0)" ::: "memory");
        }
    }
    __syncthreads();
}

constexpr int PPL = 9;
constexpr int NPHASE = 2 + 4 * PPL + 1;
constexpr int LDS_ST_OFF = 135168;
#define WSB(off) ((bf16_t*)(p.ws + (off)))
#define STATS(li) ((float*)(p.ws + WS_STATS) + (size_t)(li) * MROWS * 2)
__global__ void __launch_bounds__(NTHR, 2) trunk_fwd(Params p) {
    extern __shared__ __attribute__((aligned(16))) unsigned char lds_raw[];
    LAS unsigned char* lds = (LAS unsigned char*)lds_raw;
    if (p.ph_hi - p.ph_lo > 1) {
        if (threadIdx.x < 4) ((LAS unsigned*)(lds + LDS_ST_OFF))[threadIdx.x] = 0u;
        __syncthreads();
        (void)xcd_barrier_post((unsigned*)(p.ws + WS_BAR), (volatile LAS unsigned*)(lds + LDS_ST_OFF));
    }
    for (int ph = p.ph_lo; ph < p.ph_hi; ++ph) {
        if (ph == 0) prep_phase(lds, p);
        else if (ph == 1) { Epi E{EPI_MEMKV, nullptr, 0, nullptr, 0.f, p.out + O_MK, p.out + O_MV, WSB(WS_MKB), WSB(WS_MVB), nullptr, nullptr, nullptr, nullptr, nullptr};
            gemm_phase<EPI_MEMKV>(lds, WSB(WS_MEMP), 1024, WSB(WS_MEMW), 2048, 4096, 1024, E); }
        else if (ph == NPHASE - 1) ln_phase(p.out + O_Y, nullptr, p.in[10] + 11 * 1024, p.in[11] + 11 * 1024);
        else {
            const int layer = (ph - 2) / PPL, s = (ph - 2) % PPL, gla = layer & 1, j = layer >> 1;
            if (s == 0 || s == 7) {
                const int lf = layer * 2 + (s == 7), li = (s == 7) ? 3 * layer + 1 : 3 * layer - 1;
                const float* cv = (const float*)(p.ws + WS_CV_WGU) + (size_t)lf * 2 * 5632;
                Epi E{EPI_SWIGLU, WSB(WS_PROJ), FF, nullptr, 0.f, nullptr, nullptr, nullptr, nullptr, li >= 0 ? STATS(li) : nullptr, cv, cv + 5632, nullptr, nullptr};
                gemm_phase<EPI_SWIGLU>(lds, WSB(WS_XN), 1024, WSB(WS_WGU) + (size_t)lf * 5632 * 1024, MROWS, 5632, 1024, E); }
            else if (s == 1 || s == 8) {
                const int lf = layer * 2 + (s == 8), li_in = (s == 8) ? 3 * layer + 1 : 3 * layer - 1, li_out = (s == 8) ? 3 * layer + 2 : 3 * layer;
                Epi E{EPI_RES, nullptr, 0, p.out + O_Y, 0.5f, nullptr, nullptr, nullptr, nullptr, li_in >= 0 ? STATS(li_in) : nullptr,
                      li_in >= 0 ? p.in[10] + li_in * 1024 : nullptr, li_in >= 0 ? p.in[11] + li_in * 1024 : nullptr, STATS(li_out), WSB(WS_XN)};
                gemm_phase<EPI_RES>(lds, WSB(WS_PROJ), FF, WSB(WS_WD) + (size_t)lf * 1024 * FF, MROWS, 1024, FF, E); }
            else if (s == 2) {
                const int li = 3 * layer;
                const float* cv = gla ? (const float*)(p.ws + WS_CV_GWIN) + (size_t)j * 2 * 4096 : (const float*)(p.ws + WS_CV_HWIN) + (size_t)j * 2 * 4608;
                Epi E{EPI_BF16, WSB(WS_PROJ), gla ? GL_LD : HG_LD, nullptr, 0.f, nullptr, nullptr, nullptr, nullptr, STATS(li), cv, cv + (gla ? 4096 : 4608), nullptr, nullptr};
                if (gla) gemm_phase<EPI_BF16>(lds, WSB(WS_XN), 1024, WSB(WS_GWIN) + (size_t)j * 4096 * 1024, MROWS, 4096, 1024, E);
                else gemm_phase<EPI_BF16>(lds, WSB(WS_XN), 1024, WSB(WS_HWIN) + (size_t)j * 4608 * 1024, MROWS, 4608, 1024, E); }
            else if (s == 3) mixprep_phase(lds, p, layer);
            else if (s == 4) chain_phase(lds, p, layer);
            else if (s == 5) { if (gla) headnorm_phase(WSB(WS_PROJ), GL_LD, 2560, 1536, 32, p.in[19] + j * 1024); else headnorm_phase(WSB(WS_PROJ), HG_LD, 3072, 2048, 16, p.in[14] + j * 1024); }
            else if (s == 6) {
                const int li_in = 3 * layer;
                Epi E{EPI_RES, nullptr, 0, p.out + O_Y, 1.0f, nullptr, nullptr, nullptr, nullptr, STATS(li_in), p.in[10] + li_in * 1024, p.in[11] + li_in * 1024, STATS(li_in + 1), WSB(WS_XN)};
                gemm_phase<EPI_RES>(lds, WSB(WS_PROJ) + (gla ? 2560 : 3072), gla ? GL_LD : HG_LD, WSB(WS_WOUT) + (size_t)layer * 1024 * 1536, MROWS, 1024, 1536, E); }
        }
        if (ph + 1 < p.ph_hi) {
            if (ph == 0) cg::this_grid().sync();
            else { XcdBarrier bar; bar.bar = (unsigned*)(p.ws + WS_BAR); bar.x = xb_xcc_id(); bar.st = (volatile LAS unsigned*)(lds + LDS_ST_OFF); xcd_barrier(bar); }
        }
    }
}
#undef WSB
#undef STATS

extern "C" void kernel_launch(void* const* d_in, const int* in_sizes, int n_in, void* d_out, int out_size, void* d_ws, size_t ws_size, hipStream_t stream) {
    static int grid = 0;
    if (grid == 0) {
        if (n_in != 23 || ws_size < WS_END) { fprintf(stderr, "kernel_launch: need 23 inputs and %zu bytes of workspace; got %d, %zu\n", (size_t)WS_END, n_in, ws_size); grid = -1; return; }
        if (hipFuncSetAttribute((const void*)trunk_fwd, hipFuncAttributeMaxDynamicSharedMemorySize, LDS_BYTES) != hipSuccess) { fprintf(stderr, "kernel_launch: hipFuncSetAttribute failed\n"); grid = -1; return; }
        int dev = 0, cus = 0, per_cu = 0;
        (void)hipGetDevice(&dev); (void)hipDeviceGetAttribute(&cus, hipDeviceAttributeMultiprocessorCount, dev);
        (void)hipOccupancyMaxActiveBlocksPerMultiprocessor(&per_cu, (const void*)trunk_fwd, NTHR, LDS_BYTES);
        if (per_cu < 1) { fprintf(stderr, "kernel_launch: occupancy query says %d blocks per CU\n", per_cu); per_cu = 1; }
        (void)hipGetLastError();
        grid = cus;
    }
    if (grid < 0) return;
    Params p{};
    for (int i = 0; i < 23; ++i) p.in[i] = (const float*)d_in[i];
    p.out = (float*)d_out; p.ws = (unsigned char*)d_ws;
#if ONE_LAUNCH
    (void)hipMemsetAsync((unsigned char*)d_ws + WS_BAR, 0, WS_ZERO_END - WS_BAR, stream);
    p.ph_lo = 0; p.ph_hi = NPHASE;
    void* args[] = {&p};
    hipError_t e = hipLaunchCooperativeKernel((const void*)trunk_fwd, dim3(grid), dim3(NTHR), args, LDS_BYTES, stream);
    if (e != hipSuccess) fprintf(stderr, "cooperative launch failed: %s (grid %d)\n", hipGetErrorString(e), grid);
#else
    (void)hipMemsetAsync((unsigned char*)d_ws + WS_BAR, 0, WS_ZERO_END - WS_BAR, stream);
    for (int ph = 0; ph < NPHASE; ++ph) {
        p.ph_lo = ph; p.ph_hi = ph + 1;
        hipLaunchKernelGGL(trunk_fwd, dim3(grid), dim3(NTHR), LDS_BYTES, stream, p);
    }
#endif
}
```

```cpp
#include <hip/hip_runtime.h>
#include <hip/hip_cooperative_groups.h>
#include <cstdio>
namespace cg = cooperative_groups;

#ifndef ONE_LAUNCH
#define ONE_LAUNCH 1
#endif

#define LAS __attribute__((address_space(3)))
typedef unsigned short bf16_t;
typedef short bf16x8 __attribute__((ext_vector_type(8)));
typedef float f32x4 __attribute__((ext_vector_type(4)));
typedef float f32x2 __attribute__((ext_vector_type(2)));
typedef unsigned u32x4 __attribute__((ext_vector_type(4)));
typedef unsigned u32x2 __attribute__((ext_vector_type(2)));
typedef __bf16 nbf2 __attribute__((ext_vector_type(2)));

constexpr int D = 1024, MP = 65536, MS = 1024, MROWS = MP + MS, FF = 2816;
constexpr int HG_LD = 4608, GL_LD = 4096;
constexpr float ALPHA = 1.6817928305074292f;
constexpr int NTHR = 512;
constexpr int LDS_BYTES = 144 * 1024;
constexpr int LDS_ST_OFF = 143360;
constexpr int NCHUNK = MROWS / 64;
constexpr int LDS_X = 131072;

constexpr size_t O_Y = 0;
constexpr size_t O_SHP = (size_t)MROWS * D;
constexpr size_t O_SGP = O_SHP + 2u * 8 * 8 * 128 * 128;
constexpr size_t O_MK = O_SGP + 2u * 8 * 4 * 128 * 256;
constexpr size_t O_MV = O_MK + 4u * 2048 * 512;
constexpr size_t O_SHS = O_MV + 4u * 2048 * 512;
constexpr size_t O_SGS = O_SHS + 2u * 16 * 8 * 128 * 128;

constexpr size_t WS_WGU = 0;
constexpr size_t WS_WD = WS_WGU + 8ull * 5632 * 1024 * 2;
constexpr size_t WS_HWIN = WS_WD + 8ull * 1024 * 2816 * 2;
constexpr size_t WS_GWIN = WS_HWIN + 2ull * 4608 * 1024 * 2;
constexpr size_t WS_WOUT = WS_GWIN + 2ull * 4096 * 1024 * 2;
constexpr size_t WS_MEMW = WS_WOUT + 4ull * 1024 * 1536 * 2;
constexpr size_t WS_MEMP = WS_MEMW + 4096ull * 1024 * 2;
constexpr size_t WS_MKB = WS_MEMP + 2048ull * 1024 * 2;
constexpr size_t WS_MVB = WS_MKB + 4ull * 2048 * 512 * 2;
constexpr size_t WS_CKB = WS_MVB + 4ull * 2048 * 512 * 2;
constexpr size_t WS_CVB = WS_CKB + 4ull * 4096 * 512 * 2;
constexpr size_t WS_XN = WS_CVB + 4ull * 4096 * 512 * 2;
constexpr size_t WS_PROJ = WS_XN + (size_t)MROWS * 1024 * 2;
constexpr size_t WS_VEC = WS_PROJ + (size_t)MROWS * 4608 * 2;
constexpr size_t WS_BAR = WS_VEC + 3ull * (MROWS / 64) * 1024 * 4;
constexpr size_t WS_STATS = WS_BAR + 16384;
constexpr size_t WS_CV_WGU = WS_STATS + 12ull * MROWS * 8;
constexpr size_t WS_CV_HWIN = WS_CV_WGU + 8ull * 2 * 5632 * 4;
constexpr size_t WS_CV_GWIN = WS_CV_HWIN + 2ull * 2 * 4608 * 4;
constexpr size_t WS_ZERO_END = WS_CV_GWIN + 2ull * 2 * 4096 * 4;
constexpr size_t WS_END = WS_ZERO_END;

struct Params {
    const float* in[23];
    float* out;
    unsigned char* ws;
    int ph_lo, ph_hi;
};

__device__ __forceinline__ unsigned pk2(float lo, float hi) { f32x2 v = {lo, hi}; nbf2 b = __builtin_convertvector(v, nbf2); return __builtin_bit_cast(unsigned, b); }
__device__ __forceinline__ float bflo(unsigned u) { return __uint_as_float(u << 16); }
__device__ __forceinline__ float bfhi(unsigned u) { return __uint_as_float(u & 0xffff0000u); }
__device__ __forceinline__ bf16_t f2bf(float f) { unsigned u = pk2(f, 0.f); return (bf16_t)(u & 0xffffu); }
__device__ __forceinline__ float sigmoidf_(float x) { return 1.0f / (1.0f + __expf(-x)); }
__device__ __forceinline__ int ltid() { int t = threadIdx.x; asm volatile("" : "+v"(t)); return t; }
__device__ __forceinline__ int lbid() { int t = blockIdx.x; asm volatile("" : "+s"(t)); return t; }
#define MFMA16(a, b, c) __builtin_amdgcn_mfma_f32_16x16x32_bf16((a), (b), (c), 0, 0, 0)

constexpr int BM = 256, BK = 64, HALF = 128, HTB = HALF * BK * 2, NXCD = 8, WGM = 8;
__device__ __forceinline__ int lds_byte(int r, int c) { const int st = (r >> 4) * 2 + (c >> 5), rr = r & 15, cc = c & 31, ob = rr * 64 + cc * 2; return st * 1024 + (ob ^ (((ob >> 9) & 1) << 5)); }
__device__ __forceinline__ void stage_rc(int b, int& R, int& C) { const int st = b / 1024, sb = b % 1024, swz = sb ^ (((sb >> 9) & 1) << 5); R = (st >> 1) * 16 + swz / 64; C = (st & 1) * 32 + (swz % 64) / 2; }
__device__ __forceinline__ int perm32(int rho) { const int n = rho >> 4, i = rho & 15; return 8 * (i >> 2) + 4 * n + (i & 3); }

struct Unit { int pm, pn; };
struct StaticOrder {
    int nM, nN, nwg, G, c;
    __device__ __forceinline__ void init(int M, int N, int G_, int c_) { nM = M / BM; nN = N / BM; nwg = nM * nN; G = G_; c = c_; }
    __device__ __forceinline__ bool next(int i, Unit& u) const {
        const long L = (long)i * G + c; if (L >= nwg) return false;
        int wgid = (int)L; { const int q = nwg / NXCD, r = nwg % NXCD, xcd = wgid % NXCD, off = wgid / NXCD; wgid = (xcd < r ? xcd * (q + 1) : r * (q + 1) + (xcd - r) * q) + off; }
        const int nig = WGM * nN, gid = wgid / nig, fm = gid * WGM, gsz = (nM - fm) < WGM ? (nM - fm) : WGM;
        u.pm = fm + ((wgid % nig) % gsz); u.pn = (wgid % nig) / gsz; return true;
    }
};

enum { EPI_SWIGLU = 0, EPI_BF16 = 1, EPI_RES = 2, EPI_MEMKV = 3 };
struct Epi { int mode; bf16_t* ob; int ldo; float* xf; float scale; float* mk_out; float* mv_out; bf16_t* mkb; bf16_t* mvb;
             const float* st_in; const float* v1; const float* v2; float* st_out; bf16_t* ybf; };
__device__ __forceinline__ void row_mu_rstd(const LAS float* XS, bool has, int rl, float& mu, float& rstd) {
    if (has) { const f32x2 q = *(const LAS f32x2*)(XS + 2 * rl); mu = q.x * (1.0f / 1024.0f); rstd = 1.0f / sqrtf(fmaxf(q.y * (1.0f / 1024.0f) - mu * mu, 0.f) + 1e-5f); }
    else { mu = 0.f; rstd = 1.0f; }
}

template <int MODE> __device__ __forceinline__ void gemm_epilogue(const f32x4 (&acc)[2][2][4][2], const Unit& u, int wr, int wc, int fr, int fq, const Epi& E, LAS unsigned char* lds) {
    const int row0 = u.pm * BM + wr * 64 + fr;
    const LAS float* XS = (const LAS float*)(lds + LDS_X); const bool has = (E.st_in != nullptr); const int rl0 = wr * 64 + fr;
    if constexpr (MODE == EPI_SWIGLU) {
        const int col0 = u.pn * 128 + wc * 32 + 8 * fq;
        const int cl = wc * 32 + 8 * fq;
        f32x4 c1g[2], c2g[2], c1u[2], c2u[2];
#pragma unroll
        for (int n = 0; n < 2; ++n) {
            if (has) { c1g[n] = *(const LAS f32x4*)(XS + 512 + cl + 4 * n); c2g[n] = *(const LAS f32x4*)(XS + 768 + cl + 4 * n); c1u[n] = *(const LAS f32x4*)(XS + 512 + cl + 128 + 4 * n); c2u[n] = *(const LAS f32x4*)(XS + 768 + cl + 128 + 4 * n); }
            else { c1g[n] = c2g[n] = c1u[n] = c2u[n] = (f32x4){0.f, 0.f, 0.f, 0.f}; }
        }
#pragma unroll
        for (int ai = 0; ai < 2; ++ai)
#pragma unroll
            for (int m = 0; m < 4; ++m) {
                const int row = row0 + ai * HALF + m * 16;
                float mu, rstd; row_mu_rstd(XS, has, rl0 + ai * HALF + m * 16, mu, rstd);
                bf16_t* rowp = E.ob + (size_t)row * E.ldo + col0;
                float h[8];
#pragma unroll
                for (int n = 0; n < 2; ++n)
#pragma unroll
                    for (int j = 0; j < 4; ++j) { const float g = rstd * (acc[ai][0][m][n][j] - mu * c1g[n][j]) + c2g[n][j], up = rstd * (acc[ai][1][m][n][j] - mu * c1u[n][j]) + c2u[n][j];
                        h[n * 4 + j] = g * up * __builtin_amdgcn_rcpf(1.0f + __expf(-g)); }
                u32x4 w; w.x = pk2(h[0], h[1]); w.y = pk2(h[2], h[3]); w.z = pk2(h[4], h[5]); w.w = pk2(h[6], h[7]);
                *(u32x4*)rowp = w;
            }
    } else if constexpr (MODE == EPI_BF16) {
        const int col0 = u.pn * BM + wc * 32 + 8 * fq, cl = wc * 32 + 8 * fq;
        f32x4 c1[2][2], c2[2][2];
#pragma unroll
        for (int bj = 0; bj < 2; ++bj)
#pragma unroll
            for (int n = 0; n < 2; ++n) { c1[bj][n] = *(const LAS f32x4*)(XS + 512 + cl + bj * HALF + 4 * n); c2[bj][n] = *(const LAS f32x4*)(XS + 768 + cl + bj * HALF + 4 * n); }
#pragma unroll
        for (int ai = 0; ai < 2; ++ai)
#pragma unroll
            for (int m = 0; m < 4; ++m) {
                const int row = row0 + ai * HALF + m * 16;
                float mu, rstd; row_mu_rstd(XS, has, rl0 + ai * HALF + m * 16, mu, rstd);
                bf16_t* rowp = E.ob + (size_t)row * E.ldo + col0;
#pragma unroll
                for (int bj = 0; bj < 2; ++bj) {
                    const f32x4 v0 = (acc[ai][bj][m][0] - c1[bj][0] * mu) * rstd + c2[bj][0], v1 = (acc[ai][bj][m][1] - c1[bj][1] * mu) * rstd + c2[bj][1];
                    u32x4 w; w.x = pk2(v0[0], v0[1]); w.y = pk2(v0[2], v0[3]); w.z = pk2(v1[0], v1[1]); w.w = pk2(v1[2], v1[3]);
                    *(u32x4*)(rowp + bj * HALF) = w;
                }
            }
    } else if constexpr (MODE == EPI_RES) {
        const int col0 = u.pn * BM + wc * 32 + 4 * fq, cl = wc * 32 + 4 * fq;
#pragma unroll
        for (int bt = 0; bt < 3; ++bt) {
            const int g0 = bt * 3, ng = bt == 2 ? 2 : 3;
            f32x4 xv[3][2][2];
#pragma unroll
            for (int gi = 0; gi < 3; ++gi) if (gi < ng) { const int g = g0 + gi, ai = g >> 2, m = g & 3; const float* rowp = E.xf + (size_t)(row0 + ai * HALF + m * 16) * D + col0;
#pragma unroll
                for (int bj = 0; bj < 2; ++bj)
#pragma unroll
                    for (int n = 0; n < 2; ++n) xv[gi][bj][n] = *(const f32x4*)(rowp + bj * HALF + n * 16); }
#pragma unroll
            for (int gi = 0; gi < 3; ++gi) if (gi < ng) {
                const int g = g0 + gi, ai = g >> 2, m = g & 3;
                const int row = row0 + ai * HALF + m * 16;
                float mu, rstd; row_mu_rstd(XS, has, rl0 + ai * HALF + m * 16, mu, rstd);
                float* rowp = E.xf + (size_t)row * D + col0; bf16_t* rowb = E.ybf + (size_t)row * D + col0;
                float s1 = 0.f, s2 = 0.f;
#pragma unroll
                for (int bj = 0; bj < 2; ++bj)
#pragma unroll
                    for (int n = 0; n < 2; ++n) { f32x4 x = xv[gi][bj][n];
                        if (has) { const f32x4 gp = *(const LAS f32x4*)(XS + 512 + cl + bj * HALF + n * 16), bp = *(const LAS f32x4*)(XS + 768 + cl + bj * HALF + n * 16); x = (x - mu) * rstd * gp + bp; }
                        x = x * ALPHA + acc[ai][bj][m][n] * E.scale;
                        *(f32x4*)(rowp + bj * HALF + n * 16) = x;
                        u32x2 w; w.x = pk2(x[0], x[1]); w.y = pk2(x[2], x[3]); *(u32x2*)(rowb + bj * HALF + n * 16) = w;
                        s1 += (x[0] + x[1]) + (x[2] + x[3]); s2 += (x[0] * x[0] + x[1] * x[1]) + (x[2] * x[2] + x[3] * x[3]); }
                s1 += __shfl_xor(s1, 16); s1 += __shfl_xor(s1, 32); s2 += __shfl_xor(s2, 16); s2 += __shfl_xor(s2, 32);
                if (fq == 0) { atomicAdd(E.st_out + 2 * (size_t)row, s1); atomicAdd(E.st_out + 2 * (size_t)row + 1, s2); }
            }
            asm volatile("" ::: "memory");
        }
    } else {
        const int colt = u.pn * BM; const int l = colt >> 10, kv = (colt >> 9) & 1, cc0 = (colt & 511) + wc * 32 + 4 * fq;
        float* of = (kv ? E.mv_out : E.mk_out) + (size_t)l * 2048 * 512;
        bf16_t* ob = (kv ? E.mvb : E.mkb) + (size_t)l * 2048 * 512;
#pragma unroll
        for (int ai = 0; ai < 2; ++ai)
#pragma unroll
            for (int m = 0; m < 4; ++m) {
                const size_t ro = (size_t)(row0 + ai * HALF + m * 16) * 512 + cc0;
#pragma unroll
                for (int bj = 0; bj < 2; ++bj)
#pragma unroll
                    for (int n = 0; n < 2; ++n) { const f32x4 v = acc[ai][bj][m][n]; *(f32x4*)(of + ro + bj * HALF + n * 16) = v; u32x2 w; w.x = pk2(v[0], v[1]); w.y = pk2(v[2], v[3]); *(u32x2*)(ob + ro + bj * HALF + n * 16) = w; }
            }
    }
}

template <int MODE> __device__ __forceinline__ void gemm_phase(LAS unsigned char* lds, const bf16_t* Ag, int lda, const bf16_t* Btg, int M, int N, int K, const Epi& E) {
    int tid_ = threadIdx.x; asm volatile("" : "+v"(tid_));
    const int tid = tid_, wid = __builtin_amdgcn_readfirstlane(tid >> 6), lane = tid & 63, wr = wid >> 2, wc = wid & 3, fr = lane & 15, fq = lane >> 4;
    const int nt = K / BK;
    constexpr bool PERM = (MODE == EPI_SWIGLU || MODE == EPI_BF16);
    StaticOrder S; S.init(M, N, (int)gridDim.x, lbid());
    unsigned voffA[2], voffB[2];
#pragma unroll
    for (int i = 0; i < 2; ++i) { int R, C; stage_rc(tid * 16 + i * 8192, R, C); const int Rb = PERM ? ((R & ~31) + perm32(R & 31)) : R;
        voffA[i] = (unsigned)(R * lda + C) * 2u; voffB[i] = (unsigned)(Rb * K + C) * 2u; }
    const size_t kstep = (size_t)(BK * 2);
    const size_t hstepA = (size_t)HALF * lda * 2, hstepB = (size_t)HALF * K * 2;
    const size_t tstepA = 2 * hstepA, tstepB = 2 * hstepB;
    const unsigned ldsw = (unsigned)wid * 1024u;
    const int aoff = lds_byte(wr * 64 + fr, fq * 8), boff = lds_byte(wc * 32 + fr, fq * 8);
#define PG8_SA(b, h) (((b) * 2 + (h)) * HTB)
#define PG8_SB(b, h) ((4 + (b) * 2 + (h)) * HTB)
#define PG8_STAGE(bufoff, gbase, voff) do { _Pragma("unroll") for (int _i = 0; _i < 2; ++_i) \
        __builtin_amdgcn_global_load_lds((const unsigned*)((const char*)(gbase) + (voff)[_i]), (LAS unsigned*)(lds + (bufoff) + ldsw + _i * 8192), 16, 0, 0); } while (0)
#define PG8_LDA(dst, b, h) do { _Pragma("unroll") for (int m = 0; m < 4; ++m) _Pragma("unroll") for (int k = 0; k < 2; ++k) dst[m][k] = *(const LAS bf16x8*)(lds + PG8_SA(b, h) + aoff + m * 2048 + k * 1024); } while (0)
#define PG8_LDB(dst, b, h) do { _Pragma("unroll") for (int n = 0; n < 2; ++n) _Pragma("unroll") for (int k = 0; k < 2; ++k) dst[n][k] = *(const LAS bf16x8*)(lds + PG8_SB(b, h) + boff + n * 2048 + k * 1024); } while (0)
#define PG8_MMA(ai, bj, At, Bt) do { __builtin_amdgcn_s_setprio(1); _Pragma("unroll") for (int m = 0; m < 4; ++m) _Pragma("unroll") for (int n = 0; n < 2; ++n) _Pragma("unroll") for (int k = 0; k < 2; ++k) \
        acc[ai][bj][m][n] = __builtin_amdgcn_mfma_f32_16x16x32_bf16(Bt[n][k], At[m][k], acc[ai][bj][m][n], 0, 0, 0); __builtin_amdgcn_s_setprio(0); } while (0)
#define PG8_WAIT_V(n) asm volatile("s_waitcnt vmcnt(" #n ")" ::: "memory")
#define PG8_WAIT_L(n) asm volatile("s_waitcnt lgkmcnt(" #n ")" ::: "memory")
#define PG8_BAR __builtin_amdgcn_s_barrier()
#define PG8_SCHED __builtin_amdgcn_sched_barrier(0)
    Unit cur, nxt; int ui = 0;
    if (!S.next(0, cur)) return;
    f32x4 acc[2][2][4][2];
#pragma unroll
    for (int a = 0; a < 2; ++a)
#pragma unroll
        for (int b = 0; b < 2; ++b)
#pragma unroll
            for (int m = 0; m < 4; ++m)
#pragma unroll
                for (int n = 0; n < 2; ++n) acc[a][b][m][n] = (f32x4){0.f, 0.f, 0.f, 0.f};
    bf16x8 At[4][2], B0[2][2], B1[2][2];
    const char* cA = (const char*)Ag + (size_t)cur.pm * tstepA; const char* cB = (const char*)Btg + (size_t)cur.pn * tstepB;
    PG8_STAGE(PG8_SB(0, 0), cB, voffB); PG8_STAGE(PG8_SA(0, 0), cA, voffA); PG8_STAGE(PG8_SB(0, 1), cB + hstepB, voffB); PG8_STAGE(PG8_SA(0, 1), cA + hstepA, voffA);
    if (wr == 1) PG8_BAR;
    PG8_WAIT_V(4); PG8_BAR;
    PG8_STAGE(PG8_SB(1, 0), cB + kstep, voffB); PG8_STAGE(PG8_SA(1, 0), cA + kstep, voffA); PG8_STAGE(PG8_SB(1, 1), cB + hstepB + kstep, voffB);
    PG8_WAIT_V(6); PG8_BAR;
    for (;;) {
        const bool has_next = S.next(ui + 1, nxt);
        const char* nA = has_next ? (const char*)Ag + (size_t)nxt.pm * tstepA : cA; const char* nB = has_next ? (const char*)Btg + (size_t)nxt.pn * tstepB : cB;
        for (int t = 0; t < nt; t += 2) {
            const bool last = (t == nt - 2);
            if (MODE != EPI_MEMKV && t == nt - 4 && E.st_in != nullptr && wid < 4) {
                const char* gsrc = wid < 2 ? (const char*)(E.st_in + 2 * ((size_t)cur.pm * BM + wid * 128)) : (const char*)((wid == 2 ? E.v1 : E.v2) + cur.pn * BM);
                __builtin_amdgcn_global_load_lds((const unsigned*)(gsrc + lane * 16), (LAS unsigned*)(lds + LDS_X + wid * 1024), 16, 0, 0);
            }
            const char* a1 = cA + (size_t)(t + 1) * kstep;
            const char* a2 = last ? nA : cA + (size_t)(t + 2) * kstep; const char* b2 = last ? nB : cB + (size_t)(t + 2) * kstep;
            const char* a3 = a2 + kstep; const char* b3 = b2 + kstep;
            PG8_LDB(B0, 0, 0); PG8_SCHED; PG8_LDA(At, 0, 0); PG8_STAGE(PG8_SA(1, 1), a1 + hstepA, voffA);
            PG8_WAIT_L(8); PG8_BAR; PG8_WAIT_L(0); PG8_MMA(0, 0, At, B0); PG8_BAR; PG8_SCHED;
            PG8_LDB(B1, 0, 1); PG8_STAGE(PG8_SB(0, 0), b2, voffB);
            PG8_BAR; PG8_WAIT_L(0); PG8_MMA(0, 1, At, B1); PG8_BAR;
            PG8_LDA(At, 0, 1); PG8_STAGE(PG8_SA(0, 0), a2, voffA);
            PG8_BAR; PG8_WAIT_L(0); PG8_MMA(1, 0, At, B0); PG8_BAR; PG8_SCHED;
            PG8_STAGE(PG8_SB(0, 1), b2 + hstepB, voffB);
            PG8_WAIT_V(6); PG8_BAR; PG8_MMA(1, 1, At, B1); PG8_BAR;
            PG8_LDB(B0, 1, 0); PG8_SCHED; PG8_LDA(At, 1, 0); PG8_STAGE(PG8_SA(0, 1), a2 + hstepA, voffA);
            PG8_WAIT_L(8); PG8_BAR; PG8_WAIT_L(0); PG8_MMA(0, 0, At, B0); PG8_BAR; PG8_SCHED;
            PG8_LDB(B1, 1, 1); PG8_STAGE(PG8_SB(1, 0), b3, voffB);
            PG8_BAR; PG8_WAIT_L(0); PG8_MMA(0, 1, At, B1); PG8_BAR;
            PG8_LDA(At, 1, 1); PG8_STAGE(PG8_SA(1, 0), a3, voffA);
            PG8_BAR; PG8_WAIT_L(0); PG8_MMA(1, 0, At, B0); PG8_BAR; PG8_SCHED;
            PG8_STAGE(PG8_SB(1, 1), b3 + hstepB, voffB);
            PG8_WAIT_V(6); PG8_BAR; PG8_MMA(1, 1, At, B1); PG8_BAR;
        }
        gemm_epilogue<MODE>(acc, cur, wr, wc, fr, fq, E, lds);
        if (!has_next) break;
#pragma unroll
        for (int a = 0; a < 2; ++a)
#pragma unroll
            for (int b = 0; b < 2; ++b)
#pragma unroll
                for (int m = 0; m < 4; ++m)
#pragma unroll
                    for (int n = 0; n < 2; ++n) acc[a][b][m][n] = (f32x4){0.f, 0.f, 0.f, 0.f};
        cur = nxt; cA = nA; cB = nB; ++ui;
    }
    PG8_WAIT_V(0);
    if (wr == 0) PG8_BAR;
    PG8_BAR;
#undef PG8_SA
#undef PG8_SB
#undef PG8_STAGE
#undef PG8_LDA
#undef PG8_LDB
#undef PG8_MMA
#undef PG8_WAIT_V
#undef PG8_WAIT_L
#undef PG8_BAR
#undef PG8_SCHED
}

__device__ __forceinline__ void transpose_job(LAS unsigned char* lds, const float* src, int ld, int K, int c0, int ncols, bf16_t* dst, int rowmode, int drow0,
                                              const float* gk, const float* bk, float* c1, float* c2) {
    LAS float* tile = (LAS float*)lds;
    int tid_ = threadIdx.x; asm volatile("" : "+v"(tid_)); const int tid = tid_;
    const int nkt = K / 64, nct = ncols / 64, ntiles = nkt * nct;
    for (int t = lbid(); t < ntiles; t += gridDim.x) {
        const int kt = t % nkt, ct = t / nkt;
        const int k0 = kt * 64, n0 = ct * 64;
        { const int kr = tid >> 4, c4 = (tid & 15) * 4;
#pragma unroll
          for (int rr = 0; rr < 64; rr += 32) { const f32x4 v = *(const f32x4*)(src + (size_t)(k0 + kr + rr) * ld + c0 + n0 + c4);
              tile[(kr + rr) * 65 + c4 + 0] = v[0]; tile[(kr + rr) * 65 + c4 + 1] = v[1]; tile[(kr + rr) * 65 + c4 + 2] = v[2]; tile[(kr + rr) * 65 + c4 + 3] = v[3]; } }
        __syncthreads();
        { const int n = tid >> 3, k8 = (tid & 7) * 8; float v[8];
#pragma unroll
          for (int i = 0; i < 8; ++i) v[i] = tile[(k8 + i) * 65 + n];
          const int c = c0 + n0 + n; int drow;
          if (rowmode == 0) drow = drow0 + c; else drow = 256 * (c >> 7) + (c & 127) + (rowmode == 2 ? 128 : 0);
          u32x4 w;
          if (gk) {
              const f32x4 g0 = *(const f32x4*)(gk + k0 + k8), g1 = *(const f32x4*)(gk + k0 + k8 + 4), b0 = *(const f32x4*)(bk + k0 + k8), b1 = *(const f32x4*)(bk + k0 + k8 + 4);
              float s2 = 0.f;
#pragma unroll
              for (int i = 0; i < 4; ++i) { s2 += b0[i] * v[i] + b1[i] * v[4 + i]; v[i] *= g0[i]; v[4 + i] *= g1[i]; }
              w.x = pk2(v[0], v[1]); w.y = pk2(v[2], v[3]); w.z = pk2(v[4], v[5]); w.w = pk2(v[6], v[7]);
              float s1 = 0.f;
#pragma unroll
              for (int i = 0; i < 4; ++i) s1 += bflo(w[i]) + bfhi(w[i]);
              s1 += __shfl_xor(s1, 1); s1 += __shfl_xor(s1, 2); s1 += __shfl_xor(s1, 4);
              s2 += __shfl_xor(s2, 1); s2 += __shfl_xor(s2, 2); s2 += __shfl_xor(s2, 4);
              if ((tid & 7) == 0) { atomicAdd(c1 + drow, s1); atomicAdd(c2 + drow, s2); }
          } else { w.x = pk2(v[0], v[1]); w.y = pk2(v[2], v[3]); w.z = pk2(v[4], v[5]); w.w = pk2(v[6], v[7]); }
          *(u32x4*)(dst + (size_t)drow * K + k0 + k8) = w; }
        __syncthreads();
    }
}
__device__ __forceinline__ void convert_job(const float* src, bf16_t* dst, float* dstf, size_t n) {
    const size_t nv = n / 8;
    for (size_t i = (size_t)lbid() * NTHR + ltid(); i < nv; i += (size_t)gridDim.x * NTHR) {
        const f32x4 a = *(const f32x4*)(src + i * 8), b = *(const f32x4*)(src + i * 8 + 4);
        u32x4 w; w.x = pk2(a[0], a[1]); w.y = pk2(a[2], a[3]); w.z = pk2(b[0], b[1]); w.w = pk2(b[2], b[3]);
        *(u32x4*)(dst + i * 8) = w;
        if (dstf) { *(f32x4*)(dstf + i * 8) = a; *(f32x4*)(dstf + i * 8 + 4) = b; }
    }
}
__device__ __forceinline__ void prep_phase(LAS unsigned char* lds, const Params& p) {
    unsigned char* ws = p.ws;
    for (int jb = 0; jb < 52; ++jb) {
        const float* src; int ld, K, c0, ncols, rowmode, drow0; bf16_t* dst; int li = -1; float* cv = nullptr; int cvn = 0;
        if (jb < 24) { const int lf = jb / 3, t = jb % 3;
            if (t < 2) { src = (t == 0 ? p.in[7] : p.in[8]) + (size_t)lf * 1024 * FF; ld = FF; K = 1024; c0 = 0; ncols = FF; dst = (bf16_t*)(ws + WS_WGU) + (size_t)lf * 5632 * 1024; rowmode = 1 + t; drow0 = 0;
                if (lf > 0) { li = (lf & 1) ? 3 * (lf >> 1) + 1 : 3 * (lf >> 1) - 1; cv = (float*)(ws + WS_CV_WGU) + (size_t)lf * 2 * 5632; cvn = 5632; } }
            else { src = p.in[9] + (size_t)lf * FF * 1024; ld = 1024; K = FF; c0 = 0; ncols = 1024; dst = (bf16_t*)(ws + WS_WD) + (size_t)lf * 1024 * FF; rowmode = 0; drow0 = 0; }
        } else if (jb < 44) { const int j = (jb - 24) / 10, t = (jb - 24) % 10; rowmode = 0; K = 1024;
            if (t < 4) {
                src = p.in[12] + (size_t)j * 1024 * 4608; ld = 4608; dst = (bf16_t*)(ws + WS_HWIN) + (size_t)j * 4608 * 1024;
                c0 = t == 0 ? 0 : (t == 1 ? 3072 : (t == 2 ? 2048 : 4096)); ncols = t == 0 ? 2048 : (t == 3 ? 512 : 1024); drow0 = (t == 0 ? 0 : (t == 1 ? 2048 : (t == 2 ? 3072 : 4096))) - c0;
                li = 3 * (2 * j); cv = (float*)(ws + WS_CV_HWIN) + (size_t)j * 2 * 4608; cvn = 4608;
            } else if (t < 8) {
                src = p.in[16] + (size_t)j * 1024 * 3600; ld = 3600; dst = (bf16_t*)(ws + WS_GWIN) + (size_t)j * 4096 * 1024; const int u = t - 4;
                c0 = u == 0 ? 0 : (u == 1 ? 2048 : (u == 2 ? 1024 : 3088)); ncols = u == 3 ? 512 : 1024; drow0 = (u == 0 ? 0 : (u == 1 ? 1536 : (u == 2 ? 2560 : 3584))) - c0;
                li = 3 * (2 * j + 1); cv = (float*)(ws + WS_CV_GWIN) + (size_t)j * 2 * 4096; cvn = 4096;
            } else { src = (t == 8 ? p.in[15] : p.in[20]) + (size_t)j * 1536 * 1024; ld = 1024; K = 1536; c0 = 0; ncols = 1024; dst = (bf16_t*)(ws + WS_WOUT) + (size_t)(2 * j + (t - 8)) * 1024 * 1536; drow0 = 0; }
        } else { const int l = (jb - 44) >> 1, kv = (jb - 44) & 1; src = (kv ? p.in[22] : p.in[21]) + (size_t)l * 1024 * 512; ld = 512; K = 1024; c0 = 0; ncols = 512; dst = (bf16_t*)(ws + WS_MEMW); rowmode = 0; drow0 = l * 1024 + kv * 512; }
        const float* gk = li >= 0 ? p.in[10] + li * 1024 : nullptr; const float* bk = li >= 0 ? p.in[11] + li * 1024 : nullptr;
        transpose_job(lds, src, ld, K, c0, ncols, dst, rowmode, drow0, gk, bk, cv, cv + cvn);
    }
    for (int j = 0; j < 2; ++j) {
        const float* gs = p.in[16] + (size_t)j * 1024 * 3600; bf16_t* gd = (bf16_t*)(ws + WS_GWIN) + (size_t)j * 4096 * 1024;
        const float* w2 = p.in[17] + (size_t)j * 16 * 512;
        const int li = 3 * (2 * j + 1); const float* gk = p.in[10] + li * 1024; const float* bk = p.in[11] + li * 1024;
        float* c1 = (float*)(ws + WS_CV_GWIN) + (size_t)j * 2 * 4096; float* c2 = c1 + 4096;
        for (int i = lbid() * NTHR + ltid(); i < 512 * 1024; i += gridDim.x * NTHR) {
            const int c = i >> 10, kk = i & 1023; float sacc = 0.f;
#pragma unroll
            for (int r = 0; r < 16; ++r) sacc += gs[(size_t)kk * 3600 + 3072 + r] * w2[r * 512 + c];
            const bf16_t hv = f2bf(sacc * gk[kk]);
            gd[(size_t)(1024 + c) * 1024 + kk] = hv;
            float s1 = __uint_as_float(((unsigned)hv) << 16), s2 = sacc * bk[kk];
#pragma unroll
            for (int o = 32; o >= 1; o >>= 1) { s1 += __shfl_xor(s1, o); s2 += __shfl_xor(s2, o); }
            if ((kk & 63) == 0) { atomicAdd(c1 + 1024 + c, s1); atomicAdd(c2 + 1024 + c, s2); }
        }
    }
    for (int jb = 0; jb < 5; ++jb) {
        const float* src; bf16_t* dst; float* dstf = nullptr; size_t n;
        if (jb == 0) { src = p.in[0]; dst = (bf16_t*)(ws + WS_XN); dstf = p.out + O_Y; n = (size_t)MP * D; }
        else if (jb == 1) { src = p.in[1]; dst = (bf16_t*)(ws + WS_XN) + (size_t)MP * D; dstf = p.out + O_Y + (size_t)MP * D; n = (size_t)MS * D; }
        else if (jb == 2) { src = p.in[2]; dst = (bf16_t*)(ws + WS_MEMP); n = (size_t)2048 * 1024; }
        else if (jb == 3) { src = p.in[3]; dst = (bf16_t*)(ws + WS_CKB); n = (size_t)4 * 4096 * 512; }
        else { src = p.in[4]; dst = (bf16_t*)(ws + WS_CVB); n = (size_t)4 * 4096 * 512; }
        convert_job(src, dst, dstf, n);
    }
}

__device__ __forceinline__ void ln_phase(float* x, bf16_t* xn, const float* gain, const float* bias) {
    int tid_ = threadIdx.x; asm volatile("" : "+v"(tid_));
    const int lane = tid_ & 63, wv = tid_ >> 6;
    f32x4 g[4], b[4];
#pragma unroll
    for (int i = 0; i < 4; ++i) { g[i] = *(const f32x4*)(gain + 4 * lane + 256 * i); b[i] = *(const f32x4*)(bias + 4 * lane + 256 * i); }
    for (int row = lbid() * 8 + wv; row < MROWS; row += gridDim.x * 8) {
        float* xr = x + (size_t)row * D; f32x4 v[4]; float s = 0.f;
#pragma unroll
        for (int i = 0; i < 4; ++i) { v[i] = *(const f32x4*)(xr + 4 * lane + 256 * i); s += (v[i][0] + v[i][1]) + (v[i][2] + v[i][3]); }
#pragma unroll
        for (int o = 32; o >= 1; o >>= 1) s += __shfl_xor(s, o);
        const float mu = s * (1.0f / 1024.0f); float q = 0.f;
#pragma unroll
        for (int i = 0; i < 4; ++i) { const f32x4 d = v[i] - mu; q += (d[0] * d[0] + d[1] * d[1]) + (d[2] * d[2] + d[3] * d[3]); }
#pragma unroll
        for (int o = 32; o >= 1; o >>= 1) q += __shfl_xor(q, o);
        const float rs = 1.0f / sqrtf(q * (1.0f / 1024.0f) + 1e-5f);
#pragma unroll
        for (int i = 0; i < 4; ++i) { const f32x4 o = (v[i] - mu) * rs * g[i] + b[i]; *(f32x4*)(xr + 4 * lane + 256 * i) = o;
            if (xn) { u32x2 w; w.x = pk2(o[0], o[1]); w.y = pk2(o[2], o[3]); *(u32x2*)(xn + (size_t)row * D + 4 * lane + 256 * i) = w; } }
    }
}

__device__ __forceinline__ void headnorm_phase(bf16_t* proj, int ld, int ocol, int gcol, int lanes_per_head  , const float* gain) {
    int tid_ = threadIdx.x; asm volatile("" : "+v"(tid_));
    const int lane = tid_ & 63, wv = tid_ >> 6;
    float gn[2][8];
#pragma unroll
    for (int hh = 0; hh < 2; ++hh)
#pragma unroll
        for (int i = 0; i < 8; ++i) gn[hh][i] = gain[hh * 512 + 8 * lane + i];
    const float invn = lanes_per_head == 16 ? (1.0f / 128.0f) : (1.0f / 256.0f);
    for (int row = lbid() * 8 + wv; row < MROWS; row += gridDim.x * 8) {
        bf16_t* pr = proj + (size_t)row * ld;
#pragma unroll
        for (int hh = 0; hh < 2; ++hh) {
            const u32x4 ov = *(const u32x4*)(pr + ocol + hh * 512 + 8 * lane), gv = *(const u32x4*)(pr + gcol + hh * 512 + 8 * lane);
            float o[8], g[8];
#pragma unroll
            for (int i = 0; i < 4; ++i) { o[2 * i] = bflo(ov[i]); o[2 * i + 1] = bfhi(ov[i]); g[2 * i] = bflo(gv[i]); g[2 * i + 1] = bfhi(gv[i]); }
            float s = 0.f;
#pragma unroll
            for (int i = 0; i < 8; ++i) s += o[i] * o[i];
            s += __shfl_xor(s, 1); s += __shfl_xor(s, 2); s += __shfl_xor(s, 4); s += __shfl_xor(s, 8);
            if (lanes_per_head == 32) s += __shfl_xor(s, 16);
            const float rs = 1.0f / sqrtf(s * invn + 1e-6f);
            float r[8];
#pragma unroll
            for (int i = 0; i < 8; ++i) r[i] = o[i] * rs * gn[hh][i] * g[i] * sigmoidf_(g[i]);
            u32x4 w; w.x = pk2(r[0], r[1]); w.y = pk2(r[2], r[3]); w.z = pk2(r[4], r[5]); w.w = pk2(r[6], r[7]);
            *(u32x4*)(pr + ocol + hh * 512 + 8 * lane) = w;
        }
    }
}

constexpr int MP_G = 0, MP_T = 32768, MP_KTT = 34816, MP_END = MP_KTT + 128 * 72 * 2;
static_assert(MP_END <= 131072, "prepass LDS");

__device__ __forceinline__ void mixprep_loop(LAS unsigned char* lds, bf16_t* proj, int ld, int qcol, int kcol, int gcol, int gla, const float* lb0, const float* lb1, int lbj, const float* bgate,
                                             bf16_t* ktb_h, int nh, float* vec_h, int ci0, int cstep) {
    int tid_ = threadIdx.x; asm volatile("" : "+v"(tid_));
    const int tid = tid_;
    LAS float* G = (LAS float*)(lds + MP_G); LAS float* T = (LAS float*)(lds + MP_T); LAS bf16_t* KTT = (LAS bf16_t*)(lds + MP_KTT);
    const int t0 = tid >> 4, cv = tid & 15, c8 = cv * 8;
    float cA[8], cB[8];
#pragma unroll
    for (int i = 0; i < 8; ++i) {
        if (gla) { cA[i] = bgate[c8 + i]; cB[i] = 0.f; }
        else { float lb = 0.f; if (lbj == 1) lb = sigmoidf_(lb1[c8 + i] - lb0[c8 + i]); cA[i] = lb; cB[i] = 1.0f - lb; }
    }
    const float qscale = 0.08838834764831845f;
    u32x4 rq[2], rk[2], rg[2];
    rg[0] = rg[1] = (u32x4){0u, 0u, 0u, 0u};
    auto issue_loads = [&](int ci) {
        const bf16_t* base = proj + (size_t)ci * 64 * ld;
#pragma unroll
        for (int rr = 0; rr < 2; ++rr) { const bf16_t* rp = base + (size_t)(t0 + 32 * rr) * ld + c8; rq[rr] = *(const u32x4*)(rp + qcol); rk[rr] = *(const u32x4*)(rp + kcol); if (gla) rg[rr] = *(const u32x4*)(rp + gcol); }
    };
    if (ci0 < NCHUNK) issue_loads(ci0);
    for (int ci = ci0; ci < NCHUNK; ci += cstep) {
        bf16_t* base = proj + (size_t)ci * 64 * ld;
        float qv[2][8], kv[2][8];
#pragma unroll
        for (int rr = 0; rr < 2; ++rr) {
            float gvv[8];
#pragma unroll
            for (int i = 0; i < 8; ++i) {
                const unsigned uq = rq[rr][i >> 1], uk = rk[rr][i >> 1], ug = rg[rr][i >> 1];
                const float q = (i & 1) ? bfhi(uq) : bflo(uq), k = (i & 1) ? bfhi(uk) : bflo(uk);
                if (gla) {
                    const float g = ((i & 1) ? bfhi(ug) : bflo(ug)) + cA[i];
                    qv[rr][i] = q * qscale; kv[rr][i] = k;
                    gvv[i] = (fminf(g, 0.f) - __logf(1.0f + __expf(-fabsf(g)))) * (1.0f / 16.0f);
                } else {
                    qv[rr][i] = q * sigmoidf_(q) * qscale;
                    const float e = __expf(-k), r = 1.0f / (1.0f + e);
                    kv[rr][i] = cB[i] * e * r;
                    gvv[i] = __logf(fmaxf(cA[i] + cB[i] * r, 1e-6f));
                }
            }
            LAS float* gp = G + (t0 + 32 * rr) * 128 + c8;
            *(LAS f32x4*)gp = (f32x4){gvv[0], gvv[1], gvv[2], gvv[3]}; *(LAS f32x4*)(gp + 4) = (f32x4){gvv[4], gvv[5], gvv[6], gvv[7]};
        }
        if (ci + cstep < NCHUNK) issue_loads(ci + cstep);
        __syncthreads();
        { const int k = tid & 127, sg = tid >> 7; float run = 0.f;
#pragma unroll
          for (int i = 0; i < 16; ++i) { run += G[(16 * sg + i) * 128 + k]; G[(16 * sg + i) * 128 + k] = run; }
          T[sg * 128 + k] = run; }
        __syncthreads();
        {
            float tA[8], tB[8], tC[8], bmid[8], blast[8];
            { const f32x4 x0 = *(const LAS f32x4*)(T + c8), x1 = *(const LAS f32x4*)(T + c8 + 4), y0 = *(const LAS f32x4*)(T + 128 + c8), y1 = *(const LAS f32x4*)(T + 128 + c8 + 4),
                  z0 = *(const LAS f32x4*)(T + 256 + c8), z1 = *(const LAS f32x4*)(T + 256 + c8 + 4);
              const f32x4 m0 = *(const LAS f32x4*)(G + 31 * 128 + c8), m1 = *(const LAS f32x4*)(G + 31 * 128 + c8 + 4), l0 = *(const LAS f32x4*)(G + 63 * 128 + c8), l1 = *(const LAS f32x4*)(G + 63 * 128 + c8 + 4);
#pragma unroll
              for (int i = 0; i < 4; ++i) { tA[i] = x0[i]; tA[4 + i] = x1[i]; tB[i] = x0[i] + y0[i]; tB[4 + i] = x1[i] + y1[i]; tC[i] = tB[i] + z0[i]; tC[4 + i] = tB[4 + i] + z1[i];
                  bmid[i] = m0[i] + tA[i]; bmid[4 + i] = m1[i] + tA[4 + i]; blast[i] = l0[i] + tC[i]; blast[4 + i] = l1[i] + tC[4 + i]; } }
#pragma unroll
            for (int rr = 0; rr < 2; ++rr) {
                const int t = t0 + 32 * rr, sg = t >> 4;
                const f32x4 g0 = *(const LAS f32x4*)(G + t * 128 + c8), g1 = *(const LAS f32x4*)(G + t * 128 + c8 + 4);
                float qt[8], kt[8];
#pragma unroll
                for (int i = 0; i < 8; ++i) {
                    const float off = sg == 0 ? 0.f : (sg == 1 ? tA[i] : (sg == 2 ? tB[i] : tC[i]));
                    const float b = (i < 4 ? g0[i & 3] : g1[i & 3]) + off;
                    qt[i] = qv[rr][i] * __expf(fminf(b - bmid[i], 80.f));
                    kt[i] = kv[rr][i] * __expf(fminf(bmid[i] - b, 80.f));
                }
                bf16_t* rp = base + (size_t)t * ld + c8;
                u32x4 w;
                w.x = pk2(qt[0], qt[1]); w.y = pk2(qt[2], qt[3]); w.z = pk2(qt[4], qt[5]); w.w = pk2(qt[6], qt[7]); *(u32x4*)(rp + qcol) = w;
                w.x = pk2(kt[0], kt[1]); w.y = pk2(kt[2], kt[3]); w.z = pk2(kt[4], kt[5]); w.w = pk2(kt[6], kt[7]); *(u32x4*)(rp + kcol) = w;
#pragma unroll
                for (int i = 0; i < 4; ++i) { KTT[(c8 + 2 * i) * 72 + t] = (bf16_t)(w[i] & 0xffffu); KTT[(c8 + 2 * i + 1) * 72 + t] = (bf16_t)(w[i] >> 16); }
            }
            if (t0 == 0) {
                float* em = vec_h + (size_t)ci * 1024; float* el = em + (size_t)NCHUNK * 1024; float* elm = el + (size_t)NCHUNK * 1024;
                f32x4 v0, v1;
#pragma unroll
                for (int i = 0; i < 4; ++i) { v0[i] = __expf(bmid[i]); v1[i] = __expf(bmid[4 + i]); }
                *(f32x4*)(em + c8) = v0; *(f32x4*)(em + c8 + 4) = v1;
#pragma unroll
                for (int i = 0; i < 4; ++i) { v0[i] = __expf(blast[i]); v1[i] = __expf(blast[4 + i]); }
                *(f32x4*)(el + c8) = v0; *(f32x4*)(el + c8 + 4) = v1;
#pragma unroll
                for (int i = 0; i < 4; ++i) { v0[i] = __expf(blast[i] - bmid[i]); v1[i] = __expf(blast[4 + i] - bmid[4 + i]); }
                *(f32x4*)(elm + c8) = v0; *(f32x4*)(elm + c8 + 4) = v1;
            }
        }
        __syncthreads();
        { const int k = tid >> 2, j = tid & 3; bf16_t* ktb = ktb_h + (size_t)ci * nh * 8192;
          const u32x4 w0 = *(const LAS u32x4*)(KTT + k * 72 + 16 * j), w1 = *(const LAS u32x4*)(KTT + k * 72 + 16 * j + 8);
          *(u32x4*)(ktb + k * 64 + 16 * j) = w0; *(u32x4*)(ktb + k * 64 + 16 * j + 8) = w1; }
    }
    __syncthreads();
}

constexpr int MX_QT = 0, MX_KT = MX_QT + 17408, MX_KTT = MX_KT + 17408, MX_VT = MX_KTT + 18432, MX_PP = MX_VT + 4608, MX_ST = MX_PP + 9216, MX_END = MX_ST + 8704;
static_assert(MX_END <= 131072, "mixer LDS");

struct ChainArgs {
    bf16_t* proj; int ld; size_t row0; int nchunks;
    int qcol, kcol, vcol;
    const bf16_t* ktb;
    size_t ktb_stride;
    const float* em; const float* el; const float* elm; int vec_stride;
    const float* s0; float* sout; int sstride;
};

__device__ __forceinline__ void mixer_chain(LAS unsigned char* lds, const ChainArgs& a) {
    int tid_ = threadIdx.x; asm volatile("" : "+v"(tid_));
    const int tid = tid_, wid = __builtin_amdgcn_readfirstlane(tid >> 6), lane = tid & 63, fr = lane & 15, fq = lane >> 4;
    LAS bf16_t* QT = (LAS bf16_t*)(lds + MX_QT); LAS bf16_t* KT = (LAS bf16_t*)(lds + MX_KT); LAS bf16_t* KTT = (LAS bf16_t*)(lds + MX_KTT);
    LAS bf16_t* VT = (LAS bf16_t*)(lds + MX_VT); LAS bf16_t* PP = (LAS bf16_t*)(lds + MX_PP); LAS bf16_t* ST = (LAS bf16_t*)(lds + MX_ST);
    const int t0 = tid >> 4, c8 = (tid & 15) * 8;
    f32x4 Sacc[2];
#pragma unroll
    for (int vi = 0; vi < 2; ++vi)
#pragma unroll
        for (int j = 0; j < 4; ++j) Sacc[vi][j] = a.s0 ? a.s0[(size_t)(16 * wid + 4 * fq + j) * a.sstride + 16 * vi + fr] : 0.f;
    u32x4 rq[2], rk[2], rkt[2], rv; f32x4 vem, vel, velm;
    rv = (u32x4){0u, 0u, 0u, 0u};
    auto issue_loads = [&](int c) {
        const bf16_t* base = a.proj + (a.row0 + (size_t)c * 64) * a.ld;
#pragma unroll
        for (int rr = 0; rr < 2; ++rr) { const bf16_t* rp = base + (size_t)(t0 + 32 * rr) * a.ld + c8; rq[rr] = *(const u32x4*)(rp + a.qcol); rk[rr] = *(const u32x4*)(rp + a.kcol); }
        const bf16_t* kp = a.ktb + (size_t)c * a.ktb_stride + (tid >> 2) * 64 + 16 * (tid & 3);
        rkt[0] = *(const u32x4*)kp; rkt[1] = *(const u32x4*)(kp + 8);
        if (tid < 256) rv = *(const u32x4*)(base + (size_t)(tid >> 2) * a.ld + a.vcol + 8 * (tid & 3));
        const size_t vo = (size_t)c * a.vec_stride + 16 * wid + 4 * fq;
        vem = *(const f32x4*)(a.em + vo); vel = *(const f32x4*)(a.el + vo); velm = *(const f32x4*)(a.elm + vo);
    };
    issue_loads(0);
    for (int c = 0; c < a.nchunks; ++c) {
#pragma unroll
        for (int rr = 0; rr < 2; ++rr) { *(LAS u32x4*)(QT + (t0 + 32 * rr) * 136 + c8) = rq[rr]; *(LAS u32x4*)(KT + (t0 + 32 * rr) * 136 + c8) = rk[rr]; }
        { LAS bf16_t* kp = KTT + (tid >> 2) * 72 + 16 * (tid & 3); *(LAS u32x4*)kp = rkt[0]; *(LAS u32x4*)(kp + 8) = rkt[1]; }
        if (tid < 256) { const int tv = tid >> 2, v8 = (tid & 3) * 8;
#pragma unroll
            for (int i = 0; i < 8; ++i) VT[(v8 + i) * 72 + tv] = (bf16_t)((i & 1) ? (rv[i >> 1] >> 16) : (rv[i >> 1] & 0xffffu)); }
#pragma unroll
        for (int vi = 0; vi < 2; ++vi) { u32x2 w; w.x = pk2(Sacc[vi][0] * vem[0], Sacc[vi][1] * vem[1]); w.y = pk2(Sacc[vi][2] * vem[2], Sacc[vi][3] * vem[3]); *(LAS u32x2*)(ST + (16 * vi + fr) * 136 + 16 * wid + 4 * fq) = w; }
        const f32x4 cel = vel, celm = velm;
        if (c + 1 < a.nchunks) issue_loads(c + 1);
        __syncthreads();
        { const int ti = wid >> 1;
#pragma unroll
          for (int sh = 0; sh < 2; ++sh) { const int si = 2 * (wid & 1) + sh; f32x4 pa = {0.f, 0.f, 0.f, 0.f};
              if (si <= ti) {
#pragma unroll
                  for (int kk = 0; kk < 4; ++kk) { const bf16x8 A = *(const LAS bf16x8*)(KT + (16 * si + fr) * 136 + 32 * kk + 8 * fq), B = *(const LAS bf16x8*)(QT + (16 * ti + fr) * 136 + 32 * kk + 8 * fq); pa = MFMA16(A, B, pa); }
                  if (si == ti) {
#pragma unroll
                      for (int j = 0; j < 4; ++j) if (4 * fq + j > fr) pa[j] = 0.f; }
              }
              u32x2 w; w.x = pk2(pa[0], pa[1]); w.y = pk2(pa[2], pa[3]); *(LAS u32x2*)(PP + (16 * ti + fr) * 72 + 16 * si + 4 * fq) = w; } }
        __syncthreads();
        { const int ti = wid >> 1, vi = wid & 1; f32x4 o = {0.f, 0.f, 0.f, 0.f};
#pragma unroll
          for (int kk = 0; kk < 2; ++kk) { const bf16x8 A = *(const LAS bf16x8*)(VT + (16 * vi + fr) * 72 + 32 * kk + 8 * fq), B = *(const LAS bf16x8*)(PP + (16 * ti + fr) * 72 + 32 * kk + 8 * fq); o = MFMA16(A, B, o); }
#pragma unroll
          for (int kk = 0; kk < 4; ++kk) { const bf16x8 A = *(const LAS bf16x8*)(ST + (16 * vi + fr) * 136 + 32 * kk + 8 * fq), B = *(const LAS bf16x8*)(QT + (16 * ti + fr) * 136 + 32 * kk + 8 * fq); o = MFMA16(A, B, o); }
          u32x2 w; w.x = pk2(o[0], o[1]); w.y = pk2(o[2], o[3]);
          *(u32x2*)(a.proj + (a.row0 + (size_t)c * 64 + 16 * ti + fr) * a.ld + a.vcol + 16 * vi + 4 * fq) = w; }
#pragma unroll
        for (int vi = 0; vi < 2; ++vi) { f32x4 u = {0.f, 0.f, 0.f, 0.f};
#pragma unroll
            for (int kk = 0; kk < 2; ++kk) { const bf16x8 A = *(const LAS bf16x8*)(KTT + (16 * wid + fr) * 72 + 32 * kk + 8 * fq), B = *(const LAS bf16x8*)(VT + (16 * vi + fr) * 72 + 32 * kk + 8 * fq); u = MFMA16(A, B, u); }
            Sacc[vi] = Sacc[vi] * cel + u * celm; }
        __syncthreads();
    }
#pragma unroll
    for (int vi = 0; vi < 2; ++vi)
#pragma unroll
        for (int j = 0; j < 4; ++j) a.sout[(size_t)(16 * wid + 4 * fq + j) * a.sstride + 16 * vi + fr] = Sacc[vi][j];
}

constexpr int AT_PITCH = 264, AT_KOFF = 128 * AT_PITCH * 2, AT_KP = 136;
static_assert(AT_KOFF + 256 * AT_KP * 2 <= LDS_ST_OFF, "attention LDS");
__device__ __forceinline__ void mem_attn(LAS unsigned char* lds, const bf16_t* Kb, const bf16_t* Vb, bf16_t* Q, int ld, int nrows) {
    int tid_ = threadIdx.x; asm volatile("" : "+v"(tid_));
    const int tid = tid_, wid = __builtin_amdgcn_readfirstlane(tid >> 6), lane = tid & 63, fr = lane & 15, fq = lane >> 4;
    LAS bf16_t* VT = (LAS bf16_t*)lds;
    LAS bf16_t* KS = (LAS bf16_t*)(lds + AT_KOFF);
#pragma unroll
    for (int it = 0; it < 8; ++it) { const int idx = tid + NTHR * it, key = idx >> 4, v8 = (idx & 15) * 8; const u32x4 v = *(const u32x4*)(Vb + (size_t)key * 512 + v8), kx = *(const u32x4*)(Kb + (size_t)key * 512 + v8);
        *(LAS u32x4*)(KS + key * AT_KP + v8) = kx;
#pragma unroll
        for (int i = 0; i < 8; ++i) VT[(v8 + i) * AT_PITCH + key] = (bf16_t)((i & 1) ? (v[i >> 1] >> 16) : (v[i >> 1] & 0xffffu)); }
    __syncthreads();
    const float sc = 0.08838834764831845f;
    for (int q0 = wid * 16; q0 < nrows; q0 += 128) {
        bf16x8 Qf0, Qf1, Qf2, Qf3;
        { const bf16_t* qp = Q + (size_t)(q0 + fr) * ld + 8 * fq; Qf0 = *(const bf16x8*)(qp); Qf1 = *(const bf16x8*)(qp + 32); Qf2 = *(const bf16x8*)(qp + 64); Qf3 = *(const bf16x8*)(qp + 96); }
        f32x4 s[16];
#pragma unroll
        for (int a = 0; a < 16; ++a) {
            const LAS bf16_t* kp = KS + (16 * a + fr) * AT_KP + 8 * fq;
            f32x4 t = {0.f, 0.f, 0.f, 0.f};
            t = MFMA16(*(const LAS bf16x8*)(kp), Qf0, t); t = MFMA16(*(const LAS bf16x8*)(kp + 32), Qf1, t); t = MFMA16(*(const LAS bf16x8*)(kp + 64), Qf2, t); t = MFMA16(*(const LAS bf16x8*)(kp + 96), Qf3, t);
            s[a] = t;
            if ((a & 3) == 3) asm volatile("" ::: "memory");
        }
        float mx = -3.0e38f;
#pragma unroll
        for (int a = 0; a < 16; ++a) mx = fmaxf(fmaxf(mx, fmaxf(s[a][0], s[a][1])), fmaxf(s[a][2], s[a][3]));
        mx = fmaxf(mx, __shfl_xor(mx, 16)); mx = fmaxf(mx, __shfl_xor(mx, 32));
        float sum = 0.f; u32x2 pk[16];
#pragma unroll
        for (int a = 0; a < 16; ++a) { const float e0 = __expf((s[a][0] - mx) * sc), e1 = __expf((s[a][1] - mx) * sc), e2 = __expf((s[a][2] - mx) * sc), e3 = __expf((s[a][3] - mx) * sc);
            sum += (e0 + e1) + (e2 + e3); pk[a].x = pk2(e0, e1); pk[a].y = pk2(e2, e3); }
        sum += __shfl_xor(sum, 16); sum += __shfl_xor(sum, 32);
        const float inv = 1.0f / sum;
        f32x4 o[8];
#pragma unroll
        for (int dt = 0; dt < 8; ++dt) o[dt] = (f32x4){0.f, 0.f, 0.f, 0.f};
#pragma unroll
        for (int ap = 0; ap < 8; ++ap) {
            const u32x4 bv = {pk[2 * ap].x, pk[2 * ap].y, pk[2 * ap + 1].x, pk[2 * ap + 1].y};
            const bf16x8 B = __builtin_bit_cast(bf16x8, bv);
#pragma unroll
            for (int dt = 0; dt < 8; ++dt) {
                const u32x2 lo = *(const LAS u32x2*)(VT + (16 * dt + fr) * AT_PITCH + 32 * ap + 4 * fq), hi = *(const LAS u32x2*)(VT + (16 * dt + fr) * AT_PITCH + 32 * ap + 16 + 4 * fq);
                const u32x4 av = {lo.x, lo.y, hi.x, hi.y};
                o[dt] = MFMA16(__builtin_bit_cast(bf16x8, av), B, o[dt]);
            }
        }
#pragma unroll
        for (int dt = 0; dt < 8; ++dt) { u32x2 w; w.x = pk2(o[dt][0] * inv, o[dt][1] * inv); w.y = pk2(o[dt][2] * inv, o[dt][3] * inv);
            *(u32x2*)(Q + (size_t)(q0 + fr) * ld + 16 * dt + 4 * fq) = w; }
    }
    __syncthreads();
}

__device__ __forceinline__ void mixprep_phase(LAS unsigned char* lds, const Params& p, int layer) {
    const int j = layer >> 1, gla = layer & 1, w = lbid(), G = gridDim.x;
    bf16_t* proj = (bf16_t*)(p.ws + WS_PROJ);
    const int ld = gla ? GL_LD : HG_LD, nh = gla ? 4 : 8;
    bf16_t* ktb = (bf16_t*)(p.ws + WS_XN);
    float* vec = (float*)(p.ws + WS_VEC);
    const int xq = gla ? 3584 : 4096;
    for (int it = w; it < 256 + 64; it += G) {
        const bf16_t* Kb; const bf16_t* Vb; bf16_t* Qp; int nrows;
        if (it < 256) { const int bh = it >> 3, grp = it & 7, b = bh >> 2, h = bh & 3;
            Kb = (const bf16_t*)(p.ws + WS_MKB) + ((size_t)layer * 2048 + b * 256) * 512 + h * 128;
            Vb = (const bf16_t*)(p.ws + WS_MVB) + ((size_t)layer * 2048 + b * 256) * 512 + h * 128;
            Qp = proj + ((size_t)b * 8192 + grp * 1024) * ld + xq + h * 128; nrows = 1024;
        } else { const int bh = it - 256, b = bh >> 2, h = bh & 3;
            Kb = (const bf16_t*)(p.ws + WS_CKB) + ((size_t)layer * 4096 + b * 256) * 512 + h * 128;
            Vb = (const bf16_t*)(p.ws + WS_CVB) + ((size_t)layer * 4096 + b * 256) * 512 + h * 128;
            Qp = proj + ((size_t)MP + b * 64) * ld + xq + h * 128; nrows = 64;
        }
        mem_attn(lds, Kb, Vb, Qp, ld, nrows);
    }
    { const int h = w % nh;
      mixprep_loop(lds, proj, ld, h * 128, (gla ? 512 : 1024) + h * 128, gla ? 1024 + h * 128 : 0, gla,
                   gla ? nullptr : p.in[13] + h * 128, gla ? nullptr : p.in[13] + 1024 + h * 128, j, gla ? p.in[18] + j * 512 + h * 128 : nullptr,
                   ktb + (size_t)h * 8192, nh, vec + h * 128, w / nh, G / nh); }
}
__device__ __forceinline__ void chain_phase(LAS unsigned char* lds, const Params& p, int layer) {
    const int j = layer >> 1, gla = layer & 1, w = lbid(), G = gridDim.x;
    bf16_t* proj = (bf16_t*)(p.ws + WS_PROJ);
    const int ld = gla ? GL_LD : HG_LD;
    const int nvs = gla ? 8 : 4, nh = gla ? 4 : 8, vdim = gla ? 256 : 128;
    const bf16_t* ktb = (const bf16_t*)(p.ws + WS_XN);
    const float* vec = (const float*)(p.ws + WS_VEC);
    const int n_prompt = 8 * nh * nvs  , n_sample = 16 * nh * nvs  ;
    for (int it = w; it < n_prompt + n_sample; it += G) {
        const bool smp = it >= n_prompt; const int id = smp ? it - n_prompt : it;
        const int lo = id & 7, rest = id >> 3, vs = rest % nvs, hi = rest / nvs, bh = lo + 8 * hi, b = bh / nh, h = bh % nh;
        ChainArgs a;
        a.proj = proj; a.ld = ld;
        a.row0 = smp ? (size_t)MP + (size_t)b * 64 : (size_t)b * 8192; a.nchunks = smp ? 1 : 128;
        const int ci0 = smp ? 1024 + b : b * 128;
        if (gla) { a.qcol = h * 128; a.kcol = 512 + h * 128; a.vcol = 2560 + h * 256 + 32 * vs; }
        else { a.qcol = h * 128; a.kcol = 1024 + h * 128; a.vcol = 3072 + h * 128 + 32 * vs; }
        a.ktb = ktb + ((size_t)ci0 * nh + h) * 8192; a.ktb_stride = (size_t)nh * 8192;
        a.em = vec + (size_t)ci0 * 1024 + h * 128; a.el = a.em + (size_t)NCHUNK * 1024; a.elm = a.el + (size_t)NCHUNK * 1024; a.vec_stride = 1024;
        const size_t per_b = (size_t)nh * 128 * vdim, so = ((size_t)b * nh + h) * 128 * vdim + 32 * vs;
        if (smp) { a.s0 = (gla ? p.in[6] : p.in[5]) + (size_t)j * 16 * per_b + so; a.sout = p.out + (gla ? O_SGS : O_SHS) + (size_t)j * 16 * per_b + so; }
        else { a.s0 = nullptr; a.sout = p.out + (gla ? O_SGP : O_SHP) + (size_t)j * 8 * per_b + so; }
        a.sstride = vdim;
        mixer_chain(lds, a);
    }
}

#define XB_TMO      128
#define XB_XCNT(j)  (256  + 64 * (j))
#define XB_XSUB(j)  (1280 + 64 * (j))
#define XB_XGEN(j)  (2304 + 64 * (j))
#define XB_TOP      3328
#define XB_TOPGEN   3392
#define XCD_BAR_WORDS 3456
#define XB_SPIN_CAP (1u << 22)
__device__ __forceinline__ unsigned xb_ld(unsigned* p)              { return __hip_atomic_load(p, __ATOMIC_RELAXED, __HIP_MEMORY_SCOPE_AGENT); }
__device__ __forceinline__ unsigned xb_add(unsigned* p, unsigned v) { return __hip_atomic_fetch_add(p, v, __ATOMIC_RELAXED, __HIP_MEMORY_SCOPE_AGENT); }
__device__ __forceinline__ unsigned xb_xcc_id() { return (unsigned)__builtin_amdgcn_s_getreg((3 << 11) | 20) & 0xFu; }
#define XB_SPIN(cond, bar) do { unsigned _sp = 0; while (cond) { __builtin_amdgcn_s_sleep(1); \
    if ((++_sp & 255u) == 0u) { if (xb_ld(&(bar)[XB_TMO])) break; if (_sp > XB_SPIN_CAP) { atomicAdd(&(bar)[XB_TMO], 1u); break; } } } } while (0)
struct XcdBarrier { unsigned* bar; unsigned x; volatile LAS unsigned* st; };
__device__ __forceinline__ XcdBarrier xcd_barrier_post(unsigned* bar, volatile LAS unsigned* st) {
    XcdBarrier b; b.bar = bar; b.x = xb_xcc_id(); b.st = st;
    if (threadIdx.x == 0) (void)xb_add(&bar[XB_XCNT(b.x)], 1u);
    return b;
}
__device__ __forceinline__ void xcd_barrier_complete(unsigned* bar, unsigned x, unsigned& nloc, unsigned& nx) {
    const unsigned G = gridDim.x * gridDim.y * gridDim.z;
    unsigned sum, cnt, mine, sp = 0u;
    for (;;) {
        sum = 0u; cnt = 0u; mine = 0u;
#pragma unroll
        for (unsigned j = 0; j < 16; ++j) { const unsigned c = xb_ld(&bar[XB_XCNT(j)]); sum += c; cnt += (c > 0u) ? 1u : 0u; mine = (j == x) ? c : mine; }
        if (sum == G) break;
        __builtin_amdgcn_s_sleep(1);
        if ((++sp & 255u) == 0u) { if (xb_ld(&bar[XB_TMO])) break; if (sp > XB_SPIN_CAP) { atomicAdd(&bar[XB_TMO], 1u); break; } }
    }
    nloc = mine > 0u ? mine : 1u; nx = cnt > 0u ? cnt : 1u;
}
__device__ __forceinline__ void xcd_barrier(const XcdBarrier& b) {
    asm volatile("s_waitcnt vmcnt(0)" ::: "memory");
    __syncthreads();
    if (threadIdx.x == 0) {
        unsigned* bar = b.bar;
        __builtin_amdgcn_s_waitcnt(0);
        unsigned nloc = b.st[0], nx = b.st[1];
        if (nloc == 0u) { xcd_barrier_complete(bar, b.x, nloc, nx); b.st[0] = nloc; b.st[1] = nx; }
        const unsigned old = xb_add(&bar[XB_XSUB(b.x)], 1u);
        const unsigned gen = old / nloc;
        if (old + 1u == (gen + 1u) * nloc) {
            __builtin_amdgcn_fence(__ATOMIC_RELEASE, "agent");
            asm volatile("s_waitcnt vmcnt(0)" ::: "memory");
            const unsigned og = xb_add(&bar[XB_TOP], 1u);
            const unsigned tg = og / nx;
            if (og + 1u == (tg + 1u) * nx) xb_add(&bar[XB_TOPGEN], 1u);
            else XB_SPIN(xb_ld(&bar[XB_TOPGEN]) == tg, bar);
            __builtin_amdgcn_fence(__ATOMIC_ACQUIRE, "agent");
            xb_add(&bar[XB_XGEN(b.x)], 1u);
            asm volatile("s_waitcnt vmcnt(0)" ::: "memory");
        } else {
            XB_SPIN(xb_ld(&bar[XB_XGEN(b.x)]) == gen, bar);
            __builtin_amdgcn_fence(__ATOMIC_ACQUIRE, "agent");
            asm volatile("s_waitcnt vmcnt(0)" ::: "memory");
        }
    }
    __syncthreads();
}

constexpr int PPL = 9;
constexpr int NPHASE = 2 + 4 * PPL + 1;
#define WSB(off) ((bf16_t*)(p.ws + (off)))
#define STATS(li) ((float*)(p.ws + WS_STATS) + (size_t)(li) * MROWS * 2)
__global__ void __launch_bounds__(NTHR, 2) trunk_fwd(Params p) {
    extern __shared__ __attribute__((aligned(16))) unsigned char lds_raw[];
    LAS unsigned char* lds = (LAS unsigned char*)lds_raw;
    if (p.ph_hi - p.ph_lo > 1) {
        if (threadIdx.x < 4) ((LAS unsigned*)(lds + LDS_ST_OFF))[threadIdx.x] = 0u;
        __syncthreads();
        (void)xcd_barrier_post((unsigned*)(p.ws + WS_BAR), (volatile LAS unsigned*)(lds + LDS_ST_OFF));
    }
    for (int ph = p.ph_lo; ph < p.ph_hi; ++ph) {
        if (ph == 0) prep_phase(lds, p);
        else if (ph == 1) { Epi E{EPI_MEMKV, nullptr, 0, nullptr, 0.f, p.out + O_MK, p.out + O_MV, WSB(WS_MKB), WSB(WS_MVB), nullptr, nullptr, nullptr, nullptr, nullptr};
            gemm_phase<EPI_MEMKV>(lds, WSB(WS_MEMP), 1024, WSB(WS_MEMW), 2048, 4096, 1024, E); }
        else if (ph == NPHASE - 1) ln_phase(p.out + O_Y, nullptr, p.in[10] + 11 * 1024, p.in[11] + 11 * 1024);
        else {
            const int layer = (ph - 2) / PPL, s = (ph - 2) % PPL, gla = layer & 1, j = layer >> 1;
            if (s == 0 || s == 7) {
                const int lf = layer * 2 + (s == 7), li = (s == 7) ? 3 * layer + 1 : 3 * layer - 1;
                const float* cv = (const float*)(p.ws + WS_CV_WGU) + (size_t)lf * 2 * 5632;
                Epi E{EPI_SWIGLU, WSB(WS_PROJ), FF, nullptr, 0.f, nullptr, nullptr, nullptr, nullptr, li >= 0 ? STATS(li) : nullptr, cv, cv + 5632, nullptr, nullptr};
                gemm_phase<EPI_SWIGLU>(lds, WSB(WS_XN), 1024, WSB(WS_WGU) + (size_t)lf * 5632 * 1024, MROWS, 5632, 1024, E); }
            else if (s == 1 || s == 8) {
                const int lf = layer * 2 + (s == 8), li_in = (s == 8) ? 3 * layer + 1 : 3 * layer - 1, li_out = (s == 8) ? 3 * layer + 2 : 3 * layer;
                Epi E{EPI_RES, nullptr, 0, p.out + O_Y, 0.5f, nullptr, nullptr, nullptr, nullptr, li_in >= 0 ? STATS(li_in) : nullptr,
                      li_in >= 0 ? p.in[10] + li_in * 1024 : nullptr, li_in >= 0 ? p.in[11] + li_in * 1024 : nullptr, STATS(li_out), WSB(WS_XN)};
                gemm_phase<EPI_RES>(lds, WSB(WS_PROJ), FF, WSB(WS_WD) + (size_t)lf * 1024 * FF, MROWS, 1024, FF, E); }
            else if (s == 2) {
                const int li = 3 * layer;
                const float* cv = gla ? (const float*)(p.ws + WS_CV_GWIN) + (size_t)j * 2 * 4096 : (const float*)(p.ws + WS_CV_HWIN) + (size_t)j * 2 * 4608;
                Epi E{EPI_BF16, WSB(WS_PROJ), gla ? GL_LD : HG_LD, nullptr, 0.f, nullptr, nullptr, nullptr, nullptr, STATS(li), cv, cv + (gla ? 4096 : 4608), nullptr, nullptr};
                if (gla) gemm_phase<EPI_BF16>(lds, WSB(WS_XN), 1024, WSB(WS_GWIN) + (size_t)j * 4096 * 1024, MROWS, 4096, 1024, E);
                else gemm_phase<EPI_BF16>(lds, WSB(WS_XN), 1024, WSB(WS_HWIN) + (size_t)j * 4608 * 1024, MROWS, 4608, 1024, E); }
            else if (s == 3) mixprep_phase(lds, p, layer);
            else if (s == 4) chain_phase(lds, p, layer);
            else if (s == 5) { if (gla) headnorm_phase(WSB(WS_PROJ), GL_LD, 2560, 1536, 32, p.in[19] + j * 1024); else headnorm_phase(WSB(WS_PROJ), HG_LD, 3072, 2048, 16, p.in[14] + j * 1024); }
            else if (s == 6) {
                const int li_in = 3 * layer;
                Epi E{EPI_RES, nullptr, 0, p.out + O_Y, 1.0f, nullptr, nullptr, nullptr, nullptr, STATS(li_in), p.in[10] + li_in * 1024, p.in[11] + li_in * 1024, STATS(li_in + 1), WSB(WS_XN)};
                gemm_phase<EPI_RES>(lds, WSB(WS_PROJ) + (gla ? 2560 : 3072), gla ? GL_LD : HG_LD, WSB(WS_WOUT) + (size_t)layer * 1024 * 1536, MROWS, 1024, 1536, E); }
        }
        if (ph + 1 < p.ph_hi) {
            if (ph == 0) cg::this_grid().sync();
            else { XcdBarrier bar; bar.bar = (unsigned*)(p.ws + WS_BAR); bar.x = xb_xcc_id(); bar.st = (volatile LAS unsigned*)(lds + LDS_ST_OFF); xcd_barrier(bar); }
        }
    }
}
#undef WSB
#undef STATS

extern "C" void kernel_launch(void* const* d_in, const int* in_sizes, int n_in, void* d_out, int out_size, void* d_ws, size_t ws_size, hipStream_t stream) {
    static int grid = 0;
    if (grid == 0) {
        if (n_in != 23 || ws_size < WS_END) { fprintf(stderr, "kernel_launch: need 23 inputs and %zu bytes of workspace; got %d, %zu\n", (size_t)WS_END, n_in, ws_size); grid = -1; return; }
        if (hipFuncSetAttribute((const void*)trunk_fwd, hipFuncAttributeMaxDynamicSharedMemorySize, LDS_BYTES) != hipSuccess) { fprintf(stderr, "kernel_launch: hipFuncSetAttribute failed\n"); grid = -1; return; }
        int dev = 0, cus = 0, per_cu = 0;
        (void)hipGetDevice(&dev); (void)hipDeviceGetAttribute(&cus, hipDeviceAttributeMultiprocessorCount, dev);
        (void)hipOccupancyMaxActiveBlocksPerMultiprocessor(&per_cu, (const void*)trunk_fwd, NTHR, LDS_BYTES);
        if (per_cu < 1) { fprintf(stderr, "kernel_launch: occupancy query says %d blocks per CU\n", per_cu); per_cu = 1; }
        (void)hipGetLastError();
        grid = cus;
    }
    if (grid < 0) return;
    Params p{};
    for (int i = 0; i < 23; ++i) p.in[i] = (const float*)d_in[i];
    p.out = (float*)d_out; p.ws = (unsigned char*)d_ws;
#if ONE_LAUNCH
    (void)hipMemsetAsync((unsigned char*)d_ws + WS_BAR, 0, WS_ZERO_END - WS_BAR, stream);
    p.ph_lo = 0; p.ph_hi = NPHASE;
    void* args[] = {&p};
    hipError_t e = hipLaunchCooperativeKernel((const void*)trunk_fwd, dim3(grid), dim3(NTHR), args, LDS_BYTES, stream);
    if (e != hipSuccess) fprintf(stderr, "cooperative launch failed: %s (grid %d)\n", hipGetErrorString(e), grid);
#else
    (void)hipMemsetAsync((unsigned char*)d_ws + WS_BAR, 0, WS_ZERO_END - WS_BAR, stream);
    for (int ph = 0; ph < NPHASE; ++ph) {
        p.ph_lo = ph; p.ph_hi = ph + 1;
        hipLaunchKernelGGL(trunk_fwd, dim3(grid), dim3(NTHR), LDS_BYTES, stream, p);
    }
#endif
}
```

```cpp
#include <hip/hip_runtime.h>
#include <hip/hip_cooperative_groups.h>
#include <cstdio>
namespace cg = cooperative_groups;

#ifndef ONE_LAUNCH
#define ONE_LAUNCH 1
#endif

#define LAS __attribute__((address_space(3)))
typedef unsigned short bf16_t;
typedef short bf16x8 __attribute__((ext_vector_type(8)));
typedef float f32x4 __attribute__((ext_vector_type(4)));
typedef float f32x2 __attribute__((ext_vector_type(2)));
typedef unsigned u32x4 __attribute__((ext_vector_type(4)));
typedef unsigned u32x2 __attribute__((ext_vector_type(2)));
typedef __bf16 nbf2 __attribute__((ext_vector_type(2)));

constexpr int D = 1024, MP = 65536, MS = 1024, MROWS = MP + MS, FF = 2816;
constexpr int HG_LD = 4608, GL_LD = 4096;
constexpr float ALPHA = 1.6817928305074292f;
constexpr int NTHR = 512;
constexpr int LDS_BYTES = 144 * 1024;
constexpr int LDS_ST_OFF = 143360;
constexpr int NCHUNK = MROWS / 64;
constexpr int LDS_X = 131072;

constexpr size_t O_Y = 0;
constexpr size_t O_SHP = (size_t)MROWS * D;
constexpr size_t O_SGP = O_SHP + 2u * 8 * 8 * 128 * 128;
constexpr size_t O_MK = O_SGP + 2u * 8 * 4 * 128 * 256;
constexpr size_t O_MV = O_MK + 4u * 2048 * 512;
constexpr size_t O_SHS = O_MV + 4u * 2048 * 512;
constexpr size_t O_SGS = O_SHS + 2u * 16 * 8 * 128 * 128;

constexpr size_t WS_WGU = 0;
constexpr size_t WS_WD = WS_WGU + 8ull * 5632 * 1024 * 2;
constexpr size_t WS_HWIN = WS_WD + 8ull * 1024 * 2816 * 2;
constexpr size_t WS_GWIN = WS_HWIN + 2ull * 4608 * 1024 * 2;
constexpr size_t WS_WOUT = WS_GWIN + 2ull * 4096 * 1024 * 2;
constexpr size_t WS_MEMW = WS_WOUT + 4ull * 1024 * 1536 * 2;
constexpr size_t WS_MEMP = WS_MEMW + 4096ull * 1024 * 2;
constexpr size_t WS_MKB = WS_MEMP + 2048ull * 1024 * 2;
constexpr size_t WS_MVB = WS_MKB + 4ull * 2048 * 512 * 2;
constexpr size_t WS_CKB = WS_MVB + 4ull * 2048 * 512 * 2;
constexpr size_t WS_CVB = WS_CKB + 4ull * 4096 * 512 * 2;
constexpr size_t WS_XN = WS_CVB + 4ull * 4096 * 512 * 2;
constexpr size_t WS_PROJ = WS_XN + (size_t)MROWS * 1024 * 2;
constexpr size_t WS_VEC = WS_PROJ + (size_t)MROWS * 4608 * 2;
constexpr size_t WS_BAR = WS_VEC + 3ull * (MROWS / 64) * 1024 * 4;
constexpr size_t WS_STATS = WS_BAR + 16384;
constexpr size_t WS_CV_WGU = WS_STATS + 12ull * MROWS * 8;
constexpr size_t WS_CV_HWIN = WS_CV_WGU + 8ull * 2 * 5632 * 4;
constexpr size_t WS_CV_GWIN = WS_CV_HWIN + 2ull * 2 * 4608 * 4;
constexpr size_t WS_ZERO_END = WS_CV_GWIN + 2ull * 2 * 4096 * 4;
constexpr size_t WS_END = WS_ZERO_END;

struct Params {
    const float* in[23];
    float* out;
    unsigned char* ws;
    int ph_lo, ph_hi;
};

__device__ __forceinline__ unsigned pk2(float lo, float hi) { f32x2 v = {lo, hi}; nbf2 b = __builtin_convertvector(v, nbf2); return __builtin_bit_cast(unsigned, b); }
__device__ __forceinline__ float bflo(unsigned u) { return __uint_as_float(u << 16); }
__device__ __forceinline__ float bfhi(unsigned u) { return __uint_as_float(u & 0xffff0000u); }
__device__ __forceinline__ bf16_t f2bf(float f) { unsigned u = pk2(f, 0.f); return (bf16_t)(u & 0xffffu); }
__device__ __forceinline__ float sigmoidf_(float x) { return 1.0f / (1.0f + __expf(-x)); }
__device__ __forceinline__ int ltid() { int t = threadIdx.x; asm volatile("" : "+v"(t)); return t; }
__device__ __forceinline__ int lbid() { int t = blockIdx.x; asm volatile("" : "+s"(t)); return t; }
#define MFMA16(a, b, c) __builtin_amdgcn_mfma_f32_16x16x32_bf16((a), (b), (c), 0, 0, 0)

constexpr int BM = 256, BK = 64, HALF = 128, HTB = HALF * BK * 2, NXCD = 8, WGM = 8;
__device__ __forceinline__ int lds_byte(int r, int c) { const int st = (r >> 4) * 2 + (c >> 5), rr = r & 15, cc = c & 31, ob = rr * 64 + cc * 2; return st * 1024 + (ob ^ (((ob >> 9) & 1) << 5)); }
__device__ __forceinline__ void stage_rc(int b, int& R, int& C) { const int st = b / 1024, sb = b % 1024, swz = sb ^ (((sb >> 9) & 1) << 5); R = (st >> 1) * 16 + swz / 64; C = (st & 1) * 32 + (swz % 64) / 2; }
__device__ __forceinline__ int perm32(int rho) { const int n = rho >> 4, i = rho & 15; return 8 * (i >> 2) + 4 * n + (i & 3); }

struct Unit { int pm, pn; };
struct StaticOrder {
    int nM, nN, nwg, G, c;
    __device__ __forceinline__ void init(int M, int N, int G_, int c_) { nM = M / BM; nN = N / BM; nwg = nM * nN; G = G_; c = c_; }
    __device__ __forceinline__ bool next(int i, Unit& u) const {
        const long L = (long)i * G + c; if (L >= nwg) return false;
        int wgid = (int)L; { const int q = nwg / NXCD, r = nwg % NXCD, xcd = wgid % NXCD, off = wgid / NXCD; wgid = (xcd < r ? xcd * (q + 1) : r * (q + 1) + (xcd - r) * q) + off; }
        const int nig = WGM * nN, gid = wgid / nig, fm = gid * WGM, gsz = (nM - fm) < WGM ? (nM - fm) : WGM;
        u.pm = fm + ((wgid % nig) % gsz); u.pn = (wgid % nig) / gsz; return true;
    }
};

enum { EPI_SWIGLU = 0, EPI_BF16 = 1, EPI_RES = 2, EPI_MEMKV = 3 };
struct Epi { int mode; bf16_t* ob; int ldo; float* xf; float scale; float* mk_out; float* mv_out; bf16_t* mkb; bf16_t* mvb;
             const float* st_in; const float* v1; const float* v2; float* st_out; bf16_t* ybf; };
__device__ __forceinline__ void row_mu_rstd(const LAS float* XS, bool has, int rl, float& mu, float& rstd) {
    if (has) { const f32x2 q = *(const LAS f32x2*)(XS + 2 * rl); mu = q.x * (1.0f / 1024.0f); rstd = __builtin_amdgcn_rsqf(fmaxf(q.y * (1.0f / 1024.0f) - mu * mu, 0.f) + 1e-5f); }
    else { mu = 0.f; rstd = 1.0f; }
}

template <int MODE> __device__ __forceinline__ void gemm_epilogue(const f32x4 (&acc)[2][2][4][2], const Unit& u, int wr, int wc, int fr, int fq, const Epi& E, LAS unsigned char* lds) {
    const int row0 = u.pm * BM + wr * 64 + fr;
    const LAS float* XS = (const LAS float*)(lds + LDS_X); const bool has = (E.st_in != nullptr); const int rl0 = wr * 64 + fr;
    if constexpr (MODE == EPI_SWIGLU) {
        const int col0 = u.pn * 128 + wc * 32 + 8 * fq;
        const int cl = wc * 32 + 8 * fq;
        f32x4 c1g[2], c2g[2], c1u[2], c2u[2];
#pragma unroll
        for (int n = 0; n < 2; ++n) {
            if (has) { c1g[n] = *(const LAS f32x4*)(XS + 512 + cl + 4 * n); c2g[n] = *(const LAS f32x4*)(XS + 768 + cl + 4 * n); c1u[n] = *(const LAS f32x4*)(XS + 512 + cl + 128 + 4 * n); c2u[n] = *(const LAS f32x4*)(XS + 768 + cl + 128 + 4 * n); }
            else { c1g[n] = c2g[n] = c1u[n] = c2u[n] = (f32x4){0.f, 0.f, 0.f, 0.f}; }
        }
        float mus[2][4], rstds[2][4];
#pragma unroll
        for (int ai = 0; ai < 2; ++ai)
#pragma unroll
            for (int m = 0; m < 4; ++m) row_mu_rstd(XS, has, rl0 + ai * HALF + m * 16, mus[ai][m], rstds[ai][m]);
#pragma unroll
        for (int ai = 0; ai < 2; ++ai)
#pragma unroll
            for (int m = 0; m < 4; ++m) {
                const int row = row0 + ai * HALF + m * 16;
                const float mu = mus[ai][m], rstd = rstds[ai][m];
                bf16_t* rowp = E.ob + (size_t)row * E.ldo + col0;
                float h[8];
#pragma unroll
                for (int n = 0; n < 2; ++n)
#pragma unroll
                    for (int j = 0; j < 4; ++j) { const float g = rstd * (acc[ai][0][m][n][j] - mu * c1g[n][j]) + c2g[n][j], up = rstd * (acc[ai][1][m][n][j] - mu * c1u[n][j]) + c2u[n][j];
                        h[n * 4 + j] = g * up * __builtin_amdgcn_rcpf(1.0f + __expf(-g)); }
                u32x4 w; w.x = pk2(h[0], h[1]); w.y = pk2(h[2], h[3]); w.z = pk2(h[4], h[5]); w.w = pk2(h[6], h[7]);
                *(u32x4*)rowp = w;
            }
    } else if constexpr (MODE == EPI_BF16) {
        const int col0 = u.pn * BM + wc * 32 + 8 * fq, cl = wc * 32 + 8 * fq;
        f32x4 c1[2][2], c2[2][2];
#pragma unroll
        for (int bj = 0; bj < 2; ++bj)
#pragma unroll
            for (int n = 0; n < 2; ++n) { c1[bj][n] = *(const LAS f32x4*)(XS + 512 + cl + bj * HALF + 4 * n); c2[bj][n] = *(const LAS f32x4*)(XS + 768 + cl + bj * HALF + 4 * n); }
#pragma unroll
        for (int ai = 0; ai < 2; ++ai)
#pragma unroll
            for (int m = 0; m < 4; ++m) {
                const int row = row0 + ai * HALF + m * 16;
                float mu, rstd; row_mu_rstd(XS, has, rl0 + ai * HALF + m * 16, mu, rstd);
                bf16_t* rowp = E.ob + (size_t)row * E.ldo + col0;
#pragma unroll
                for (int bj = 0; bj < 2; ++bj) {
                    const f32x4 v0 = (acc[ai][bj][m][0] - c1[bj][0] * mu) * rstd + c2[bj][0], v1 = (acc[ai][bj][m][1] - c1[bj][1] * mu) * rstd + c2[bj][1];
                    u32x4 w; w.x = pk2(v0[0], v0[1]); w.y = pk2(v0[2], v0[3]); w.z = pk2(v1[0], v1[1]); w.w = pk2(v1[2], v1[3]);
                    *(u32x4*)(rowp + bj * HALF) = w;
                }
            }
    } else if constexpr (MODE == EPI_RES) {
        const int col0 = u.pn * BM + wc * 32 + 4 * fq, cl = wc * 32 + 4 * fq;
#pragma unroll
        for (int bt = 0; bt < 3; ++bt) {
            const int g0 = bt * 3, ng = bt == 2 ? 2 : 3;
            f32x4 xv[3][2][2];
#pragma unroll
            for (int gi = 0; gi < 3; ++gi) if (gi < ng) { const int g = g0 + gi, ai = g >> 2, m = g & 3; const float* rowp = E.xf + (size_t)(row0 + ai * HALF + m * 16) * D + col0;
#pragma unroll
                for (int bj = 0; bj < 2; ++bj)
#pragma unroll
                    for (int n = 0; n < 2; ++n) xv[gi][bj][n] = *(const f32x4*)(rowp + bj * HALF + n * 16); }
#pragma unroll
            for (int gi = 0; gi < 3; ++gi) if (gi < ng) {
                const int g = g0 + gi, ai = g >> 2, m = g & 3;
                const int row = row0 + ai * HALF + m * 16;
                float mu, rstd; row_mu_rstd(XS, has, rl0 + ai * HALF + m * 16, mu, rstd);
                float* rowp = E.xf + (size_t)row * D + col0; bf16_t* rowb = E.ybf + (size_t)row * D + col0;
                float s1 = 0.f, s2 = 0.f;
#pragma unroll
                for (int bj = 0; bj < 2; ++bj)
#pragma unroll
                    for (int n = 0; n < 2; ++n) { f32x4 x = xv[gi][bj][n];
                        if (has) { const f32x4 gp = *(const LAS f32x4*)(XS + 512 + cl + bj * HALF + n * 16), bp = *(const LAS f32x4*)(XS + 768 + cl + bj * HALF + n * 16); x = (x - mu) * rstd * gp + bp; }
                        x = x * ALPHA + acc[ai][bj][m][n] * E.scale;
                        *(f32x4*)(rowp + bj * HALF + n * 16) = x;
                        u32x2 w; w.x = pk2(x[0], x[1]); w.y = pk2(x[2], x[3]); *(u32x2*)(rowb + bj * HALF + n * 16) = w;
                        s1 += (x[0] + x[1]) + (x[2] + x[3]); s2 += (x[0] * x[0] + x[1] * x[1]) + (x[2] * x[2] + x[3] * x[3]); }
                s1 += __shfl_xor(s1, 16); s1 += __shfl_xor(s1, 32); s2 += __shfl_xor(s2, 16); s2 += __shfl_xor(s2, 32);
                if (fq == 0) { atomicAdd(E.st_out + 2 * (size_t)row, s1); atomicAdd(E.st_out + 2 * (size_t)row + 1, s2); }
            }
            asm volatile("" ::: "memory");
        }
    } else {
        const int colt = u.pn * BM; const int l = colt >> 10, kv = (colt >> 9) & 1, cc0 = (colt & 511) + wc * 32 + 4 * fq;
        float* of = (kv ? E.mv_out : E.mk_out) + (size_t)l * 2048 * 512;
        bf16_t* ob = (kv ? E.mvb : E.mkb) + (size_t)l * 2048 * 512;
#pragma unroll
        for (int ai = 0; ai < 2; ++ai)
#pragma unroll
            for (int m = 0; m < 4; ++m) {
                const size_t ro = (size_t)(row0 + ai * HALF + m * 16) * 512 + cc0;
#pragma unroll
                for (int bj = 0; bj < 2; ++bj)
#pragma unroll
                    for (int n = 0; n < 2; ++n) { const f32x4 v = acc[ai][bj][m][n]; *(f32x4*)(of + ro + bj * HALF + n * 16) = v; u32x2 w; w.x = pk2(v[0], v[1]); w.y = pk2(v[2], v[3]); *(u32x2*)(ob + ro + bj * HALF + n * 16) = w; }
            }
    }
}

template <int MODE> __device__ __forceinline__ void gemm_phase(LAS unsigned char* lds, const bf16_t* Ag, int lda, const bf16_t* Btg, int M, int N, int K, const Epi& E) {
    int tid_ = threadIdx.x; asm volatile("" : "+v"(tid_));
    const int tid = tid_, wid = __builtin_amdgcn_readfirstlane(tid >> 6), lane = tid & 63, wr = wid >> 2, wc = wid & 3, fr = lane & 15, fq = lane >> 4;
    const int nt = K / BK;
    constexpr bool PERM = (MODE == EPI_SWIGLU || MODE == EPI_BF16);
    StaticOrder S; { const int G_ = (int)gridDim.x; int c_ = lbid(); if (MODE == EPI_MEMKV) c_ = (c_ + G_ / 2) % G_; S.init(M, N, G_, c_); }
    unsigned voffA[2], voffB[2];
#pragma unroll
    for (int i = 0; i < 2; ++i) { int R, C; stage_rc(tid * 16 + i * 8192, R, C); const int Rb = PERM ? ((R & ~31) + perm32(R & 31)) : R;
        voffA[i] = (unsigned)(R * lda + C) * 2u; voffB[i] = (unsigned)(Rb * K + C) * 2u; }
    const size_t kstep = (size_t)(BK * 2);
    const size_t hstepA = (size_t)HALF * lda * 2, hstepB = (size_t)HALF * K * 2;
    const size_t tstepA = 2 * hstepA, tstepB = 2 * hstepB;
    const unsigned ldsw = (unsigned)wid * 1024u;
    const int aoff = lds_byte(wr * 64 + fr, fq * 8), boff = lds_byte(wc * 32 + fr, fq * 8);
#define PG8_SA(b, h) (((b) * 2 + (h)) * HTB)
#define PG8_SB(b, h) ((4 + (b) * 2 + (h)) * HTB)
#define PG8_STAGE(bufoff, gbase, voff) do { _Pragma("unroll") for (int _i = 0; _i < 2; ++_i) \
        __builtin_amdgcn_global_load_lds((const unsigned*)((const char*)(gbase) + (voff)[_i]), (LAS unsigned*)(lds + (bufoff) + ldsw + _i * 8192), 16, 0, 0); } while (0)
#define PG8_LDA(dst, b, h) do { _Pragma("unroll") for (int m = 0; m < 4; ++m) _Pragma("unroll") for (int k = 0; k < 2; ++k) dst[m][k] = *(const LAS bf16x8*)(lds + PG8_SA(b, h) + aoff + m * 2048 + k * 1024); } while (0)
#define PG8_LDB(dst, b, h) do { _Pragma("unroll") for (int n = 0; n < 2; ++n) _Pragma("unroll") for (int k = 0; k < 2; ++k) dst[n][k] = *(const LAS bf16x8*)(lds + PG8_SB(b, h) + boff + n * 2048 + k * 1024); } while (0)
#define PG8_MMA(ai, bj, At, Bt) do { __builtin_amdgcn_s_setprio(1); _Pragma("unroll") for (int m = 0; m < 4; ++m) _Pragma("unroll") for (int n = 0; n < 2; ++n) _Pragma("unroll") for (int k = 0; k < 2; ++k) \
        acc[ai][bj][m][n] = __builtin_amdgcn_mfma_f32_16x16x32_bf16(Bt[n][k], At[m][k], acc[ai][bj][m][n], 0, 0, 0); __builtin_amdgcn_s_setprio(0); } while (0)
#define PG8_WAIT_V(n) asm volatile("s_waitcnt vmcnt(" #n ")" ::: "memory")
#define PG8_WAIT_L(n) asm volatile("s_waitcnt lgkmcnt(" #n ")" ::: "memory")
#define PG8_BAR __builtin_amdgcn_s_barrier()
#define PG8_SCHED __builtin_amdgcn_sched_barrier(0)
    Unit cur, nxt; int ui = 0;
    if (!S.next(0, cur)) return;
    f32x4 acc[2][2][4][2];
#pragma unroll
    for (int a = 0; a < 2; ++a)
#pragma unroll
        for (int b = 0; b < 2; ++b)
#pragma unroll
            for (int m = 0; m < 4; ++m)
#pragma unroll
                for (int n = 0; n < 2; ++n) acc[a][b][m][n] = (f32x4){0.f, 0.f, 0.f, 0.f};
    bf16x8 At[4][2], B0[2][2], B1[2][2];
    const char* cA = (const char*)Ag + (size_t)cur.pm * tstepA; const char* cB = (const char*)Btg + (size_t)cur.pn * tstepB;
    PG8_STAGE(PG8_SB(0, 0), cB, voffB); PG8_STAGE(PG8_SA(0, 0), cA, voffA); PG8_STAGE(PG8_SB(0, 1), cB + hstepB, voffB); PG8_STAGE(PG8_SA(0, 1), cA + hstepA, voffA);
    if (wr == 1) PG8_BAR;
    PG8_WAIT_V(4); PG8_BAR;
    PG8_STAGE(PG8_SB(1, 0), cB + kstep, voffB); PG8_STAGE(PG8_SA(1, 0), cA + kstep, voffA); PG8_STAGE(PG8_SB(1, 1), cB + hstepB + kstep, voffB);
    PG8_WAIT_V(6); PG8_BAR;
    for (;;) {
        const bool has_next = S.next(ui + 1, nxt);
        const char* nA = has_next ? (const char*)Ag + (size_t)nxt.pm * tstepA : cA; const char* nB = has_next ? (const char*)Btg + (size_t)nxt.pn * tstepB : cB;
        for (int t = 0; t < nt; t += 2) {
            const bool last = (t == nt - 2);
            if (MODE != EPI_MEMKV && t == nt - 4 && E.st_in != nullptr && wid < 4) {
                const char* gsrc = wid < 2 ? (const char*)(E.st_in + 2 * ((size_t)cur.pm * BM + wid * 128)) : (const char*)((wid == 2 ? E.v1 : E.v2) + cur.pn * BM);
                __builtin_amdgcn_global_load_lds((const unsigned*)(gsrc + lane * 16), (LAS unsigned*)(lds + LDS_X + wid * 1024), 16, 0, 0);
            }
            const char* a1 = cA + (size_t)(t + 1) * kstep;
            const char* a2 = last ? nA : cA + (size_t)(t + 2) * kstep; const char* b2 = last ? nB : cB + (size_t)(t + 2) * kstep;
            const char* a3 = a2 + kstep; const char* b3 = b2 + kstep;
            PG8_LDB(B0, 0, 0); PG8_SCHED; PG8_LDA(At, 0, 0); PG8_STAGE(PG8_SA(1, 1), a1 + hstepA, voffA);
            PG8_WAIT_L(8); PG8_BAR; PG8_WAIT_L(0); PG8_MMA(0, 0, At, B0); PG8_BAR; PG8_SCHED;
            PG8_LDB(B1, 0, 1); PG8_STAGE(PG8_SB(0, 0), b2, voffB);
            PG8_BAR; PG8_WAIT_L(0); PG8_MMA(0, 1, At, B1); PG8_BAR;
            PG8_LDA(At, 0, 1); PG8_STAGE(PG8_SA(0, 0), a2, voffA);
            PG8_BAR; PG8_WAIT_L(0); PG8_MMA(1, 0, At, B0); PG8_BAR; PG8_SCHED;
            PG8_STAGE(PG8_SB(0, 1), b2 + hstepB, voffB);
            PG8_WAIT_V(6); PG8_BAR; PG8_MMA(1, 1, At, B1); PG8_BAR;
            PG8_LDB(B0, 1, 0); PG8_SCHED; PG8_LDA(At, 1, 0); PG8_STAGE(PG8_SA(0, 1), a2 + hstepA, voffA);
            PG8_WAIT_L(8); PG8_BAR; PG8_WAIT_L(0); PG8_MMA(0, 0, At, B0); PG8_BAR; PG8_SCHED;
            PG8_LDB(B1, 1, 1); PG8_STAGE(PG8_SB(1, 0), b3, voffB);
            PG8_BAR; PG8_WAIT_L(0); PG8_MMA(0, 1, At, B1); PG8_BAR;
            PG8_LDA(At, 1, 1); PG8_STAGE(PG8_SA(1, 0), a3, voffA);
            PG8_BAR; PG8_WAIT_L(0); PG8_MMA(1, 0, At, B0); PG8_BAR; PG8_SCHED;
            PG8_STAGE(PG8_SB(1, 1), b3 + hstepB, voffB);
            PG8_WAIT_V(6); PG8_BAR; PG8_MMA(1, 1, At, B1); PG8_BAR;
        }
        gemm_epilogue<MODE>(acc, cur, wr, wc, fr, fq, E, lds);
        if (!has_next) break;
#pragma unroll
        for (int a = 0; a < 2; ++a)
#pragma unroll
            for (int b = 0; b < 2; ++b)
#pragma unroll
                for (int m = 0; m < 4; ++m)
#pragma unroll
                    for (int n = 0; n < 2; ++n) acc[a][b][m][n] = (f32x4){0.f, 0.f, 0.f, 0.f};
        cur = nxt; cA = nA; cB = nB; ++ui;
    }
    PG8_WAIT_V(0);
    if (wr == 0) PG8_BAR;
    PG8_BAR;
#undef PG8_SA
#undef PG8_SB
#undef PG8_STAGE
#undef PG8_LDA
#undef PG8_LDB
#undef PG8_MMA
#undef PG8_WAIT_V
#undef PG8_WAIT_L
#undef PG8_BAR
#undef PG8_SCHED
}

__device__ __forceinline__ void transpose_job(LAS unsigned char* lds, const float* src, int ld, int K, int c0, int ncols, bf16_t* dst, int rowmode, int drow0,
                                              const float* gk, const float* bk, float* c1, float* c2) {
    LAS float* tile = (LAS float*)lds;
    int tid_ = threadIdx.x; asm volatile("" : "+v"(tid_)); const int tid = tid_;
    const int nkt = K / 64, nct = ncols / 64, ntiles = nkt * nct;
    for (int t = lbid(); t < ntiles; t += gridDim.x) {
        const int kt = t % nkt, ct = t / nkt;
        const int k0 = kt * 64, n0 = ct * 64;
        { const int kr = tid >> 4, c4 = (tid & 15) * 4;
#pragma unroll
          for (int rr = 0; rr < 64; rr += 32) { const f32x4 v = *(const f32x4*)(src + (size_t)(k0 + kr + rr) * ld + c0 + n0 + c4);
              tile[(kr + rr) * 65 + c4 + 0] = v[0]; tile[(kr + rr) * 65 + c4 + 1] = v[1]; tile[(kr + rr) * 65 + c4 + 2] = v[2]; tile[(kr + rr) * 65 + c4 + 3] = v[3]; } }
        __syncthreads();
        { const int n = tid >> 3, k8 = (tid & 7) * 8; float v[8];
#pragma unroll
          for (int i = 0; i < 8; ++i) v[i] = tile[(k8 + i) * 65 + n];
          const int c = c0 + n0 + n; int drow;
          if (rowmode == 0) drow = drow0 + c; else drow = 256 * (c >> 7) + (c & 127) + (rowmode == 2 ? 128 : 0);
          u32x4 w;
          if (gk) {
              const f32x4 g0 = *(const f32x4*)(gk + k0 + k8), g1 = *(const f32x4*)(gk + k0 + k8 + 4), b0 = *(const f32x4*)(bk + k0 + k8), b1 = *(const f32x4*)(bk + k0 + k8 + 4);
              float s2 = 0.f;
#pragma unroll
              for (int i = 0; i < 4; ++i) { s2 += b0[i] * v[i] + b1[i] * v[4 + i]; v[i] *= g0[i]; v[4 + i] *= g1[i]; }
              w.x = pk2(v[0], v[1]); w.y = pk2(v[2], v[3]); w.z = pk2(v[4], v[5]); w.w = pk2(v[6], v[7]);
              float s1 = 0.f;
#pragma unroll
              for (int i = 0; i < 4; ++i) s1 += bflo(w[i]) + bfhi(w[i]);
              s1 += __shfl_xor(s1, 1); s1 += __shfl_xor(s1, 2); s1 += __shfl_xor(s1, 4);
              s2 += __shfl_xor(s2, 1); s2 += __shfl_xor(s2, 2); s2 += __shfl_xor(s2, 4);
              if ((tid & 7) == 0) { atomicAdd(c1 + drow, s1); atomicAdd(c2 + drow, s2); }
          } else { w.x = pk2(v[0], v[1]); w.y = pk2(v[2], v[3]); w.z = pk2(v[4], v[5]); w.w = pk2(v[6], v[7]); }
          *(u32x4*)(dst + (size_t)drow * K + k0 + k8) = w; }
        __syncthreads();
    }
}
__device__ __forceinline__ void convert_job(const float* src, bf16_t* dst, float* dstf, size_t n) {
    const size_t nv = n / 8;
    for (size_t i = (size_t)lbid() * NTHR + ltid(); i < nv; i += (size_t)gridDim.x * NTHR) {
        const f32x4 a = *(const f32x4*)(src + i * 8), b = *(const f32x4*)(src + i * 8 + 4);
        u32x4 w; w.x = pk2(a[0], a[1]); w.y = pk2(a[2], a[3]); w.z = pk2(b[0], b[1]); w.w = pk2(b[2], b[3]);
        *(u32x4*)(dst + i * 8) = w;
        if (dstf) { *(f32x4*)(dstf + i * 8) = a; *(f32x4*)(dstf + i * 8 + 4) = b; }
    }
}
__device__ __forceinline__ void prep_phase(LAS unsigned char* lds, const Params& p) {
    unsigned char* ws = p.ws;
    for (int jb = 0; jb < 52; ++jb) {
        const float* src; int ld, K, c0, ncols, rowmode, drow0; bf16_t* dst; int li = -1; float* cv = nullptr; int cvn = 0;
        if (jb < 24) { const int lf = jb / 3, t = jb % 3;
            if (t < 2) { src = (t == 0 ? p.in[7] : p.in[8]) + (size_t)lf * 1024 * FF; ld = FF; K = 1024; c0 = 0; ncols = FF; dst = (bf16_t*)(ws + WS_WGU) + (size_t)lf * 5632 * 1024; rowmode = 1 + t; drow0 = 0;
                if (lf > 0) { li = (lf & 1) ? 3 * (lf >> 1) + 1 : 3 * (lf >> 1) - 1; cv = (float*)(ws + WS_CV_WGU) + (size_t)lf * 2 * 5632; cvn = 5632; } }
            else { src = p.in[9] + (size_t)lf * FF * 1024; ld = 1024; K = FF; c0 = 0; ncols = 1024; dst = (bf16_t*)(ws + WS_WD) + (size_t)lf * 1024 * FF; rowmode = 0; drow0 = 0; }
        } else if (jb < 44) { const int j = (jb - 24) / 10, t = (jb - 24) % 10; rowmode = 0; K = 1024;
            if (t < 4) {
                src = p.in[12] + (size_t)j * 1024 * 4608; ld = 4608; dst = (bf16_t*)(ws + WS_HWIN) + (size_t)j * 4608 * 1024;
                c0 = t == 0 ? 0 : (t == 1 ? 3072 : (t == 2 ? 2048 : 4096)); ncols = t == 0 ? 2048 : (t == 3 ? 512 : 1024); drow0 = (t == 0 ? 0 : (t == 1 ? 2048 : (t == 2 ? 3072 : 4096))) - c0;
                li = 3 * (2 * j); cv = (float*)(ws + WS_CV_HWIN) + (size_t)j * 2 * 4608; cvn = 4608;
            } else if (t < 8) {
                src = p.in[16] + (size_t)j * 1024 * 3600; ld = 3600; dst = (bf16_t*)(ws + WS_GWIN) + (size_t)j * 4096 * 1024; const int u = t - 4;
                c0 = u == 0 ? 0 : (u == 1 ? 2048 : (u == 2 ? 1024 : 3088)); ncols = u == 3 ? 512 : 1024; drow0 = (u == 0 ? 0 : (u == 1 ? 1536 : (u == 2 ? 2560 : 3584))) - c0;
                li = 3 * (2 * j + 1); cv = (float*)(ws + WS_CV_GWIN) + (size_t)j * 2 * 4096; cvn = 4096;
            } else { src = (t == 8 ? p.in[15] : p.in[20]) + (size_t)j * 1536 * 1024; ld = 1024; K = 1536; c0 = 0; ncols = 1024; dst = (bf16_t*)(ws + WS_WOUT) + (size_t)(2 * j + (t - 8)) * 1024 * 1536; drow0 = 0; }
        } else { const int l = (jb - 44) >> 1, kv = (jb - 44) & 1; src = (kv ? p.in[22] : p.in[21]) + (size_t)l * 1024 * 512; ld = 512; K = 1024; c0 = 0; ncols = 512; dst = (bf16_t*)(ws + WS_MEMW); rowmode = 0; drow0 = l * 1024 + kv * 512; }
        const float* gk = li >= 0 ? p.in[10] + li * 1024 : nullptr; const float* bk = li >= 0 ? p.in[11] + li * 1024 : nullptr;
        transpose_job(lds, src, ld, K, c0, ncols, dst, rowmode, drow0, gk, bk, cv, cv + cvn);
    }
    for (int j = 0; j < 2; ++j) {
        const float* gs = p.in[16] + (size_t)j * 1024 * 3600; bf16_t* gd = (bf16_t*)(ws + WS_GWIN) + (size_t)j * 4096 * 1024;
        const float* w2 = p.in[17] + (size_t)j * 16 * 512;
        const int li = 3 * (2 * j + 1); const float* gk = p.in[10] + li * 1024; const float* bk = p.in[11] + li * 1024;
        float* c1 = (float*)(ws + WS_CV_GWIN) + (size_t)j * 2 * 4096; float* c2 = c1 + 4096;
        for (int i = lbid() * NTHR + ltid(); i < 512 * 1024; i += gridDim.x * NTHR) {
            const int c = i >> 10, kk = i & 1023; float sacc = 0.f;
#pragma unroll
            for (int r = 0; r < 16; ++r) sacc += gs[(size_t)kk * 3600 + 3072 + r] * w2[r * 512 + c];
            const bf16_t hv = f2bf(sacc * gk[kk]);
            gd[(size_t)(1024 + c) * 1024 + kk] = hv;
            float s1 = __uint_as_float(((unsigned)hv) << 16), s2 = sacc * bk[kk];
#pragma unroll
            for (int o = 32; o >= 1; o >>= 1) { s1 += __shfl_xor(s1, o); s2 += __shfl_xor(s2, o); }
            if ((kk & 63) == 0) { atomicAdd(c1 + 1024 + c, s1); atomicAdd(c2 + 1024 + c, s2); }
        }
    }
    for (int jb = 0; jb < 5; ++jb) {
        const float* src; bf16_t* dst; float* dstf = nullptr; size_t n;
        if (jb == 0) { src = p.in[0]; dst = (bf16_t*)(ws + WS_XN); dstf = p.out + O_Y; n = (size_t)MP * D; }
        else if (jb == 1) { src = p.in[1]; dst = (bf16_t*)(ws + WS_XN) + (size_t)MP * D; dstf = p.out + O_Y + (size_t)MP * D; n = (size_t)MS * D; }
        else if (jb == 2) { src = p.in[2]; dst = (bf16_t*)(ws + WS_MEMP); n = (size_t)2048 * 1024; }
        else if (jb == 3) { src = p.in[3]; dst = (bf16_t*)(ws + WS_CKB); n = (size_t)4 * 4096 * 512; }
        else { src = p.in[4]; dst = (bf16_t*)(ws + WS_CVB); n = (size_t)4 * 4096 * 512; }
        convert_job(src, dst, dstf, n);
    }
}

__device__ __forceinline__ void ln_phase(float* x, bf16_t* xn, const float* gain, const float* bias) {
    int tid_ = threadIdx.x; asm volatile("" : "+v"(tid_));
    const int lane = tid_ & 63, wv = tid_ >> 6;
    f32x4 g[4], b[4];
#pragma unroll
    for (int i = 0; i < 4; ++i) { g[i] = *(const f32x4*)(gain + 4 * lane + 256 * i); b[i] = *(const f32x4*)(bias + 4 * lane + 256 * i); }
    for (int row = lbid() * 8 + wv; row < MROWS; row += gridDim.x * 8) {
        float* xr = x + (size_t)row * D; f32x4 v[4]; float s = 0.f;
#pragma unroll
        for (int i = 0; i < 4; ++i) { v[i] = *(const f32x4*)(xr + 4 * lane + 256 * i); s += (v[i][0] + v[i][1]) + (v[i][2] + v[i][3]); }
#pragma unroll
        for (int o = 32; o >= 1; o >>= 1) s += __shfl_xor(s, o);
        const float mu = s * (1.0f / 1024.0f); float q = 0.f;
#pragma unroll
        for (int i = 0; i < 4; ++i) { const f32x4 d = v[i] - mu; q += (d[0] * d[0] + d[1] * d[1]) + (d[2] * d[2] + d[3] * d[3]); }
#pragma unroll
        for (int o = 32; o >= 1; o >>= 1) q += __shfl_xor(q, o);
        const float rs = 1.0f / sqrtf(q * (1.0f / 1024.0f) + 1e-5f);
#pragma unroll
        for (int i = 0; i < 4; ++i) { const f32x4 o = (v[i] - mu) * rs * g[i] + b[i]; *(f32x4*)(xr + 4 * lane + 256 * i) = o;
            if (xn) { u32x2 w; w.x = pk2(o[0], o[1]); w.y = pk2(o[2], o[3]); *(u32x2*)(xn + (size_t)row * D + 4 * lane + 256 * i) = w; } }
    }
}

__device__ __forceinline__ void headnorm_phase(bf16_t* proj, int ld, int ocol, int gcol, int lanes_per_head  , const float* gain) {
    int tid_ = threadIdx.x; asm volatile("" : "+v"(tid_));
    const int lane = tid_ & 63, wv = tid_ >> 6;
    float gn[2][8];
#pragma unroll
    for (int hh = 0; hh < 2; ++hh)
#pragma unroll
        for (int i = 0; i < 8; ++i) gn[hh][i] = gain[hh * 512 + 8 * lane + i];
    const float invn = lanes_per_head == 16 ? (1.0f / 128.0f) : (1.0f / 256.0f);
    for (int row = lbid() * 8 + wv; row < MROWS; row += gridDim.x * 8) {
        bf16_t* pr = proj + (size_t)row * ld;
#pragma unroll
        for (int hh = 0; hh < 2; ++hh) {
            const u32x4 ov = *(const u32x4*)(pr + ocol + hh * 512 + 8 * lane), gv = *(const u32x4*)(pr + gcol + hh * 512 + 8 * lane);
            float o[8], g[8];
#pragma unroll
            for (int i = 0; i < 4; ++i) { o[2 * i] = bflo(ov[i]); o[2 * i + 1] = bfhi(ov[i]); g[2 * i] = bflo(gv[i]); g[2 * i + 1] = bfhi(gv[i]); }
            float s = 0.f;
#pragma unroll
            for (int i = 0; i < 8; ++i) s += o[i] * o[i];
            s += __shfl_xor(s, 1); s += __shfl_xor(s, 2); s += __shfl_xor(s, 4); s += __shfl_xor(s, 8);
            if (lanes_per_head == 32) s += __shfl_xor(s, 16);
            const float rs = 1.0f / sqrtf(s * invn + 1e-6f);
            float r[8];
#pragma unroll
            for (int i = 0; i < 8; ++i) r[i] = o[i] * rs * gn[hh][i] * g[i] * sigmoidf_(g[i]);
            u32x4 w; w.x = pk2(r[0], r[1]); w.y = pk2(r[2], r[3]); w.z = pk2(r[4], r[5]); w.w = pk2(r[6], r[7]);
            *(u32x4*)(pr + ocol + hh * 512 + 8 * lane) = w;
        }
    }
}

constexpr int MP_G = 0, MP_T = 32768, MP_KTT = 34816, MP_QT = MP_KTT + 128 * 72 * 2, MP_KT = MP_QT + 64 * 136 * 2, MP_END = MP_KT + 64 * 136 * 2;
static_assert(MP_END <= 131072, "prepass LDS");

__device__ __forceinline__ void mixprep_loop(LAS unsigned char* lds, bf16_t* proj, int ld, int qcol, int kcol, int gcol, int gla, const float* lb0, const float* lb1, int lbj, const float* bgate,
                                             bf16_t* ktb_h, int nh, float* vec_h, int ci0, int cstep) {
    int tid_ = threadIdx.x; asm volatile("" : "+v"(tid_));
    const int tid = tid_, wid = __builtin_amdgcn_readfirstlane(tid >> 6), lane = tid & 63, fr = lane & 15, fq = lane >> 4;
    LAS float* G = (LAS float*)(lds + MP_G); LAS float* T = (LAS float*)(lds + MP_T); LAS bf16_t* KTT = (LAS bf16_t*)(lds + MP_KTT);
    LAS bf16_t* QT = (LAS bf16_t*)(lds + MP_QT); LAS bf16_t* KT = (LAS bf16_t*)(lds + MP_KT);
    const int t0 = tid >> 4, cv = tid & 15, c8 = cv * 8;
    float cA[8], cB[8];
#pragma unroll
    for (int i = 0; i < 8; ++i) {
        if (gla) { cA[i] = bgate[c8 + i]; cB[i] = 0.f; }
        else { float lb = 0.f; if (lbj == 1) lb = sigmoidf_(lb1[c8 + i] - lb0[c8 + i]); cA[i] = lb; cB[i] = 1.0f - lb; }
    }
    const float qscale = 0.08838834764831845f;
    u32x4 rq[2], rk[2], rg[2];
    rg[0] = rg[1] = (u32x4){0u, 0u, 0u, 0u};
    auto issue_loads = [&](int ci) {
        const bf16_t* base = proj + (size_t)ci * 64 * ld;
#pragma unroll
        for (int rr = 0; rr < 2; ++rr) { const bf16_t* rp = base + (size_t)(t0 + 32 * rr) * ld + c8; rq[rr] = *(const u32x4*)(rp + qcol); rk[rr] = *(const u32x4*)(rp + kcol); if (gla) rg[rr] = *(const u32x4*)(rp + gcol); }
    };
    if (ci0 < NCHUNK) issue_loads(ci0);
    for (int ci = ci0; ci < NCHUNK; ci += cstep) {
        bf16_t* base = proj + (size_t)ci * 64 * ld;
        float qv[2][8], kv[2][8];
#pragma unroll
        for (int rr = 0; rr < 2; ++rr) {
            float gvv[8];
#pragma unroll
            for (int i = 0; i < 8; ++i) {
                const unsigned uq = rq[rr][i >> 1], uk = rk[rr][i >> 1], ug = rg[rr][i >> 1];
                const float q = (i & 1) ? bfhi(uq) : bflo(uq), k = (i & 1) ? bfhi(uk) : bflo(uk);
                if (gla) {
                    const float g = ((i & 1) ? bfhi(ug) : bflo(ug)) + cA[i];
                    qv[rr][i] = q * qscale; kv[rr][i] = k;
                    gvv[i] = (fminf(g, 0.f) - __logf(1.0f + __expf(-fabsf(g)))) * (1.0f / 16.0f);
                } else {
                    qv[rr][i] = q * sigmoidf_(q) * qscale;
                    const float e = __expf(-k), r = 1.0f / (1.0f + e);
                    kv[rr][i] = cB[i] * e * r;
                    gvv[i] = __logf(fmaxf(cA[i] + cB[i] * r, 1e-6f));
                }
            }
            LAS float* gp = G + (t0 + 32 * rr) * 128 + c8;
            *(LAS f32x4*)gp = (f32x4){gvv[0], gvv[1], gvv[2], gvv[3]}; *(LAS f32x4*)(gp + 4) = (f32x4){gvv[4], gvv[5], gvv[6], gvv[7]};
        }
        if (ci + cstep < NCHUNK) issue_loads(ci + cstep);
        __syncthreads();
        { const int k = tid & 127, sg = tid >> 7; float run = 0.f;
#pragma unroll
          for (int i = 0; i < 16; ++i) { run += G[(16 * sg + i) * 128 + k]; G[(16 * sg + i) * 128 + k] = run; }
          T[sg * 128 + k] = run; }
        __syncthreads();
        {
            float tA[8], tB[8], tC[8], bmid[8], blast[8];
            { const f32x4 x0 = *(const LAS f32x4*)(T + c8), x1 = *(const LAS f32x4*)(T + c8 + 4), y0 = *(const LAS f32x4*)(T + 128 + c8), y1 = *(const LAS f32x4*)(T + 128 + c8 + 4),
                  z0 = *(const LAS f32x4*)(T + 256 + c8), z1 = *(const LAS f32x4*)(T + 256 + c8 + 4);
              const f32x4 m0 = *(const LAS f32x4*)(G + 31 * 128 + c8), m1 = *(const LAS f32x4*)(G + 31 * 128 + c8 + 4), l0 = *(const LAS f32x4*)(G + 63 * 128 + c8), l1 = *(const LAS f32x4*)(G + 63 * 128 + c8 + 4);
#pragma unroll
              for (int i = 0; i < 4; ++i) { tA[i] = x0[i]; tA[4 + i] = x1[i]; tB[i] = x0[i] + y0[i]; tB[4 + i] = x1[i] + y1[i]; tC[i] = tB[i] + z0[i]; tC[4 + i] = tB[4 + i] + z1[i];
                  bmid[i] = m0[i] + tA[i]; bmid[4 + i] = m1[i] + tA[4 + i]; blast[i] = l0[i] + tC[i]; blast[4 + i] = l1[i] + tC[4 + i]; } }
#pragma unroll
            for (int rr = 0; rr < 2; ++rr) {
                const int t = t0 + 32 * rr, sg = t >> 4;
                const f32x4 g0 = *(const LAS f32x4*)(G + t * 128 + c8), g1 = *(const LAS f32x4*)(G + t * 128 + c8 + 4);
                float qt[8], kt[8];
#pragma unroll
                for (int i = 0; i < 8; ++i) {
                    const float off = sg == 0 ? 0.f : (sg == 1 ? tA[i] : (sg == 2 ? tB[i] : tC[i]));
                    const float b = (i < 4 ? g0[i & 3] : g1[i & 3]) + off;
                    qt[i] = qv[rr][i] * __expf(fminf(b - bmid[i], 80.f));
                    kt[i] = kv[rr][i] * __expf(fminf(bmid[i] - b, 80.f));
                }
                bf16_t* rp = base + (size_t)t * ld + c8;
                u32x4 w;
                w.x = pk2(qt[0], qt[1]); w.y = pk2(qt[2], qt[3]); w.z = pk2(qt[4], qt[5]); w.w = pk2(qt[6], qt[7]); *(u32x4*)(rp + qcol) = w; *(LAS u32x4*)(QT + t * 136 + c8) = w;
                w.x = pk2(kt[0], kt[1]); w.y = pk2(kt[2], kt[3]); w.z = pk2(kt[4], kt[5]); w.w = pk2(kt[6], kt[7]); *(LAS u32x4*)(KT + t * 136 + c8) = w;
#pragma unroll
                for (int i = 0; i < 4; ++i) { KTT[(c8 + 2 * i) * 72 + t] = (bf16_t)(w[i] & 0xffffu); KTT[(c8 + 2 * i + 1) * 72 + t] = (bf16_t)(w[i] >> 16); }
            }
            if (t0 == 0) {
                float* em = vec_h + (size_t)ci * 1024; float* el = em + (size_t)NCHUNK * 1024; float* elm = el + (size_t)NCHUNK * 1024;
                f32x4 v0, v1;
#pragma unroll
                for (int i = 0; i < 4; ++i) { v0[i] = __expf(bmid[i]); v1[i] = __expf(bmid[4 + i]); }
                *(f32x4*)(em + c8) = v0; *(f32x4*)(em + c8 + 4) = v1;
#pragma unroll
                for (int i = 0; i < 4; ++i) { v0[i] = __expf(blast[i]); v1[i] = __expf(blast[4 + i]); }
                *(f32x4*)(el + c8) = v0; *(f32x4*)(el + c8 + 4) = v1;
#pragma unroll
                for (int i = 0; i < 4; ++i) { v0[i] = __expf(blast[i] - bmid[i]); v1[i] = __expf(blast[4 + i] - bmid[4 + i]); }
                *(f32x4*)(elm + c8) = v0; *(f32x4*)(elm + c8 + 4) = v1;
            }
        }
        __syncthreads();
        { const int k = tid >> 2, j = tid & 3; bf16_t* ktb = ktb_h + (size_t)ci * nh * 8192;
          const u32x4 w0 = *(const LAS u32x4*)(KTT + k * 72 + 16 * j), w1 = *(const LAS u32x4*)(KTT + k * 72 + 16 * j + 8);
          *(u32x4*)(ktb + k * 64 + 16 * j) = w0; *(u32x4*)(ktb + k * 64 + 16 * j + 8) = w1; }
        { const int ti = wid >> 1;
#pragma unroll
          for (int sh = 0; sh < 2; ++sh) { const int si = 2 * (wid & 1) + sh; f32x4 pa = {0.f, 0.f, 0.f, 0.f};
              if (si <= ti) {
#pragma unroll
                  for (int kk = 0; kk < 4; ++kk) { const bf16x8 A = *(const LAS bf16x8*)(KT + (16 * si + fr) * 136 + 32 * kk + 8 * fq), B = *(const LAS bf16x8*)(QT + (16 * ti + fr) * 136 + 32 * kk + 8 * fq); pa = MFMA16(A, B, pa); }
                  if (si == ti) {
#pragma unroll
                      for (int j = 0; j < 4; ++j) if (4 * fq + j > fr) pa[j] = 0.f; }
              }
              u32x2 w; w.x = pk2(pa[0], pa[1]); w.y = pk2(pa[2], pa[3]); *(u32x2*)(base + (size_t)(16 * ti + fr) * ld + kcol + 16 * si + 4 * fq) = w; } }
    }
    __syncthreads();
}

constexpr int MXB = 49664, MXB_QT = 0, MXB_KTT = 17408, MXB_VT = 35840, MXB_PP = 40448, MX_ST = 2 * MXB, MX_END = MX_ST + 2 * 8704;
static_assert(MX_END <= LDS_ST_OFF, "mixer LDS");

struct ChainArgs {
    bf16_t* proj; int ld; size_t row0; int nchunks;
    int qcol, kcol, vcol;
    const bf16_t* ktb;
    size_t ktb_stride;
    const float* em; const float* el; const float* elm; int vec_stride;
    const float* s0; float* sout; int sstride;
};

__device__ __forceinline__ void mixer_chain(LAS unsigned char* lds, const ChainArgs& a) {
    int tid_ = threadIdx.x; asm volatile("" : "+v"(tid_));
    const int tid = tid_, wid = __builtin_amdgcn_readfirstlane(tid >> 6), lane = tid & 63, fr = lane & 15, fq = lane >> 4;
    const int t0 = tid >> 4, c8 = (tid & 15) * 8;
    f32x4 Sacc[2];
#pragma unroll
    for (int vi = 0; vi < 2; ++vi)
#pragma unroll
        for (int j = 0; j < 4; ++j) Sacc[vi][j] = a.s0 ? a.s0[(size_t)(16 * wid + 4 * fq + j) * a.sstride + 16 * vi + fr] : 0.f;
    struct Regs { u32x4 rq[2], rkt[2], rp, rv; f32x4 vem, vel, velm; };
    Regs R0, R1;
    R0.rv = (u32x4){0u, 0u, 0u, 0u}; R1.rv = (u32x4){0u, 0u, 0u, 0u};
    auto issue_loads = [&](Regs& R, int c) {
        const bf16_t* base = a.proj + (a.row0 + (size_t)c * 64) * a.ld;
#pragma unroll
        for (int rr = 0; rr < 2; ++rr) R.rq[rr] = *(const u32x4*)(base + (size_t)(t0 + 32 * rr) * a.ld + c8 + a.qcol);
        R.rp = *(const u32x4*)(base + (size_t)(tid >> 3) * a.ld + a.kcol + 8 * (tid & 7));
        const bf16_t* kp = a.ktb + (size_t)c * a.ktb_stride + (tid >> 2) * 64 + 16 * (tid & 3);
        R.rkt[0] = *(const u32x4*)kp; R.rkt[1] = *(const u32x4*)(kp + 8);
        if (tid < 256) R.rv = *(const u32x4*)(base + (size_t)(tid >> 2) * a.ld + a.vcol + 8 * (tid & 3));
        const size_t vo = (size_t)c * a.vec_stride + 16 * wid + 4 * fq;
        R.vem = *(const f32x4*)(a.em + vo); R.vel = *(const f32x4*)(a.el + vo); R.velm = *(const f32x4*)(a.elm + vo);
    };
    f32x4 cel, celm;
    auto fill = [&](int b, const Regs& R) {
        LAS bf16_t* QT = (LAS bf16_t*)(lds + b * MXB + MXB_QT); LAS bf16_t* KTT = (LAS bf16_t*)(lds + b * MXB + MXB_KTT);
        LAS bf16_t* VT = (LAS bf16_t*)(lds + b * MXB + MXB_VT); LAS bf16_t* PP = (LAS bf16_t*)(lds + b * MXB + MXB_PP); LAS bf16_t* ST = (LAS bf16_t*)(lds + MX_ST + b * 8704);
#pragma unroll
        for (int rr = 0; rr < 2; ++rr) *(LAS u32x4*)(QT + (t0 + 32 * rr) * 136 + c8) = R.rq[rr];
        *(LAS u32x4*)(PP + (tid >> 3) * 72 + 8 * (tid & 7)) = R.rp;
        { LAS bf16_t* kp = KTT + (tid >> 2) * 72 + 16 * (tid & 3); *(LAS u32x4*)kp = R.rkt[0]; *(LAS u32x4*)(kp + 8) = R.rkt[1]; }
        if (tid < 256) { const int tv = tid >> 2, v8 = (tid & 3) * 8;
#pragma unroll
            for (int i = 0; i < 8; ++i) VT[(v8 + i) * 72 + tv] = (bf16_t)((i & 1) ? (R.rv[i >> 1] >> 16) : (R.rv[i >> 1] & 0xffffu)); }
#pragma unroll
        for (int vi = 0; vi < 2; ++vi) { u32x2 w; w.x = pk2(Sacc[vi][0] * R.vem[0], Sacc[vi][1] * R.vem[1]); w.y = pk2(Sacc[vi][2] * R.vem[2], Sacc[vi][3] * R.vem[3]); *(LAS u32x2*)(ST + (16 * vi + fr) * 136 + 16 * wid + 4 * fq) = w; }
        cel = R.vel; celm = R.velm;
    };
    auto compute = [&](int b, int c) {
        const LAS bf16_t* QT = (const LAS bf16_t*)(lds + b * MXB + MXB_QT); const LAS bf16_t* KTT = (const LAS bf16_t*)(lds + b * MXB + MXB_KTT);
        const LAS bf16_t* VT = (const LAS bf16_t*)(lds + b * MXB + MXB_VT); const LAS bf16_t* PP = (const LAS bf16_t*)(lds + b * MXB + MXB_PP); const LAS bf16_t* ST = (const LAS bf16_t*)(lds + MX_ST + b * 8704);
        { const int ti = wid >> 1, vi = wid & 1; f32x4 o = {0.f, 0.f, 0.f, 0.f};
#pragma unroll
          for (int kk = 0; kk < 2; ++kk) { const bf16x8 A = *(const LAS bf16x8*)(VT + (16 * vi + fr) * 72 + 32 * kk + 8 * fq), B = *(const LAS bf16x8*)(PP + (16 * ti + fr) * 72 + 32 * kk + 8 * fq); o = MFMA16(A, B, o); }
#pragma unroll
          for (int kk = 0; kk < 4; ++kk) { const bf16x8 A = *(const LAS bf16x8*)(ST + (16 * vi + fr) * 136 + 32 * kk + 8 * fq), B = *(const LAS bf16x8*)(QT + (16 * ti + fr) * 136 + 32 * kk + 8 * fq); o = MFMA16(A, B, o); }
          u32x2 w; w.x = pk2(o[0], o[1]); w.y = pk2(o[2], o[3]);
          *(u32x2*)(a.proj + (a.row0 + (size_t)c * 64 + 16 * ti + fr) * a.ld + a.vcol + 16 * vi + 4 * fq) = w; }
#pragma unroll
        for (int vi = 0; vi < 2; ++vi) { f32x4 u = {0.f, 0.f, 0.f, 0.f};
#pragma unroll
            for (int kk = 0; kk < 2; ++kk) { const bf16x8 A = *(const LAS bf16x8*)(KTT + (16 * wid + fr) * 72 + 32 * kk + 8 * fq), B = *(const LAS bf16x8*)(VT + (16 * vi + fr) * 72 + 32 * kk + 8 * fq); u = MFMA16(A, B, u); }
            Sacc[vi] = Sacc[vi] * cel + u * celm; }
    };
    const int n = a.nchunks;
    issue_loads(R0, 0);
    if (n > 1) issue_loads(R1, 1);
    fill(0, R0);
    if (n > 2) issue_loads(R0, 2);
    for (int c = 0; c < n; c += 2) {
        __syncthreads();
        compute(0, c);
        if (c + 1 < n) { fill(1, R1); if (c + 3 < n) issue_loads(R1, c + 3); }
        if (c + 1 < n) {
            __syncthreads();
            compute(1, c + 1);
            if (c + 2 < n) { fill(0, R0); if (c + 4 < n) issue_loads(R0, c + 4); }
        }
    }
#pragma unroll
    for (int vi = 0; vi < 2; ++vi)
#pragma unroll
        for (int j = 0; j < 4; ++j) a.sout[(size_t)(16 * wid + 4 * fq + j) * a.sstride + 16 * vi + fr] = Sacc[vi][j];
    __syncthreads();
}

constexpr int AT_PITCH = 264, AT_KOFF = 128 * AT_PITCH * 2, AT_KP = 136;
static_assert(AT_KOFF + 256 * AT_KP * 2 <= LDS_ST_OFF, "attention LDS");
__device__ __forceinline__ void mem_attn(LAS unsigned char* lds, const bf16_t* Kb, const bf16_t* Vb, bf16_t* Q, int ld, int nrows) {
    int tid_ = threadIdx.x; asm volatile("" : "+v"(tid_));
    const int tid = tid_, wid = __builtin_amdgcn_readfirstlane(tid >> 6), lane = tid & 63, fr = lane & 15, fq = lane >> 4;
    LAS bf16_t* VT = (LAS bf16_t*)lds;
    LAS bf16_t* KS = (LAS bf16_t*)(lds + AT_KOFF);
#pragma unroll
    for (int it = 0; it < 8; ++it) { const int idx = tid + NTHR * it, key = idx >> 4, v8 = (idx & 15) * 8; const u32x4 v = *(const u32x4*)(Vb + (size_t)key * 512 + v8), kx = *(const u32x4*)(Kb + (size_t)key * 512 + v8);
        *(LAS u32x4*)(KS + key * AT_KP + v8) = kx;
#pragma unroll
        for (int i = 0; i < 8; ++i) VT[(v8 + i) * AT_PITCH + key] = (bf16_t)((i & 1) ? (v[i >> 1] >> 16) : (v[i >> 1] & 0xffffu)); }
    __syncthreads();
    const float sc = 0.08838834764831845f;
    for (int q0 = wid * 16; q0 < nrows; q0 += 128) {
        bf16x8 Qf0, Qf1, Qf2, Qf3;
        { const bf16_t* qp = Q + (size_t)(q0 + fr) * ld + 8 * fq; Qf0 = *(const bf16x8*)(qp); Qf1 = *(const bf16x8*)(qp + 32); Qf2 = *(const bf16x8*)(qp + 64); Qf3 = *(const bf16x8*)(qp + 96); }
        f32x4 s[16];
#pragma unroll
        for (int a = 0; a < 16; ++a) {
            const LAS bf16_t* kp = KS + (16 * a + fr) * AT_KP + 8 * fq;
            f32x4 t = {0.f, 0.f, 0.f, 0.f};
            t = MFMA16(*(const LAS bf16x8*)(kp), Qf0, t); t = MFMA16(*(const LAS bf16x8*)(kp + 32), Qf1, t); t = MFMA16(*(const LAS bf16x8*)(kp + 64), Qf2, t); t = MFMA16(*(const LAS bf16x8*)(kp + 96), Qf3, t);
            s[a] = t;
            if ((a & 3) == 3) asm volatile("" ::: "memory");
        }
        float mx = -3.0e38f;
#pragma unroll
        for (int a = 0; a < 16; ++a) mx = fmaxf(fmaxf(mx, fmaxf(s[a][0], s[a][1])), fmaxf(s[a][2], s[a][3]));
        mx = fmaxf(mx, __shfl_xor(mx, 16)); mx = fmaxf(mx, __shfl_xor(mx, 32));
        float sum = 0.f; u32x2 pk[16];
#pragma unroll
        for (int a = 0; a < 16; ++a) { const float e0 = __expf((s[a][0] - mx) * sc), e1 = __expf((s[a][1] - mx) * sc), e2 = __expf((s[a][2] - mx) * sc), e3 = __expf((s[a][3] - mx) * sc);
            sum += (e0 + e1) + (e2 + e3); pk[a].x = pk2(e0, e1); pk[a].y = pk2(e2, e3); }
        sum += __shfl_xor(sum, 16); sum += __shfl_xor(sum, 32);
        const float inv = 1.0f / sum;
        f32x4 o[8];
#pragma unroll
        for (int dt = 0; dt < 8; ++dt) o[dt] = (f32x4){0.f, 0.f, 0.f, 0.f};
#pragma unroll
        for (int ap = 0; ap < 8; ++ap) {
            const u32x4 bv = {pk[2 * ap].x, pk[2 * ap].y, pk[2 * ap + 1].x, pk[2 * ap + 1].y};
            const bf16x8 B = __builtin_bit_cast(bf16x8, bv);
#pragma unroll
            for (int dt = 0; dt < 8; ++dt) {
                const u32x2 lo = *(const LAS u32x2*)(VT + (16 * dt + fr) * AT_PITCH + 32 * ap + 4 * fq), hi = *(const LAS u32x2*)(VT + (16 * dt + fr) * AT_PITCH + 32 * ap + 16 + 4 * fq);
                const u32x4 av = {lo.x, lo.y, hi.x, hi.y};
                o[dt] = MFMA16(__builtin_bit_cast(bf16x8, av), B, o[dt]);
            }
        }
#pragma unroll
        for (int dt = 0; dt < 8; ++dt) { u32x2 w; w.x = pk2(o[dt][0] * inv, o[dt][1] * inv); w.y = pk2(o[dt][2] * inv, o[dt][3] * inv);
            *(u32x2*)(Q + (size_t)(q0 + fr) * ld + 16 * dt + 4 * fq) = w; }
    }
    __syncthreads();
}

__device__ __forceinline__ void mixprep_phase(LAS unsigned char* lds, const Params& p, int layer) {
    const int j = layer >> 1, gla = layer & 1, w = lbid(), G = gridDim.x;
    bf16_t* proj = (bf16_t*)(p.ws + WS_PROJ);
    const int ld = gla ? GL_LD : HG_LD, nh = gla ? 4 : 8;
    bf16_t* ktb = (bf16_t*)(p.ws + WS_XN);
    float* vec = (float*)(p.ws + WS_VEC);
    const int xq = gla ? 3584 : 4096;
    for (int it = w; it < 256 + 64; it += G) {
        const bf16_t* Kb; const bf16_t* Vb; bf16_t* Qp; int nrows;
        if (it < 256) { const int bh = it >> 3, grp = it & 7, b = bh >> 2, h = bh & 3;
            Kb = (const bf16_t*)(p.ws + WS_MKB) + ((size_t)layer * 2048 + b * 256) * 512 + h * 128;
            Vb = (const bf16_t*)(p.ws + WS_MVB) + ((size_t)layer * 2048 + b * 256) * 512 + h * 128;
            Qp = proj + ((size_t)b * 8192 + grp * 1024) * ld + xq + h * 128; nrows = 1024;
        } else { const int bh = it - 256, b = bh >> 2, h = bh & 3;
            Kb = (const bf16_t*)(p.ws + WS_CKB) + ((size_t)layer * 4096 + b * 256) * 512 + h * 128;
            Vb = (const bf16_t*)(p.ws + WS_CVB) + ((size_t)layer * 4096 + b * 256) * 512 + h * 128;
            Qp = proj + ((size_t)MP + b * 64) * ld + xq + h * 128; nrows = 64;
        }
        mem_attn(lds, Kb, Vb, Qp, ld, nrows);
    }
    { const int h = w % nh;
      mixprep_loop(lds, proj, ld, h * 128, (gla ? 512 : 1024) + h * 128, gla ? 1024 + h * 128 : 0, gla,
                   gla ? nullptr : p.in[13] + h * 128, gla ? nullptr : p.in[13] + 1024 + h * 128, j, gla ? p.in[18] + j * 512 + h * 128 : nullptr,
                   ktb + (size_t)h * 8192, nh, vec + h * 128, w / nh, G / nh); }
}
__device__ __forceinline__ void chain_phase(LAS unsigned char* lds, const Params& p, int layer) {
    const int j = layer >> 1, gla = layer & 1, w = lbid(), G = gridDim.x;
    bf16_t* proj = (bf16_t*)(p.ws + WS_PROJ);
    const int ld = gla ? GL_LD : HG_LD;
    const int nvs = gla ? 8 : 4, nh = gla ? 4 : 8, vdim = gla ? 256 : 128;
    const bf16_t* ktb = (const bf16_t*)(p.ws + WS_XN);
    const float* vec = (const float*)(p.ws + WS_VEC);
    const int n_prompt = 8 * nh * nvs  , n_sample = 16 * nh * nvs  ;
    for (int it = w; it < n_prompt + n_sample; it += G) {
        const bool smp = it >= n_prompt; const int id = smp ? it - n_prompt : it;
        const int lo = id & 7, rest = id >> 3, vs = rest % nvs, hi = rest / nvs, bh = lo + 8 * hi, b = bh / nh, h = bh % nh;
        ChainArgs a;
        a.proj = proj; a.ld = ld;
        a.row0 = smp ? (size_t)MP + (size_t)b * 64 : (size_t)b * 8192; a.nchunks = smp ? 1 : 128;
        const int ci0 = smp ? 1024 + b : b * 128;
        if (gla) { a.qcol = h * 128; a.kcol = 512 + h * 128; a.vcol = 2560 + h * 256 + 32 * vs; }
        else { a.qcol = h * 128; a.kcol = 1024 + h * 128; a.vcol = 3072 + h * 128 + 32 * vs; }
        a.ktb = ktb + ((size_t)ci0 * nh + h) * 8192; a.ktb_stride = (size_t)nh * 8192;
        a.em = vec + (size_t)ci0 * 1024 + h * 128; a.el = a.em + (size_t)NCHUNK * 1024; a.elm = a.el + (size_t)NCHUNK * 1024; a.vec_stride = 1024;
        const size_t per_b = (size_t)nh * 128 * vdim, so = ((size_t)b * nh + h) * 128 * vdim + 32 * vs;
        if (smp) { a.s0 = (gla ? p.in[6] : p.in[5]) + (size_t)j * 16 * per_b + so; a.sout = p.out + (gla ? O_SGS : O_SHS) + (size_t)j * 16 * per_b + so; }
        else { a.s0 = nullptr; a.sout = p.out + (gla ? O_SGP : O_SHP) + (size_t)j * 8 * per_b + so; }
        a.sstride = vdim;
        mixer_chain(lds, a);
    }
}

#define XB_TMO      128
#define XB_XCNT(j)  (256  + 64 * (j))
#define XB_XSUB(j)  (1280 + 64 * (j))
#define XB_XGEN(j)  (2304 + 64 * (j))
#define XB_TOP      3328
#define XB_TOPGEN   3392
#define XCD_BAR_WORDS 3456
#define XB_SPIN_CAP (1u << 22)
__device__ __forceinline__ unsigned xb_ld(unsigned* p)              { return __hip_atomic_load(p, __ATOMIC_RELAXED, __HIP_MEMORY_SCOPE_AGENT); }
__device__ __forceinline__ unsigned xb_add(unsigned* p, unsigned v) { return __hip_atomic_fetch_add(p, v, __ATOMIC_RELAXED, __HIP_MEMORY_SCOPE_AGENT); }
__device__ __forceinline__ unsigned xb_xcc_id() { return (unsigned)__builtin_amdgcn_s_getreg((3 << 11) | 20) & 0xFu; }
#define XB_SPIN(cond, bar) do { unsigned _sp = 0; while (cond) { __builtin_amdgcn_s_sleep(1); \
    if ((++_sp & 255u) == 0u) { if (xb_ld(&(bar)[XB_TMO])) break; if (_sp > XB_SPIN_CAP) { atomicAdd(&(bar)[XB_TMO], 1u); break; } } } } while (0)
struct XcdBarrier { unsigned* bar; unsigned x; volatile LAS unsigned* st; };
__device__ __forceinline__ XcdBarrier xcd_barrier_post(unsigned* bar, volatile LAS unsigned* st) {
    XcdBarrier b; b.bar = bar; b.x = xb_xcc_id(); b.st = st;
    if (threadIdx.x == 0) (void)xb_add(&bar[XB_XCNT(b.x)], 1u);
    return b;
}
__device__ __forceinline__ void xcd_barrier_complete(unsigned* bar, unsigned x, unsigned& nloc, unsigned& nx) {
    const unsigned G = gridDim.x * gridDim.y * gridDim.z;
    unsigned sum, cnt, mine, sp = 0u;
    for (;;) {
        sum = 0u; cnt = 0u; mine = 0u;
#pragma unroll
        for (unsigned j = 0; j < 16; ++j) { const unsigned c = xb_ld(&bar[XB_XCNT(j)]); sum += c; cnt += (c > 0u) ? 1u : 0u; mine = (j == x) ? c : mine; }
        if (sum == G) break;
        __builtin_amdgcn_s_sleep(1);
        if ((++sp & 255u) == 0u) { if (xb_ld(&bar[XB_TMO])) break; if (sp > XB_SPIN_CAP) { atomicAdd(&bar[XB_TMO], 1u); break; } }
    }
    nloc = mine > 0u ? mine : 1u; nx = cnt > 0u ? cnt : 1u;
}
__device__ __forceinline__ void xcd_barrier(const XcdBarrier& b) {
    asm volatile("s_waitcnt vmcnt(0)" ::: "memory");
    __syncthreads();
    if (threadIdx.x == 0) {
        unsigned* bar = b.bar;
        __builtin_amdgcn_s_waitcnt(0);
        unsigned nloc = b.st[0], nx = b.st[1];
        if (nloc == 0u) { xcd_barrier_complete(bar, b.x, nloc, nx); b.st[0] = nloc; b.st[1] = nx; }
        const unsigned old = xb_add(&bar[XB_XSUB(b.x)], 1u);
        const unsigned gen = old / nloc;
        if (old + 1u == (gen + 1u) * nloc) {
            __builtin_amdgcn_fence(__ATOMIC_RELEASE, "agent");
            asm volatile("s_waitcnt vmcnt(0)" ::: "memory");
            const unsigned og = xb_add(&bar[XB_TOP], 1u);
            const unsigned tg = og / nx;
            if (og + 1u == (tg + 1u) * nx) xb_add(&bar[XB_TOPGEN], 1u);
            else XB_SPIN(xb_ld(&bar[XB_TOPGEN]) == tg, bar);
            __builtin_amdgcn_fence(__ATOMIC_ACQUIRE, "agent");
            xb_add(&bar[XB_XGEN(b.x)], 1u);
            asm volatile("s_waitcnt vmcnt(0)" ::: "memory");
        } else {
            XB_SPIN(xb_ld(&bar[XB_XGEN(b.x)]) == gen, bar);
            __builtin_amdgcn_fence(__ATOMIC_ACQUIRE, "agent");
            asm volatile("s_waitcnt vmcnt(0)" ::: "memory");
        }
    }
    __syncthreads();
}

constexpr int PPL = 9;
constexpr int NPHASE = 2 + 4 * PPL + 1;
#define WSB(off) ((bf16_t*)(p.ws + (off)))
#define STATS(li) ((float*)(p.ws + WS_STATS) + (size_t)(li) * MROWS * 2)
__global__ void __launch_bounds__(NTHR, 2) trunk_fwd(Params p) {
    extern __shared__ __attribute__((aligned(16))) unsigned char lds_raw[];
    LAS unsigned char* lds = (LAS unsigned char*)lds_raw;
    if (p.ph_hi - p.ph_lo > 1) {
        if (threadIdx.x < 4) ((LAS unsigned*)(lds + LDS_ST_OFF))[threadIdx.x] = 0u;
        __syncthreads();
        (void)xcd_barrier_post((unsigned*)(p.ws + WS_BAR), (volatile LAS unsigned*)(lds + LDS_ST_OFF));
    }
    for (int ph = p.ph_lo; ph < p.ph_hi; ++ph) {
        if (ph == 0) prep_phase(lds, p);
        else if (ph == 1) { }
        else if (false) { Epi E{EPI_MEMKV, nullptr, 0, nullptr, 0.f, p.out + O_MK, p.out + O_MV, WSB(WS_MKB), WSB(WS_MVB), nullptr, nullptr, nullptr, nullptr, nullptr};
            gemm_phase<EPI_MEMKV>(lds, WSB(WS_MEMP), 1024, WSB(WS_MEMW), 2048, 4096, 1024, E); }
        else if (ph == NPHASE - 1) ln_phase(p.out + O_Y, nullptr, p.in[10] + 11 * 1024, p.in[11] + 11 * 1024);
        else {
            const int layer = (ph - 2) / PPL, s = (ph - 2) % PPL, gla = layer & 1, j = layer >> 1;
            if (s == 0 || s == 7) {
                const int lf = layer * 2 + (s == 7), li = (s == 7) ? 3 * layer + 1 : 3 * layer - 1;
                const float* cv = (const float*)(p.ws + WS_CV_WGU) + (size_t)lf * 2 * 5632;
                Epi E{EPI_SWIGLU, WSB(WS_PROJ), FF, nullptr, 0.f, nullptr, nullptr, nullptr, nullptr, li >= 0 ? STATS(li) : nullptr, cv, cv + 5632, nullptr, nullptr};
                gemm_phase<EPI_SWIGLU>(lds, WSB(WS_XN), 1024, WSB(WS_WGU) + (size_t)lf * 5632 * 1024, MROWS, 5632, 1024, E);
                if (ph == 2) { Epi Em{EPI_MEMKV, nullptr, 0, nullptr, 0.f, p.out + O_MK, p.out + O_MV, WSB(WS_MKB), WSB(WS_MVB), nullptr, nullptr, nullptr, nullptr, nullptr};
                    gemm_phase<EPI_MEMKV>(lds, WSB(WS_MEMP), 1024, WSB(WS_MEMW), 2048, 4096, 1024, Em); } }
            else if (s == 1 || s == 8) {
                const int lf = layer * 2 + (s == 8), li_in = (s == 8) ? 3 * layer + 1 : 3 * layer - 1, li_out = (s == 8) ? 3 * layer + 2 : 3 * layer;
                Epi E{EPI_RES, nullptr, 0, p.out + O_Y, 0.5f, nullptr, nullptr, nullptr, nullptr, li_in >= 0 ? STATS(li_in) : nullptr,
                      li_in >= 0 ? p.in[10] + li_in * 1024 : nullptr, li_in >= 0 ? p.in[11] + li_in * 1024 : nullptr, STATS(li_out), WSB(WS_XN)};
                gemm_phase<EPI_RES>(lds, WSB(WS_PROJ), FF, WSB(WS_WD) + (size_t)lf * 1024 * FF, MROWS, 1024, FF, E); }
            else if (s == 2) {
                const int li = 3 * layer;
                const float* cv = gla ? (const float*)(p.ws + WS_CV_GWIN) + (size_t)j * 2 * 4096 : (const float*)(p.ws + WS_CV_HWIN) + (size_t)j * 2 * 4608;
                Epi E{EPI_BF16, WSB(WS_PROJ), gla ? GL_LD : HG_LD, nullptr, 0.f, nullptr, nullptr, nullptr, nullptr, STATS(li), cv, cv + (gla ? 4096 : 4608), nullptr, nullptr};
                if (gla) gemm_phase<EPI_BF16>(lds, WSB(WS_XN), 1024, WSB(WS_GWIN) + (size_t)j * 4096 * 1024, MROWS, 4096, 1024, E);
                else gemm_phase<EPI_BF16>(lds, WSB(WS_XN), 1024, WSB(WS_HWIN) + (size_t)j * 4608 * 1024, MROWS, 4608, 1024, E); }
            else if (s == 3) mixprep_phase(lds, p, layer);
            else if (s == 4) chain_phase(lds, p, layer);
            else if (s == 5) { if (gla) headnorm_phase(WSB(WS_PROJ), GL_LD, 2560, 1536, 32, p.in[19] + j * 1024); else headnorm_phase(WSB(WS_PROJ), HG_LD, 3072, 2048, 16, p.in[14] + j * 1024); }
            else if (s == 6) {
                const int li_in = 3 * layer;
                Epi E{EPI_RES, nullptr, 0, p.out + O_Y, 1.0f, nullptr, nullptr, nullptr, nullptr, STATS(li_in), p.in[10] + li_in * 1024, p.in[11] + li_in * 1024, STATS(li_in + 1), WSB(WS_XN)};
                gemm_phase<EPI_RES>(lds, WSB(WS_PROJ) + (gla ? 2560 : 3072), gla ? GL_LD : HG_LD, WSB(WS_WOUT) + (size_t)layer * 1024 * 1536, MROWS, 1024, 1536, E); }
        }
        if (ph + 1 < p.ph_hi && ph != 1) {
            if (ph == 0) cg::this_grid().sync();
            else { XcdBarrier bar; bar.bar = (unsigned*)(p.ws + WS_BAR); bar.x = xb_xcc_id(); bar.st = (volatile LAS unsigned*)(lds + LDS_ST_OFF); xcd_barrier(bar); }
        }
    }
}
#undef WSB
#undef STATS

extern "C" void kernel_launch(void* const* d_in, const int* in_sizes, int n_in, void* d_out, int out_size, void* d_ws, size_t ws_size, hipStream_t stream) {
    static int grid = 0;
    if (grid == 0) {
        if (n_in != 23 || ws_size < WS_END) { fprintf(stderr, "kernel_launch: need 23 inputs and %zu bytes of workspace; got %d, %zu\n", (size_t)WS_END, n_in, ws_size); grid = -1; return; }
        if (hipFuncSetAttribute((const void*)trunk_fwd, hipFuncAttributeMaxDynamicSharedMemorySize, LDS_BYTES) != hipSuccess) { fprintf(stderr, "kernel_launch: hipFuncSetAttribute failed\n"); grid = -1; return; }
        int dev = 0, cus = 0, per_cu = 0;
        (void)hipGetDevice(&dev); (void)hipDeviceGetAttribute(&cus, hipDeviceAttributeMultiprocessorCount, dev);
        (void)hipOccupancyMaxActiveBlocksPerMultiprocessor(&per_cu, (const void*)trunk_fwd, NTHR, LDS_BYTES);
        if (per_cu < 1) { fprintf(stderr, "kernel_launch: occupancy query says %d blocks per CU\n", per_cu); per_cu = 1; }
        (void)hipGetLastError();
        grid = cus;
    }
    if (grid < 0) return;
    Params p{};
    for (int i = 0; i < 23; ++i) p.in[i] = (const float*)d_in[i];
    p.out = (float*)d_out; p.ws = (unsigned char*)d_ws;
#if ONE_LAUNCH
    (void)hipMemsetAsync((unsigned char*)d_ws + WS_BAR, 0, WS_ZERO_END - WS_BAR, stream);
    p.ph_lo = 0; p.ph_hi = NPHASE;
    void* args[] = {&p};
    hipError_t e = hipLaunchCooperativeKernel((const void*)trunk_fwd, dim3(grid), dim3(NTHR), args, LDS_BYTES, stream);
    if (e != hipSuccess) fprintf(stderr, "cooperative launch failed: %s (grid %d)\n", hipGetErrorString(e), grid);
#else
    (void)hipMemsetAsync((unsigned char*)d_ws + WS_BAR, 0, WS_ZERO_END - WS_BAR, stream);
    for (int ph = 0; ph < NPHASE; ++ph) {
        p.ph_lo = ph; p.ph_hi = ph + 1;
        hipLaunchKernelGGL(trunk_fwd, dim3(grid), dim3(NTHR), LDS_BYTES, stream, p);
    }
#endif
}
```

```cpp
#include <hip/hip_runtime.h>
#include <hip/hip_cooperative_groups.h>
#include <cstdio>
namespace cg = cooperative_groups;

#ifndef ONE_LAUNCH
#define ONE_LAUNCH 1
#endif

#define LAS __attribute__((address_space(3)))
typedef unsigned short bf16_t;
typedef short bf16x8 __attribute__((ext_vector_type(8)));
typedef float f32x4 __attribute__((ext_vector_type(4)));
typedef float f32x2 __attribute__((ext_vector_type(2)));
typedef unsigned u32x4 __attribute__((ext_vector_type(4)));
typedef unsigned u32x2 __attribute__((ext_vector_type(2)));
typedef __bf16 nbf2 __attribute__((ext_vector_type(2)));

constexpr int D = 1024, MP = 65536, MS = 1024, MROWS = MP + MS, FF = 2816;
constexpr int HG_LD = 4608, GL_LD = 4096;
constexpr float ALPHA = 1.6817928305074292f;
constexpr int NTHR = 512;
constexpr int LDS_BYTES = 144 * 1024;
constexpr int LDS_ST_OFF = 143360;
constexpr int NCHUNK = MROWS / 64;
constexpr int LDS_X = 131072;

constexpr size_t O_Y = 0;
constexpr size_t O_SHP = (size_t)MROWS * D;
constexpr size_t O_SGP = O_SHP + 2u * 8 * 8 * 128 * 128;
constexpr size_t O_MK = O_SGP + 2u * 8 * 4 * 128 * 256;
constexpr size_t O_MV = O_MK + 4u * 2048 * 512;
constexpr size_t O_SHS = O_MV + 4u * 2048 * 512;
constexpr size_t O_SGS = O_SHS + 2u * 16 * 8 * 128 * 128;

constexpr size_t WS_WGU = 0;
constexpr size_t WS_WD = WS_WGU + 8ull * 5632 * 1024 * 2;
constexpr size_t WS_HWIN = WS_WD + 8ull * 1024 * 2816 * 2;
constexpr size_t WS_GWIN = WS_HWIN + 2ull * 4608 * 1024 * 2;
constexpr size_t WS_WOUT = WS_GWIN + 2ull * 4096 * 1024 * 2;
constexpr size_t WS_MEMW = WS_WOUT + 4ull * 1024 * 1536 * 2;
constexpr size_t WS_MEMP = WS_MEMW + 4096ull * 1024 * 2;
constexpr size_t WS_MKB = WS_MEMP + 2048ull * 1024 * 2;
constexpr size_t WS_MVB = WS_MKB + 4ull * 2048 * 512 * 2;
constexpr size_t WS_CKB = WS_MVB + 4ull * 2048 * 512 * 2;
constexpr size_t WS_CVB = WS_CKB + 4ull * 4096 * 512 * 2;
constexpr size_t WS_XN = WS_CVB + 4ull * 4096 * 512 * 2;
constexpr size_t WS_PROJ = WS_XN + (size_t)MROWS * 1024 * 2;
constexpr size_t WS_VEC = WS_PROJ + (size_t)MROWS * 4608 * 2;
constexpr size_t WS_BAR = WS_VEC + 3ull * (MROWS / 64) * 1024 * 4;
constexpr size_t WS_STATS = WS_BAR + 16384;
constexpr size_t WS_CV_WGU = WS_STATS + 12ull * MROWS * 8;
constexpr size_t WS_CV_HWIN = WS_CV_WGU + 8ull * 2 * 5632 * 4;
constexpr size_t WS_CV_GWIN = WS_CV_HWIN + 2ull * 2 * 4608 * 4;
constexpr size_t WS_ZERO_END = WS_CV_GWIN + 2ull * 2 * 4096 * 4;
constexpr size_t WS_END = WS_ZERO_END;

struct Params {
    const float* in[23];
    float* out;
    unsigned char* ws;
    int ph_lo, ph_hi;
};

__device__ __forceinline__ unsigned pk2(float lo, float hi) { f32x2 v = {lo, hi}; nbf2 b = __builtin_convertvector(v, nbf2); return __builtin_bit_cast(unsigned, b); }
__device__ __forceinline__ float bflo(unsigned u) { return __uint_as_float(u << 16); }
__device__ __forceinline__ float bfhi(unsigned u) { return __uint_as_float(u & 0xffff0000u); }
__device__ __forceinline__ bf16_t f2bf(float f) { unsigned u = pk2(f, 0.f); return (bf16_t)(u & 0xffffu); }
__device__ __forceinline__ float sigmoidf_(float x) { return __builtin_amdgcn_rcpf(1.0f + __expf(-x)); }
__device__ __forceinline__ int ltid() { int t = threadIdx.x; asm volatile("" : "+v"(t)); return t; }
__device__ __forceinline__ int lbid() { int t = blockIdx.x; asm volatile("" : "+s"(t)); return t; }
#define MFMA16(a, b, c) __builtin_amdgcn_mfma_f32_16x16x32_bf16((a), (b), (c), 0, 0, 0)

constexpr int BM = 256, BK = 64, HALF = 128, HTB = HALF * BK * 2, NXCD = 8, WGM = 8;
__device__ __forceinline__ int lds_byte(int r, int c) { const int st = (r >> 4) * 2 + (c >> 5), rr = r & 15, cc = c & 31, ob = rr * 64 + cc * 2; return st * 1024 + (ob ^ (((ob >> 9) & 1) << 5)); }
__device__ __forceinline__ void stage_rc(int b, int& R, int& C) { const int st = b / 1024, sb = b % 1024, swz = sb ^ (((sb >> 9) & 1) << 5); R = (st >> 1) * 16 + swz / 64; C = (st & 1) * 32 + (swz % 64) / 2; }
__device__ __forceinline__ int perm32(int rho) { const int n = rho >> 4, i = rho & 15; return 8 * (i >> 2) + 4 * n + (i & 3); }

struct Unit { int pm, pn; };
struct StaticOrder {
    int nM, nN, nwg, G, c;
    __device__ __forceinline__ void init(int M, int N, int G_, int c_) { nM = M / BM; nN = N / BM; nwg = nM * nN; G = G_; c = c_; }
    __device__ __forceinline__ bool next(int i, Unit& u) const {
        const long L = (long)i * G + c; if (L >= nwg) return false;
        int wgid = (int)L; { const int q = nwg / NXCD, r = nwg % NXCD, xcd = wgid % NXCD, off = wgid / NXCD; wgid = (xcd < r ? xcd * (q + 1) : r * (q + 1) + (xcd - r) * q) + off; }
        const int nig = WGM * nN, gid = wgid / nig, fm = gid * WGM, gsz = (nM - fm) < WGM ? (nM - fm) : WGM;
        u.pm = fm + ((wgid % nig) % gsz); u.pn = (wgid % nig) / gsz; return true;
    }
};

enum { EPI_SWIGLU = 0, EPI_BF16 = 1, EPI_RES = 2, EPI_MEMKV = 3 };
struct Epi { int mode; bf16_t* ob; int ldo; float* xf; float scale; float* mk_out; float* mv_out; bf16_t* mkb; bf16_t* mvb;
             const float* st_in; const float* v1; const float* v2; float* st_out; bf16_t* ybf; };
__device__ __forceinline__ void row_mu_rstd(const LAS float* XS, bool has, int rl, float& mu, float& rstd) {
    if (has) { const f32x2 q = *(const LAS f32x2*)(XS + 2 * rl); mu = q.x * (1.0f / 1024.0f); rstd = __builtin_amdgcn_rsqf(fmaxf(q.y * (1.0f / 1024.0f) - mu * mu, 0.f) + 1e-5f); }
    else { mu = 0.f; rstd = 1.0f; }
}

template <int MODE> __device__ __forceinline__ void gemm_epilogue(const f32x4 (&acc)[2][2][4][2], const Unit& u, int wr, int wc, int fr, int fq, const Epi& E, LAS unsigned char* lds) {
    const int row0 = u.pm * BM + wr * 64 + fr;
    const LAS float* XS = (const LAS float*)(lds + LDS_X); const bool has = (E.st_in != nullptr); const int rl0 = wr * 64 + fr;
    if constexpr (MODE == EPI_SWIGLU) {
        const int col0 = u.pn * 128 + wc * 32 + 8 * fq;
        const int cl = wc * 32 + 8 * fq;
        f32x4 c1g[2], c2g[2], c1u[2], c2u[2];
#pragma unroll
        for (int n = 0; n < 2; ++n) {
            if (has) { c1g[n] = *(const LAS f32x4*)(XS + 512 + cl + 4 * n); c2g[n] = *(const LAS f32x4*)(XS + 768 + cl + 4 * n); c1u[n] = *(const LAS f32x4*)(XS + 512 + cl + 128 + 4 * n); c2u[n] = *(const LAS f32x4*)(XS + 768 + cl + 128 + 4 * n); }
            else { c1g[n] = c2g[n] = c1u[n] = c2u[n] = (f32x4){0.f, 0.f, 0.f, 0.f}; }
        }
        float mus[2][4], rstds[2][4];
#pragma unroll
        for (int ai = 0; ai < 2; ++ai)
#pragma unroll
            for (int m = 0; m < 4; ++m) row_mu_rstd(XS, has, rl0 + ai * HALF + m * 16, mus[ai][m], rstds[ai][m]);
#pragma unroll
        for (int ai = 0; ai < 2; ++ai)
#pragma unroll
            for (int m = 0; m < 4; ++m) {
                const int row = row0 + ai * HALF + m * 16;
                const float mu = mus[ai][m], rstd = rstds[ai][m];
                bf16_t* rowp = E.ob + (size_t)row * E.ldo + col0;
                float h[8];
#pragma unroll
                for (int n = 0; n < 2; ++n)
#pragma unroll
                    for (int j = 0; j < 4; ++j) { const float g = rstd * (acc[ai][0][m][n][j] - mu * c1g[n][j]) + c2g[n][j], up = rstd * (acc[ai][1][m][n][j] - mu * c1u[n][j]) + c2u[n][j];
                        h[n * 4 + j] = g * up * __builtin_amdgcn_rcpf(1.0f + __expf(-g)); }
                u32x4 w; w.x = pk2(h[0], h[1]); w.y = pk2(h[2], h[3]); w.z = pk2(h[4], h[5]); w.w = pk2(h[6], h[7]);
                *(u32x4*)rowp = w;
            }
    } else if constexpr (MODE == EPI_BF16) {
        const int col0 = u.pn * BM + wc * 32 + 8 * fq, cl = wc * 32 + 8 * fq;
        f32x4 c1[2][2], c2[2][2];
#pragma unroll
        for (int bj = 0; bj < 2; ++bj)
#pragma unroll
            for (int n = 0; n < 2; ++n) { c1[bj][n] = *(const LAS f32x4*)(XS + 512 + cl + bj * HALF + 4 * n); c2[bj][n] = *(const LAS f32x4*)(XS + 768 + cl + bj * HALF + 4 * n); }
#pragma unroll
        for (int ai = 0; ai < 2; ++ai)
#pragma unroll
            for (int m = 0; m < 4; ++m) {
                const int row = row0 + ai * HALF + m * 16;
                float mu, rstd; row_mu_rstd(XS, has, rl0 + ai * HALF + m * 16, mu, rstd);
                bf16_t* rowp = E.ob + (size_t)row * E.ldo + col0;
#pragma unroll
                for (int bj = 0; bj < 2; ++bj) {
                    const f32x4 v0 = (acc[ai][bj][m][0] - c1[bj][0] * mu) * rstd + c2[bj][0], v1 = (acc[ai][bj][m][1] - c1[bj][1] * mu) * rstd + c2[bj][1];
                    u32x4 w; w.x = pk2(v0[0], v0[1]); w.y = pk2(v0[2], v0[3]); w.z = pk2(v1[0], v1[1]); w.w = pk2(v1[2], v1[3]);
                    *(u32x4*)(rowp + bj * HALF) = w;
                }
            }
    } else if constexpr (MODE == EPI_RES) {
        const int col0 = u.pn * BM + wc * 32 + 4 * fq, cl = wc * 32 + 4 * fq;
#pragma unroll
        for (int bt = 0; bt < 3; ++bt) {
            const int g0 = bt * 3, ng = bt == 2 ? 2 : 3;
            f32x4 xv[3][2][2];
#pragma unroll
            for (int gi = 0; gi < 3; ++gi) if (gi < ng) { const int g = g0 + gi, ai = g >> 2, m = g & 3; const float* rowp = E.xf + (size_t)(row0 + ai * HALF + m * 16) * D + col0;
#pragma unroll
                for (int bj = 0; bj < 2; ++bj)
#pragma unroll
                    for (int n = 0; n < 2; ++n) xv[gi][bj][n] = *(const f32x4*)(rowp + bj * HALF + n * 16); }
#pragma unroll
            for (int gi = 0; gi < 3; ++gi) if (gi < ng) {
                const int g = g0 + gi, ai = g >> 2, m = g & 3;
                const int row = row0 + ai * HALF + m * 16;
                float mu, rstd; row_mu_rstd(XS, has, rl0 + ai * HALF + m * 16, mu, rstd);
                float* rowp = E.xf + (size_t)row * D + col0; bf16_t* rowb = E.ybf + (size_t)row * D + col0;
                float s1 = 0.f, s2 = 0.f;
#pragma unroll
                for (int bj = 0; bj < 2; ++bj)
#pragma unroll
                    for (int n = 0; n < 2; ++n) { f32x4 x = xv[gi][bj][n];
                        if (has) { const f32x4 gp = *(const LAS f32x4*)(XS + 512 + cl + bj * HALF + n * 16), bp = *(const LAS f32x4*)(XS + 768 + cl + bj * HALF + n * 16); x = (x - mu) * rstd * gp + bp; }
                        x = x * ALPHA + acc[ai][bj][m][n] * E.scale;
                        *(f32x4*)(rowp + bj * HALF + n * 16) = x;
                        u32x2 w; w.x = pk2(x[0], x[1]); w.y = pk2(x[2], x[3]); *(u32x2*)(rowb + bj * HALF + n * 16) = w;
                        s1 += (x[0] + x[1]) + (x[2] + x[3]); s2 += (x[0] * x[0] + x[1] * x[1]) + (x[2] * x[2] + x[3] * x[3]); }
                s1 += __shfl_xor(s1, 16); s1 += __shfl_xor(s1, 32); s2 += __shfl_xor(s2, 16); s2 += __shfl_xor(s2, 32);
                if (fq == 0) { atomicAdd(E.st_out + 2 * (size_t)row, s1); atomicAdd(E.st_out + 2 * (size_t)row + 1, s2); }
            }
            asm volatile("" ::: "memory");
        }
    } else {
        const int colt = u.pn * BM; const int l = colt >> 10, kv = (colt >> 9) & 1, cc0 = (colt & 511) + wc * 32 + 4 * fq;
        float* of = (kv ? E.mv_out : E.mk_out) + (size_t)l * 2048 * 512;
        bf16_t* ob = (kv ? E.mvb : E.mkb) + (size_t)l * 2048 * 512;
#pragma unroll
        for (int ai = 0; ai < 2; ++ai)
#pragma unroll
            for (int m = 0; m < 4; ++m) {
                const size_t ro = (size_t)(row0 + ai * HALF + m * 16) * 512 + cc0;
#pragma unroll
                for (int bj = 0; bj < 2; ++bj)
#pragma unroll
                    for (int n = 0; n < 2; ++n) { const f32x4 v = acc[ai][bj][m][n]; *(f32x4*)(of + ro + bj * HALF + n * 16) = v; u32x2 w; w.x = pk2(v[0], v[1]); w.y = pk2(v[2], v[3]); *(u32x2*)(ob + ro + bj * HALF + n * 16) = w; }
            }
    }
}

template <int MODE> __device__ __forceinline__ void gemm_phase(LAS unsigned char* lds, const bf16_t* Ag, int lda, const bf16_t* Btg, int M, int N, int K, const Epi& E) {
    int tid_ = threadIdx.x; asm volatile("" : "+v"(tid_));
    const int tid = tid_, wid = __builtin_amdgcn_readfirstlane(tid >> 6), lane = tid & 63, wr = wid >> 2, wc = wid & 3, fr = lane & 15, fq = lane >> 4;
    const int nt = K / BK;
    constexpr bool PERM = (MODE == EPI_SWIGLU || MODE == EPI_BF16);
    StaticOrder S; { const int G_ = (int)gridDim.x; int c_ = lbid(); if (MODE == EPI_MEMKV) c_ = (c_ + G_ / 2) % G_; S.init(M, N, G_, c_); }
    unsigned voffA[2], voffB[2];
#pragma unroll
    for (int i = 0; i < 2; ++i) { int R, C; stage_rc(tid * 16 + i * 8192, R, C); const int Rb = PERM ? ((R & ~31) + perm32(R & 31)) : R;
        voffA[i] = (unsigned)(R * lda + C) * 2u; voffB[i] = (unsigned)(Rb * K + C) * 2u; }
    const size_t kstep = (size_t)(BK * 2);
    const size_t hstepA = (size_t)HALF * lda * 2, hstepB = (size_t)HALF * K * 2;
    const size_t tstepA = 2 * hstepA, tstepB = 2 * hstepB;
    const unsigned ldsw = (unsigned)wid * 1024u;
    const int aoff = lds_byte(wr * 64 + fr, fq * 8), boff = lds_byte(wc * 32 + fr, fq * 8);
#define PG8_SA(b, h) (((b) * 2 + (h)) * HTB)
#define PG8_SB(b, h) ((4 + (b) * 2 + (h)) * HTB)
#define PG8_STAGE(bufoff, gbase, voff) do { _Pragma("unroll") for (int _i = 0; _i < 2; ++_i) \
        __builtin_amdgcn_global_load_lds((const unsigned*)((const char*)(gbase) + (voff)[_i]), (LAS unsigned*)(lds + (bufoff) + ldsw + _i * 8192), 16, 0, 0); } while (0)
#define PG8_LDA(dst, b, h) do { _Pragma("unroll") for (int m = 0; m < 4; ++m) _Pragma("unroll") for (int k = 0; k < 2; ++k) dst[m][k] = *(const LAS bf16x8*)(lds + PG8_SA(b, h) + aoff + m * 2048 + k * 1024); } while (0)
#define PG8_LDB(dst, b, h) do { _Pragma("unroll") for (int n = 0; n < 2; ++n) _Pragma("unroll") for (int k = 0; k < 2; ++k) dst[n][k] = *(const LAS bf16x8*)(lds + PG8_SB(b, h) + boff + n * 2048 + k * 1024); } while (0)
#define PG8_MMA(ai, bj, At, Bt) do { __builtin_amdgcn_s_setprio(1); _Pragma("unroll") for (int m = 0; m < 4; ++m) _Pragma("unroll") for (int n = 0; n < 2; ++n) _Pragma("unroll") for (int k = 0; k < 2; ++k) \
        acc[ai][bj][m][n] = __builtin_amdgcn_mfma_f32_16x16x32_bf16(Bt[n][k], At[m][k], acc[ai][bj][m][n], 0, 0, 0); __builtin_amdgcn_s_setprio(0); } while (0)
#define PG8_WAIT_V(n) asm volatile("s_waitcnt vmcnt(" #n ")" ::: "memory")
#define PG8_WAIT_L(n) asm volatile("s_waitcnt lgkmcnt(" #n ")" ::: "memory")
#define PG8_BAR __builtin_amdgcn_s_barrier()
#define PG8_SCHED __builtin_amdgcn_sched_barrier(0)
    Unit cur, nxt; int ui = 0;
    if (!S.next(0, cur)) return;
    f32x4 acc[2][2][4][2];
#pragma unroll
    for (int a = 0; a < 2; ++a)
#pragma unroll
        for (int b = 0; b < 2; ++b)
#pragma unroll
            for (int m = 0; m < 4; ++m)
#pragma unroll
                for (int n = 0; n < 2; ++n) acc[a][b][m][n] = (f32x4){0.f, 0.f, 0.f, 0.f};
    bf16x8 At[4][2], B0[2][2], B1[2][2];
    const char* cA = (const char*)Ag + (size_t)cur.pm * tstepA; const char* cB = (const char*)Btg + (size_t)cur.pn * tstepB;
    PG8_STAGE(PG8_SB(0, 0), cB, voffB); PG8_STAGE(PG8_SA(0, 0), cA, voffA); PG8_STAGE(PG8_SB(0, 1), cB + hstepB, voffB); PG8_STAGE(PG8_SA(0, 1), cA + hstepA, voffA);
    if (wr == 1) PG8_BAR;
    PG8_WAIT_V(4); PG8_BAR;
    PG8_STAGE(PG8_SB(1, 0), cB + kstep, voffB); PG8_STAGE(PG8_SA(1, 0), cA + kstep, voffA); PG8_STAGE(PG8_SB(1, 1), cB + hstepB + kstep, voffB);
    PG8_WAIT_V(6); PG8_BAR;
    for (;;) {
        const bool has_next = S.next(ui + 1, nxt);
        const char* nA = has_next ? (const char*)Ag + (size_t)nxt.pm * tstepA : cA; const char* nB = has_next ? (const char*)Btg + (size_t)nxt.pn * tstepB : cB;
        for (int t = 0; t < nt; t += 2) {
            const bool last = (t == nt - 2);
            if (MODE != EPI_MEMKV && t == nt - 4 && E.st_in != nullptr && wid < 4) {
                const char* gsrc = wid < 2 ? (const char*)(E.st_in + 2 * ((size_t)cur.pm * BM + wid * 128)) : (const char*)((wid == 2 ? E.v1 : E.v2) + cur.pn * BM);
                __builtin_amdgcn_global_load_lds((const unsigned*)(gsrc + lane * 16), (LAS unsigned*)(lds + LDS_X + wid * 1024), 16, 0, 0);
            }
            const char* a1 = cA + (size_t)(t + 1) * kstep;
            const char* a2 = last ? nA : cA + (size_t)(t + 2) * kstep; const char* b2 = last ? nB : cB + (size_t)(t + 2) * kstep;
            const char* a3 = a2 + kstep; const char* b3 = b2 + kstep;
            PG8_LDB(B0, 0, 0); PG8_SCHED; PG8_LDA(At, 0, 0); PG8_STAGE(PG8_SA(1, 1), a1 + hstepA, voffA);
            PG8_WAIT_L(8); PG8_BAR; PG8_WAIT_L(0); PG8_MMA(0, 0, At, B0); PG8_BAR; PG8_SCHED;
            PG8_LDB(B1, 0, 1); PG8_STAGE(PG8_SB(0, 0), b2, voffB);
            PG8_BAR; PG8_WAIT_L(0); PG8_MMA(0, 1, At, B1); PG8_BAR;
            PG8_LDA(At, 0, 1); PG8_STAGE(PG8_SA(0, 0), a2, voffA);
            PG8_BAR; PG8_WAIT_L(0); PG8_MMA(1, 0, At, B0); PG8_BAR; PG8_SCHED;
            PG8_STAGE(PG8_SB(0, 1), b2 + hstepB, voffB);
            PG8_WAIT_V(6); PG8_BAR; PG8_MMA(1, 1, At, B1); PG8_BAR;
            PG8_LDB(B0, 1, 0); PG8_SCHED; PG8_LDA(At, 1, 0); PG8_STAGE(PG8_SA(0, 1), a2 + hstepA, voffA);
            PG8_WAIT_L(8); PG8_BAR; PG8_WAIT_L(0); PG8_MMA(0, 0, At, B0); PG8_BAR; PG8_SCHED;
            PG8_LDB(B1, 1, 1); PG8_STAGE(PG8_SB(1, 0), b3, voffB);
            PG8_BAR; PG8_WAIT_L(0); PG8_MMA(0, 1, At, B1); PG8_BAR;
            PG8_LDA(At, 1, 1); PG8_STAGE(PG8_SA(1, 0), a3, voffA);
            PG8_BAR; PG8_WAIT_L(0); PG8_MMA(1, 0, At, B0); PG8_BAR; PG8_SCHED;
            PG8_STAGE(PG8_SB(1, 1), b3 + hstepB, voffB);
            PG8_WAIT_V(6); PG8_BAR; PG8_MMA(1, 1, At, B1); PG8_BAR;
        }
        gemm_epilogue<MODE>(acc, cur, wr, wc, fr, fq, E, lds);
        if (!has_next) break;
#pragma unroll
        for (int a = 0; a < 2; ++a)
#pragma unroll
            for (int b = 0; b < 2; ++b)
#pragma unroll
                for (int m = 0; m < 4; ++m)
#pragma unroll
                    for (int n = 0; n < 2; ++n) acc[a][b][m][n] = (f32x4){0.f, 0.f, 0.f, 0.f};
        cur = nxt; cA = nA; cB = nB; ++ui;
    }
    PG8_WAIT_V(0);
    if (wr == 0) PG8_BAR;
    PG8_BAR;
#undef PG8_SA
#undef PG8_SB
#undef PG8_STAGE
#undef PG8_LDA
#undef PG8_LDB
#undef PG8_MMA
#undef PG8_WAIT_V
#undef PG8_WAIT_L
#undef PG8_BAR
#undef PG8_SCHED
}

__device__ __forceinline__ void transpose_job(LAS unsigned char* lds, const float* src, int ld, int K, int c0, int ncols, bf16_t* dst, int rowmode, int drow0,
                                              const float* gk, const float* bk, float* c1, float* c2) {
    LAS float* tile = (LAS float*)lds;
    int tid_ = threadIdx.x; asm volatile("" : "+v"(tid_)); const int tid = tid_;
    const int nkt = K / 64, nct = ncols / 64, ntiles = nkt * nct;
    for (int t = lbid(); t < ntiles; t += gridDim.x) {
        const int kt = t % nkt, ct = t / nkt;
        const int k0 = kt * 64, n0 = ct * 64;
        { const int kr = tid >> 4, c4 = (tid & 15) * 4;
#pragma unroll
          for (int rr = 0; rr < 64; rr += 32) { const f32x4 v = *(const f32x4*)(src + (size_t)(k0 + kr + rr) * ld + c0 + n0 + c4);
              tile[(kr + rr) * 65 + c4 + 0] = v[0]; tile[(kr + rr) * 65 + c4 + 1] = v[1]; tile[(kr + rr) * 65 + c4 + 2] = v[2]; tile[(kr + rr) * 65 + c4 + 3] = v[3]; } }
        __syncthreads();
        { const int n = tid >> 3, k8 = (tid & 7) * 8; float v[8];
#pragma unroll
          for (int i = 0; i < 8; ++i) v[i] = tile[(k8 + i) * 65 + n];
          const int c = c0 + n0 + n; int drow;
          if (rowmode == 0) drow = drow0 + c; else drow = 256 * (c >> 7) + (c & 127) + (rowmode == 2 ? 128 : 0);
          u32x4 w;
          if (gk) {
              const f32x4 g0 = *(const f32x4*)(gk + k0 + k8), g1 = *(const f32x4*)(gk + k0 + k8 + 4), b0 = *(const f32x4*)(bk + k0 + k8), b1 = *(const f32x4*)(bk + k0 + k8 + 4);
              float s2 = 0.f;
#pragma unroll
              for (int i = 0; i < 4; ++i) { s2 += b0[i] * v[i] + b1[i] * v[4 + i]; v[i] *= g0[i]; v[4 + i] *= g1[i]; }
              w.x = pk2(v[0], v[1]); w.y = pk2(v[2], v[3]); w.z = pk2(v[4], v[5]); w.w = pk2(v[6], v[7]);
              float s1 = 0.f;
#pragma unroll
              for (int i = 0; i < 4; ++i) s1 += bflo(w[i]) + bfhi(w[i]);
              s1 += __shfl_xor(s1, 1); s1 += __shfl_xor(s1, 2); s1 += __shfl_xor(s1, 4);
              s2 += __shfl_xor(s2, 1); s2 += __shfl_xor(s2, 2); s2 += __shfl_xor(s2, 4);
              if ((tid & 7) == 0) { atomicAdd(c1 + drow, s1); atomicAdd(c2 + drow, s2); }
          } else { w.x = pk2(v[0], v[1]); w.y = pk2(v[2], v[3]); w.z = pk2(v[4], v[5]); w.w = pk2(v[6], v[7]); }
          *(u32x4*)(dst + (size_t)drow * K + k0 + k8) = w; }
        __syncthreads();
    }
}
__device__ __forceinline__ void convert_job(const float* src, bf16_t* dst, float* dstf, size_t n) {
    const size_t nv = n / 8;
    for (size_t i = (size_t)lbid() * NTHR + ltid(); i < nv; i += (size_t)gridDim.x * NTHR) {
        const f32x4 a = *(const f32x4*)(src + i * 8), b = *(const f32x4*)(src + i * 8 + 4);
        u32x4 w; w.x = pk2(a[0], a[1]); w.y = pk2(a[2], a[3]); w.z = pk2(b[0], b[1]); w.w = pk2(b[2], b[3]);
        *(u32x4*)(dst + i * 8) = w;
        if (dstf) { *(f32x4*)(dstf + i * 8) = a; *(f32x4*)(dstf + i * 8 + 4) = b; }
    }
}
__device__ __forceinline__ void prep_phase(LAS unsigned char* lds, const Params& p) {
    unsigned char* ws = p.ws;
    for (int jb = 0; jb < 52; ++jb) {
        const float* src; int ld, K, c0, ncols, rowmode, drow0; bf16_t* dst; int li = -1; float* cv = nullptr; int cvn = 0;
        if (jb < 24) { const int lf = jb / 3, t = jb % 3;
            if (t < 2) { src = (t == 0 ? p.in[7] : p.in[8]) + (size_t)lf * 1024 * FF; ld = FF; K = 1024; c0 = 0; ncols = FF; dst = (bf16_t*)(ws + WS_WGU) + (size_t)lf * 5632 * 1024; rowmode = 1 + t; drow0 = 0;
                if (lf > 0) { li = (lf & 1) ? 3 * (lf >> 1) + 1 : 3 * (lf >> 1) - 1; cv = (float*)(ws + WS_CV_WGU) + (size_t)lf * 2 * 5632; cvn = 5632; } }
            else { src = p.in[9] + (size_t)lf * FF * 1024; ld = 1024; K = FF; c0 = 0; ncols = 1024; dst = (bf16_t*)(ws + WS_WD) + (size_t)lf * 1024 * FF; rowmode = 0; drow0 = 0; }
        } else if (jb < 44) { const int j = (jb - 24) / 10, t = (jb - 24) % 10; rowmode = 0; K = 1024;
            if (t < 4) {
                src = p.in[12] + (size_t)j * 1024 * 4608; ld = 4608; dst = (bf16_t*)(ws + WS_HWIN) + (size_t)j * 4608 * 1024;
                c0 = t == 0 ? 0 : (t == 1 ? 3072 : (t == 2 ? 2048 : 4096)); ncols = t == 0 ? 2048 : (t == 3 ? 512 : 1024); drow0 = (t == 0 ? 0 : (t == 1 ? 2048 : (t == 2 ? 3072 : 4096))) - c0;
                li = 3 * (2 * j); cv = (float*)(ws + WS_CV_HWIN) + (size_t)j * 2 * 4608; cvn = 4608;
            } else if (t < 8) {
                src = p.in[16] + (size_t)j * 1024 * 3600; ld = 3600; dst = (bf16_t*)(ws + WS_GWIN) + (size_t)j * 4096 * 1024; const int u = t - 4;
                c0 = u == 0 ? 0 : (u == 1 ? 2048 : (u == 2 ? 1024 : 3088)); ncols = u == 3 ? 512 : 1024; drow0 = (u == 0 ? 0 : (u == 1 ? 1536 : (u == 2 ? 2560 : 3584))) - c0;
                li = 3 * (2 * j + 1); cv = (float*)(ws + WS_CV_GWIN) + (size_t)j * 2 * 4096; cvn = 4096;
            } else { src = (t == 8 ? p.in[15] : p.in[20]) + (size_t)j * 1536 * 1024; ld = 1024; K = 1536; c0 = 0; ncols = 1024; dst = (bf16_t*)(ws + WS_WOUT) + (size_t)(2 * j + (t - 8)) * 1024 * 1536; drow0 = 0; }
        } else { const int l = (jb - 44) >> 1, kv = (jb - 44) & 1; src = (kv ? p.in[22] : p.in[21]) + (size_t)l * 1024 * 512; ld = 512; K = 1024; c0 = 0; ncols = 512; dst = (bf16_t*)(ws + WS_MEMW); rowmode = 0; drow0 = l * 1024 + kv * 512; }
        const float* gk = li >= 0 ? p.in[10] + li * 1024 : nullptr; const float* bk = li >= 0 ? p.in[11] + li * 1024 : nullptr;
        transpose_job(lds, src, ld, K, c0, ncols, dst, rowmode, drow0, gk, bk, cv, cv + cvn);
    }
    for (int j = 0; j < 2; ++j) {
        const float* gs = p.in[16] + (size_t)j * 1024 * 3600; bf16_t* gd = (bf16_t*)(ws + WS_GWIN) + (size_t)j * 4096 * 1024;
        const float* w2 = p.in[17] + (size_t)j * 16 * 512;
        const int li = 3 * (2 * j + 1); const float* gk = p.in[10] + li * 1024; const float* bk = p.in[11] + li * 1024;
        float* c1 = (float*)(ws + WS_CV_GWIN) + (size_t)j * 2 * 4096; float* c2 = c1 + 4096;
        for (int i = lbid() * NTHR + ltid(); i < 512 * 1024; i += gridDim.x * NTHR) {
            const int c = i >> 10, kk = i & 1023; float sacc = 0.f;
#pragma unroll
            for (int r = 0; r < 16; ++r) sacc += gs[(size_t)kk * 3600 + 3072 + r] * w2[r * 512 + c];
            const bf16_t hv = f2bf(sacc * gk[kk]);
            gd[(size_t)(1024 + c) * 1024 + kk] = hv;
            float s1 = __uint_as_float(((unsigned)hv) << 16), s2 = sacc * bk[kk];
#pragma unroll
            for (int o = 32; o >= 1; o >>= 1) { s1 += __shfl_xor(s1, o); s2 += __shfl_xor(s2, o); }
            if ((kk & 63) == 0) { atomicAdd(c1 + 1024 + c, s1); atomicAdd(c2 + 1024 + c, s2); }
        }
    }
    for (int jb = 0; jb < 5; ++jb) {
        const float* src; bf16_t* dst; float* dstf = nullptr; size_t n;
        if (jb == 0) { src = p.in[0]; dst = (bf16_t*)(ws + WS_XN); dstf = p.out + O_Y; n = (size_t)MP * D; }
        else if (jb == 1) { src = p.in[1]; dst = (bf16_t*)(ws + WS_XN) + (size_t)MP * D; dstf = p.out + O_Y + (size_t)MP * D; n = (size_t)MS * D; }
        else if (jb == 2) { src = p.in[2]; dst = (bf16_t*)(ws + WS_MEMP); n = (size_t)2048 * 1024; }
        else if (jb == 3) { src = p.in[3]; dst = (bf16_t*)(ws + WS_CKB); n = (size_t)4 * 4096 * 512; }
        else { src = p.in[4]; dst = (bf16_t*)(ws + WS_CVB); n = (size_t)4 * 4096 * 512; }
        convert_job(src, dst, dstf, n);
    }
}

__device__ __forceinline__ void ln_phase(float* x, bf16_t* xn, const float* gain, const float* bias) {
    int tid_ = threadIdx.x; asm volatile("" : "+v"(tid_));
    const int lane = tid_ & 63, wv = tid_ >> 6;
    f32x4 g[4], b[4];
#pragma unroll
    for (int i = 0; i < 4; ++i) { g[i] = *(const f32x4*)(gain + 4 * lane + 256 * i); b[i] = *(const f32x4*)(bias + 4 * lane + 256 * i); }
    for (int row = lbid() * 8 + wv; row < MROWS; row += gridDim.x * 8) {
        float* xr = x + (size_t)row * D; f32x4 v[4]; float s = 0.f;
#pragma unroll
        for (int i = 0; i < 4; ++i) { v[i] = *(const f32x4*)(xr + 4 * lane + 256 * i); s += (v[i][0] + v[i][1]) + (v[i][2] + v[i][3]); }
#pragma unroll
        for (int o = 32; o >= 1; o >>= 1) s += __shfl_xor(s, o);
        const float mu = s * (1.0f / 1024.0f); float q = 0.f;
#pragma unroll
        for (int i = 0; i < 4; ++i) { const f32x4 d = v[i] - mu; q += (d[0] * d[0] + d[1] * d[1]) + (d[2] * d[2] + d[3] * d[3]); }
#pragma unroll
        for (int o = 32; o >= 1; o >>= 1) q += __shfl_xor(q, o);
        const float rs = 1.0f / sqrtf(q * (1.0f / 1024.0f) + 1e-5f);
#pragma unroll
        for (int i = 0; i < 4; ++i) { const f32x4 o = (v[i] - mu) * rs * g[i] + b[i]; *(f32x4*)(xr + 4 * lane + 256 * i) = o;
            if (xn) { u32x2 w; w.x = pk2(o[0], o[1]); w.y = pk2(o[2], o[3]); *(u32x2*)(xn + (size_t)row * D + 4 * lane + 256 * i) = w; } }
    }
}

__device__ __forceinline__ void headnorm_phase(bf16_t* proj, int ld, int ocol, int gcol, int lanes_per_head  , const float* gain) {
    int tid_ = threadIdx.x; asm volatile("" : "+v"(tid_));
    const int lane = tid_ & 63, wv = tid_ >> 6;
    float gn[2][8];
#pragma unroll
    for (int hh = 0; hh < 2; ++hh)
#pragma unroll
        for (int i = 0; i < 8; ++i) gn[hh][i] = gain[hh * 512 + 8 * lane + i];
    const float invn = lanes_per_head == 16 ? (1.0f / 128.0f) : (1.0f / 256.0f);
    for (int row = lbid() * 8 + wv; row < MROWS; row += gridDim.x * 8) {
        bf16_t* pr = proj + (size_t)row * ld;
#pragma unroll
        for (int hh = 0; hh < 2; ++hh) {
            const u32x4 ov = *(const u32x4*)(pr + ocol + hh * 512 + 8 * lane), gv = *(const u32x4*)(pr + gcol + hh * 512 + 8 * lane);
            float o[8], g[8];
#pragma unroll
            for (int i = 0; i < 4; ++i) { o[2 * i] = bflo(ov[i]); o[2 * i + 1] = bfhi(ov[i]); g[2 * i] = bflo(gv[i]); g[2 * i + 1] = bfhi(gv[i]); }
            float s = 0.f;
#pragma unroll
            for (int i = 0; i < 8; ++i) s += o[i] * o[i];
            s += __shfl_xor(s, 1); s += __shfl_xor(s, 2); s += __shfl_xor(s, 4); s += __shfl_xor(s, 8);
            if (lanes_per_head == 32) s += __shfl_xor(s, 16);
            const float rs = __builtin_amdgcn_rsqf(s * invn + 1e-6f);
            float r[8];
#pragma unroll
            for (int i = 0; i < 8; ++i) r[i] = o[i] * rs * gn[hh][i] * g[i] * sigmoidf_(g[i]);
            u32x4 w; w.x = pk2(r[0], r[1]); w.y = pk2(r[2], r[3]); w.z = pk2(r[4], r[5]); w.w = pk2(r[6], r[7]);
            *(u32x4*)(pr + ocol + hh * 512 + 8 * lane) = w;
        }
    }
}

constexpr int MP_G = 0, MP_T = 32768, MP_KTT = 34816, MP_QT = MP_KTT + 128 * 72 * 2, MP_KT = MP_QT + 64 * 136 * 2, MP_END = MP_KT + 64 * 136 * 2;
static_assert(MP_END <= 131072, "prepass LDS");

__device__ __forceinline__ void mixprep_loop(LAS unsigned char* lds, bf16_t* proj, int ld, int qcol, int kcol, int gcol, int gla, const float* lb0, const float* lb1, int lbj, const float* bgate,
                                             bf16_t* ktb_h, int nh, float* vec_h, int ci0, int cstep) {
    int tid_ = threadIdx.x; asm volatile("" : "+v"(tid_));
    const int tid = tid_, wid = __builtin_amdgcn_readfirstlane(tid >> 6), lane = tid & 63, fr = lane & 15, fq = lane >> 4;
    LAS float* G = (LAS float*)(lds + MP_G); LAS float* T = (LAS float*)(lds + MP_T); LAS bf16_t* KTT = (LAS bf16_t*)(lds + MP_KTT);
    LAS bf16_t* QT = (LAS bf16_t*)(lds + MP_QT); LAS bf16_t* KT = (LAS bf16_t*)(lds + MP_KT);
    const int t0 = tid >> 4, cv = tid & 15, c8 = cv * 8;
    float cA[8], cB[8];
#pragma unroll
    for (int i = 0; i < 8; ++i) {
        if (gla) { cA[i] = bgate[c8 + i]; cB[i] = 0.f; }
        else { float lb = 0.f; if (lbj == 1) lb = sigmoidf_(lb1[c8 + i] - lb0[c8 + i]); cA[i] = lb; cB[i] = 1.0f - lb; }
    }
    const float qscale = 0.08838834764831845f;
    u32x4 rq[2], rk[2], rg[2];
    rg[0] = rg[1] = (u32x4){0u, 0u, 0u, 0u};
    auto issue_loads = [&](int ci) {
        const bf16_t* base = proj + (size_t)ci * 64 * ld;
#pragma unroll
        for (int rr = 0; rr < 2; ++rr) { const bf16_t* rp = base + (size_t)(t0 + 32 * rr) * ld + c8; rq[rr] = *(const u32x4*)(rp + qcol); rk[rr] = *(const u32x4*)(rp + kcol); if (gla) rg[rr] = *(const u32x4*)(rp + gcol); }
    };
    if (ci0 < NCHUNK) issue_loads(ci0);
    for (int ci = ci0; ci < NCHUNK; ci += cstep) {
        bf16_t* base = proj + (size_t)ci * 64 * ld;
        float qv[2][8], kv[2][8];
#pragma unroll
        for (int rr = 0; rr < 2; ++rr) {
            float gvv[8];
#pragma unroll
            for (int i = 0; i < 8; ++i) {
                const unsigned uq = rq[rr][i >> 1], uk = rk[rr][i >> 1], ug = rg[rr][i >> 1];
                const float q = (i & 1) ? bfhi(uq) : bflo(uq), k = (i & 1) ? bfhi(uk) : bflo(uk);
                if (gla) {
                    const float g = ((i & 1) ? bfhi(ug) : bflo(ug)) + cA[i];
                    qv[rr][i] = q * qscale; kv[rr][i] = k;
                    gvv[i] = (fminf(g, 0.f) - __logf(1.0f + __expf(-fabsf(g)))) * (1.0f / 16.0f);
                } else {
                    qv[rr][i] = q * sigmoidf_(q) * qscale;
                    const float e = __expf(-k), r = __builtin_amdgcn_rcpf(1.0f + e);
                    kv[rr][i] = cB[i] * e * r;
                    gvv[i] = __logf(fmaxf(cA[i] + cB[i] * r, 1e-6f));
                }
            }
            LAS float* gp = G + (t0 + 32 * rr) * 128 + c8;
            *(LAS f32x4*)gp = (f32x4){gvv[0], gvv[1], gvv[2], gvv[3]}; *(LAS f32x4*)(gp + 4) = (f32x4){gvv[4], gvv[5], gvv[6], gvv[7]};
        }
        if (ci + cstep < NCHUNK) issue_loads(ci + cstep);
        __syncthreads();
        { const int k = tid & 127, sg = tid >> 7; float run = 0.f;
#pragma unroll
          for (int i = 0; i < 16; ++i) { run += G[(16 * sg + i) * 128 + k]; G[(16 * sg + i) * 128 + k] = run; }
          T[sg * 128 + k] = run; }
        __syncthreads();
        {
            float tA[8], tB[8], tC[8], bmid[8], blast[8];
            { const f32x4 x0 = *(const LAS f32x4*)(T + c8), x1 = *(const LAS f32x4*)(T + c8 + 4), y0 = *(const LAS f32x4*)(T + 128 + c8), y1 = *(const LAS f32x4*)(T + 128 + c8 + 4),
                  z0 = *(const LAS f32x4*)(T + 256 + c8), z1 = *(const LAS f32x4*)(T + 256 + c8 + 4);
              const f32x4 m0 = *(const LAS f32x4*)(G + 31 * 128 + c8), m1 = *(const LAS f32x4*)(G + 31 * 128 + c8 + 4), l0 = *(const LAS f32x4*)(G + 63 * 128 + c8), l1 = *(const LAS f32x4*)(G + 63 * 128 + c8 + 4);
#pragma unroll
              for (int i = 0; i < 4; ++i) { tA[i] = x0[i]; tA[4 + i] = x1[i]; tB[i] = x0[i] + y0[i]; tB[4 + i] = x1[i] + y1[i]; tC[i] = tB[i] + z0[i]; tC[4 + i] = tB[4 + i] + z1[i];
                  bmid[i] = m0[i] + tA[i]; bmid[4 + i] = m1[i] + tA[4 + i]; blast[i] = l0[i] + tC[i]; blast[4 + i] = l1[i] + tC[4 + i]; } }
#pragma unroll
            for (int rr = 0; rr < 2; ++rr) {
                const int t = t0 + 32 * rr, sg = t >> 4;
                const f32x4 g0 = *(const LAS f32x4*)(G + t * 128 + c8), g1 = *(const LAS f32x4*)(G + t * 128 + c8 + 4);
                float qt[8], kt[8];
#pragma unroll
                for (int i = 0; i < 8; ++i) {
                    const float off = sg == 0 ? 0.f : (sg == 1 ? tA[i] : (sg == 2 ? tB[i] : tC[i]));
                    const float b = (i < 4 ? g0[i & 3] : g1[i & 3]) + off;
                    qt[i] = qv[rr][i] * __expf(fminf(b - bmid[i], 80.f));
                    kt[i] = kv[rr][i] * __expf(fminf(bmid[i] - b, 80.f));
                }
                bf16_t* rp = base + (size_t)t * ld + c8;
                u32x4 w;
                w.x = pk2(qt[0], qt[1]); w.y = pk2(qt[2], qt[3]); w.z = pk2(qt[4], qt[5]); w.w = pk2(qt[6], qt[7]); *(u32x4*)(rp + qcol) = w; *(LAS u32x4*)(QT + t * 136 + c8) = w;
                w.x = pk2(kt[0], kt[1]); w.y = pk2(kt[2], kt[3]); w.z = pk2(kt[4], kt[5]); w.w = pk2(kt[6], kt[7]); *(LAS u32x4*)(KT + t * 136 + c8) = w;
#pragma unroll
                for (int i = 0; i < 4; ++i) { KTT[(c8 + 2 * i) * 72 + t] = (bf16_t)(w[i] & 0xffffu); KTT[(c8 + 2 * i + 1) * 72 + t] = (bf16_t)(w[i] >> 16); }
            }
            if (t0 == 0) {
                float* em = vec_h + (size_t)ci * 1024; float* el = em + (size_t)NCHUNK * 1024; float* elm = el + (size_t)NCHUNK * 1024;
                f32x4 v0, v1;
#pragma unroll
                for (int i = 0; i < 4; ++i) { v0[i] = __expf(bmid[i]); v1[i] = __expf(bmid[4 + i]); }
                *(f32x4*)(em + c8) = v0; *(f32x4*)(em + c8 + 4) = v1;
#pragma unroll
                for (int i = 0; i < 4; ++i) { v0[i] = __expf(blast[i]); v1[i] = __expf(blast[4 + i]); }
                *(f32x4*)(el + c8) = v0; *(f32x4*)(el + c8 + 4) = v1;
#pragma unroll
                for (int i = 0; i < 4; ++i) { v0[i] = __expf(blast[i] - bmid[i]); v1[i] = __expf(blast[4 + i] - bmid[4 + i]); }
                *(f32x4*)(elm + c8) = v0; *(f32x4*)(elm + c8 + 4) = v1;
            }
        }
        __syncthreads();
        { const int k = tid >> 2, j = tid & 3; bf16_t* ktb = ktb_h + (size_t)ci * nh * 8192;
          const u32x4 w0 = *(const LAS u32x4*)(KTT + k * 72 + 16 * j), w1 = *(const LAS u32x4*)(KTT + k * 72 + 16 * j + 8);
          *(u32x4*)(ktb + k * 64 + 16 * j) = w0; *(u32x4*)(ktb + k * 64 + 16 * j + 8) = w1; }
        { const int ti = wid >> 1;
#pragma unroll
          for (int sh = 0; sh < 2; ++sh) { const int si = 2 * (wid & 1) + sh; f32x4 pa = {0.f, 0.f, 0.f, 0.f};
              if (si <= ti) {
#pragma unroll
                  for (int kk = 0; kk < 4; ++kk) { const bf16x8 A = *(const LAS bf16x8*)(KT + (16 * si + fr) * 136 + 32 * kk + 8 * fq), B = *(const LAS bf16x8*)(QT + (16 * ti + fr) * 136 + 32 * kk + 8 * fq); pa = MFMA16(A, B, pa); }
                  if (si == ti) {
#pragma unroll
                      for (int j = 0; j < 4; ++j) if (4 * fq + j > fr) pa[j] = 0.f; }
              }
              u32x2 w; w.x = pk2(pa[0], pa[1]); w.y = pk2(pa[2], pa[3]); *(u32x2*)(base + (size_t)(16 * ti + fr) * ld + kcol + 16 * si + 4 * fq) = w; } }
    }
    __syncthreads();
}

constexpr int MXB = 49664, MXB_QT = 0, MXB_KTT = 17408, MXB_VT = 35840, MXB_PP = 40448, MX_ST = 2 * MXB, MX_END = MX_ST + 2 * 8704;
static_assert(MX_END <= LDS_ST_OFF, "mixer LDS");

struct ChainArgs {
    bf16_t* proj; int ld; size_t row0; int nchunks;
    int qcol, kcol, vcol;
    const bf16_t* ktb;
    size_t ktb_stride;
    const float* em; const float* el; const float* elm; int vec_stride;
    const float* s0; float* sout; int sstride;
};

__device__ __forceinline__ void mixer_chain(LAS unsigned char* lds, const ChainArgs& a) {
    int tid_ = threadIdx.x; asm volatile("" : "+v"(tid_));
    const int tid = tid_, wid = __builtin_amdgcn_readfirstlane(tid >> 6), lane = tid & 63, fr = lane & 15, fq = lane >> 4;
    const int t0 = tid >> 4, c8 = (tid & 15) * 8;
    f32x4 Sacc[2];
#pragma unroll
    for (int vi = 0; vi < 2; ++vi)
#pragma unroll
        for (int j = 0; j < 4; ++j) Sacc[vi][j] = a.s0 ? a.s0[(size_t)(16 * wid + 4 * fq + j) * a.sstride + 16 * vi + fr] : 0.f;
    struct Regs { u32x4 rq[2], rkt[2], rp, rv; f32x4 vem, vel, velm; };
    Regs R0, R1;
    R0.rv = (u32x4){0u, 0u, 0u, 0u}; R1.rv = (u32x4){0u, 0u, 0u, 0u};
    auto issue_loads = [&](Regs& R, int c) {
        const bf16_t* base = a.proj + (a.row0 + (size_t)c * 64) * a.ld;
#pragma unroll
        for (int rr = 0; rr < 2; ++rr) R.rq[rr] = *(const u32x4*)(base + (size_t)(t0 + 32 * rr) * a.ld + c8 + a.qcol);
        R.rp = *(const u32x4*)(base + (size_t)(tid >> 3) * a.ld + a.kcol + 8 * (tid & 7));
        const bf16_t* kp = a.ktb + (size_t)c * a.ktb_stride + (tid >> 2) * 64 + 16 * (tid & 3);
        R.rkt[0] = *(const u32x4*)kp; R.rkt[1] = *(const u32x4*)(kp + 8);
        if (tid < 256) R.rv = *(const u32x4*)(base + (size_t)(tid >> 2) * a.ld + a.vcol + 8 * (tid & 3));
        const size_t vo = (size_t)c * a.vec_stride + 16 * wid + 4 * fq;
        R.vem = *(const f32x4*)(a.em + vo); R.vel = *(const f32x4*)(a.el + vo); R.velm = *(const f32x4*)(a.elm + vo);
    };
    f32x4 cel, celm;
    auto fill = [&](int b, const Regs& R) {
        LAS bf16_t* QT = (LAS bf16_t*)(lds + b * MXB + MXB_QT); LAS bf16_t* KTT = (LAS bf16_t*)(lds + b * MXB + MXB_KTT);
        LAS bf16_t* VT = (LAS bf16_t*)(lds + b * MXB + MXB_VT); LAS bf16_t* PP = (LAS bf16_t*)(lds + b * MXB + MXB_PP); LAS bf16_t* ST = (LAS bf16_t*)(lds + MX_ST + b * 8704);
#pragma unroll
        for (int rr = 0; rr < 2; ++rr) *(LAS u32x4*)(QT + (t0 + 32 * rr) * 136 + c8) = R.rq[rr];
        *(LAS u32x4*)(PP + (tid >> 3) * 72 + 8 * (tid & 7)) = R.rp;
        { LAS bf16_t* kp = KTT + (tid >> 2) * 72 + 16 * (tid & 3); *(LAS u32x4*)kp = R.rkt[0]; *(LAS u32x4*)(kp + 8) = R.rkt[1]; }
        if (tid < 256) { const int tv = tid >> 2, v8 = (tid & 3) * 8;
#pragma unroll
            for (int i = 0; i < 8; ++i) VT[(v8 + i) * 72 + tv] = (bf16_t)((i & 1) ? (R.rv[i >> 1] >> 16) : (R.rv[i >> 1] & 0xffffu)); }
#pragma unroll
        for (int vi = 0; vi < 2; ++vi) { u32x2 w; w.x = pk2(Sacc[vi][0] * R.vem[0], Sacc[vi][1] * R.vem[1]); w.y = pk2(Sacc[vi][2] * R.vem[2], Sacc[vi][3] * R.vem[3]); *(LAS u32x2*)(ST + (16 * vi + fr) * 136 + 16 * wid + 4 * fq) = w; }
        cel = R.vel; celm = R.velm;
    };
    auto compute = [&](int b, int c) {
        const LAS bf16_t* QT = (const LAS bf16_t*)(lds + b * MXB + MXB_QT); const LAS bf16_t* KTT = (const LAS bf16_t*)(lds + b * MXB + MXB_KTT);
        const LAS bf16_t* VT = (const LAS bf16_t*)(lds + b * MXB + MXB_VT); const LAS bf16_t* PP = (const LAS bf16_t*)(lds + b * MXB + MXB_PP); const LAS bf16_t* ST = (const LAS bf16_t*)(lds + MX_ST + b * 8704);
        { const int ti = wid >> 1, vi = wid & 1; f32x4 o = {0.f, 0.f, 0.f, 0.f};
#pragma unroll
          for (int kk = 0; kk < 2; ++kk) { const bf16x8 A = *(const LAS bf16x8*)(VT + (16 * vi + fr) * 72 + 32 * kk + 8 * fq), B = *(const LAS bf16x8*)(PP + (16 * ti + fr) * 72 + 32 * kk + 8 * fq); o = MFMA16(A, B, o); }
#pragma unroll
          for (int kk = 0; kk < 4; ++kk) { const bf16x8 A = *(const LAS bf16x8*)(ST + (16 * vi + fr) * 136 + 32 * kk + 8 * fq), B = *(const LAS bf16x8*)(QT + (16 * ti + fr) * 136 + 32 * kk + 8 * fq); o = MFMA16(A, B, o); }
          u32x2 w; w.x = pk2(o[0], o[1]); w.y = pk2(o[2], o[3]);
          *(u32x2*)(a.proj + (a.row0 + (size_t)c * 64 + 16 * ti + fr) * a.ld + a.vcol + 16 * vi + 4 * fq) = w; }
#pragma unroll
        for (int vi = 0; vi < 2; ++vi) { f32x4 u = {0.f, 0.f, 0.f, 0.f};
#pragma unroll
            for (int kk = 0; kk < 2; ++kk) { const bf16x8 A = *(const LAS bf16x8*)(KTT + (16 * wid + fr) * 72 + 32 * kk + 8 * fq), B = *(const LAS bf16x8*)(VT + (16 * vi + fr) * 72 + 32 * kk + 8 * fq); u = MFMA16(A, B, u); }
            Sacc[vi] = Sacc[vi] * cel + u * celm; }
    };
    const int n = a.nchunks;
    issue_loads(R0, 0);
    if (n > 1) issue_loads(R1, 1);
    fill(0, R0);
    if (n > 2) issue_loads(R0, 2);
    for (int c = 0; c < n; c += 2) {
        __syncthreads();
        compute(0, c);
        if (c + 1 < n) { fill(1, R1); if (c + 3 < n) issue_loads(R1, c + 3); }
        if (c + 1 < n) {
            __syncthreads();
            compute(1, c + 1);
            if (c + 2 < n) { fill(0, R0); if (c + 4 < n) issue_loads(R0, c + 4); }
        }
    }
#pragma unroll
    for (int vi = 0; vi < 2; ++vi)
#pragma unroll
        for (int j = 0; j < 4; ++j) a.sout[(size_t)(16 * wid + 4 * fq + j) * a.sstride + 16 * vi + fr] = Sacc[vi][j];
    __syncthreads();
}

constexpr int AT_PITCH = 264, AT_KOFF = 128 * AT_PITCH * 2, AT_KP = 136;
static_assert(AT_KOFF + 256 * AT_KP * 2 <= LDS_ST_OFF, "attention LDS");
__device__ __forceinline__ void mem_attn(LAS unsigned char* lds, const bf16_t* Kb, const bf16_t* Vb, bf16_t* Q, int ld, int nrows) {
    int tid_ = threadIdx.x; asm volatile("" : "+v"(tid_));
    const int tid = tid_, wid = __builtin_amdgcn_readfirstlane(tid >> 6), lane = tid & 63, fr = lane & 15, fq = lane >> 4;
    LAS bf16_t* VT = (LAS bf16_t*)lds;
    LAS bf16_t* KS = (LAS bf16_t*)(lds + AT_KOFF);
#pragma unroll
    for (int it = 0; it < 8; ++it) { const int idx = tid + NTHR * it, key = idx >> 4, v8 = (idx & 15) * 8; const u32x4 v = *(const u32x4*)(Vb + (size_t)key * 512 + v8), kx = *(const u32x4*)(Kb + (size_t)key * 512 + v8);
        *(LAS u32x4*)(KS + key * AT_KP + v8) = kx;
#pragma unroll
        for (int i = 0; i < 8; ++i) VT[(v8 + i) * AT_PITCH + key] = (bf16_t)((i & 1) ? (v[i >> 1] >> 16) : (v[i >> 1] & 0xffffu)); }
    __syncthreads();
    const float sc = 0.08838834764831845f;
    for (int q0 = wid * 16; q0 < nrows; q0 += 128) {
        bf16x8 Qf0, Qf1, Qf2, Qf3;
        { const bf16_t* qp = Q + (size_t)(q0 + fr) * ld + 8 * fq; Qf0 = *(const bf16x8*)(qp); Qf1 = *(const bf16x8*)(qp + 32); Qf2 = *(const bf16x8*)(qp + 64); Qf3 = *(const bf16x8*)(qp + 96); }
        f32x4 s[16];
#pragma unroll
        for (int a = 0; a < 16; ++a) {
            const LAS bf16_t* kp = KS + (16 * a + fr) * AT_KP + 8 * fq;
            f32x4 t = {0.f, 0.f, 0.f, 0.f};
            t = MFMA16(*(const LAS bf16x8*)(kp), Qf0, t); t = MFMA16(*(const LAS bf16x8*)(kp + 32), Qf1, t); t = MFMA16(*(const LAS bf16x8*)(kp + 64), Qf2, t); t = MFMA16(*(const LAS bf16x8*)(kp + 96), Qf3, t);
            s[a] = t;
            if ((a & 3) == 3) asm volatile("" ::: "memory");
        }
        float mx = -3.0e38f;
#pragma unroll
        for (int a = 0; a < 16; ++a) mx = fmaxf(fmaxf(mx, fmaxf(s[a][0], s[a][1])), fmaxf(s[a][2], s[a][3]));
        mx = fmaxf(mx, __shfl_xor(mx, 16)); mx = fmaxf(mx, __shfl_xor(mx, 32));
        float sum = 0.f; u32x2 pk[16];
#pragma unroll
        for (int a = 0; a < 16; ++a) { const float e0 = __expf((s[a][0] - mx) * sc), e1 = __expf((s[a][1] - mx) * sc), e2 = __expf((s[a][2] - mx) * sc), e3 = __expf((s[a][3] - mx) * sc);
            sum += (e0 + e1) + (e2 + e3); pk[a].x = pk2(e0, e1); pk[a].y = pk2(e2, e3); }
        sum += __shfl_xor(sum, 16); sum += __shfl_xor(sum, 32);
        const float inv = 1.0f / sum;
        f32x4 o[8];
#pragma unroll
        for (int dt = 0; dt < 8; ++dt) o[dt] = (f32x4){0.f, 0.f, 0.f, 0.f};
#pragma unroll
        for (int ap = 0; ap < 8; ++ap) {
            const u32x4 bv = {pk[2 * ap].x, pk[2 * ap].y, pk[2 * ap + 1].x, pk[2 * ap + 1].y};
            const bf16x8 B = __builtin_bit_cast(bf16x8, bv);
#pragma unroll
            for (int dt = 0; dt < 8; ++dt) {
                const u32x2 lo = *(const LAS u32x2*)(VT + (16 * dt + fr) * AT_PITCH + 32 * ap + 4 * fq), hi = *(const LAS u32x2*)(VT + (16 * dt + fr) * AT_PITCH + 32 * ap + 16 + 4 * fq);
                const u32x4 av = {lo.x, lo.y, hi.x, hi.y};
                o[dt] = MFMA16(__builtin_bit_cast(bf16x8, av), B, o[dt]);
            }
        }
#pragma unroll
        for (int dt = 0; dt < 8; ++dt) { u32x2 w; w.x = pk2(o[dt][0] * inv, o[dt][1] * inv); w.y = pk2(o[dt][2] * inv, o[dt][3] * inv);
            *(u32x2*)(Q + (size_t)(q0 + fr) * ld + 16 * dt + 4 * fq) = w; }
    }
    __syncthreads();
}

__device__ __forceinline__ void mixprep_phase(LAS unsigned char* lds, const Params& p, int layer) {
    const int j = layer >> 1, gla = layer & 1, w = lbid(), G = gridDim.x;
    bf16_t* proj = (bf16_t*)(p.ws + WS_PROJ);
    const int ld = gla ? GL_LD : HG_LD, nh = gla ? 4 : 8;
    bf16_t* ktb = (bf16_t*)(p.ws + WS_XN);
    float* vec = (float*)(p.ws + WS_VEC);
    const int xq = gla ? 3584 : 4096;
    for (int it = w; it < 256 + 64; it += G) {
        const bf16_t* Kb; const bf16_t* Vb; bf16_t* Qp; int nrows;
        if (it < 256) { const int bh = it >> 3, grp = it & 7, b = bh >> 2, h = bh & 3;
            Kb = (const bf16_t*)(p.ws + WS_MKB) + ((size_t)layer * 2048 + b * 256) * 512 + h * 128;
            Vb = (const bf16_t*)(p.ws + WS_MVB) + ((size_t)layer * 2048 + b * 256) * 512 + h * 128;
            Qp = proj + ((size_t)b * 8192 + grp * 1024) * ld + xq + h * 128; nrows = 1024;
        } else { const int bh = it - 256, b = bh >> 2, h = bh & 3;
            Kb = (const bf16_t*)(p.ws + WS_CKB) + ((size_t)layer * 4096 + b * 256) * 512 + h * 128;
            Vb = (const bf16_t*)(p.ws + WS_CVB) + ((size_t)layer * 4096 + b * 256) * 512 + h * 128;
            Qp = proj + ((size_t)MP + b * 64) * ld + xq + h * 128; nrows = 64;
        }
        mem_attn(lds, Kb, Vb, Qp, ld, nrows);
    }
    { const int h = w % nh;
      mixprep_loop(lds, proj, ld, h * 128, (gla ? 512 : 1024) + h * 128, gla ? 1024 + h * 128 : 0, gla,
                   gla ? nullptr : p.in[13] + h * 128, gla ? nullptr : p.in[13] + 1024 + h * 128, j, gla ? p.in[18] + j * 512 + h * 128 : nullptr,
                   ktb + (size_t)h * 8192, nh, vec + h * 128, w / nh, G / nh); }
}
__device__ __forceinline__ void chain_phase(LAS unsigned char* lds, const Params& p, int layer) {
    const int j = layer >> 1, gla = layer & 1, w = lbid(), G = gridDim.x;
    bf16_t* proj = (bf16_t*)(p.ws + WS_PROJ);
    const int ld = gla ? GL_LD : HG_LD;
    const int nvs = gla ? 8 : 4, nh = gla ? 4 : 8, vdim = gla ? 256 : 128;
    const bf16_t* ktb = (const bf16_t*)(p.ws + WS_XN);
    const float* vec = (const float*)(p.ws + WS_VEC);
    const int n_prompt = 8 * nh * nvs  , n_sample = 16 * nh * nvs  ;
    for (int it = w; it < n_prompt + n_sample; it += G) {
        const bool smp = it >= n_prompt; const int id = smp ? it - n_prompt : it;
        const int lo = id & 7, rest = id >> 3, vs = rest % nvs, hi = rest / nvs, bh = lo + 8 * hi, b = bh / nh, h = bh % nh;
        ChainArgs a;
        a.proj = proj; a.ld = ld;
        a.row0 = smp ? (size_t)MP + (size_t)b * 64 : (size_t)b * 8192; a.nchunks = smp ? 1 : 128;
        const int ci0 = smp ? 1024 + b : b * 128;
        if (gla) { a.qcol = h * 128; a.kcol = 512 + h * 128; a.vcol = 2560 + h * 256 + 32 * vs; }
        else { a.qcol = h * 128; a.kcol = 1024 + h * 128; a.vcol = 3072 + h * 128 + 32 * vs; }
        a.ktb = ktb + ((size_t)ci0 * nh + h) * 8192; a.ktb_stride = (size_t)nh * 8192;
        a.em = vec + (size_t)ci0 * 1024 + h * 128; a.el = a.em + (size_t)NCHUNK * 1024; a.elm = a.el + (size_t)NCHUNK * 1024; a.vec_stride = 1024;
        const size_t per_b = (size_t)nh * 128 * vdim, so = ((size_t)b * nh + h) * 128 * vdim + 32 * vs;
        if (smp) { a.s0 = (gla ? p.in[6] : p.in[5]) + (size_t)j * 16 * per_b + so; a.sout = p.out + (gla ? O_SGS : O_SHS) + (size_t)j * 16 * per_b + so; }
        else { a.s0 = nullptr; a.sout = p.out + (gla ? O_SGP : O_SHP) + (size_t)j * 8 * per_b + so; }
        a.sstride = vdim;
        mixer_chain(lds, a);
    }
}

#define XB_TMO      128
#define XB_XCNT(j)  (256  + 64 * (j))
#define XB_XSUB(j)  (1280 + 64 * (j))
#define XB_XGEN(j)  (2304 + 64 * (j))
#define XB_TOP      3328
#define XB_TOPGEN   3392
#define XCD_BAR_WORDS 3456
#define XB_SPIN_CAP (1u << 22)
__device__ __forceinline__ unsigned xb_ld(unsigned* p)              { return __hip_atomic_load(p, __ATOMIC_RELAXED, __HIP_MEMORY_SCOPE_AGENT); }
__device__ __forceinline__ unsigned xb_add(unsigned* p, unsigned v) { return __hip_atomic_fetch_add(p, v, __ATOMIC_RELAXED, __HIP_MEMORY_SCOPE_AGENT); }
__device__ __forceinline__ unsigned xb_xcc_id() { return (unsigned)__builtin_amdgcn_s_getreg((3 << 11) | 20) & 0xFu; }
#define XB_SPIN(cond, bar) do { unsigned _sp = 0; while (cond) { __builtin_amdgcn_s_sleep(1); \
    if ((++_sp & 255u) == 0u) { if (xb_ld(&(bar)[XB_TMO])) break; if (_sp > XB_SPIN_CAP) { atomicAdd(&(bar)[XB_TMO], 1u); break; } } } } while (0)
struct XcdBarrier { unsigned* bar; unsigned x; volatile LAS unsigned* st; };
__device__ __forceinline__ XcdBarrier xcd_barrier_post(unsigned* bar, volatile LAS unsigned* st) {
    XcdBarrier b; b.bar = bar; b.x = xb_xcc_id(); b.st = st;
    if (threadIdx.x == 0) (void)xb_add(&bar[XB_XCNT(b.x)], 1u);
    return b;
}
__device__ __forceinline__ void xcd_barrier_complete(unsigned* bar, unsigned x, unsigned& nloc, unsigned& nx) {
    const unsigned G = gridDim.x * gridDim.y * gridDim.z;
    unsigned sum, cnt, mine, sp = 0u;
    for (;;) {
        sum = 0u; cnt = 0u; mine = 0u;
#pragma unroll
        for (unsigned j = 0; j < 16; ++j) { const unsigned c = xb_ld(&bar[XB_XCNT(j)]); sum += c; cnt += (c > 0u) ? 1u : 0u; mine = (j == x) ? c : mine; }
        if (sum == G) break;
        __builtin_amdgcn_s_sleep(1);
        if ((++sp & 255u) == 0u) { if (xb_ld(&bar[XB_TMO])) break; if (sp > XB_SPIN_CAP) { atomicAdd(&bar[XB_TMO], 1u); break; } }
    }
    nloc = mine > 0u ? mine : 1u; nx = cnt > 0u ? cnt : 1u;
}
__device__ __forceinline__ void xcd_barrier(const XcdBarrier& b) {
    asm volatile("s_waitcnt vmcnt(0)" ::: "memory");
    __syncthreads();
    if (threadIdx.x == 0) {
        unsigned* bar = b.bar;
        __builtin_amdgcn_s_waitcnt(0);
        unsigned nloc = b.st[0], nx = b.st[1];
        if (nloc == 0u) { xcd_barrier_complete(bar, b.x, nloc, nx); b.st[0] = nloc; b.st[1] = nx; }
        const unsigned old = xb_add(&bar[XB_XSUB(b.x)], 1u);
        const unsigned gen = old / nloc;
        if (old + 1u == (gen + 1u) * nloc) {
            __builtin_amdgcn_fence(__ATOMIC_RELEASE, "agent");
            asm volatile("s_waitcnt vmcnt(0)" ::: "memory");
            const unsigned og = xb_add(&bar[XB_TOP], 1u);
            const unsigned tg = og / nx;
            if (og + 1u == (tg + 1u) * nx) xb_add(&bar[XB_TOPGEN], 1u);
            else XB_SPIN(xb_ld(&bar[XB_TOPGEN]) == tg, bar);
            __builtin_amdgcn_fence(__ATOMIC_ACQUIRE, "agent");
            xb_add(&bar[XB_XGEN(b.x)], 1u);
            asm volatile("s_waitcnt vmcnt(0)" ::: "memory");
        } else {
            XB_SPIN(xb_ld(&bar[XB_XGEN(b.x)]) == gen, bar);
            __builtin_amdgcn_fence(__ATOMIC_ACQUIRE, "agent");
            asm volatile("s_waitcnt vmcnt(0)" ::: "memory");
        }
    }
    __syncthreads();
}

constexpr int PPL = 9;
constexpr int NPHASE = 2 + 4 * PPL + 1;
#define WSB(off) ((bf16_t*)(p.ws + (off)))
#define STATS(li) ((float*)(p.ws + WS_STATS) + (size_t)(li) * MROWS * 2)
__global__ void __launch_bounds__(NTHR, 2) trunk_fwd(Params p) {
    extern __shared__ __attribute__((aligned(16))) unsigned char lds_raw[];
    LAS unsigned char* lds = (LAS unsigned char*)lds_raw;
    if (p.ph_hi - p.ph_lo > 1) {
        if (threadIdx.x < 4) ((LAS unsigned*)(lds + LDS_ST_OFF))[threadIdx.x] = 0u;
        __syncthreads();
        (void)xcd_barrier_post((unsigned*)(p.ws + WS_BAR), (volatile LAS unsigned*)(lds + LDS_ST_OFF));
    }
    for (int ph = p.ph_lo; ph < p.ph_hi; ++ph) {
        if (ph == 0) prep_phase(lds, p);
        else if (ph == 1) { }
        else if (false) { Epi E{EPI_MEMKV, nullptr, 0, nullptr, 0.f, p.out + O_MK, p.out + O_MV, WSB(WS_MKB), WSB(WS_MVB), nullptr, nullptr, nullptr, nullptr, nullptr};
            gemm_phase<EPI_MEMKV>(lds, WSB(WS_MEMP), 1024, WSB(WS_MEMW), 2048, 4096, 1024, E); }
        else if (ph == NPHASE - 1) ln_phase(p.out + O_Y, nullptr, p.in[10] + 11 * 1024, p.in[11] + 11 * 1024);
        else {
            const int layer = (ph - 2) / PPL, s = (ph - 2) % PPL, gla = layer & 1, j = layer >> 1;
            if (s == 0 || s == 7) {
                const int lf = layer * 2 + (s == 7), li = (s == 7) ? 3 * layer + 1 : 3 * layer - 1;
                const float* cv = (const float*)(p.ws + WS_CV_WGU) + (size_t)lf * 2 * 5632;
                Epi E{EPI_SWIGLU, WSB(WS_PROJ), FF, nullptr, 0.f, nullptr, nullptr, nullptr, nullptr, li >= 0 ? STATS(li) : nullptr, cv, cv + 5632, nullptr, nullptr};
                gemm_phase<EPI_SWIGLU>(lds, WSB(WS_XN), 1024, WSB(WS_WGU) + (size_t)lf * 5632 * 1024, MROWS, 5632, 1024, E);
                if (ph == 2) { Epi Em{EPI_MEMKV, nullptr, 0, nullptr, 0.f, p.out + O_MK, p.out + O_MV, WSB(WS_MKB), WSB(WS_MVB), nullptr, nullptr, nullptr, nullptr, nullptr};
                    gemm_phase<EPI_MEMKV>(lds, WSB(WS_MEMP), 1024, WSB(WS_MEMW), 2048, 4096, 1024, Em); } }
            else if (s == 1 || s == 8) {
                const int lf = layer * 2 + (s == 8), li_in = (s == 8) ? 3 * layer + 1 : 3 * layer - 1, li_out = (s == 8) ? 3 * layer + 2 : 3 * layer;
                Epi E{EPI_RES, nullptr, 0, p.out + O_Y, 0.5f, nullptr, nullptr, nullptr, nullptr, li_in >= 0 ? STATS(li_in) : nullptr,
                      li_in >= 0 ? p.in[10] + li_in * 1024 : nullptr, li_in >= 0 ? p.in[11] + li_in * 1024 : nullptr, STATS(li_out), WSB(WS_XN)};
                gemm_phase<EPI_RES>(lds, WSB(WS_PROJ), FF, WSB(WS_WD) + (size_t)lf * 1024 * FF, MROWS, 1024, FF, E); }
            else if (s == 2) {
                const int li = 3 * layer;
                const float* cv = gla ? (const float*)(p.ws + WS_CV_GWIN) + (size_t)j * 2 * 4096 : (const float*)(p.ws + WS_CV_HWIN) + (size_t)j * 2 * 4608;
                Epi E{EPI_BF16, WSB(WS_PROJ), gla ? GL_LD : HG_LD, nullptr, 0.f, nullptr, nullptr, nullptr, nullptr, STATS(li), cv, cv + (gla ? 4096 : 4608), nullptr, nullptr};
                if (gla) gemm_phase<EPI_BF16>(lds, WSB(WS_XN), 1024, WSB(WS_GWIN) + (size_t)j * 4096 * 1024, MROWS, 4096, 1024, E);
                else gemm_phase<EPI_BF16>(lds, WSB(WS_XN), 1024, WSB(WS_HWIN) + (size_t)j * 4608 * 1024, MROWS, 4608, 1024, E); }
            else if (s == 3) mixprep_phase(lds, p, layer);
            else if (s == 4) chain_phase(lds, p, layer);
            else if (s == 5) { if (gla) headnorm_phase(WSB(WS_PROJ), GL_LD, 2560, 1536, 32, p.in[19] + j * 1024); else headnorm_phase(WSB(WS_PROJ), HG_LD, 3072, 2048, 16, p.in[14] + j * 1024); }
            else if (s == 6) {
                const int li_in = 3 * layer;
                Epi E{EPI_RES, nullptr, 0, p.out + O_Y, 1.0f, nullptr, nullptr, nullptr, nullptr, STATS(li_in), p.in[10] + li_in * 1024, p.in[11] + li_in * 1024, STATS(li_in + 1), WSB(WS_XN)};
                gemm_phase<EPI_RES>(lds, WSB(WS_PROJ) + (gla ? 2560 : 3072), gla ? GL_LD : HG_LD, WSB(WS_WOUT) + (size_t)layer * 1024 * 1536, MROWS, 1024, 1536, E); }
        }
        if (ph + 1 < p.ph_hi && ph != 1) {
            if (ph == 0) cg::this_grid().sync();
            else { XcdBarrier bar; bar.bar = (unsigned*)(p.ws + WS_BAR); bar.x = xb_xcc_id(); bar.st = (volatile LAS unsigned*)(lds + LDS_ST_OFF); xcd_barrier(bar); }
        }
    }
}
#undef WSB
#undef STATS

extern "C" void kernel_launch(void* const* d_in, const int* in_sizes, int n_in, void* d_out, int out_size, void* d_ws, size_t ws_size, hipStream_t stream) {
    static int grid = 0;
    if (grid == 0) {
        if (n_in != 23 || ws_size < WS_END) { fprintf(stderr, "kernel_launch: need 23 inputs and %zu bytes of workspace; got %d, %zu\n", (size_t)WS_END, n_in, ws_size); grid = -1; return; }
        if (hipFuncSetAttribute((const void*)trunk_fwd, hipFuncAttributeMaxDynamicSharedMemorySize, LDS_BYTES) != hipSuccess) { fprintf(stderr, "kernel_launch: hipFuncSetAttribute failed\n"); grid = -1; return; }
        int dev = 0, cus = 0, per_cu = 0;
        (void)hipGetDevice(&dev); (void)hipDeviceGetAttribute(&cus, hipDeviceAttributeMultiprocessorCount, dev);
        (void)hipOccupancyMaxActiveBlocksPerMultiprocessor(&per_cu, (const void*)trunk_fwd, NTHR, LDS_BYTES);
        if (per_cu < 1) { fprintf(stderr, "kernel_launch: occupancy query says %d blocks per CU\n", per_cu); per_cu = 1; }
        (void)hipGetLastError();
        grid = cus;
    }
    if (grid < 0) return;
    Params p{};
    for (int i = 0; i < 23; ++i) p.in[i] = (const float*)d_in[i];
    p.out = (float*)d_out; p.ws = (unsigned char*)d_ws;
#if ONE_LAUNCH
    (void)hipMemsetAsync((unsigned char*)d_ws + WS_BAR, 0, WS_ZERO_END - WS_BAR, stream);
    p.ph_lo = 0; p.ph_hi = NPHASE;
    void* args[] = {&p};
    hipError_t e = hipLaunchCooperativeKernel((const void*)trunk_fwd, dim3(grid), dim3(NTHR), args, LDS_BYTES, stream);
    if (e != hipSuccess) fprintf(stderr, "cooperative launch failed: %s (grid %d)\n", hipGetErrorString(e), grid);
#else
    (void)hipMemsetAsync((unsigned char*)d_ws + WS_BAR, 0, WS_ZERO_END - WS_BAR, stream);
    for (int ph = 0; ph < NPHASE; ++ph) {
        p.ph_lo = ph; p.ph_hi = ph + 1;
        hipLaunchKernelGGL(trunk_fwd, dim3(grid), dim3(NTHR), LDS_BYTES, stream, p);
    }
#endif
}
```

```cpp
#include <hip/hip_runtime.h>
#include <hip/hip_cooperative_groups.h>
#include <cstdio>
namespace cg = cooperative_groups;

#ifndef ONE_LAUNCH
#define ONE_LAUNCH 1
#endif

#define LAS __attribute__((address_space(3)))
typedef unsigned short bf16_t;
typedef short bf16x8 __attribute__((ext_vector_type(8)));
typedef float f32x4 __attribute__((ext_vector_type(4)));
typedef float f32x2 __attribute__((ext_vector_type(2)));
typedef unsigned u32x4 __attribute__((ext_vector_type(4)));
typedef unsigned u32x2 __attribute__((ext_vector_type(2)));
typedef __bf16 nbf2 __attribute__((ext_vector_type(2)));

constexpr int D = 1024, MP = 65536, MS = 1024, MROWS = MP + MS, FF = 2816;
constexpr int HG_LD = 4608, GL_LD = 4096;
constexpr float ALPHA = 1.6817928305074292f;
constexpr int NTHR = 512;
constexpr int LDS_BYTES = 144 * 1024;
constexpr int LDS_ST_OFF = 143360;
constexpr int NCHUNK = MROWS / 64;
constexpr int LDS_X = 131072;

constexpr size_t O_Y = 0;
constexpr size_t O_SHP = (size_t)MROWS * D;
constexpr size_t O_SGP = O_SHP + 2u * 8 * 8 * 128 * 128;
constexpr size_t O_MK = O_SGP + 2u * 8 * 4 * 128 * 256;
constexpr size_t O_MV = O_MK + 4u * 2048 * 512;
constexpr size_t O_SHS = O_MV + 4u * 2048 * 512;
constexpr size_t O_SGS = O_SHS + 2u * 16 * 8 * 128 * 128;

constexpr size_t WS_WGU = 0;
constexpr size_t WS_WD = WS_WGU + 8ull * 5632 * 1024 * 2;
constexpr size_t WS_HWIN = WS_WD + 8ull * 1024 * 2816 * 2;
constexpr size_t WS_GWIN = WS_HWIN + 2ull * 4608 * 1024 * 2;
constexpr size_t WS_WOUT = WS_GWIN + 2ull * 4096 * 1024 * 2;
constexpr size_t WS_MEMW = WS_WOUT + 4ull * 1024 * 1536 * 2;
constexpr size_t WS_MEMP = WS_MEMW + 4096ull * 1024 * 2;
constexpr size_t WS_MKB = WS_MEMP + 2048ull * 1024 * 2;
constexpr size_t WS_MVB = WS_MKB + 4ull * 2048 * 512 * 2;
constexpr size_t WS_CKB = WS_MVB + 4ull * 2048 * 512 * 2;
constexpr size_t WS_CVB = WS_CKB + 4ull * 4096 * 512 * 2;
constexpr size_t WS_XN = WS_CVB + 4ull * 4096 * 512 * 2;
constexpr size_t WS_PROJ = WS_XN + (size_t)MROWS * 1024 * 2;
constexpr size_t WS_VEC = WS_PROJ + (size_t)MROWS * 4608 * 2;
constexpr size_t WS_BAR = WS_VEC + 3ull * (MROWS / 64) * 1024 * 4;
constexpr size_t WS_STATS = WS_BAR + 16384;
constexpr size_t WS_CV_WGU = WS_STATS + 12ull * MROWS * 8;
constexpr size_t WS_CV_HWIN = WS_CV_WGU + 8ull * 2 * 5632 * 4;
constexpr size_t WS_CV_GWIN = WS_CV_HWIN + 2ull * 2 * 4608 * 4;
constexpr size_t WS_ZERO_END = WS_CV_GWIN + 2ull * 2 * 4096 * 4;
constexpr size_t WS_END = WS_ZERO_END;

struct Params {
    const float* in[23];
    float* out;
    unsigned char* ws;
    int ph_lo, ph_hi;
};

__device__ __forceinline__ unsigned pk2(float lo, float hi) { f32x2 v = {lo, hi}; nbf2 b = __builtin_convertvector(v, nbf2); return __builtin_bit_cast(unsigned, b); }
__device__ __forceinline__ float bflo(unsigned u) { return __uint_as_float(u << 16); }
__device__ __forceinline__ float bfhi(unsigned u) { return __uint_as_float(u & 0xffff0000u); }
__device__ __forceinline__ bf16_t f2bf(float f) { unsigned u = pk2(f, 0.f); return (bf16_t)(u & 0xffffu); }
__device__ __forceinline__ float sigmoidf_(float x) { return __builtin_amdgcn_rcpf(1.0f + __expf(-x)); }
__device__ __forceinline__ int ltid() { int t = threadIdx.x; asm volatile("" : "+v"(t)); return t; }
__device__ __forceinline__ int lbid() { int t = blockIdx.x; asm volatile("" : "+s"(t)); return t; }
#define MFMA16(a, b, c) __builtin_amdgcn_mfma_f32_16x16x32_bf16((a), (b), (c), 0, 0, 0)

constexpr int BM = 256, BK = 64, HALF = 128, HTB = HALF * BK * 2, NXCD = 8, WGM = 8;
__device__ __forceinline__ int lds_byte(int r, int c) { const int st = (r >> 4) * 2 + (c >> 5), rr = r & 15, cc = c & 31, ob = rr * 64 + cc * 2; return st * 1024 + (ob ^ (((ob >> 9) & 1) << 5)); }
__device__ __forceinline__ void stage_rc(int b, int& R, int& C) { const int st = b / 1024, sb = b % 1024, swz = sb ^ (((sb >> 9) & 1) << 5); R = (st >> 1) * 16 + swz / 64; C = (st & 1) * 32 + (swz % 64) / 2; }
__device__ __forceinline__ int perm32(int rho) { const int n = rho >> 4, i = rho & 15; return 8 * (i >> 2) + 4 * n + (i & 3); }

struct Unit { int pm, pn; };
struct StaticOrder {
    int nM, nN, nwg, G, c;
    __device__ __forceinline__ void init(int M, int N, int G_, int c_) { nM = M / BM; nN = N / BM; nwg = nM * nN; G = G_; c = c_; }
    __device__ __forceinline__ bool next(int i, Unit& u) const {
        const long L = (long)i * G + c; if (L >= nwg) return false;
        int wgid = (int)L; { const int q = nwg / NXCD, r = nwg % NXCD, xcd = wgid % NXCD, off = wgid / NXCD; wgid = (xcd < r ? xcd * (q + 1) : r * (q + 1) + (xcd - r) * q) + off; }
        const int nig = WGM * nN, gid = wgid / nig, fm = gid * WGM, gsz = (nM - fm) < WGM ? (nM - fm) : WGM;
        u.pm = fm + ((wgid % nig) % gsz); u.pn = (wgid % nig) / gsz; return true;
    }
};

enum { EPI_SWIGLU = 0, EPI_BF16 = 1, EPI_RES = 2, EPI_MEMKV = 3 };
struct Epi { int mode; bf16_t* ob; int ldo; float* xf; float scale; float* mk_out; float* mv_out; bf16_t* mkb; bf16_t* mvb;
             const float* st_in; const float* v1; const float* v2; float* st_out; bf16_t* ybf; };
__device__ __forceinline__ void row_mu_rstd(const LAS float* XS, bool has, int rl, float& mu, float& rstd) {
    if (has) { const f32x2 q = *(const LAS f32x2*)(XS + 2 * rl); mu = q.x * (1.0f / 1024.0f); rstd = __builtin_amdgcn_rsqf(fmaxf(q.y * (1.0f / 1024.0f) - mu * mu, 0.f) + 1e-5f); }
    else { mu = 0.f; rstd = 1.0f; }
}

template <int MODE, bool HALFM> __device__ __forceinline__ void gemm_epilogue(const f32x4 (&acc)[2][2][4][2], const Unit& u, int rb, int wr, int wc, int fr, int fq, const Epi& E, LAS unsigned char* lds) {
    const int row0 = rb + wr * 64 + fr;
    const LAS float* XS = (const LAS float*)(lds + LDS_X); const bool has = (E.st_in != nullptr); const int rl0 = wr * 64 + fr;
    if constexpr (MODE == EPI_SWIGLU) {
        const int col0 = u.pn * 128 + wc * 32 + 8 * fq;
        const int cl = wc * 32 + 8 * fq;
        f32x4 c1g[2], c2g[2], c1u[2], c2u[2];
#pragma unroll
        for (int n = 0; n < 2; ++n) {
            if (has) { c1g[n] = *(const LAS f32x4*)(XS + 512 + cl + 4 * n); c2g[n] = *(const LAS f32x4*)(XS + 768 + cl + 4 * n); c1u[n] = *(const LAS f32x4*)(XS + 512 + cl + 128 + 4 * n); c2u[n] = *(const LAS f32x4*)(XS + 768 + cl + 128 + 4 * n); }
            else { c1g[n] = c2g[n] = c1u[n] = c2u[n] = (f32x4){0.f, 0.f, 0.f, 0.f}; }
        }
        float mus[2][4], rstds[2][4];
#pragma unroll
        for (int ai = 0; ai < 2; ++ai)
#pragma unroll
            for (int m = 0; m < 4; ++m) row_mu_rstd(XS, has, rl0 + ai * HALF + m * 16, mus[ai][m], rstds[ai][m]);
#pragma unroll
        for (int ai = 0; ai < 2; ++ai)
#pragma unroll
            for (int m = 0; m < 4; ++m) {
                const int row = row0 + ai * HALF + m * 16;
                const float mu = mus[ai][m], rstd = rstds[ai][m];
                bf16_t* rowp = E.ob + (size_t)row * E.ldo + col0;
                float h[8];
#pragma unroll
                for (int n = 0; n < 2; ++n)
#pragma unroll
                    for (int j = 0; j < 4; ++j) { const float g = rstd * (acc[ai][0][m][n][j] - mu * c1g[n][j]) + c2g[n][j], up = rstd * (acc[ai][1][m][n][j] - mu * c1u[n][j]) + c2u[n][j];
                        h[n * 4 + j] = g * up * __builtin_amdgcn_rcpf(1.0f + __expf(-g)); }
                u32x4 w; w.x = pk2(h[0], h[1]); w.y = pk2(h[2], h[3]); w.z = pk2(h[4], h[5]); w.w = pk2(h[6], h[7]);
                *(u32x4*)rowp = w;
            }
    } else if constexpr (MODE == EPI_BF16) {
        const int col0 = u.pn * BM + wc * 32 + 8 * fq, cl = wc * 32 + 8 * fq;
        f32x4 c1[2][2], c2[2][2];
#pragma unroll
        for (int bj = 0; bj < 2; ++bj)
#pragma unroll
            for (int n = 0; n < 2; ++n) { c1[bj][n] = *(const LAS f32x4*)(XS + 512 + cl + bj * HALF + 4 * n); c2[bj][n] = *(const LAS f32x4*)(XS + 768 + cl + bj * HALF + 4 * n); }
#pragma unroll
        for (int ai = 0; ai < 2; ++ai)
#pragma unroll
            for (int m = 0; m < 4; ++m) {
                const int row = row0 + ai * HALF + m * 16;
                float mu, rstd; row_mu_rstd(XS, has, rl0 + ai * HALF + m * 16, mu, rstd);
                bf16_t* rowp = E.ob + (size_t)row * E.ldo + col0;
#pragma unroll
                for (int bj = 0; bj < 2; ++bj) {
                    const f32x4 v0 = (acc[ai][bj][m][0] - c1[bj][0] * mu) * rstd + c2[bj][0], v1 = (acc[ai][bj][m][1] - c1[bj][1] * mu) * rstd + c2[bj][1];
                    u32x4 w; w.x = pk2(v0[0], v0[1]); w.y = pk2(v0[2], v0[3]); w.z = pk2(v1[0], v1[1]); w.w = pk2(v1[2], v1[3]);
                    *(u32x4*)(rowp + bj * HALF) = w;
                }
            }
    } else if constexpr (MODE == EPI_RES) {
        const int col0 = u.pn * BM + wc * 32 + 4 * fq, cl = wc * 32 + 4 * fq;
        constexpr int NG = HALFM ? 4 : 8;
#pragma unroll
        for (int bt = 0; bt < (NG + 2) / 3; ++bt) {
            const int g0 = bt * 3, ng = (NG - g0) < 3 ? (NG - g0) : 3;
            f32x4 xv[3][2][2];
#pragma unroll
            for (int gi = 0; gi < 3; ++gi) if (gi < ng) { const int g = g0 + gi, ai = g >> 2, m = g & 3; const float* rowp = E.xf + (size_t)(row0 + ai * HALF + m * 16) * D + col0;
#pragma unroll
                for (int bj = 0; bj < 2; ++bj)
#pragma unroll
                    for (int n = 0; n < 2; ++n) xv[gi][bj][n] = *(const f32x4*)(rowp + bj * HALF + n * 16); }
#pragma unroll
            for (int gi = 0; gi < 3; ++gi) if (gi < ng) {
                const int g = g0 + gi, ai = g >> 2, m = g & 3;
                const int row = row0 + ai * HALF + m * 16;
                float mu, rstd; row_mu_rstd(XS, has, rl0 + ai * HALF + m * 16, mu, rstd);
                float* rowp = E.xf + (size_t)row * D + col0; bf16_t* rowb = E.ybf + (size_t)row * D + col0;
                float s1 = 0.f, s2 = 0.f;
#pragma unroll
                for (int bj = 0; bj < 2; ++bj)
#pragma unroll
                    for (int n = 0; n < 2; ++n) { f32x4 x = xv[gi][bj][n];
                        if (has) { const f32x4 gp = *(const LAS f32x4*)(XS + 512 + cl + bj * HALF + n * 16), bp = *(const LAS f32x4*)(XS + 768 + cl + bj * HALF + n * 16); x = (x - mu) * rstd * gp + bp; }
                        x = x * ALPHA + acc[ai][bj][m][n] * E.scale;
                        *(f32x4*)(rowp + bj * HALF + n * 16) = x;
                        u32x2 w; w.x = pk2(x[0], x[1]); w.y = pk2(x[2], x[3]); *(u32x2*)(rowb + bj * HALF + n * 16) = w;
                        s1 += (x[0] + x[1]) + (x[2] + x[3]); s2 += (x[0] * x[0] + x[1] * x[1]) + (x[2] * x[2] + x[3] * x[3]); }
                s1 += __shfl_xor(s1, 16); s1 += __shfl_xor(s1, 32); s2 += __shfl_xor(s2, 16); s2 += __shfl_xor(s2, 32);
                if (fq == 0) { atomicAdd(E.st_out + 2 * (size_t)row, s1); atomicAdd(E.st_out + 2 * (size_t)row + 1, s2); }
            }
            asm volatile("" ::: "memory");
        }
    } else {
        const int colt = u.pn * BM; const int l = colt >> 10, kv = (colt >> 9) & 1, cc0 = (colt & 511) + wc * 32 + 4 * fq;
        float* of = (kv ? E.mv_out : E.mk_out) + (size_t)l * 2048 * 512;
        bf16_t* ob = (kv ? E.mvb : E.mkb) + (size_t)l * 2048 * 512;
#pragma unroll
        for (int ai = 0; ai < 2; ++ai)
#pragma unroll
            for (int m = 0; m < 4; ++m) {
                const size_t ro = (size_t)(row0 + ai * HALF + m * 16) * 512 + cc0;
#pragma unroll
                for (int bj = 0; bj < 2; ++bj)
#pragma unroll
                    for (int n = 0; n < 2; ++n) { const f32x4 v = acc[ai][bj][m][n]; *(f32x4*)(of + ro + bj * HALF + n * 16) = v; u32x2 w; w.x = pk2(v[0], v[1]); w.y = pk2(v[2], v[3]); *(u32x2*)(ob + ro + bj * HALF + n * 16) = w; }
            }
    }
}

template <int MODE, bool HALFM = false> __device__ __forceinline__ void gemm_phase(LAS unsigned char* lds, const bf16_t* Ag, int lda, const bf16_t* Btg, int M, int N, int K, const Epi& E) {
    int tid_ = threadIdx.x; asm volatile("" : "+v"(tid_));
    const int tid = tid_, wid = __builtin_amdgcn_readfirstlane(tid >> 6), lane = tid & 63, wr = wid >> 2, wc = wid & 3, fr = lane & 15, fq = lane >> 4;
    const int nt = K / BK;
    constexpr bool PERM = (MODE == EPI_SWIGLU || MODE == EPI_BF16);
    StaticOrder S; { const int G_ = (int)gridDim.x; int c_ = lbid(); if (MODE == EPI_MEMKV) c_ = (c_ + G_ / 2) % G_; S.init(M, N, G_, c_); }
    unsigned voffA[2], voffB[2];
#pragma unroll
    for (int i = 0; i < 2; ++i) { int R, C; stage_rc(tid * 16 + i * 8192, R, C); const int Rb = PERM ? ((R & ~31) + perm32(R & 31)) : R;
        voffA[i] = (unsigned)(R * lda + C) * 2u; voffB[i] = (unsigned)(Rb * K + C) * 2u; }
    const size_t kstep = (size_t)(BK * 2);
    const size_t hstepA = (size_t)HALF * lda * 2, hstepB = (size_t)HALF * K * 2;
    const size_t tstepA = 2 * hstepA, tstepB = 2 * hstepB;
    const size_t hA1 = HALFM ? 0 : hstepA;
    const unsigned ldsw = (unsigned)wid * 1024u;
    const int aoff = lds_byte(wr * 64 + fr, fq * 8), boff = lds_byte(wc * 32 + fr, fq * 8);
#define PG8_SA(b, h) (((b) * 2 + (h)) * HTB)
#define PG8_SB(b, h) ((4 + (b) * 2 + (h)) * HTB)
#define PG8_STAGE(bufoff, gbase, voff) do { _Pragma("unroll") for (int _i = 0; _i < 2; ++_i) \
        __builtin_amdgcn_global_load_lds((const unsigned*)((const char*)(gbase) + (voff)[_i]), (LAS unsigned*)(lds + (bufoff) + ldsw + _i * 8192), 16, 0, 0); } while (0)
#define PG8_LDA(dst, b, h) do { _Pragma("unroll") for (int m = 0; m < 4; ++m) _Pragma("unroll") for (int k = 0; k < 2; ++k) dst[m][k] = *(const LAS bf16x8*)(lds + PG8_SA(b, h) + aoff + m * 2048 + k * 1024); } while (0)
#define PG8_LDB(dst, b, h) do { _Pragma("unroll") for (int n = 0; n < 2; ++n) _Pragma("unroll") for (int k = 0; k < 2; ++k) dst[n][k] = *(const LAS bf16x8*)(lds + PG8_SB(b, h) + boff + n * 2048 + k * 1024); } while (0)
#define PG8_MMA(ai, bj, At, Bt) do { __builtin_amdgcn_s_setprio(1); _Pragma("unroll") for (int m = 0; m < 4; ++m) _Pragma("unroll") for (int n = 0; n < 2; ++n) _Pragma("unroll") for (int k = 0; k < 2; ++k) \
        acc[ai][bj][m][n] = __builtin_amdgcn_mfma_f32_16x16x32_bf16(Bt[n][k], At[m][k], acc[ai][bj][m][n], 0, 0, 0); __builtin_amdgcn_s_setprio(0); } while (0)
#define PG8_WAIT_V(n) asm volatile("s_waitcnt vmcnt(" #n ")" ::: "memory")
#define PG8_WAIT_L(n) asm volatile("s_waitcnt lgkmcnt(" #n ")" ::: "memory")
#define PG8_BAR __builtin_amdgcn_s_barrier()
#define PG8_SCHED __builtin_amdgcn_sched_barrier(0)
    Unit cur, nxt; int ui = 0; int rb;
    if constexpr (HALFM) { const int c_ = S.c; if (c_ >= 8 * (N / BM)) return; cur.pm = M / 128 + (c_ & 7); cur.pn = c_ >> 3; rb = cur.pm * 128; }
    else { if (!S.next(0, cur)) return; rb = cur.pm * BM; }
    f32x4 acc[2][2][4][2];
#pragma unroll
    for (int a = 0; a < 2; ++a)
#pragma unroll
        for (int b = 0; b < 2; ++b)
#pragma unroll
            for (int m = 0; m < 4; ++m)
#pragma unroll
                for (int n = 0; n < 2; ++n) acc[a][b][m][n] = (f32x4){0.f, 0.f, 0.f, 0.f};
    bf16x8 At[4][2], B0[2][2], B1[2][2];
    const char* cA = (const char*)Ag + (size_t)cur.pm * (HALFM ? hstepA : tstepA); const char* cB = (const char*)Btg + (size_t)cur.pn * tstepB;
    PG8_STAGE(PG8_SB(0, 0), cB, voffB); PG8_STAGE(PG8_SA(0, 0), cA, voffA); PG8_STAGE(PG8_SB(0, 1), cB + hstepB, voffB); PG8_STAGE(PG8_SA(0, 1), cA + hA1, voffA);
    if (wr == 1) PG8_BAR;
    PG8_WAIT_V(4); PG8_BAR;
    PG8_STAGE(PG8_SB(1, 0), cB + kstep, voffB); PG8_STAGE(PG8_SA(1, 0), cA + kstep, voffA); PG8_STAGE(PG8_SB(1, 1), cB + hstepB + kstep, voffB);
    PG8_WAIT_V(6); PG8_BAR;
    for (;;) {
        const bool has_next = HALFM ? false : S.next(ui + 1, nxt);
        const char* nA = has_next ? (const char*)Ag + (size_t)nxt.pm * tstepA : cA; const char* nB = has_next ? (const char*)Btg + (size_t)nxt.pn * tstepB : cB;
        for (int t = 0; t < nt; t += 2) {
            const bool last = (t == nt - 2);
            if (MODE != EPI_MEMKV && t == nt - 4 && E.st_in != nullptr && wid < 4) {
                const char* gsrc = wid < 2 ? (const char*)(E.st_in + 2 * ((size_t)rb + (HALFM ? 0 : wid * 128))) : (const char*)((wid == 2 ? E.v1 : E.v2) + cur.pn * BM);
                __builtin_amdgcn_global_load_lds((const unsigned*)(gsrc + lane * 16), (LAS unsigned*)(lds + LDS_X + wid * 1024), 16, 0, 0);
            }
            const char* a1 = cA + (size_t)(t + 1) * kstep;
            const char* a2 = last ? nA : cA + (size_t)(t + 2) * kstep; const char* b2 = last ? nB : cB + (size_t)(t + 2) * kstep;
            const char* a3 = a2 + kstep; const char* b3 = b2 + kstep;
            PG8_LDB(B0, 0, 0); PG8_SCHED; PG8_LDA(At, 0, 0); PG8_STAGE(PG8_SA(1, 1), a1 + hA1, voffA);
            PG8_WAIT_L(8); PG8_BAR; PG8_WAIT_L(0); PG8_MMA(0, 0, At, B0); PG8_BAR; PG8_SCHED;
            PG8_LDB(B1, 0, 1); PG8_STAGE(PG8_SB(0, 0), b2, voffB);
            PG8_BAR; PG8_WAIT_L(0); PG8_MMA(0, 1, At, B1); PG8_BAR;
            if constexpr (!HALFM) PG8_LDA(At, 0, 1); PG8_STAGE(PG8_SA(0, 0), a2, voffA);
            PG8_BAR; PG8_WAIT_L(0); if constexpr (!HALFM) PG8_MMA(1, 0, At, B0); PG8_BAR; PG8_SCHED;
            PG8_STAGE(PG8_SB(0, 1), b2 + hstepB, voffB);
            PG8_WAIT_V(6); PG8_BAR; if constexpr (!HALFM) PG8_MMA(1, 1, At, B1); PG8_BAR;
            PG8_LDB(B0, 1, 0); PG8_SCHED; PG8_LDA(At, 1, 0); PG8_STAGE(PG8_SA(0, 1), a2 + hA1, voffA);
            PG8_WAIT_L(8); PG8_BAR; PG8_WAIT_L(0); PG8_MMA(0, 0, At, B0); PG8_BAR; PG8_SCHED;
            PG8_LDB(B1, 1, 1); PG8_STAGE(PG8_SB(1, 0), b3, voffB);
            PG8_BAR; PG8_WAIT_L(0); PG8_MMA(0, 1, At, B1); PG8_BAR;
            if constexpr (!HALFM) PG8_LDA(At, 1, 1); PG8_STAGE(PG8_SA(1, 0), a3, voffA);
            PG8_BAR; PG8_WAIT_L(0); if constexpr (!HALFM) PG8_MMA(1, 0, At, B0); PG8_BAR; PG8_SCHED;
            PG8_STAGE(PG8_SB(1, 1), b3 + hstepB, voffB);
            PG8_WAIT_V(6); PG8_BAR; if constexpr (!HALFM) PG8_MMA(1, 1, At, B1); PG8_BAR;
        }
        gemm_epilogue<MODE, HALFM>(acc, cur, rb, wr, wc, fr, fq, E, lds);
        if (!has_next) break;
#pragma unroll
        for (int a = 0; a < 2; ++a)
#pragma unroll
            for (int b = 0; b < 2; ++b)
#pragma unroll
                for (int m = 0; m < 4; ++m)
#pragma unroll
                    for (int n = 0; n < 2; ++n) acc[a][b][m][n] = (f32x4){0.f, 0.f, 0.f, 0.f};
        cur = nxt; cA = nA; cB = nB; ++ui; rb = cur.pm * BM;
    }
    PG8_WAIT_V(0);
    if (wr == 0) PG8_BAR;
    PG8_BAR;
#undef PG8_SA
#undef PG8_SB
#undef PG8_STAGE
#undef PG8_LDA
#undef PG8_LDB
#undef PG8_MMA
#undef PG8_WAIT_V
#undef PG8_WAIT_L
#undef PG8_BAR
#undef PG8_SCHED
}

__device__ __forceinline__ void transpose_job(LAS unsigned char* lds, const float* src, int ld, int K, int c0, int ncols, bf16_t* dst, int rowmode, int drow0,
                                              const float* gk, const float* bk, float* c1, float* c2) {
    LAS float* tile = (LAS float*)lds;
    int tid_ = threadIdx.x; asm volatile("" : "+v"(tid_)); const int tid = tid_;
    const int nkt = K / 64, nct = ncols / 64, ntiles = nkt * nct;
    for (int t = lbid(); t < ntiles; t += gridDim.x) {
        const int kt = t % nkt, ct = t / nkt;
        const int k0 = kt * 64, n0 = ct * 64;
        { const int kr = tid >> 4, c4 = (tid & 15) * 4;
#pragma unroll
          for (int rr = 0; rr < 64; rr += 32) { const f32x4 v = *(const f32x4*)(src + (size_t)(k0 + kr + rr) * ld + c0 + n0 + c4);
              tile[(kr + rr) * 65 + c4 + 0] = v[0]; tile[(kr + rr) * 65 + c4 + 1] = v[1]; tile[(kr + rr) * 65 + c4 + 2] = v[2]; tile[(kr + rr) * 65 + c4 + 3] = v[3]; } }
        __syncthreads();
        { const int n = tid >> 3, k8 = (tid & 7) * 8; float v[8];
#pragma unroll
          for (int i = 0; i < 8; ++i) v[i] = tile[(k8 + i) * 65 + n];
          const int c = c0 + n0 + n; int drow;
          if (rowmode == 0) drow = drow0 + c; else drow = 256 * (c >> 7) + (c & 127) + (rowmode == 2 ? 128 : 0);
          u32x4 w;
          if (gk) {
              const f32x4 g0 = *(const f32x4*)(gk + k0 + k8), g1 = *(const f32x4*)(gk + k0 + k8 + 4), b0 = *(const f32x4*)(bk + k0 + k8), b1 = *(const f32x4*)(bk + k0 + k8 + 4);
              float s2 = 0.f;
#pragma unroll
              for (int i = 0; i < 4; ++i) { s2 += b0[i] * v[i] + b1[i] * v[4 + i]; v[i] *= g0[i]; v[4 + i] *= g1[i]; }
              w.x = pk2(v[0], v[1]); w.y = pk2(v[2], v[3]); w.z = pk2(v[4], v[5]); w.w = pk2(v[6], v[7]);
              float s1 = 0.f;
#pragma unroll
              for (int i = 0; i < 4; ++i) s1 += bflo(w[i]) + bfhi(w[i]);
              s1 += __shfl_xor(s1, 1); s1 += __shfl_xor(s1, 2); s1 += __shfl_xor(s1, 4);
              s2 += __shfl_xor(s2, 1); s2 += __shfl_xor(s2, 2); s2 += __shfl_xor(s2, 4);
              if ((tid & 7) == 0) { atomicAdd(c1 + drow, s1); atomicAdd(c2 + drow, s2); }
          } else { w.x = pk2(v[0], v[1]); w.y = pk2(v[2], v[3]); w.z = pk2(v[4], v[5]); w.w = pk2(v[6], v[7]); }
          *(u32x4*)(dst + (size_t)drow * K + k0 + k8) = w; }
        __syncthreads();
    }
}
__device__ __forceinline__ void convert_job(const float* src, bf16_t* dst, float* dstf, size_t n) {
    const size_t nv = n / 8;
    for (size_t i = (size_t)lbid() * NTHR + ltid(); i < nv; i += (size_t)gridDim.x * NTHR) {
        const f32x4 a = *(const f32x4*)(src + i * 8), b = *(const f32x4*)(src + i * 8 + 4);
        u32x4 w; w.x = pk2(a[0], a[1]); w.y = pk2(a[2], a[3]); w.z = pk2(b[0], b[1]); w.w = pk2(b[2], b[3]);
        *(u32x4*)(dst + i * 8) = w;
        if (dstf) { *(f32x4*)(dstf + i * 8) = a; *(f32x4*)(dstf + i * 8 + 4) = b; }
    }
}
__device__ __forceinline__ void prep_phase(LAS unsigned char* lds, const Params& p) {
    unsigned char* ws = p.ws;
    for (int jb = 0; jb < 52; ++jb) {
        const float* src; int ld, K, c0, ncols, rowmode, drow0; bf16_t* dst; int li = -1; float* cv = nullptr; int cvn = 0;
        if (jb < 24) { const int lf = jb / 3, t = jb % 3;
            if (t < 2) { src = (t == 0 ? p.in[7] : p.in[8]) + (size_t)lf * 1024 * FF; ld = FF; K = 1024; c0 = 0; ncols = FF; dst = (bf16_t*)(ws + WS_WGU) + (size_t)lf * 5632 * 1024; rowmode = 1 + t; drow0 = 0;
                if (lf > 0) { li = (lf & 1) ? 3 * (lf >> 1) + 1 : 3 * (lf >> 1) - 1; cv = (float*)(ws + WS_CV_WGU) + (size_t)lf * 2 * 5632; cvn = 5632; } }
            else { src = p.in[9] + (size_t)lf * FF * 1024; ld = 1024; K = FF; c0 = 0; ncols = 1024; dst = (bf16_t*)(ws + WS_WD) + (size_t)lf * 1024 * FF; rowmode = 0; drow0 = 0; }
        } else if (jb < 44) { const int j = (jb - 24) / 10, t = (jb - 24) % 10; rowmode = 0; K = 1024;
            if (t < 4) {
                src = p.in[12] + (size_t)j * 1024 * 4608; ld = 4608; dst = (bf16_t*)(ws + WS_HWIN) + (size_t)j * 4608 * 1024;
                c0 = t == 0 ? 0 : (t == 1 ? 3072 : (t == 2 ? 2048 : 4096)); ncols = t == 0 ? 2048 : (t == 3 ? 512 : 1024); drow0 = (t == 0 ? 0 : (t == 1 ? 2048 : (t == 2 ? 3072 : 4096))) - c0;
                li = 3 * (2 * j); cv = (float*)(ws + WS_CV_HWIN) + (size_t)j * 2 * 4608; cvn = 4608;
            } else if (t < 8) {
                src = p.in[16] + (size_t)j * 1024 * 3600; ld = 3600; dst = (bf16_t*)(ws + WS_GWIN) + (size_t)j * 4096 * 1024; const int u = t - 4;
                c0 = u == 0 ? 0 : (u == 1 ? 2048 : (u == 2 ? 1024 : 3088)); ncols = u == 3 ? 512 : 1024; drow0 = (u == 0 ? 0 : (u == 1 ? 1536 : (u == 2 ? 2560 : 3584))) - c0;
                li = 3 * (2 * j + 1); cv = (float*)(ws + WS_CV_GWIN) + (size_t)j * 2 * 4096; cvn = 4096;
            } else { src = (t == 8 ? p.in[15] : p.in[20]) + (size_t)j * 1536 * 1024; ld = 1024; K = 1536; c0 = 0; ncols = 1024; dst = (bf16_t*)(ws + WS_WOUT) + (size_t)(2 * j + (t - 8)) * 1024 * 1536; drow0 = 0; }
        } else { const int l = (jb - 44) >> 1, kv = (jb - 44) & 1; src = (kv ? p.in[22] : p.in[21]) + (size_t)l * 1024 * 512; ld = 512; K = 1024; c0 = 0; ncols = 512; dst = (bf16_t*)(ws + WS_MEMW); rowmode = 0; drow0 = l * 1024 + kv * 512; }
        const float* gk = li >= 0 ? p.in[10] + li * 1024 : nullptr; const float* bk = li >= 0 ? p.in[11] + li * 1024 : nullptr;
        transpose_job(lds, src, ld, K, c0, ncols, dst, rowmode, drow0, gk, bk, cv, cv + cvn);
    }
    for (int j = 0; j < 2; ++j) {
        const float* gs = p.in[16] + (size_t)j * 1024 * 3600; bf16_t* gd = (bf16_t*)(ws + WS_GWIN) + (size_t)j * 4096 * 1024;
        const float* w2 = p.in[17] + (size_t)j * 16 * 512;
        const int li = 3 * (2 * j + 1); const float* gk = p.in[10] + li * 1024; const float* bk = p.in[11] + li * 1024;
        float* c1 = (float*)(ws + WS_CV_GWIN) + (size_t)j * 2 * 4096; float* c2 = c1 + 4096;
        for (int i = lbid() * NTHR + ltid(); i < 512 * 1024; i += gridDim.x * NTHR) {
            const int c = i >> 10, kk = i & 1023; float sacc = 0.f;
#pragma unroll
            for (int r = 0; r < 16; ++r) sacc += gs[(size_t)kk * 3600 + 3072 + r] * w2[r * 512 + c];
            const bf16_t hv = f2bf(sacc * gk[kk]);
            gd[(size_t)(1024 + c) * 1024 + kk] = hv;
            float s1 = __uint_as_float(((unsigned)hv) << 16), s2 = sacc * bk[kk];
#pragma unroll
            for (int o = 32; o >= 1; o >>= 1) { s1 += __shfl_xor(s1, o); s2 += __shfl_xor(s2, o); }
            if ((kk & 63) == 0) { atomicAdd(c1 + 1024 + c, s1); atomicAdd(c2 + 1024 + c, s2); }
        }
    }
    for (int jb = 0; jb < 5; ++jb) {
        const float* src; bf16_t* dst; float* dstf = nullptr; size_t n;
        if (jb == 0) { src = p.in[0]; dst = (bf16_t*)(ws + WS_XN); dstf = p.out + O_Y; n = (size_t)MP * D; }
        else if (jb == 1) { src = p.in[1]; dst = (bf16_t*)(ws + WS_XN) + (size_t)MP * D; dstf = p.out + O_Y + (size_t)MP * D; n = (size_t)MS * D; }
        else if (jb == 2) { src = p.in[2]; dst = (bf16_t*)(ws + WS_MEMP); n = (size_t)2048 * 1024; }
        else if (jb == 3) { src = p.in[3]; dst = (bf16_t*)(ws + WS_CKB); n = (size_t)4 * 4096 * 512; }
        else { src = p.in[4]; dst = (bf16_t*)(ws + WS_CVB); n = (size_t)4 * 4096 * 512; }
        convert_job(src, dst, dstf, n);
    }
}

__device__ __forceinline__ void ln_phase(float* x, bf16_t* xn, const float* gain, const float* bias) {
    int tid_ = threadIdx.x; asm volatile("" : "+v"(tid_));
    const int lane = tid_ & 63, wv = tid_ >> 6;
    f32x4 g[4], b[4];
#pragma unroll
    for (int i = 0; i < 4; ++i) { g[i] = *(const f32x4*)(gain + 4 * lane + 256 * i); b[i] = *(const f32x4*)(bias + 4 * lane + 256 * i); }
    for (int row = lbid() * 8 + wv; row < MROWS; row += gridDim.x * 8) {
        float* xr = x + (size_t)row * D; f32x4 v[4]; float s = 0.f;
#pragma unroll
        for (int i = 0; i < 4; ++i) { v[i] = *(const f32x4*)(xr + 4 * lane + 256 * i); s += (v[i][0] + v[i][1]) + (v[i][2] + v[i][3]); }
#pragma unroll
        for (int o = 32; o >= 1; o >>= 1) s += __shfl_xor(s, o);
        const float mu = s * (1.0f / 1024.0f); float q = 0.f;
#pragma unroll
        for (int i = 0; i < 4; ++i) { const f32x4 d = v[i] - mu; q += (d[0] * d[0] + d[1] * d[1]) + (d[2] * d[2] + d[3] * d[3]); }
#pragma unroll
        for (int o = 32; o >= 1; o >>= 1) q += __shfl_xor(q, o);
        const float rs = 1.0f / sqrtf(q * (1.0f / 1024.0f) + 1e-5f);
#pragma unroll
        for (int i = 0; i < 4; ++i) { const f32x4 o = (v[i] - mu) * rs * g[i] + b[i]; *(f32x4*)(xr + 4 * lane + 256 * i) = o;
            if (xn) { u32x2 w; w.x = pk2(o[0], o[1]); w.y = pk2(o[2], o[3]); *(u32x2*)(xn + (size_t)row * D + 4 * lane + 256 * i) = w; } }
    }
}

__device__ __forceinline__ void headnorm_phase(bf16_t* proj, int ld, int ocol, int gcol, int lanes_per_head  , const float* gain) {
    int tid_ = threadIdx.x; asm volatile("" : "+v"(tid_));
    const int lane = tid_ & 63, wv = tid_ >> 6;
    float gn[2][8];
#pragma unroll
    for (int hh = 0; hh < 2; ++hh)
#pragma unroll
        for (int i = 0; i < 8; ++i) gn[hh][i] = gain[hh * 512 + 8 * lane + i];
    const float invn = lanes_per_head == 16 ? (1.0f / 128.0f) : (1.0f / 256.0f);
    for (int row = lbid() * 8 + wv; row < MROWS; row += gridDim.x * 8) {
        bf16_t* pr = proj + (size_t)row * ld;
#pragma unroll
        for (int hh = 0; hh < 2; ++hh) {
            const u32x4 ov = *(const u32x4*)(pr + ocol + hh * 512 + 8 * lane), gv = *(const u32x4*)(pr + gcol + hh * 512 + 8 * lane);
            float o[8], g[8];
#pragma unroll
            for (int i = 0; i < 4; ++i) { o[2 * i] = bflo(ov[i]); o[2 * i + 1] = bfhi(ov[i]); g[2 * i] = bflo(gv[i]); g[2 * i + 1] = bfhi(gv[i]); }
            float s = 0.f;
#pragma unroll
            for (int i = 0; i < 8; ++i) s += o[i] * o[i];
            s += __shfl_xor(s, 1); s += __shfl_xor(s, 2); s += __shfl_xor(s, 4); s += __shfl_xor(s, 8);
            if (lanes_per_head == 32) s += __shfl_xor(s, 16);
            const float rs = __builtin_amdgcn_rsqf(s * invn + 1e-6f);
            float r[8];
#pragma unroll
            for (int i = 0; i < 8; ++i) r[i] = o[i] * rs * gn[hh][i] * g[i] * sigmoidf_(g[i]);
            u32x4 w; w.x = pk2(r[0], r[1]); w.y = pk2(r[2], r[3]); w.z = pk2(r[4], r[5]); w.w = pk2(r[6], r[7]);
            *(u32x4*)(pr + ocol + hh * 512 + 8 * lane) = w;
        }
    }
}

constexpr int MP_G = 0, MP_T = 32768, MP_KTT = 34816, MP_QT = MP_KTT + 128 * 72 * 2, MP_KT = MP_QT + 64 * 136 * 2, MP_END = MP_KT + 64 * 136 * 2;
static_assert(MP_END <= 131072, "prepass LDS");

__device__ __forceinline__ void mixprep_loop(LAS unsigned char* lds, bf16_t* proj, int ld, int qcol, int kcol, int gcol, int gla, const float* lb0, const float* lb1, int lbj, const float* bgate,
                                             bf16_t* ktb_h, int nh, float* vec_h, int ci0, int cstep) {
    int tid_ = threadIdx.x; asm volatile("" : "+v"(tid_));
    const int tid = tid_, wid = __builtin_amdgcn_readfirstlane(tid >> 6), lane = tid & 63, fr = lane & 15, fq = lane >> 4;
    LAS float* G = (LAS float*)(lds + MP_G); LAS float* T = (LAS float*)(lds + MP_T); LAS bf16_t* KTT = (LAS bf16_t*)(lds + MP_KTT);
    LAS bf16_t* QT = (LAS bf16_t*)(lds + MP_QT); LAS bf16_t* KT = (LAS bf16_t*)(lds + MP_KT);
    const int t0 = tid >> 4, cv = tid & 15, c8 = cv * 8;
    float cA[8], cB[8];
#pragma unroll
    for (int i = 0; i < 8; ++i) {
        if (gla) { cA[i] = bgate[c8 + i]; cB[i] = 0.f; }
        else { float lb = 0.f; if (lbj == 1) lb = sigmoidf_(lb1[c8 + i] - lb0[c8 + i]); cA[i] = lb; cB[i] = 1.0f - lb; }
    }
    const float qscale = 0.08838834764831845f;
    u32x4 rq[2], rk[2], rg[2];
    rg[0] = rg[1] = (u32x4){0u, 0u, 0u, 0u};
    auto issue_loads = [&](int ci) {
        const bf16_t* base = proj + (size_t)ci * 64 * ld;
#pragma unroll
        for (int rr = 0; rr < 2; ++rr) { const bf16_t* rp = base + (size_t)(t0 + 32 * rr) * ld + c8; rq[rr] = *(const u32x4*)(rp + qcol); rk[rr] = *(const u32x4*)(rp + kcol); if (gla) rg[rr] = *(const u32x4*)(rp + gcol); }
    };
    if (ci0 < NCHUNK) issue_loads(ci0);
    for (int ci = ci0; ci < NCHUNK; ci += cstep) {
        bf16_t* base = proj + (size_t)ci * 64 * ld;
        float qv[2][8], kv[2][8];
#pragma unroll
        for (int rr = 0; rr < 2; ++rr) {
            float gvv[8];
#pragma unroll
            for (int i = 0; i < 8; ++i) {
                const unsigned uq = rq[rr][i >> 1], uk = rk[rr][i >> 1], ug = rg[rr][i >> 1];
                const float q = (i & 1) ? bfhi(uq) : bflo(uq), k = (i & 1) ? bfhi(uk) : bflo(uk);
                if (gla) {
                    const float g = ((i & 1) ? bfhi(ug) : bflo(ug)) + cA[i];
                    qv[rr][i] = q * qscale; kv[rr][i] = k;
                    gvv[i] = (fminf(g, 0.f) - __logf(1.0f + __expf(-fabsf(g)))) * (1.0f / 16.0f);
                } else {
                    qv[rr][i] = q * sigmoidf_(q) * qscale;
                    const float e = __expf(-k), r = __builtin_amdgcn_rcpf(1.0f + e);
                    kv[rr][i] = cB[i] * e * r;
                    gvv[i] = __logf(fmaxf(cA[i] + cB[i] * r, 1e-6f));
                }
            }
            LAS float* gp = G + (t0 + 32 * rr) * 128 + c8;
            *(LAS f32x4*)gp = (f32x4){gvv[0], gvv[1], gvv[2], gvv[3]}; *(LAS f32x4*)(gp + 4) = (f32x4){gvv[4], gvv[5], gvv[6], gvv[7]};
        }
        if (ci + cstep < NCHUNK) issue_loads(ci + cstep);
        __syncthreads();
        { const int k = tid & 127, sg = tid >> 7; float run = 0.f;
#pragma unroll
          for (int i = 0; i < 16; ++i) { run += G[(16 * sg + i) * 128 + k]; G[(16 * sg + i) * 128 + k] = run; }
          T[sg * 128 + k] = run; }
        __syncthreads();
        {
            float tA[8], tB[8], tC[8], bmid[8], blast[8];
            { const f32x4 x0 = *(const LAS f32x4*)(T + c8), x1 = *(const LAS f32x4*)(T + c8 + 4), y0 = *(const LAS f32x4*)(T + 128 + c8), y1 = *(const LAS f32x4*)(T + 128 + c8 + 4),
                  z0 = *(const LAS f32x4*)(T + 256 + c8), z1 = *(const LAS f32x4*)(T + 256 + c8 + 4);
              const f32x4 m0 = *(const LAS f32x4*)(G + 31 * 128 + c8), m1 = *(const LAS f32x4*)(G + 31 * 128 + c8 + 4), l0 = *(const LAS f32x4*)(G + 63 * 128 + c8), l1 = *(const LAS f32x4*)(G + 63 * 128 + c8 + 4);
#pragma unroll
              for (int i = 0; i < 4; ++i) { tA[i] = x0[i]; tA[4 + i] = x1[i]; tB[i] = x0[i] + y0[i]; tB[4 + i] = x1[i] + y1[i]; tC[i] = tB[i] + z0[i]; tC[4 + i] = tB[4 + i] + z1[i];
                  bmid[i] = m0[i] + tA[i]; bmid[4 + i] = m1[i] + tA[4 + i]; blast[i] = l0[i] + tC[i]; blast[4 + i] = l1[i] + tC[4 + i]; } }
#pragma unroll
            for (int rr = 0; rr < 2; ++rr) {
                const int t = t0 + 32 * rr, sg = t >> 4;
                const f32x4 g0 = *(const LAS f32x4*)(G + t * 128 + c8), g1 = *(const LAS f32x4*)(G + t * 128 + c8 + 4);
                float qt[8], kt[8];
#pragma unroll
                for (int i = 0; i < 8; ++i) {
                    const float off = sg == 0 ? 0.f : (sg == 1 ? tA[i] : (sg == 2 ? tB[i] : tC[i]));
                    const float b = (i < 4 ? g0[i & 3] : g1[i & 3]) + off;
                    qt[i] = qv[rr][i] * __expf(fminf(b - bmid[i], 80.f));
                    kt[i] = kv[rr][i] * __expf(fminf(bmid[i] - b, 80.f));
                }
                bf16_t* rp = base + (size_t)t * ld + c8;
                u32x4 w;
                w.x = pk2(qt[0], qt[1]); w.y = pk2(qt[2], qt[3]); w.z = pk2(qt[4], qt[5]); w.w = pk2(qt[6], qt[7]); *(u32x4*)(rp + qcol) = w; *(LAS u32x4*)(QT + t * 136 + c8) = w;
                w.x = pk2(kt[0], kt[1]); w.y = pk2(kt[2], kt[3]); w.z = pk2(kt[4], kt[5]); w.w = pk2(kt[6], kt[7]); *(LAS u32x4*)(KT + t * 136 + c8) = w;
#pragma unroll
                for (int i = 0; i < 4; ++i) { KTT[(c8 + 2 * i) * 72 + t] = (bf16_t)(w[i] & 0xffffu); KTT[(c8 + 2 * i + 1) * 72 + t] = (bf16_t)(w[i] >> 16); }
            }
            if (t0 == 0) {
                float* em = vec_h + (size_t)ci * 1024; float* el = em + (size_t)NCHUNK * 1024; float* elm = el + (size_t)NCHUNK * 1024;
                f32x4 v0, v1;
#pragma unroll
                for (int i = 0; i < 4; ++i) { v0[i] = __expf(bmid[i]); v1[i] = __expf(bmid[4 + i]); }
                *(f32x4*)(em + c8) = v0; *(f32x4*)(em + c8 + 4) = v1;
#pragma unroll
                for (int i = 0; i < 4; ++i) { v0[i] = __expf(blast[i]); v1[i] = __expf(blast[4 + i]); }
                *(f32x4*)(el + c8) = v0; *(f32x4*)(el + c8 + 4) = v1;
#pragma unroll
                for (int i = 0; i < 4; ++i) { v0[i] = __expf(blast[i] - bmid[i]); v1[i] = __expf(blast[4 + i] - bmid[4 + i]); }
                *(f32x4*)(elm + c8) = v0; *(f32x4*)(elm + c8 + 4) = v1;
            }
        }
        __syncthreads();
        { const int k = tid >> 2, j = tid & 3; bf16_t* ktb = ktb_h + (size_t)ci * nh * 8192;
          const u32x4 w0 = *(const LAS u32x4*)(KTT + k * 72 + 16 * j), w1 = *(const LAS u32x4*)(KTT + k * 72 + 16 * j + 8);
          *(u32x4*)(ktb + k * 64 + 16 * j) = w0; *(u32x4*)(ktb + k * 64 + 16 * j + 8) = w1; }
        { const int ti = wid >> 1;
#pragma unroll
          for (int sh = 0; sh < 2; ++sh) { const int si = 2 * (wid & 1) + sh; f32x4 pa = {0.f, 0.f, 0.f, 0.f};
              if (si <= ti) {
#pragma unroll
                  for (int kk = 0; kk < 4; ++kk) { const bf16x8 A = *(const LAS bf16x8*)(KT + (16 * si + fr) * 136 + 32 * kk + 8 * fq), B = *(const LAS bf16x8*)(QT + (16 * ti + fr) * 136 + 32 * kk + 8 * fq); pa = MFMA16(A, B, pa); }
                  if (si == ti) {
#pragma unroll
                      for (int j = 0; j < 4; ++j) if (4 * fq + j > fr) pa[j] = 0.f; }
              }
              u32x2 w; w.x = pk2(pa[0], pa[1]); w.y = pk2(pa[2], pa[3]); *(u32x2*)(base + (size_t)(16 * ti + fr) * ld + kcol + 16 * si + 4 * fq) = w; } }
    }
    __syncthreads();
}

constexpr int MXB = 49664, MXB_QT = 0, MXB_KTT = 17408, MXB_VT = 35840, MXB_PP = 40448, MX_ST = 2 * MXB, MX_END = MX_ST + 2 * 8704;
static_assert(MX_END <= LDS_ST_OFF, "mixer LDS");

struct ChainArgs {
    bf16_t* proj; int ld; size_t row0; int nchunks;
    int qcol, kcol, vcol;
    const bf16_t* ktb;
    size_t ktb_stride;
    const float* em; const float* el; const float* elm; int vec_stride;
    const float* s0; float* sout; int sstride;
};

__device__ __forceinline__ void mixer_chain(LAS unsigned char* lds, const ChainArgs& a) {
    int tid_ = threadIdx.x; asm volatile("" : "+v"(tid_));
    const int tid = tid_, wid = __builtin_amdgcn_readfirstlane(tid >> 6), lane = tid & 63, fr = lane & 15, fq = lane >> 4;
    const int t0 = tid >> 4, c8 = (tid & 15) * 8;
    f32x4 Sacc[2];
#pragma unroll
    for (int vi = 0; vi < 2; ++vi)
#pragma unroll
        for (int j = 0; j < 4; ++j) Sacc[vi][j] = a.s0 ? a.s0[(size_t)(16 * wid + 4 * fq + j) * a.sstride + 16 * vi + fr] : 0.f;
    struct Regs { u32x4 rq[2], rkt[2], rp, rv; f32x4 vem, vel, velm; };
    Regs R0, R1;
    R0.rv = (u32x4){0u, 0u, 0u, 0u}; R1.rv = (u32x4){0u, 0u, 0u, 0u};
    auto issue_loads = [&](Regs& R, int c) {
        const bf16_t* base = a.proj + (a.row0 + (size_t)c * 64) * a.ld;
#pragma unroll
        for (int rr = 0; rr < 2; ++rr) R.rq[rr] = *(const u32x4*)(base + (size_t)(t0 + 32 * rr) * a.ld + c8 + a.qcol);
        R.rp = *(const u32x4*)(base + (size_t)(tid >> 3) * a.ld + a.kcol + 8 * (tid & 7));
        const bf16_t* kp = a.ktb + (size_t)c * a.ktb_stride + (tid >> 2) * 64 + 16 * (tid & 3);
        R.rkt[0] = *(const u32x4*)kp; R.rkt[1] = *(const u32x4*)(kp + 8);
        if (tid < 256) R.rv = *(const u32x4*)(base + (size_t)(tid >> 2) * a.ld + a.vcol + 8 * (tid & 3));
        const size_t vo = (size_t)c * a.vec_stride + 16 * wid + 4 * fq;
        R.vem = *(const f32x4*)(a.em + vo); R.vel = *(const f32x4*)(a.el + vo); R.velm = *(const f32x4*)(a.elm + vo);
    };
    f32x4 cel, celm;
    auto fill = [&](int b, const Regs& R) {
        LAS bf16_t* QT = (LAS bf16_t*)(lds + b * MXB + MXB_QT); LAS bf16_t* KTT = (LAS bf16_t*)(lds + b * MXB + MXB_KTT);
        LAS bf16_t* VT = (LAS bf16_t*)(lds + b * MXB + MXB_VT); LAS bf16_t* PP = (LAS bf16_t*)(lds + b * MXB + MXB_PP); LAS bf16_t* ST = (LAS bf16_t*)(lds + MX_ST + b * 8704);
#pragma unroll
        for (int rr = 0; rr < 2; ++rr) *(LAS u32x4*)(QT + (t0 + 32 * rr) * 136 + c8) = R.rq[rr];
        *(LAS u32x4*)(PP + (tid >> 3) * 72 + 8 * (tid & 7)) = R.rp;
        { LAS bf16_t* kp = KTT + (tid >> 2) * 72 + 16 * (tid & 3); *(LAS u32x4*)kp = R.rkt[0]; *(LAS u32x4*)(kp + 8) = R.rkt[1]; }
        if (tid < 256) { const int tv = tid >> 2, v8 = (tid & 3) * 8;
#pragma unroll
            for (int i = 0; i < 8; ++i) VT[(v8 + i) * 72 + tv] = (bf16_t)((i & 1) ? (R.rv[i >> 1] >> 16) : (R.rv[i >> 1] & 0xffffu)); }
#pragma unroll
        for (int vi = 0; vi < 2; ++vi) { u32x2 w; w.x = pk2(Sacc[vi][0] * R.vem[0], Sacc[vi][1] * R.vem[1]); w.y = pk2(Sacc[vi][2] * R.vem[2], Sacc[vi][3] * R.vem[3]); *(LAS u32x2*)(ST + (16 * vi + fr) * 136 + 16 * wid + 4 * fq) = w; }
        cel = R.vel; celm = R.velm;
    };
    auto compute = [&](int b, int c) {
        const LAS bf16_t* QT = (const LAS bf16_t*)(lds + b * MXB + MXB_QT); const LAS bf16_t* KTT = (const LAS bf16_t*)(lds + b * MXB + MXB_KTT);
        const LAS bf16_t* VT = (const LAS bf16_t*)(lds + b * MXB + MXB_VT); const LAS bf16_t* PP = (const LAS bf16_t*)(lds + b * MXB + MXB_PP); const LAS bf16_t* ST = (const LAS bf16_t*)(lds + MX_ST + b * 8704);
        { const int ti = wid >> 1, vi = wid & 1; f32x4 o = {0.f, 0.f, 0.f, 0.f};
#pragma unroll
          for (int kk = 0; kk < 2; ++kk) { const bf16x8 A = *(const LAS bf16x8*)(VT + (16 * vi + fr) * 72 + 32 * kk + 8 * fq), B = *(const LAS bf16x8*)(PP + (16 * ti + fr) * 72 + 32 * kk + 8 * fq); o = MFMA16(A, B, o); }
#pragma unroll
          for (int kk = 0; kk < 4; ++kk) { const bf16x8 A = *(const LAS bf16x8*)(ST + (16 * vi + fr) * 136 + 32 * kk + 8 * fq), B = *(const LAS bf16x8*)(QT + (16 * ti + fr) * 136 + 32 * kk + 8 * fq); o = MFMA16(A, B, o); }
          u32x2 w; w.x = pk2(o[0], o[1]); w.y = pk2(o[2], o[3]);
          *(u32x2*)(a.proj + (a.row0 + (size_t)c * 64 + 16 * ti + fr) * a.ld + a.vcol + 16 * vi + 4 * fq) = w; }
#pragma unroll
        for (int vi = 0; vi < 2; ++vi) { f32x4 u = {0.f, 0.f, 0.f, 0.f};
#pragma unroll
            for (int kk = 0; kk < 2; ++kk) { const bf16x8 A = *(const LAS bf16x8*)(KTT + (16 * wid + fr) * 72 + 32 * kk + 8 * fq), B = *(const LAS bf16x8*)(VT + (16 * vi + fr) * 72 + 32 * kk + 8 * fq); u = MFMA16(A, B, u); }
            Sacc[vi] = Sacc[vi] * cel + u * celm; }
    };
    const int n = a.nchunks;
    issue_loads(R0, 0);
    if (n > 1) issue_loads(R1, 1);
    fill(0, R0);
    if (n > 2) issue_loads(R0, 2);
    for (int c = 0; c < n; c += 2) {
        __syncthreads();
        compute(0, c);
        if (c + 1 < n) { fill(1, R1); if (c + 3 < n) issue_loads(R1, c + 3); }
        if (c + 1 < n) {
            __syncthreads();
            compute(1, c + 1);
            if (c + 2 < n) { fill(0, R0); if (c + 4 < n) issue_loads(R0, c + 4); }
        }
    }
#pragma unroll
    for (int vi = 0; vi < 2; ++vi)
#pragma unroll
        for (int j = 0; j < 4; ++j) a.sout[(size_t)(16 * wid + 4 * fq + j) * a.sstride + 16 * vi + fr] = Sacc[vi][j];
    __syncthreads();
}

constexpr int AT_PITCH = 264, AT_KOFF = 128 * AT_PITCH * 2, AT_KP = 136;
static_assert(AT_KOFF + 256 * AT_KP * 2 <= LDS_ST_OFF, "attention LDS");
__device__ __forceinline__ void mem_attn(LAS unsigned char* lds, const bf16_t* Kb, const bf16_t* Vb, bf16_t* Q, int ld, int nrows) {
    int tid_ = threadIdx.x; asm volatile("" : "+v"(tid_));
    const int tid = tid_, wid = __builtin_amdgcn_readfirstlane(tid >> 6), lane = tid & 63, fr = lane & 15, fq = lane >> 4;
    LAS bf16_t* VT = (LAS bf16_t*)lds;
    LAS bf16_t* KS = (LAS bf16_t*)(lds + AT_KOFF);
#pragma unroll
    for (int it = 0; it < 8; ++it) { const int idx = tid + NTHR * it, key = idx >> 4, v8 = (idx & 15) * 8; const u32x4 v = *(const u32x4*)(Vb + (size_t)key * 512 + v8), kx = *(const u32x4*)(Kb + (size_t)key * 512 + v8);
        *(LAS u32x4*)(KS + key * AT_KP + v8) = kx;
#pragma unroll
        for (int i = 0; i < 8; ++i) VT[(v8 + i) * AT_PITCH + key] = (bf16_t)((i & 1) ? (v[i >> 1] >> 16) : (v[i >> 1] & 0xffffu)); }
    __syncthreads();
    const float sc = 0.08838834764831845f;
    for (int q0 = wid * 16; q0 < nrows; q0 += 128) {
        bf16x8 Qf0, Qf1, Qf2, Qf3;
        { const bf16_t* qp = Q + (size_t)(q0 + fr) * ld + 8 * fq; Qf0 = *(const bf16x8*)(qp); Qf1 = *(const bf16x8*)(qp + 32); Qf2 = *(const bf16x8*)(qp + 64); Qf3 = *(const bf16x8*)(qp + 96); }
        f32x4 s[16];
#pragma unroll
        for (int a = 0; a < 16; ++a) {
            const LAS bf16_t* kp = KS + (16 * a + fr) * AT_KP + 8 * fq;
            f32x4 t = {0.f, 0.f, 0.f, 0.f};
            t = MFMA16(*(const LAS bf16x8*)(kp), Qf0, t); t = MFMA16(*(const LAS bf16x8*)(kp + 32), Qf1, t); t = MFMA16(*(const LAS bf16x8*)(kp + 64), Qf2, t); t = MFMA16(*(const LAS bf16x8*)(kp + 96), Qf3, t);
            s[a] = t;
            if ((a & 3) == 3) asm volatile("" ::: "memory");
        }
        float mx = -3.0e38f;
#pragma unroll
        for (int a = 0; a < 16; ++a) mx = fmaxf(fmaxf(mx, fmaxf(s[a][0], s[a][1])), fmaxf(s[a][2], s[a][3]));
        mx = fmaxf(mx, __shfl_xor(mx, 16)); mx = fmaxf(mx, __shfl_xor(mx, 32));
        float sum = 0.f; u32x2 pk[16];
#pragma unroll
        for (int a = 0; a < 16; ++a) { const float e0 = __expf((s[a][0] - mx) * sc), e1 = __expf((s[a][1] - mx) * sc), e2 = __expf((s[a][2] - mx) * sc), e3 = __expf((s[a][3] - mx) * sc);
            sum += (e0 + e1) + (e2 + e3); pk[a].x = pk2(e0, e1); pk[a].y = pk2(e2, e3); }
        sum += __shfl_xor(sum, 16); sum += __shfl_xor(sum, 32);
        const float inv = 1.0f / sum;
        f32x4 o[8];
#pragma unroll
        for (int dt = 0; dt < 8; ++dt) o[dt] = (f32x4){0.f, 0.f, 0.f, 0.f};
#pragma unroll
        for (int ap = 0; ap < 8; ++ap) {
            const u32x4 bv = {pk[2 * ap].x, pk[2 * ap].y, pk[2 * ap + 1].x, pk[2 * ap + 1].y};
            const bf16x8 B = __builtin_bit_cast(bf16x8, bv);
#pragma unroll
            for (int dt = 0; dt < 8; ++dt) {
                const u32x2 lo = *(const LAS u32x2*)(VT + (16 * dt + fr) * AT_PITCH + 32 * ap + 4 * fq), hi = *(const LAS u32x2*)(VT + (16 * dt + fr) * AT_PITCH + 32 * ap + 16 + 4 * fq);
                const u32x4 av = {lo.x, lo.y, hi.x, hi.y};
                o[dt] = MFMA16(__builtin_bit_cast(bf16x8, av), B, o[dt]);
            }
        }
#pragma unroll
        for (int dt = 0; dt < 8; ++dt) { u32x2 w; w.x = pk2(o[dt][0] * inv, o[dt][1] * inv); w.y = pk2(o[dt][2] * inv, o[dt][3] * inv);
            *(u32x2*)(Q + (size_t)(q0 + fr) * ld + 16 * dt + 4 * fq) = w; }
    }
    __syncthreads();
}

__device__ __forceinline__ void mixprep_phase(LAS unsigned char* lds, const Params& p, int layer) {
    const int j = layer >> 1, gla = layer & 1, w = lbid(), G = gridDim.x;
    bf16_t* proj = (bf16_t*)(p.ws + WS_PROJ);
    const int ld = gla ? GL_LD : HG_LD, nh = gla ? 4 : 8;
    bf16_t* ktb = (bf16_t*)(p.ws + WS_XN);
    float* vec = (float*)(p.ws + WS_VEC);
    const int xq = gla ? 3584 : 4096;
    for (int it = w; it < 256 + 64; it += G) {
        const bf16_t* Kb; const bf16_t* Vb; bf16_t* Qp; int nrows;
        if (it < 256) { const int bh = it >> 3, grp = it & 7, b = bh >> 2, h = bh & 3;
            Kb = (const bf16_t*)(p.ws + WS_MKB) + ((size_t)layer * 2048 + b * 256) * 512 + h * 128;
            Vb = (const bf16_t*)(p.ws + WS_MVB) + ((size_t)layer * 2048 + b * 256) * 512 + h * 128;
            Qp = proj + ((size_t)b * 8192 + grp * 1024) * ld + xq + h * 128; nrows = 1024;
        } else { const int bh = it - 256, b = bh >> 2, h = bh & 3;
            Kb = (const bf16_t*)(p.ws + WS_CKB) + ((size_t)layer * 4096 + b * 256) * 512 + h * 128;
            Vb = (const bf16_t*)(p.ws + WS_CVB) + ((size_t)layer * 4096 + b * 256) * 512 + h * 128;
            Qp = proj + ((size_t)MP + b * 64) * ld + xq + h * 128; nrows = 64;
        }
        mem_attn(lds, Kb, Vb, Qp, ld, nrows);
    }
    { const int h = w % nh;
      mixprep_loop(lds, proj, ld, h * 128, (gla ? 512 : 1024) + h * 128, gla ? 1024 + h * 128 : 0, gla,
                   gla ? nullptr : p.in[13] + h * 128, gla ? nullptr : p.in[13] + 1024 + h * 128, j, gla ? p.in[18] + j * 512 + h * 128 : nullptr,
                   ktb + (size_t)h * 8192, nh, vec + h * 128, w / nh, G / nh); }
}
__device__ __forceinline__ void chain_phase(LAS unsigned char* lds, const Params& p, int layer) {
    const int j = layer >> 1, gla = layer & 1, w = lbid(), G = gridDim.x;
    bf16_t* proj = (bf16_t*)(p.ws + WS_PROJ);
    const int ld = gla ? GL_LD : HG_LD;
    const int nvs = gla ? 8 : 4, nh = gla ? 4 : 8, vdim = gla ? 256 : 128;
    const bf16_t* ktb = (const bf16_t*)(p.ws + WS_XN);
    const float* vec = (const float*)(p.ws + WS_VEC);
    const int n_prompt = 8 * nh * nvs  , n_sample = 16 * nh * nvs  ;
    for (int it = w; it < n_prompt + n_sample; it += G) {
        const bool smp = it >= n_prompt; const int id = smp ? it - n_prompt : it;
        const int lo = id & 7, rest = id >> 3, vs = rest % nvs, hi = rest / nvs, bh = lo + 8 * hi, b = bh / nh, h = bh % nh;
        ChainArgs a;
        a.proj = proj; a.ld = ld;
        a.row0 = smp ? (size_t)MP + (size_t)b * 64 : (size_t)b * 8192; a.nchunks = smp ? 1 : 128;
        const int ci0 = smp ? 1024 + b : b * 128;
        if (gla) { a.qcol = h * 128; a.kcol = 512 + h * 128; a.vcol = 2560 + h * 256 + 32 * vs; }
        else { a.qcol = h * 128; a.kcol = 1024 + h * 128; a.vcol = 3072 + h * 128 + 32 * vs; }
        a.ktb = ktb + ((size_t)ci0 * nh + h) * 8192; a.ktb_stride = (size_t)nh * 8192;
        a.em = vec + (size_t)ci0 * 1024 + h * 128; a.el = a.em + (size_t)NCHUNK * 1024; a.elm = a.el + (size_t)NCHUNK * 1024; a.vec_stride = 1024;
        const size_t per_b = (size_t)nh * 128 * vdim, so = ((size_t)b * nh + h) * 128 * vdim + 32 * vs;
        if (smp) { a.s0 = (gla ? p.in[6] : p.in[5]) + (size_t)j * 16 * per_b + so; a.sout = p.out + (gla ? O_SGS : O_SHS) + (size_t)j * 16 * per_b + so; }
        else { a.s0 = nullptr; a.sout = p.out + (gla ? O_SGP : O_SHP) + (size_t)j * 8 * per_b + so; }
        a.sstride = vdim;
        mixer_chain(lds, a);
    }
}

#define XB_TMO      128
#define XB_XCNT(j)  (256  + 64 * (j))
#define XB_XSUB(j)  (1280 + 64 * (j))
#define XB_XGEN(j)  (2304 + 64 * (j))
#define XB_TOP      3328
#define XB_TOPGEN   3392
#define XCD_BAR_WORDS 3456
#define XB_SPIN_CAP (1u << 22)
__device__ __forceinline__ unsigned xb_ld(unsigned* p)              { return __hip_atomic_load(p, __ATOMIC_RELAXED, __HIP_MEMORY_SCOPE_AGENT); }
__device__ __forceinline__ unsigned xb_add(unsigned* p, unsigned v) { return __hip_atomic_fetch_add(p, v, __ATOMIC_RELAXED, __HIP_MEMORY_SCOPE_AGENT); }
__device__ __forceinline__ unsigned xb_xcc_id() { return (unsigned)__builtin_amdgcn_s_getreg((3 << 11) | 20) & 0xFu; }
#define XB_SPIN(cond, bar) do { unsigned _sp = 0; while (cond) { __builtin_amdgcn_s_sleep(1); \
    if ((++_sp & 255u) == 0u) { if (xb_ld(&(bar)[XB_TMO])) break; if (_sp > XB_SPIN_CAP) { atomicAdd(&(bar)[XB_TMO], 1u); break; } } } } while (0)
struct XcdBarrier { unsigned* bar; unsigned x; volatile LAS unsigned* st; };
__device__ __forceinline__ XcdBarrier xcd_barrier_post(unsigned* bar, volatile LAS unsigned* st) {
    XcdBarrier b; b.bar = bar; b.x = xb_xcc_id(); b.st = st;
    if (threadIdx.x == 0) (void)xb_add(&bar[XB_XCNT(b.x)], 1u);
    return b;
}
__device__ __forceinline__ void xcd_barrier_complete(unsigned* bar, unsigned x, unsigned& nloc, unsigned& nx) {
    const unsigned G = gridDim.x * gridDim.y * gridDim.z;
    unsigned sum, cnt, mine, sp = 0u;
    for (;;) {
        sum = 0u; cnt = 0u; mine = 0u;
#pragma unroll
        for (unsigned j = 0; j < 16; ++j) { const unsigned c = xb_ld(&bar[XB_XCNT(j)]); sum += c; cnt += (c > 0u) ? 1u : 0u; mine = (j == x) ? c : mine; }
        if (sum == G) break;
        __builtin_amdgcn_s_sleep(1);
        if ((++sp & 255u) == 0u) { if (xb_ld(&bar[XB_TMO])) break; if (sp > XB_SPIN_CAP) { atomicAdd(&bar[XB_TMO], 1u); break; } }
    }
    nloc = mine > 0u ? mine : 1u; nx = cnt > 0u ? cnt : 1u;
}
__device__ __forceinline__ void xcd_barrier(const XcdBarrier& b) {
    asm volatile("s_waitcnt vmcnt(0)" ::: "memory");
    __syncthreads();
    if (threadIdx.x == 0) {
        unsigned* bar = b.bar;
        __builtin_amdgcn_s_waitcnt(0);
        unsigned nloc = b.st[0], nx = b.st[1];
        if (nloc == 0u) { xcd_barrier_complete(bar, b.x, nloc, nx); b.st[0] = nloc; b.st[1] = nx; }
        const unsigned old = xb_add(&bar[XB_XSUB(b.x)], 1u);
        const unsigned gen = old / nloc;
        if (old + 1u == (gen + 1u) * nloc) {
            __builtin_amdgcn_fence(__ATOMIC_RELEASE, "agent");
            asm volatile("s_waitcnt vmcnt(0)" ::: "memory");
            const unsigned og = xb_add(&bar[XB_TOP], 1u);
            const unsigned tg = og / nx;
            if (og + 1u == (tg + 1u) * nx) xb_add(&bar[XB_TOPGEN], 1u);
            else XB_SPIN(xb_ld(&bar[XB_TOPGEN]) == tg, bar);
            __builtin_amdgcn_fence(__ATOMIC_ACQUIRE, "agent");
            xb_add(&bar[XB_XGEN(b.x)], 1u);
            asm volatile("s_waitcnt vmcnt(0)" ::: "memory");
        } else {
            XB_SPIN(xb_ld(&bar[XB_XGEN(b.x)]) == gen, bar);
            __builtin_amdgcn_fence(__ATOMIC_ACQUIRE, "agent");
            asm volatile("s_waitcnt vmcnt(0)" ::: "memory");
        }
    }
    __syncthreads();
}

constexpr int PPL = 9;
constexpr int NPHASE = 2 + 4 * PPL + 1;
#define WSB(off) ((bf16_t*)(p.ws + (off)))
#define STATS(li) ((float*)(p.ws + WS_STATS) + (size_t)(li) * MROWS * 2)
__global__ void __launch_bounds__(NTHR, 2) trunk_fwd(Params p) {
    extern __shared__ __attribute__((aligned(16))) unsigned char lds_raw[];
    LAS unsigned char* lds = (LAS unsigned char*)lds_raw;
    if (p.ph_hi - p.ph_lo > 1) {
        if (threadIdx.x < 4) ((LAS unsigned*)(lds + LDS_ST_OFF))[threadIdx.x] = 0u;
        __syncthreads();
        (void)xcd_barrier_post((unsigned*)(p.ws + WS_BAR), (volatile LAS unsigned*)(lds + LDS_ST_OFF));
    }
    for (int ph = p.ph_lo; ph < p.ph_hi; ++ph) {
        if (ph == 0) prep_phase(lds, p);
        else if (ph == 1) { }
        else if (false) { Epi E{EPI_MEMKV, nullptr, 0, nullptr, 0.f, p.out + O_MK, p.out + O_MV, WSB(WS_MKB), WSB(WS_MVB), nullptr, nullptr, nullptr, nullptr, nullptr};
            gemm_phase<EPI_MEMKV>(lds, WSB(WS_MEMP), 1024, WSB(WS_MEMW), 2048, 4096, 1024, E); }
        else if (ph == NPHASE - 1) ln_phase(p.out + O_Y, nullptr, p.in[10] + 11 * 1024, p.in[11] + 11 * 1024);
        else {
            const int layer = (ph - 2) / PPL, s = (ph - 2) % PPL, gla = layer & 1, j = layer >> 1;
            if (s == 0 || s == 7) {
                const int lf = layer * 2 + (s == 7), li = (s == 7) ? 3 * layer + 1 : 3 * layer - 1;
                const float* cv = (const float*)(p.ws + WS_CV_WGU) + (size_t)lf * 2 * 5632;
                Epi E{EPI_SWIGLU, WSB(WS_PROJ), FF, nullptr, 0.f, nullptr, nullptr, nullptr, nullptr, li >= 0 ? STATS(li) : nullptr, cv, cv + 5632, nullptr, nullptr};
                gemm_phase<EPI_SWIGLU>(lds, WSB(WS_XN), 1024, WSB(WS_WGU) + (size_t)lf * 5632 * 1024, MROWS, 5632, 1024, E);
                if (ph == 2) { Epi Em{EPI_MEMKV, nullptr, 0, nullptr, 0.f, p.out + O_MK, p.out + O_MV, WSB(WS_MKB), WSB(WS_MVB), nullptr, nullptr, nullptr, nullptr, nullptr};
                    gemm_phase<EPI_MEMKV>(lds, WSB(WS_MEMP), 1024, WSB(WS_MEMW), 2048, 4096, 1024, Em); } }
            else if (s == 1 || s == 8) {
                const int lf = layer * 2 + (s == 8), li_in = (s == 8) ? 3 * layer + 1 : 3 * layer - 1, li_out = (s == 8) ? 3 * layer + 2 : 3 * layer;
                Epi E{EPI_RES, nullptr, 0, p.out + O_Y, 0.5f, nullptr, nullptr, nullptr, nullptr, li_in >= 0 ? STATS(li_in) : nullptr,
                      li_in >= 0 ? p.in[10] + li_in * 1024 : nullptr, li_in >= 0 ? p.in[11] + li_in * 1024 : nullptr, STATS(li_out), WSB(WS_XN)};
                gemm_phase<EPI_RES>(lds, WSB(WS_PROJ), FF, WSB(WS_WD) + (size_t)lf * 1024 * FF, MP, 1024, FF, E);
                gemm_phase<EPI_RES, true>(lds, WSB(WS_PROJ), FF, WSB(WS_WD) + (size_t)lf * 1024 * FF, MP, 1024, FF, E); }

            else if (s == 2) {
                const int li = 3 * layer;
                const float* cv = gla ? (const float*)(p.ws + WS_CV_GWIN) + (size_t)j * 2 * 4096 : (const float*)(p.ws + WS_CV_HWIN) + (size_t)j * 2 * 4608;
                Epi E{EPI_BF16, WSB(WS_PROJ), gla ? GL_LD : HG_LD, nullptr, 0.f, nullptr, nullptr, nullptr, nullptr, STATS(li), cv, cv + (gla ? 4096 : 4608), nullptr, nullptr};
                if (gla) gemm_phase<EPI_BF16>(lds, WSB(WS_XN), 1024, WSB(WS_GWIN) + (size_t)j * 4096 * 1024, MROWS, 4096, 1024, E);
                else gemm_phase<EPI_BF16>(lds, WSB(WS_XN), 1024, WSB(WS_HWIN) + (size_t)j * 4608 * 1024, MROWS, 4608, 1024, E); }
            else if (s == 3) mixprep_phase(lds, p, layer);
            else if (s == 4) chain_phase(lds, p, layer);
            else if (s == 5) { if (gla) headnorm_phase(WSB(WS_PROJ), GL_LD, 2560, 1536, 32, p.in[19] + j * 1024); else headnorm_phase(WSB(WS_PROJ), HG_LD, 3072, 2048, 16, p.in[14] + j * 1024); }
            else if (s == 6) {
                const int li_in = 3 * layer;
                Epi E{EPI_RES, nullptr, 0, p.out + O_Y, 1.0f, nullptr, nullptr, nullptr, nullptr, STATS(li_in), p.in[10] + li_in * 1024, p.in[11] + li_in * 1024, STATS(li_in + 1), WSB(WS_XN)};
                gemm_phase<EPI_RES>(lds, WSB(WS_PROJ) + (gla ? 2560 : 3072), gla ? GL_LD : HG_LD, WSB(WS_WOUT) + (size_t)layer * 1024 * 1536, MP, 1024, 1536, E);
                gemm_phase<EPI_RES, true>(lds, WSB(WS_PROJ) + (gla ? 2560 : 3072), gla ? GL_LD : HG_LD, WSB(WS_WOUT) + (size_t)layer * 1024 * 1536, MP, 1024, 1536, E); }

        }
        if (ph + 1 < p.ph_hi && ph != 1) {
            if (ph == 0) cg::this_grid().sync();
            else { XcdBarrier bar; bar.bar = (unsigned*)(p.ws + WS_BAR); bar.x = xb_xcc_id(); bar.st = (volatile LAS unsigned*)(lds + LDS_ST_OFF); xcd_barrier(bar); }
        }
    }
}
#undef WSB
#undef STATS

extern "C" void kernel_launch(void* const* d_in, const int* in_sizes, int n_in, void* d_out, int out_size, void* d_ws, size_t ws_size, hipStream_t stream) {
    static int grid = 0;
    if (grid == 0) {
        if (n_in != 23 || ws_size < WS_END) { fprintf(stderr, "kernel_launch: need 23 inputs and %zu bytes of workspace; got %d, %zu\n", (size_t)WS_END, n_in, ws_size); grid = -1; return; }
        if (hipFuncSetAttribute((const void*)trunk_fwd, hipFuncAttributeMaxDynamicSharedMemorySize, LDS_BYTES) != hipSuccess) { fprintf(stderr, "kernel_launch: hipFuncSetAttribute failed\n"); grid = -1; return; }
        int dev = 0, cus = 0, per_cu = 0;
        (void)hipGetDevice(&dev); (void)hipDeviceGetAttribute(&cus, hipDeviceAttributeMultiprocessorCount, dev);
        (void)hipOccupancyMaxActiveBlocksPerMultiprocessor(&per_cu, (const void*)trunk_fwd, NTHR, LDS_BYTES);
        if (per_cu < 1) { fprintf(stderr, "kernel_launch: occupancy query says %d blocks per CU\n", per_cu); per_cu = 1; }
        (void)hipGetLastError();
        grid = cus;
    }
    if (grid < 0) return;
    Params p{};
    for (int i = 0; i < 23; ++i) p.in[i] = (const float*)d_in[i];
    p.out = (float*)d_out; p.ws = (unsigned char*)d_ws;
#if ONE_LAUNCH
    (void)hipMemsetAsync((unsigned char*)d_ws + WS_BAR, 0, WS_ZERO_END - WS_BAR, stream);
    p.ph_lo = 0; p.ph_hi = NPHASE;
    void* args[] = {&p};
    hipError_t e = hipLaunchCooperativeKernel((const void*)trunk_fwd, dim3(grid), dim3(NTHR), args, LDS_BYTES, stream);
    if (e != hipSuccess) fprintf(stderr, "cooperative launch failed: %s (grid %d)\n", hipGetErrorString(e), grid);
#else
    (void)hipMemsetAsync((unsigned char*)d_ws + WS_BAR, 0, WS_ZERO_END - WS_BAR, stream);
    for (int ph = 0; ph < NPHASE; ++ph) {
        p.ph_lo = ph; p.ph_hi = ph + 1;
        hipLaunchKernelGGL(trunk_fwd, dim3(grid), dim3(NTHR), LDS_BYTES, stream, p);
    }
#endif
}
```

```cpp
#include <hip/hip_runtime.h>
#include <hip/hip_cooperative_groups.h>
#include <cstdio>
namespace cg = cooperative_groups;

#ifndef ONE_LAUNCH
#define ONE_LAUNCH 1
#endif

#define LAS __attribute__((address_space(3)))
typedef unsigned short bf16_t;
typedef short bf16x8 __attribute__((ext_vector_type(8)));
typedef float f32x4 __attribute__((ext_vector_type(4)));
typedef float f32x2 __attribute__((ext_vector_type(2)));
typedef unsigned u32x4 __attribute__((ext_vector_type(4)));
typedef unsigned u32x2 __attribute__((ext_vector_type(2)));
typedef __bf16 nbf2 __attribute__((ext_vector_type(2)));

constexpr int D = 1024, MP = 65536, MS = 1024, MROWS = MP + MS, FF = 2816;
constexpr int HG_LD = 4608, GL_LD = 4096;
constexpr float ALPHA = 1.6817928305074292f;
constexpr int NTHR = 512;
constexpr int LDS_BYTES = 144 * 1024;
constexpr int LDS_ST_OFF = 143360;
constexpr int NCHUNK = MROWS / 64;
constexpr int LDS_X = 131072;

constexpr size_t O_Y = 0;
constexpr size_t O_SHP = (size_t)MROWS * D;
constexpr size_t O_SGP = O_SHP + 2u * 8 * 8 * 128 * 128;
constexpr size_t O_MK = O_SGP + 2u * 8 * 4 * 128 * 256;
constexpr size_t O_MV = O_MK + 4u * 2048 * 512;
constexpr size_t O_SHS = O_MV + 4u * 2048 * 512;
constexpr size_t O_SGS = O_SHS + 2u * 16 * 8 * 128 * 128;

constexpr size_t WS_WGU = 0;
constexpr size_t WS_WD = WS_WGU + 8ull * 5632 * 1024 * 2;
constexpr size_t WS_HWIN = WS_WD + 8ull * 1024 * 2816 * 2;
constexpr size_t WS_GWIN = WS_HWIN + 2ull * 4608 * 1024 * 2;
constexpr size_t WS_WOUT = WS_GWIN + 2ull * 4096 * 1024 * 2;
constexpr size_t WS_MEMW = WS_WOUT + 4ull * 1024 * 1536 * 2;
constexpr size_t WS_MEMP = WS_MEMW + 4096ull * 1024 * 2;
constexpr size_t WS_MKB = WS_MEMP + 2048ull * 1024 * 2;
constexpr size_t WS_MVB = WS_MKB + 4ull * 2048 * 512 * 2;
constexpr size_t WS_CKB = WS_MVB + 4ull * 2048 * 512 * 2;
constexpr size_t WS_CVB = WS_CKB + 4ull * 4096 * 512 * 2;
constexpr size_t WS_XN = WS_CVB + 4ull * 4096 * 512 * 2;
constexpr size_t WS_PROJ = WS_XN + (size_t)MROWS * 1024 * 2;
constexpr size_t WS_VEC = WS_PROJ + (size_t)MROWS * 4608 * 2;
constexpr size_t WS_BAR = WS_VEC + 3ull * (MROWS / 64) * 1024 * 4;
constexpr size_t WS_STATS = WS_BAR + 16384;
constexpr size_t WS_CV_WGU = WS_STATS + 12ull * MROWS * 8;
constexpr size_t WS_CV_HWIN = WS_CV_WGU + 8ull * 2 * 5632 * 4;
constexpr size_t WS_CV_GWIN = WS_CV_HWIN + 2ull * 2 * 4608 * 4;
constexpr size_t WS_ZERO_END = WS_CV_GWIN + 2ull * 2 * 4096 * 4;
constexpr size_t WS_END = WS_ZERO_END;

struct Params {
    const float* in[23];
    float* out;
    unsigned char* ws;
    int ph_lo, ph_hi;
};

__device__ __forceinline__ unsigned pk2(float lo, float hi) { f32x2 v = {lo, hi}; nbf2 b = __builtin_convertvector(v, nbf2); return __builtin_bit_cast(unsigned, b); }
__device__ __forceinline__ float bflo(unsigned u) { return __uint_as_float(u << 16); }
__device__ __forceinline__ float bfhi(unsigned u) { return __uint_as_float(u & 0xffff0000u); }
__device__ __forceinline__ bf16_t f2bf(float f) { unsigned u = pk2(f, 0.f); return (bf16_t)(u & 0xffffu); }
__device__ __forceinline__ float sigmoidf_(float x) { return __builtin_amdgcn_rcpf(1.0f + __expf(-x)); }
__device__ __forceinline__ int ltid() { int t = threadIdx.x; asm volatile("" : "+v"(t)); return t; }
__device__ __forceinline__ int lbid() { int t = blockIdx.x; asm volatile("" : "+s"(t)); return t; }
#define MFMA16(a, b, c) __builtin_amdgcn_mfma_f32_16x16x32_bf16((a), (b), (c), 0, 0, 0)

constexpr int BM = 256, BK = 64, HALF = 128, HTB = HALF * BK * 2, NXCD = 8, WGM = 8;
__device__ __forceinline__ int lds_byte(int r, int c) { const int st = (r >> 4) * 2 + (c >> 5), rr = r & 15, cc = c & 31, ob = rr * 64 + cc * 2; return st * 1024 + (ob ^ (((ob >> 9) & 1) << 5)); }
__device__ __forceinline__ void stage_rc(int b, int& R, int& C) { const int st = b / 1024, sb = b % 1024, swz = sb ^ (((sb >> 9) & 1) << 5); R = (st >> 1) * 16 + swz / 64; C = (st & 1) * 32 + (swz % 64) / 2; }
__device__ __forceinline__ int perm32(int rho) { const int n = rho >> 4, i = rho & 15; return 8 * (i >> 2) + 4 * n + (i & 3); }

struct Unit { int pm, pn; };
struct StaticOrder {
    int nM, nN, nwg, G, c;
    __device__ __forceinline__ void init(int M, int N, int G_, int c_) { nM = M / BM; nN = N / BM; nwg = nM * nN; G = G_; c = c_; }
    __device__ __forceinline__ bool next(int i, Unit& u) const {
        const long L = (long)i * G + c; if (L >= nwg) return false;
        int wgid = (int)L; { const int q = nwg / NXCD, r = nwg % NXCD, xcd = wgid % NXCD, off = wgid / NXCD; wgid = (xcd < r ? xcd * (q + 1) : r * (q + 1) + (xcd - r) * q) + off; }
        const int nig = WGM * nN, gid = wgid / nig, fm = gid * WGM, gsz = (nM - fm) < WGM ? (nM - fm) : WGM;
        u.pm = fm + ((wgid % nig) % gsz); u.pn = (wgid % nig) / gsz; return true;
    }
};

enum { EPI_SWIGLU = 0, EPI_BF16 = 1, EPI_RES = 2, EPI_MEMKV = 3 };
struct Epi { int mode; bf16_t* ob; int ldo; float* xf; float scale; float* mk_out; float* mv_out; bf16_t* mkb; bf16_t* mvb;
             const float* st_in; const float* v1; const float* v2; float* st_out; bf16_t* ybf; };
__device__ __forceinline__ void row_mu_rstd(const LAS float* XS, bool has, int rl, float& mu, float& rstd) {
    if (has) { const f32x2 q = *(const LAS f32x2*)(XS + 2 * rl); mu = q.x * (1.0f / 1024.0f); rstd = __builtin_amdgcn_rsqf(fmaxf(q.y * (1.0f / 1024.0f) - mu * mu, 0.f) + 1e-5f); }
    else { mu = 0.f; rstd = 1.0f; }
}

template <int MODE, bool HALFM> __device__ __forceinline__ void gemm_epilogue(const f32x4 (&acc)[2][2][4][2], const Unit& u, int rb, int wr, int wc, int fr, int fq, const Epi& E, LAS unsigned char* lds) {
    const int row0 = rb + wr * 64 + fr;
    const LAS float* XS = (const LAS float*)(lds + LDS_X); const bool has = (E.st_in != nullptr); const int rl0 = wr * 64 + fr;
    if constexpr (MODE == EPI_SWIGLU) {
        const int col0 = u.pn * 128 + wc * 32 + 8 * fq;
        const int cl = wc * 32 + 8 * fq;
        f32x4 c1g[2], c2g[2], c1u[2], c2u[2];
#pragma unroll
        for (int n = 0; n < 2; ++n) {
            if (has) { c1g[n] = *(const LAS f32x4*)(XS + 512 + cl + 4 * n); c2g[n] = *(const LAS f32x4*)(XS + 768 + cl + 4 * n); c1u[n] = *(const LAS f32x4*)(XS + 512 + cl + 128 + 4 * n); c2u[n] = *(const LAS f32x4*)(XS + 768 + cl + 128 + 4 * n); }
            else { c1g[n] = c2g[n] = c1u[n] = c2u[n] = (f32x4){0.f, 0.f, 0.f, 0.f}; }
        }
        float mus[2][4], rstds[2][4];
#pragma unroll
        for (int ai = 0; ai < 2; ++ai)
#pragma unroll
            for (int m = 0; m < 4; ++m) row_mu_rstd(XS, has, rl0 + ai * HALF + m * 16, mus[ai][m], rstds[ai][m]);
#pragma unroll
        for (int ai = 0; ai < 2; ++ai)
#pragma unroll
            for (int m = 0; m < 4; ++m) {
                const int row = row0 + ai * HALF + m * 16;
                const float mu = mus[ai][m], rstd = rstds[ai][m];
                bf16_t* rowp = E.ob + (size_t)row * E.ldo + col0;
                float h[8];
#pragma unroll
                for (int n = 0; n < 2; ++n)
#pragma unroll
                    for (int j = 0; j < 4; ++j) { const float g = rstd * (acc[ai][0][m][n][j] - mu * c1g[n][j]) + c2g[n][j], up = rstd * (acc[ai][1][m][n][j] - mu * c1u[n][j]) + c2u[n][j];
                        h[n * 4 + j] = g * up * __builtin_amdgcn_rcpf(1.0f + __expf(-g)); }
                u32x4 w; w.x = pk2(h[0], h[1]); w.y = pk2(h[2], h[3]); w.z = pk2(h[4], h[5]); w.w = pk2(h[6], h[7]);
                *(u32x4*)rowp = w;
            }
    } else if constexpr (MODE == EPI_BF16) {
        const int col0 = u.pn * BM + wc * 32 + 8 * fq, cl = wc * 32 + 8 * fq;
        f32x4 c1[2][2], c2[2][2];
#pragma unroll
        for (int bj = 0; bj < 2; ++bj)
#pragma unroll
            for (int n = 0; n < 2; ++n) { c1[bj][n] = *(const LAS f32x4*)(XS + 512 + cl + bj * HALF + 4 * n); c2[bj][n] = *(const LAS f32x4*)(XS + 768 + cl + bj * HALF + 4 * n); }
#pragma unroll
        for (int ai = 0; ai < 2; ++ai)
#pragma unroll
            for (int m = 0; m < 4; ++m) {
                const int row = row0 + ai * HALF + m * 16;
                float mu, rstd; row_mu_rstd(XS, has, rl0 + ai * HALF + m * 16, mu, rstd);
                bf16_t* rowp = E.ob + (size_t)row * E.ldo + col0;
#pragma unroll
                for (int bj = 0; bj < 2; ++bj) {
                    const f32x4 v0 = (acc[ai][bj][m][0] - c1[bj][0] * mu) * rstd + c2[bj][0], v1 = (acc[ai][bj][m][1] - c1[bj][1] * mu) * rstd + c2[bj][1];
                    u32x4 w; w.x = pk2(v0[0], v0[1]); w.y = pk2(v0[2], v0[3]); w.z = pk2(v1[0], v1[1]); w.w = pk2(v1[2], v1[3]);
                    *(u32x4*)(rowp + bj * HALF) = w;
                }
            }
    } else if constexpr (MODE == EPI_RES) {
        const int col0 = u.pn * BM + wc * 32 + 4 * fq, cl = wc * 32 + 4 * fq;
        constexpr int NG = HALFM ? 4 : 8;
#pragma unroll
        for (int bt = 0; bt < (NG + 2) / 3; ++bt) {
            const int g0 = bt * 3, ng = (NG - g0) < 3 ? (NG - g0) : 3;
            f32x4 xv[3][2][2];
#pragma unroll
            for (int gi = 0; gi < 3; ++gi) if (gi < ng) { const int g = g0 + gi, ai = g >> 2, m = g & 3; const float* rowp = E.xf + (size_t)(row0 + ai * HALF + m * 16) * D + col0;
#pragma unroll
                for (int bj = 0; bj < 2; ++bj)
#pragma unroll
                    for (int n = 0; n < 2; ++n) xv[gi][bj][n] = *(const f32x4*)(rowp + bj * HALF + n * 16); }
#pragma unroll
            for (int gi = 0; gi < 3; ++gi) if (gi < ng) {
                const int g = g0 + gi, ai = g >> 2, m = g & 3;
                const int row = row0 + ai * HALF + m * 16;
                float mu, rstd; row_mu_rstd(XS, has, rl0 + ai * HALF + m * 16, mu, rstd);
                float* rowp = E.xf + (size_t)row * D + col0; bf16_t* rowb = E.ybf + (size_t)row * D + col0;
                float s1 = 0.f, s2 = 0.f;
#pragma unroll
                for (int bj = 0; bj < 2; ++bj)
#pragma unroll
                    for (int n = 0; n < 2; ++n) { f32x4 x = xv[gi][bj][n];
                        if (has) { const f32x4 gp = *(const LAS f32x4*)(XS + 512 + cl + bj * HALF + n * 16), bp = *(const LAS f32x4*)(XS + 768 + cl + bj * HALF + n * 16); x = (x - mu) * rstd * gp + bp; }
                        x = x * ALPHA + acc[ai][bj][m][n] * E.scale;
                        *(f32x4*)(rowp + bj * HALF + n * 16) = x;
                        u32x2 w; w.x = pk2(x[0], x[1]); w.y = pk2(x[2], x[3]); *(u32x2*)(rowb + bj * HALF + n * 16) = w;
                        s1 += (x[0] + x[1]) + (x[2] + x[3]); s2 += (x[0] * x[0] + x[1] * x[1]) + (x[2] * x[2] + x[3] * x[3]); }
                s1 += __shfl_xor(s1, 16); s1 += __shfl_xor(s1, 32); s2 += __shfl_xor(s2, 16); s2 += __shfl_xor(s2, 32);
                if (fq == 0) { atomicAdd(E.st_out + 2 * (size_t)row, s1); atomicAdd(E.st_out + 2 * (size_t)row + 1, s2); }
            }
            asm volatile("" ::: "memory");
        }
    } else {
        const int colt = u.pn * BM; const int l = colt >> 10, kv = (colt >> 9) & 1, cc0 = (colt & 511) + wc * 32 + 4 * fq;
        float* of = (kv ? E.mv_out : E.mk_out) + (size_t)l * 2048 * 512;
        bf16_t* ob = (kv ? E.mvb : E.mkb) + (size_t)l * 2048 * 512;
#pragma unroll
        for (int ai = 0; ai < 2; ++ai)
#pragma unroll
            for (int m = 0; m < 4; ++m) {
                const size_t ro = (size_t)(row0 + ai * HALF + m * 16) * 512 + cc0;
#pragma unroll
                for (int bj = 0; bj < 2; ++bj)
#pragma unroll
                    for (int n = 0; n < 2; ++n) { const f32x4 v = acc[ai][bj][m][n]; *(f32x4*)(of + ro + bj * HALF + n * 16) = v; u32x2 w; w.x = pk2(v[0], v[1]); w.y = pk2(v[2], v[3]); *(u32x2*)(ob + ro + bj * HALF + n * 16) = w; }
            }
    }
}

template <int MODE, bool HALFM = false> __device__ __forceinline__ void gemm_phase(LAS unsigned char* lds, const bf16_t* Ag, int lda, const bf16_t* Btg, int M, int N, int K, const Epi& E) {
    int tid_ = threadIdx.x; asm volatile("" : "+v"(tid_));
    const int tid = tid_, wid = __builtin_amdgcn_readfirstlane(tid >> 6), lane = tid & 63, wr = wid >> 2, wc = wid & 3, fr = lane & 15, fq = lane >> 4;
    const int nt = K / BK;
    constexpr bool PERM = (MODE == EPI_SWIGLU || MODE == EPI_BF16);
    StaticOrder S; { const int G_ = (int)gridDim.x; int c_ = lbid(); if (MODE == EPI_MEMKV) c_ = (c_ + G_ / 2) % G_; S.init(M, N, G_, c_); }
    unsigned voffA[2], voffB[2];
#pragma unroll
    for (int i = 0; i < 2; ++i) { int R, C; stage_rc(tid * 16 + i * 8192, R, C); const int Rb = PERM ? ((R & ~31) + perm32(R & 31)) : R;
        voffA[i] = (unsigned)(R * lda + C) * 2u; voffB[i] = (unsigned)(Rb * K + C) * 2u; }
    const size_t kstep = (size_t)(BK * 2);
    const size_t hstepA = (size_t)HALF * lda * 2, hstepB = (size_t)HALF * K * 2;
    const size_t tstepA = 2 * hstepA, tstepB = 2 * hstepB;
    const size_t hA1 = HALFM ? 0 : hstepA;
    const unsigned ldsw = (unsigned)wid * 1024u;
    const int aoff = lds_byte(wr * 64 + fr, fq * 8), boff = lds_byte(wc * 32 + fr, fq * 8);
#define PG8_SA(b, h) (((b) * 2 + (h)) * HTB)
#define PG8_SB(b, h) ((4 + (b) * 2 + (h)) * HTB)
#define PG8_STAGE(bufoff, gbase, voff) do { _Pragma("unroll") for (int _i = 0; _i < 2; ++_i) \
        __builtin_amdgcn_global_load_lds((const unsigned*)((const char*)(gbase) + (voff)[_i]), (LAS unsigned*)(lds + (bufoff) + ldsw + _i * 8192), 16, 0, 0); } while (0)
#define PG8_LDA(dst, b, h) do { _Pragma("unroll") for (int m = 0; m < 4; ++m) _Pragma("unroll") for (int k = 0; k < 2; ++k) dst[m][k] = *(const LAS bf16x8*)(lds + PG8_SA(b, h) + aoff + m * 2048 + k * 1024); } while (0)
#define PG8_LDB(dst, b, h) do { _Pragma("unroll") for (int n = 0; n < 2; ++n) _Pragma("unroll") for (int k = 0; k < 2; ++k) dst[n][k] = *(const LAS bf16x8*)(lds + PG8_SB(b, h) + boff + n * 2048 + k * 1024); } while (0)
#define PG8_MMA(ai, bj, At, Bt) do { __builtin_amdgcn_s_setprio(1); _Pragma("unroll") for (int m = 0; m < 4; ++m) _Pragma("unroll") for (int n = 0; n < 2; ++n) _Pragma("unroll") for (int k = 0; k < 2; ++k) \
        acc[ai][bj][m][n] = __builtin_amdgcn_mfma_f32_16x16x32_bf16(Bt[n][k], At[m][k], acc[ai][bj][m][n], 0, 0, 0); __builtin_amdgcn_s_setprio(0); } while (0)
#define PG8_WAIT_V(n) asm volatile("s_waitcnt vmcnt(" #n ")" ::: "memory")
#define PG8_WAIT_L(n) asm volatile("s_waitcnt lgkmcnt(" #n ")" ::: "memory")
#define PG8_BAR __builtin_amdgcn_s_barrier()
#define PG8_SCHED __builtin_amdgcn_sched_barrier(0)
    Unit cur, nxt; int ui = 0; int rb;
    if constexpr (HALFM) { const int c_ = S.c; if (c_ >= 8 * (N / BM)) return; cur.pm = M / 128 + (c_ & 7); cur.pn = c_ >> 3; rb = cur.pm * 128; }
    else { if (!S.next(0, cur)) return; rb = cur.pm * BM; }
    f32x4 acc[2][2][4][2];
#pragma unroll
    for (int a = 0; a < 2; ++a)
#pragma unroll
        for (int b = 0; b < 2; ++b)
#pragma unroll
            for (int m = 0; m < 4; ++m)
#pragma unroll
                for (int n = 0; n < 2; ++n) acc[a][b][m][n] = (f32x4){0.f, 0.f, 0.f, 0.f};
    bf16x8 At[4][2], B0[2][2], B1[2][2];
    const char* cA = (const char*)Ag + (size_t)cur.pm * (HALFM ? hstepA : tstepA); const char* cB = (const char*)Btg + (size_t)cur.pn * tstepB;
    PG8_STAGE(PG8_SB(0, 0), cB, voffB); PG8_STAGE(PG8_SA(0, 0), cA, voffA); PG8_STAGE(PG8_SB(0, 1), cB + hstepB, voffB); PG8_STAGE(PG8_SA(0, 1), cA + hA1, voffA);
    if (wr == 1) PG8_BAR;
    PG8_WAIT_V(4); PG8_BAR;
    PG8_STAGE(PG8_SB(1, 0), cB + kstep, voffB); PG8_STAGE(PG8_SA(1, 0), cA + kstep, voffA); PG8_STAGE(PG8_SB(1, 1), cB + hstepB + kstep, voffB);
    PG8_WAIT_V(6); PG8_BAR;
    for (;;) {
        const bool has_next = HALFM ? false : S.next(ui + 1, nxt);
        const char* nA = has_next ? (const char*)Ag + (size_t)nxt.pm * tstepA : cA; const char* nB = has_next ? (const char*)Btg + (size_t)nxt.pn * tstepB : cB;
        for (int t = 0; t < nt; t += 2) {
            const bool last = (t == nt - 2);
            if (MODE != EPI_MEMKV && t == nt - 4 && E.st_in != nullptr && wid < 4) {
                const char* gsrc = wid < 2 ? (const char*)(E.st_in + 2 * ((size_t)rb + (HALFM ? 0 : wid * 128))) : (const char*)((wid == 2 ? E.v1 : E.v2) + cur.pn * BM);
                __builtin_amdgcn_global_load_lds((const unsigned*)(gsrc + lane * 16), (LAS unsigned*)(lds + LDS_X + wid * 1024), 16, 0, 0);
            }
            const char* a1 = cA + (size_t)(t + 1) * kstep;
            const char* a2 = last ? nA : cA + (size_t)(t + 2) * kstep; const char* b2 = last ? nB : cB + (size_t)(t + 2) * kstep;
            const char* a3 = a2 + kstep; const char* b3 = b2 + kstep;
            PG8_LDB(B0, 0, 0); PG8_SCHED; PG8_LDA(At, 0, 0); PG8_STAGE(PG8_SA(1, 1), a1 + hA1, voffA);
            PG8_WAIT_L(8); PG8_BAR; PG8_WAIT_L(0); PG8_MMA(0, 0, At, B0); PG8_BAR; PG8_SCHED;
            PG8_LDB(B1, 0, 1); PG8_STAGE(PG8_SB(0, 0), b2, voffB);
            PG8_BAR; PG8_WAIT_L(0); PG8_MMA(0, 1, At, B1); PG8_BAR;
            if constexpr (!HALFM) PG8_LDA(At, 0, 1); PG8_STAGE(PG8_SA(0, 0), a2, voffA);
            PG8_BAR; PG8_WAIT_L(0); if constexpr (!HALFM) PG8_MMA(1, 0, At, B0); PG8_BAR; PG8_SCHED;
            PG8_STAGE(PG8_SB(0, 1), b2 + hstepB, voffB);
            PG8_WAIT_V(6); PG8_BAR; if constexpr (!HALFM) PG8_MMA(1, 1, At, B1); PG8_BAR;
            PG8_LDB(B0, 1, 0); PG8_SCHED; PG8_LDA(At, 1, 0); PG8_STAGE(PG8_SA(0, 1), a2 + hA1, voffA);
            PG8_WAIT_L(8); PG8_BAR; PG8_WAIT_L(0); PG8_MMA(0, 0, At, B0); PG8_BAR; PG8_SCHED;
            PG8_LDB(B1, 1, 1); PG8_STAGE(PG8_SB(1, 0), b3, voffB);
            PG8_BAR; PG8_WAIT_L(0); PG8_MMA(0, 1, At, B1); PG8_BAR;
            if constexpr (!HALFM) PG8_LDA(At, 1, 1); PG8_STAGE(PG8_SA(1, 0), a3, voffA);
            PG8_BAR; PG8_WAIT_L(0); if constexpr (!HALFM) PG8_MMA(1, 0, At, B0); PG8_BAR; PG8_SCHED;
            PG8_STAGE(PG8_SB(1, 1), b3 + hstepB, voffB);
            PG8_WAIT_V(6); PG8_BAR; if constexpr (!HALFM) PG8_MMA(1, 1, At, B1); PG8_BAR;
        }
        gemm_epilogue<MODE, HALFM>(acc, cur, rb, wr, wc, fr, fq, E, lds);
        if (!has_next) break;
#pragma unroll
        for (int a = 0; a < 2; ++a)
#pragma unroll
            for (int b = 0; b < 2; ++b)
#pragma unroll
                for (int m = 0; m < 4; ++m)
#pragma unroll
                    for (int n = 0; n < 2; ++n) acc[a][b][m][n] = (f32x4){0.f, 0.f, 0.f, 0.f};
        cur = nxt; cA = nA; cB = nB; ++ui; rb = cur.pm * BM;
    }
    PG8_WAIT_V(0);
    if (wr == 0) PG8_BAR;
    PG8_BAR;
#undef PG8_SA
#undef PG8_SB
#undef PG8_STAGE
#undef PG8_LDA
#undef PG8_LDB
#undef PG8_MMA
#undef PG8_WAIT_V
#undef PG8_WAIT_L
#undef PG8_BAR
#undef PG8_SCHED
}

__device__ __forceinline__ void transpose_job(LAS unsigned char* lds, const float* src, int ld, int K, int c0, int ncols, bf16_t* dst, int rowmode, int drow0,
                                              const float* gk, const float* bk, float* c1, float* c2) {
    LAS float* tile = (LAS float*)lds;
    int tid_ = threadIdx.x; asm volatile("" : "+v"(tid_)); const int tid = tid_;
    const int nkt = K / 64, nct = ncols / 64, ntiles = nkt * nct;
    const int kr = tid >> 4, c4 = (tid & 15) * 4;
    f32x4 pv[2];
    { const int t = lbid(); if (t < ntiles) { const int k0 = (t % nkt) * 64, n0 = (t / nkt) * 64;
#pragma unroll
        for (int rr = 0; rr < 2; ++rr) pv[rr] = *(const f32x4*)(src + (size_t)(k0 + kr + 32 * rr) * ld + c0 + n0 + c4); } }
    for (int t = lbid(); t < ntiles; t += gridDim.x) {
        const int kt = t % nkt, ct = t / nkt;
        const int k0 = kt * 64, n0 = ct * 64;
#pragma unroll
        for (int rr = 0; rr < 2; ++rr) { const f32x4 v = pv[rr];
            tile[(kr + 32 * rr) * 65 + c4 + 0] = v[0]; tile[(kr + 32 * rr) * 65 + c4 + 1] = v[1]; tile[(kr + 32 * rr) * 65 + c4 + 2] = v[2]; tile[(kr + 32 * rr) * 65 + c4 + 3] = v[3]; }
        { const int tn = t + gridDim.x; if (tn < ntiles) { const int k1 = (tn % nkt) * 64, n1 = (tn / nkt) * 64;
#pragma unroll
            for (int rr = 0; rr < 2; ++rr) pv[rr] = *(const f32x4*)(src + (size_t)(k1 + kr + 32 * rr) * ld + c0 + n1 + c4); } }
        __syncthreads();
        { const int n = tid >> 3, k8 = (tid & 7) * 8; float v[8];
#pragma unroll
          for (int i = 0; i < 8; ++i) v[i] = tile[(k8 + i) * 65 + n];
          const int c = c0 + n0 + n; int drow;
          if (rowmode == 0) drow = drow0 + c; else drow = 256 * (c >> 7) + (c & 127) + (rowmode == 2 ? 128 : 0);
          u32x4 w;
          if (gk) {
              const f32x4 g0 = *(const f32x4*)(gk + k0 + k8), g1 = *(const f32x4*)(gk + k0 + k8 + 4), b0 = *(const f32x4*)(bk + k0 + k8), b1 = *(const f32x4*)(bk + k0 + k8 + 4);
              float s2 = 0.f;
#pragma unroll
              for (int i = 0; i < 4; ++i) { s2 += b0[i] * v[i] + b1[i] * v[4 + i]; v[i] *= g0[i]; v[4 + i] *= g1[i]; }
              w.x = pk2(v[0], v[1]); w.y = pk2(v[2], v[3]); w.z = pk2(v[4], v[5]); w.w = pk2(v[6], v[7]);
              float s1 = 0.f;
#pragma unroll
              for (int i = 0; i < 4; ++i) s1 += bflo(w[i]) + bfhi(w[i]);
              s1 += __shfl_xor(s1, 1); s1 += __shfl_xor(s1, 2); s1 += __shfl_xor(s1, 4);
              s2 += __shfl_xor(s2, 1); s2 += __shfl_xor(s2, 2); s2 += __shfl_xor(s2, 4);
              if ((tid & 7) == 0) { atomicAdd(c1 + drow, s1); atomicAdd(c2 + drow, s2); }
          } else { w.x = pk2(v[0], v[1]); w.y = pk2(v[2], v[3]); w.z = pk2(v[4], v[5]); w.w = pk2(v[6], v[7]); }
          *(u32x4*)(dst + (size_t)drow * K + k0 + k8) = w; }
        __syncthreads();
    }
}
__device__ __forceinline__ void convert_job(const float* src, bf16_t* dst, float* dstf, size_t n) {
    const size_t nv = n / 8, stride = (size_t)gridDim.x * NTHR;
    for (size_t i = (size_t)lbid() * NTHR + ltid(); i < nv; i += 2 * stride) {
        const size_t i2 = i + stride; const bool two = i2 < nv;
        const f32x4 a = *(const f32x4*)(src + i * 8), b = *(const f32x4*)(src + i * 8 + 4);
        f32x4 c = a, d = b; if (two) { c = *(const f32x4*)(src + i2 * 8); d = *(const f32x4*)(src + i2 * 8 + 4); }
        u32x4 w; w.x = pk2(a[0], a[1]); w.y = pk2(a[2], a[3]); w.z = pk2(b[0], b[1]); w.w = pk2(b[2], b[3]);
        *(u32x4*)(dst + i * 8) = w;
        if (dstf) { *(f32x4*)(dstf + i * 8) = a; *(f32x4*)(dstf + i * 8 + 4) = b; }
        if (two) { w.x = pk2(c[0], c[1]); w.y = pk2(c[2], c[3]); w.z = pk2(d[0], d[1]); w.w = pk2(d[2], d[3]);
            *(u32x4*)(dst + i2 * 8) = w;
            if (dstf) { *(f32x4*)(dstf + i2 * 8) = c; *(f32x4*)(dstf + i2 * 8 + 4) = d; } }
    }
}
__device__ __forceinline__ void prep_phase(LAS unsigned char* lds, const Params& p) {
    unsigned char* ws = p.ws;
    for (int jb = 0; jb < 52; ++jb) {
        const float* src; int ld, K, c0, ncols, rowmode, drow0; bf16_t* dst; int li = -1; float* cv = nullptr; int cvn = 0;
        if (jb < 24) { const int lf = jb / 3, t = jb % 3;
            if (t < 2) { src = (t == 0 ? p.in[7] : p.in[8]) + (size_t)lf * 1024 * FF; ld = FF; K = 1024; c0 = 0; ncols = FF; dst = (bf16_t*)(ws + WS_WGU) + (size_t)lf * 5632 * 1024; rowmode = 1 + t; drow0 = 0;
                if (lf > 0) { li = (lf & 1) ? 3 * (lf >> 1) + 1 : 3 * (lf >> 1) - 1; cv = (float*)(ws + WS_CV_WGU) + (size_t)lf * 2 * 5632; cvn = 5632; } }
            else { src = p.in[9] + (size_t)lf * FF * 1024; ld = 1024; K = FF; c0 = 0; ncols = 1024; dst = (bf16_t*)(ws + WS_WD) + (size_t)lf * 1024 * FF; rowmode = 0; drow0 = 0; }
        } else if (jb < 44) { const int j = (jb - 24) / 10, t = (jb - 24) % 10; rowmode = 0; K = 1024;
            if (t < 4) {
                src = p.in[12] + (size_t)j * 1024 * 4608; ld = 4608; dst = (bf16_t*)(ws + WS_HWIN) + (size_t)j * 4608 * 1024;
                c0 = t == 0 ? 0 : (t == 1 ? 3072 : (t == 2 ? 2048 : 4096)); ncols = t == 0 ? 2048 : (t == 3 ? 512 : 1024); drow0 = (t == 0 ? 0 : (t == 1 ? 2048 : (t == 2 ? 3072 : 4096))) - c0;
                li = 3 * (2 * j); cv = (float*)(ws + WS_CV_HWIN) + (size_t)j * 2 * 4608; cvn = 4608;
            } else if (t < 8) {
                src = p.in[16] + (size_t)j * 1024 * 3600; ld = 3600; dst = (bf16_t*)(ws + WS_GWIN) + (size_t)j * 4096 * 1024; const int u = t - 4;
                c0 = u == 0 ? 0 : (u == 1 ? 2048 : (u == 2 ? 1024 : 3088)); ncols = u == 3 ? 512 : 1024; drow0 = (u == 0 ? 0 : (u == 1 ? 1536 : (u == 2 ? 2560 : 3584))) - c0;
                li = 3 * (2 * j + 1); cv = (float*)(ws + WS_CV_GWIN) + (size_t)j * 2 * 4096; cvn = 4096;
            } else { src = (t == 8 ? p.in[15] : p.in[20]) + (size_t)j * 1536 * 1024; ld = 1024; K = 1536; c0 = 0; ncols = 1024; dst = (bf16_t*)(ws + WS_WOUT) + (size_t)(2 * j + (t - 8)) * 1024 * 1536; drow0 = 0; }
        } else { const int l = (jb - 44) >> 1, kv = (jb - 44) & 1; src = (kv ? p.in[22] : p.in[21]) + (size_t)l * 1024 * 512; ld = 512; K = 1024; c0 = 0; ncols = 512; dst = (bf16_t*)(ws + WS_MEMW); rowmode = 0; drow0 = l * 1024 + kv * 512; }
        const float* gk = li >= 0 ? p.in[10] + li * 1024 : nullptr; const float* bk = li >= 0 ? p.in[11] + li * 1024 : nullptr;
        transpose_job(lds, src, ld, K, c0, ncols, dst, rowmode, drow0, gk, bk, cv, cv + cvn);
    }
    for (int j = 0; j < 2; ++j) {
        const float* gs = p.in[16] + (size_t)j * 1024 * 3600; bf16_t* gd = (bf16_t*)(ws + WS_GWIN) + (size_t)j * 4096 * 1024;
        const float* w2 = p.in[17] + (size_t)j * 16 * 512;
        const int li = 3 * (2 * j + 1); const float* gk = p.in[10] + li * 1024; const float* bk = p.in[11] + li * 1024;
        float* c1 = (float*)(ws + WS_CV_GWIN) + (size_t)j * 2 * 4096; float* c2 = c1 + 4096;
        for (int i = lbid() * NTHR + ltid(); i < 512 * 1024; i += gridDim.x * NTHR) {
            const int c = i >> 10, kk = i & 1023; float sacc = 0.f;
#pragma unroll
            for (int r = 0; r < 16; ++r) sacc += gs[(size_t)kk * 3600 + 3072 + r] * w2[r * 512 + c];
            const bf16_t hv = f2bf(sacc * gk[kk]);
            gd[(size_t)(1024 + c) * 1024 + kk] = hv;
            float s1 = __uint_as_float(((unsigned)hv) << 16), s2 = sacc * bk[kk];
#pragma unroll
            for (int o = 32; o >= 1; o >>= 1) { s1 += __shfl_xor(s1, o); s2 += __shfl_xor(s2, o); }
            if ((kk & 63) == 0) { atomicAdd(c1 + 1024 + c, s1); atomicAdd(c2 + 1024 + c, s2); }
        }
    }
    for (int jb = 0; jb < 5; ++jb) {
        const float* src; bf16_t* dst; float* dstf = nullptr; size_t n;
        if (jb == 0) { src = p.in[0]; dst = (bf16_t*)(ws + WS_XN); dstf = p.out + O_Y; n = (size_t)MP * D; }
        else if (jb == 1) { src = p.in[1]; dst = (bf16_t*)(ws + WS_XN) + (size_t)MP * D; dstf = p.out + O_Y + (size_t)MP * D; n = (size_t)MS * D; }
        else if (jb == 2) { src = p.in[2]; dst = (bf16_t*)(ws + WS_MEMP); n = (size_t)2048 * 1024; }
        else if (jb == 3) { src = p.in[3]; dst = (bf16_t*)(ws + WS_CKB); n = (size_t)4 * 4096 * 512; }
        else { src = p.in[4]; dst = (bf16_t*)(ws + WS_CVB); n = (size_t)4 * 4096 * 512; }
        convert_job(src, dst, dstf, n);
    }
}

__device__ __forceinline__ void ln_phase(float* x, bf16_t* xn, const float* gain, const float* bias) {
    int tid_ = threadIdx.x; asm volatile("" : "+v"(tid_));
    const int lane = tid_ & 63, wv = tid_ >> 6;
    f32x4 g[4], b[4];
#pragma unroll
    for (int i = 0; i < 4; ++i) { g[i] = *(const f32x4*)(gain + 4 * lane + 256 * i); b[i] = *(const f32x4*)(bias + 4 * lane + 256 * i); }
    const int rstep = gridDim.x * 8;
    int row = lbid() * 8 + wv;
    f32x4 nv[4];
    if (row < MROWS) {
#pragma unroll
        for (int i = 0; i < 4; ++i) nv[i] = *(const f32x4*)(x + (size_t)row * D + 4 * lane + 256 * i); }
    for (; row < MROWS; row += rstep) {
        float* xr = x + (size_t)row * D; f32x4 v[4]; float s = 0.f;
#pragma unroll
        for (int i = 0; i < 4; ++i) { v[i] = nv[i]; s += (v[i][0] + v[i][1]) + (v[i][2] + v[i][3]); }
        if (row + rstep < MROWS) {
#pragma unroll
            for (int i = 0; i < 4; ++i) nv[i] = *(const f32x4*)(x + (size_t)(row + rstep) * D + 4 * lane + 256 * i); }
#pragma unroll
        for (int o = 32; o >= 1; o >>= 1) s += __shfl_xor(s, o);
        const float mu = s * (1.0f / 1024.0f); float q = 0.f;
#pragma unroll
        for (int i = 0; i < 4; ++i) { const f32x4 d = v[i] - mu; q += (d[0] * d[0] + d[1] * d[1]) + (d[2] * d[2] + d[3] * d[3]); }
#pragma unroll
        for (int o = 32; o >= 1; o >>= 1) q += __shfl_xor(q, o);
        const float rs = 1.0f / sqrtf(q * (1.0f / 1024.0f) + 1e-5f);
#pragma unroll
        for (int i = 0; i < 4; ++i) { const f32x4 o = (v[i] - mu) * rs * g[i] + b[i]; *(f32x4*)(xr + 4 * lane + 256 * i) = o;
            if (xn) { u32x2 w; w.x = pk2(o[0], o[1]); w.y = pk2(o[2], o[3]); *(u32x2*)(xn + (size_t)row * D + 4 * lane + 256 * i) = w; } }
    }
}

__device__ __forceinline__ void headnorm_phase(bf16_t* proj, int ld, int ocol, int gcol, int lanes_per_head  , const float* gain) {
    int tid_ = threadIdx.x; asm volatile("" : "+v"(tid_));
    const int lane = tid_ & 63, wv = tid_ >> 6;
    float gn[2][8];
#pragma unroll
    for (int hh = 0; hh < 2; ++hh)
#pragma unroll
        for (int i = 0; i < 8; ++i) gn[hh][i] = gain[hh * 512 + 8 * lane + i];
    const float invn = lanes_per_head == 16 ? (1.0f / 128.0f) : (1.0f / 256.0f);
    const int rstep = gridDim.x * 8;
    int row = lbid() * 8 + wv;
    u32x4 nov[2], ngv[2];
    if (row < MROWS) { const bf16_t* pr = proj + (size_t)row * ld;
#pragma unroll
        for (int hh = 0; hh < 2; ++hh) { nov[hh] = *(const u32x4*)(pr + ocol + hh * 512 + 8 * lane); ngv[hh] = *(const u32x4*)(pr + gcol + hh * 512 + 8 * lane); } }
    for (; row < MROWS; row += rstep) {
        bf16_t* pr = proj + (size_t)row * ld;
        u32x4 cov[2], cgv[2];
#pragma unroll
        for (int hh = 0; hh < 2; ++hh) { cov[hh] = nov[hh]; cgv[hh] = ngv[hh]; }
        if (row + rstep < MROWS) { const bf16_t* pn = proj + (size_t)(row + rstep) * ld;
#pragma unroll
            for (int hh = 0; hh < 2; ++hh) { nov[hh] = *(const u32x4*)(pn + ocol + hh * 512 + 8 * lane); ngv[hh] = *(const u32x4*)(pn + gcol + hh * 512 + 8 * lane); } }
#pragma unroll
        for (int hh = 0; hh < 2; ++hh) {
            const u32x4 ov = cov[hh], gv = cgv[hh];
            float o[8], g[8];
#pragma unroll
            for (int i = 0; i < 4; ++i) { o[2 * i] = bflo(ov[i]); o[2 * i + 1] = bfhi(ov[i]); g[2 * i] = bflo(gv[i]); g[2 * i + 1] = bfhi(gv[i]); }
            float s = 0.f;
#pragma unroll
            for (int i = 0; i < 8; ++i) s += o[i] * o[i];
            s += __shfl_xor(s, 1); s += __shfl_xor(s, 2); s += __shfl_xor(s, 4); s += __shfl_xor(s, 8);
            if (lanes_per_head == 32) s += __shfl_xor(s, 16);
            const float rs = __builtin_amdgcn_rsqf(s * invn + 1e-6f);
            float r[8];
#pragma unroll
            for (int i = 0; i < 8; ++i) r[i] = o[i] * rs * gn[hh][i] * g[i] * sigmoidf_(g[i]);
            u32x4 w; w.x = pk2(r[0], r[1]); w.y = pk2(r[2], r[3]); w.z = pk2(r[4], r[5]); w.w = pk2(r[6], r[7]);
            *(u32x4*)(pr + ocol + hh * 512 + 8 * lane) = w;
        }
    }
}

constexpr int MP_G = 0, MP_T = 32768, MP_KTT = 34816, MP_QT = MP_KTT + 128 * 72 * 2, MP_KT = MP_QT + 64 * 136 * 2, MP_END = MP_KT + 64 * 136 * 2;
static_assert(MP_END <= 131072, "prepass LDS");

__device__ __forceinline__ void mixprep_loop(LAS unsigned char* lds, bf16_t* proj, int ld, int qcol, int kcol, int gcol, int gla, const float* lb0, const float* lb1, int lbj, const float* bgate,
                                             bf16_t* ktb_h, int nh, float* vec_h, int ci0, int cstep) {
    int tid_ = threadIdx.x; asm volatile("" : "+v"(tid_));
    const int tid = tid_, wid = __builtin_amdgcn_readfirstlane(tid >> 6), lane = tid & 63, fr = lane & 15, fq = lane >> 4;
    LAS float* G = (LAS float*)(lds + MP_G); LAS float* T = (LAS float*)(lds + MP_T); LAS bf16_t* KTT = (LAS bf16_t*)(lds + MP_KTT);
    LAS bf16_t* QT = (LAS bf16_t*)(lds + MP_QT); LAS bf16_t* KT = (LAS bf16_t*)(lds + MP_KT);
    const int t0 = tid >> 4, cv = tid & 15, c8 = cv * 8;
    float cA[8], cB[8];
#pragma unroll
    for (int i = 0; i < 8; ++i) {
        if (gla) { cA[i] = bgate[c8 + i]; cB[i] = 0.f; }
        else { float lb = 0.f; if (lbj == 1) lb = sigmoidf_(lb1[c8 + i] - lb0[c8 + i]); cA[i] = lb; cB[i] = 1.0f - lb; }
    }
    const float qscale = 0.08838834764831845f;
    u32x4 rq[2], rk[2], rg[2];
    rg[0] = rg[1] = (u32x4){0u, 0u, 0u, 0u};
    auto issue_loads = [&](int ci) {
        const bf16_t* base = proj + (size_t)ci * 64 * ld;
#pragma unroll
        for (int rr = 0; rr < 2; ++rr) { const bf16_t* rp = base + (size_t)(t0 + 32 * rr) * ld + c8; rq[rr] = *(const u32x4*)(rp + qcol); rk[rr] = *(const u32x4*)(rp + kcol); if (gla) rg[rr] = *(const u32x4*)(rp + gcol); }
    };
    if (ci0 < NCHUNK) issue_loads(ci0);
    for (int ci = ci0; ci < NCHUNK; ci += cstep) {
        bf16_t* base = proj + (size_t)ci * 64 * ld;
        float qv[2][8], kv[2][8];
#pragma unroll
        for (int rr = 0; rr < 2; ++rr) {
            float gvv[8];
#pragma unroll
            for (int i = 0; i < 8; ++i) {
                const unsigned uq = rq[rr][i >> 1], uk = rk[rr][i >> 1], ug = rg[rr][i >> 1];
                const float q = (i & 1) ? bfhi(uq) : bflo(uq), k = (i & 1) ? bfhi(uk) : bflo(uk);
                if (gla) {
                    const float g = ((i & 1) ? bfhi(ug) : bflo(ug)) + cA[i];
                    qv[rr][i] = q * qscale; kv[rr][i] = k;
                    gvv[i] = (fminf(g, 0.f) - __logf(1.0f + __expf(-fabsf(g)))) * (1.0f / 16.0f);
                } else {
                    qv[rr][i] = q * sigmoidf_(q) * qscale;
                    const float e = __expf(-k), r = __builtin_amdgcn_rcpf(1.0f + e);
                    kv[rr][i] = cB[i] * e * r;
                    gvv[i] = __logf(fmaxf(cA[i] + cB[i] * r, 1e-6f));
                }
            }
            LAS float* gp = G + (t0 + 32 * rr) * 128 + c8;
            *(LAS f32x4*)gp = (f32x4){gvv[0], gvv[1], gvv[2], gvv[3]}; *(LAS f32x4*)(gp + 4) = (f32x4){gvv[4], gvv[5], gvv[6], gvv[7]};
        }
        if (ci + cstep < NCHUNK) issue_loads(ci + cstep);
        __syncthreads();
        { const int k = tid & 127, sg = tid >> 7; float run = 0.f;
#pragma unroll
          for (int i = 0; i < 16; ++i) { run += G[(16 * sg + i) * 128 + k]; G[(16 * sg + i) * 128 + k] = run; }
          T[sg * 128 + k] = run; }
        __syncthreads();
        {
            float tA[8], tB[8], tC[8], bmid[8], blast[8];
            { const f32x4 x0 = *(const LAS f32x4*)(T + c8), x1 = *(const LAS f32x4*)(T + c8 + 4), y0 = *(const LAS f32x4*)(T + 128 + c8), y1 = *(const LAS f32x4*)(T + 128 + c8 + 4),
                  z0 = *(const LAS f32x4*)(T + 256 + c8), z1 = *(const LAS f32x4*)(T + 256 + c8 + 4);
              const f32x4 m0 = *(const LAS f32x4*)(G + 31 * 128 + c8), m1 = *(const LAS f32x4*)(G + 31 * 128 + c8 + 4), l0 = *(const LAS f32x4*)(G + 63 * 128 + c8), l1 = *(const LAS f32x4*)(G + 63 * 128 + c8 + 4);
#pragma unroll
              for (int i = 0; i < 4; ++i) { tA[i] = x0[i]; tA[4 + i] = x1[i]; tB[i] = x0[i] + y0[i]; tB[4 + i] = x1[i] + y1[i]; tC[i] = tB[i] + z0[i]; tC[4 + i] = tB[4 + i] + z1[i];
                  bmid[i] = m0[i] + tA[i]; bmid[4 + i] = m1[i] + tA[4 + i]; blast[i] = l0[i] + tC[i]; blast[4 + i] = l1[i] + tC[4 + i]; } }
#pragma unroll
            for (int rr = 0; rr < 2; ++rr) {
                const int t = t0 + 32 * rr, sg = t >> 4;
                const f32x4 g0 = *(const LAS f32x4*)(G + t * 128 + c8), g1 = *(const LAS f32x4*)(G + t * 128 + c8 + 4);
                float qt[8], kt[8];
#pragma unroll
                for (int i = 0; i < 8; ++i) {
                    const float off = sg == 0 ? 0.f : (sg == 1 ? tA[i] : (sg == 2 ? tB[i] : tC[i]));
                    const float b = (i < 4 ? g0[i & 3] : g1[i & 3]) + off;
                    qt[i] = qv[rr][i] * __expf(fminf(b - bmid[i], 80.f));
                    kt[i] = kv[rr][i] * __expf(fminf(bmid[i] - b, 80.f));
                }
                bf16_t* rp = base + (size_t)t * ld + c8;
                u32x4 w;
                w.x = pk2(qt[0], qt[1]); w.y = pk2(qt[2], qt[3]); w.z = pk2(qt[4], qt[5]); w.w = pk2(qt[6], qt[7]); *(u32x4*)(rp + qcol) = w; *(LAS u32x4*)(QT + t * 136 + c8) = w;
                w.x = pk2(kt[0], kt[1]); w.y = pk2(kt[2], kt[3]); w.z = pk2(kt[4], kt[5]); w.w = pk2(kt[6], kt[7]); *(LAS u32x4*)(KT + t * 136 + c8) = w;
#pragma unroll
                for (int i = 0; i < 4; ++i) { KTT[(c8 + 2 * i) * 72 + t] = (bf16_t)(w[i] & 0xffffu); KTT[(c8 + 2 * i + 1) * 72 + t] = (bf16_t)(w[i] >> 16); }
            }
            if (t0 == 0) {
                float* em = vec_h + (size_t)ci * 1024; float* el = em + (size_t)NCHUNK * 1024; float* elm = el + (size_t)NCHUNK * 1024;
                f32x4 v0, v1;
#pragma unroll
                for (int i = 0; i < 4; ++i) { v0[i] = __expf(bmid[i]); v1[i] = __expf(bmid[4 + i]); }
                *(f32x4*)(em + c8) = v0; *(f32x4*)(em + c8 + 4) = v1;
#pragma unroll
                for (int i = 0; i < 4; ++i) { v0[i] = __expf(blast[i]); v1[i] = __expf(blast[4 + i]); }
                *(f32x4*)(el + c8) = v0; *(f32x4*)(el + c8 + 4) = v1;
#pragma unroll
                for (int i = 0; i < 4; ++i) { v0[i] = __expf(blast[i] - bmid[i]); v1[i] = __expf(blast[4 + i] - bmid[4 + i]); }
                *(f32x4*)(elm + c8) = v0; *(f32x4*)(elm + c8 + 4) = v1;
            }
        }
        __syncthreads();
        { const int k = tid >> 2, j = tid & 3; bf16_t* ktb = ktb_h + (size_t)ci * nh * 8192;
          const u32x4 w0 = *(const LAS u32x4*)(KTT + k * 72 + 16 * j), w1 = *(const LAS u32x4*)(KTT + k * 72 + 16 * j + 8);
          *(u32x4*)(ktb + k * 64 + 16 * j) = w0; *(u32x4*)(ktb + k * 64 + 16 * j + 8) = w1; }
        { const int ti = wid >> 1;
#pragma unroll
          for (int sh = 0; sh < 2; ++sh) { const int si = 2 * (wid & 1) + sh; f32x4 pa = {0.f, 0.f, 0.f, 0.f};
              if (si <= ti) {
#pragma unroll
                  for (int kk = 0; kk < 4; ++kk) { const bf16x8 A = *(const LAS bf16x8*)(KT + (16 * si + fr) * 136 + 32 * kk + 8 * fq), B = *(const LAS bf16x8*)(QT + (16 * ti + fr) * 136 + 32 * kk + 8 * fq); pa = MFMA16(A, B, pa); }
                  if (si == ti) {
#pragma unroll
                      for (int j = 0; j < 4; ++j) if (4 * fq + j > fr) pa[j] = 0.f; }
              }
              u32x2 w; w.x = pk2(pa[0], pa[1]); w.y = pk2(pa[2], pa[3]); *(u32x2*)(base + (size_t)(16 * ti + fr) * ld + kcol + 16 * si + 4 * fq) = w; } }
    }
    __syncthreads();
}

constexpr int MXB = 49664, MXB_QT = 0, MXB_KTT = 17408, MXB_VT = 35840, MXB_PP = 40448, MX_ST = 2 * MXB, MX_END = MX_ST + 2 * 8704;
static_assert(MX_END <= LDS_ST_OFF, "mixer LDS");

struct ChainArgs {
    bf16_t* proj; int ld; size_t row0; int nchunks;
    int qcol, kcol, vcol;
    const bf16_t* ktb;
    size_t ktb_stride;
    const float* em; const float* el; const float* elm; int vec_stride;
    const float* s0; float* sout; int sstride;
};

__device__ __forceinline__ void mixer_chain(LAS unsigned char* lds, const ChainArgs& a) {
    int tid_ = threadIdx.x; asm volatile("" : "+v"(tid_));
    const int tid = tid_, wid = __builtin_amdgcn_readfirstlane(tid >> 6), lane = tid & 63, fr = lane & 15, fq = lane >> 4;
    const int t0 = tid >> 4, c8 = (tid & 15) * 8;
    f32x4 Sacc[2];
#pragma unroll
    for (int vi = 0; vi < 2; ++vi)
#pragma unroll
        for (int j = 0; j < 4; ++j) Sacc[vi][j] = a.s0 ? a.s0[(size_t)(16 * wid + 4 * fq + j) * a.sstride + 16 * vi + fr] : 0.f;
    struct Regs { u32x4 rq[2], rkt[2], rp, rv; f32x4 vem, vel, velm; };
    Regs R0, R1;
    R0.rv = (u32x4){0u, 0u, 0u, 0u}; R1.rv = (u32x4){0u, 0u, 0u, 0u};
    auto issue_loads = [&](Regs& R, int c) {
        const bf16_t* base = a.proj + (a.row0 + (size_t)c * 64) * a.ld;
#pragma unroll
        for (int rr = 0; rr < 2; ++rr) R.rq[rr] = *(const u32x4*)(base + (size_t)(t0 + 32 * rr) * a.ld + c8 + a.qcol);
        R.rp = *(const u32x4*)(base + (size_t)(tid >> 3) * a.ld + a.kcol + 8 * (tid & 7));
        const bf16_t* kp = a.ktb + (size_t)c * a.ktb_stride + (tid >> 2) * 64 + 16 * (tid & 3);
        R.rkt[0] = *(const u32x4*)kp; R.rkt[1] = *(const u32x4*)(kp + 8);
        if (tid < 256) R.rv = *(const u32x4*)(base + (size_t)(tid >> 2) * a.ld + a.vcol + 8 * (tid & 3));
        const size_t vo = (size_t)c * a.vec_stride + 16 * wid + 4 * fq;
        R.vem = *(const f32x4*)(a.em + vo); R.vel = *(const f32x4*)(a.el + vo); R.velm = *(const f32x4*)(a.elm + vo);
    };
    f32x4 cel, celm;
    auto fill = [&](int b, const Regs& R) {
        LAS bf16_t* QT = (LAS bf16_t*)(lds + b * MXB + MXB_QT); LAS bf16_t* KTT = (LAS bf16_t*)(lds + b * MXB + MXB_KTT);
        LAS bf16_t* VT = (LAS bf16_t*)(lds + b * MXB + MXB_VT); LAS bf16_t* PP = (LAS bf16_t*)(lds + b * MXB + MXB_PP); LAS bf16_t* ST = (LAS bf16_t*)(lds + MX_ST + b * 8704);
#pragma unroll
        for (int rr = 0; rr < 2; ++rr) *(LAS u32x4*)(QT + (t0 + 32 * rr) * 136 + c8) = R.rq[rr];
        *(LAS u32x4*)(PP + (tid >> 3) * 72 + 8 * (tid & 7)) = R.rp;
        { LAS bf16_t* kp = KTT + (tid >> 2) * 72 + 16 * (tid & 3); *(LAS u32x4*)kp = R.rkt[0]; *(LAS u32x4*)(kp + 8) = R.rkt[1]; }
        if (tid < 256) { const int tv = tid >> 2, v8 = (tid & 3) * 8;
#pragma unroll
            for (int i = 0; i < 8; ++i) VT[(v8 + i) * 72 + tv] = (bf16_t)((i & 1) ? (R.rv[i >> 1] >> 16) : (R.rv[i >> 1] & 0xffffu)); }
#pragma unroll
        for (int vi = 0; vi < 2; ++vi) { u32x2 w; w.x = pk2(Sacc[vi][0] * R.vem[0], Sacc[vi][1] * R.vem[1]); w.y = pk2(Sacc[vi][2] * R.vem[2], Sacc[vi][3] * R.vem[3]); *(LAS u32x2*)(ST + (16 * vi + fr) * 136 + 16 * wid + 4 * fq) = w; }
        cel = R.vel; celm = R.velm;
    };
    auto compute = [&](int b, int c) {
        const LAS bf16_t* QT = (const LAS bf16_t*)(lds + b * MXB + MXB_QT); const LAS bf16_t* KTT = (const LAS bf16_t*)(lds + b * MXB + MXB_KTT);
        const LAS bf16_t* VT = (const LAS bf16_t*)(lds + b * MXB + MXB_VT); const LAS bf16_t* PP = (const LAS bf16_t*)(lds + b * MXB + MXB_PP); const LAS bf16_t* ST = (const LAS bf16_t*)(lds + MX_ST + b * 8704);
        { const int ti = wid >> 1, vi = wid & 1; f32x4 o = {0.f, 0.f, 0.f, 0.f};
#pragma unroll
          for (int kk = 0; kk < 2; ++kk) { const bf16x8 A = *(const LAS bf16x8*)(VT + (16 * vi + fr) * 72 + 32 * kk + 8 * fq), B = *(const LAS bf16x8*)(PP + (16 * ti + fr) * 72 + 32 * kk + 8 * fq); o = MFMA16(A, B, o); }
#pragma unroll
          for (int kk = 0; kk < 4; ++kk) { const bf16x8 A = *(const LAS bf16x8*)(ST + (16 * vi + fr) * 136 + 32 * kk + 8 * fq), B = *(const LAS bf16x8*)(QT + (16 * ti + fr) * 136 + 32 * kk + 8 * fq); o = MFMA16(A, B, o); }
          u32x2 w; w.x = pk2(o[0], o[1]); w.y = pk2(o[2], o[3]);
          *(u32x2*)(a.proj + (a.row0 + (size_t)c * 64 + 16 * ti + fr) * a.ld + a.vcol + 16 * vi + 4 * fq) = w; }
#pragma unroll
        for (int vi = 0; vi < 2; ++vi) { f32x4 u = {0.f, 0.f, 0.f, 0.f};
#pragma unroll
            for (int kk = 0; kk < 2; ++kk) { const bf16x8 A = *(const LAS bf16x8*)(KTT + (16 * wid + fr) * 72 + 32 * kk + 8 * fq), B = *(const LAS bf16x8*)(VT + (16 * vi + fr) * 72 + 32 * kk + 8 * fq); u = MFMA16(A, B, u); }
            Sacc[vi] = Sacc[vi] * cel + u * celm; }
    };
    const int n = a.nchunks;
    issue_loads(R0, 0);
    if (n > 1) issue_loads(R1, 1);
    fill(0, R0);
    if (n > 2) issue_loads(R0, 2);
    for (int c = 0; c < n; c += 2) {
        __syncthreads();
        compute(0, c);
        if (c + 1 < n) { fill(1, R1); if (c + 3 < n) issue_loads(R1, c + 3); }
        if (c + 1 < n) {
            __syncthreads();
            compute(1, c + 1);
            if (c + 2 < n) { fill(0, R0); if (c + 4 < n) issue_loads(R0, c + 4); }
        }
    }
#pragma unroll
    for (int vi = 0; vi < 2; ++vi)
#pragma unroll
        for (int j = 0; j < 4; ++j) a.sout[(size_t)(16 * wid + 4 * fq + j) * a.sstride + 16 * vi + fr] = Sacc[vi][j];
    __syncthreads();
}

constexpr int AT_PITCH = 264, AT_KOFF = 128 * AT_PITCH * 2, AT_KP = 136;
static_assert(AT_KOFF + 256 * AT_KP * 2 <= LDS_ST_OFF, "attention LDS");
__device__ __forceinline__ void mem_attn(LAS unsigned char* lds, const bf16_t* Kb, const bf16_t* Vb, bf16_t* Q, int ld, int nrows) {
    int tid_ = threadIdx.x; asm volatile("" : "+v"(tid_));
    const int tid = tid_, wid = __builtin_amdgcn_readfirstlane(tid >> 6), lane = tid & 63, fr = lane & 15, fq = lane >> 4;
    LAS bf16_t* VT = (LAS bf16_t*)lds;
    LAS bf16_t* KS = (LAS bf16_t*)(lds + AT_KOFF);
#pragma unroll
    for (int it = 0; it < 8; ++it) { const int idx = tid + NTHR * it, key = idx >> 4, v8 = (idx & 15) * 8; const u32x4 v = *(const u32x4*)(Vb + (size_t)key * 512 + v8), kx = *(const u32x4*)(Kb + (size_t)key * 512 + v8);
        *(LAS u32x4*)(KS + key * AT_KP + v8) = kx;
#pragma unroll
        for (int i = 0; i < 8; ++i) VT[(v8 + i) * AT_PITCH + key] = (bf16_t)((i & 1) ? (v[i >> 1] >> 16) : (v[i >> 1] & 0xffffu)); }
    __syncthreads();
    const float sc = 0.08838834764831845f;
    for (int q0 = wid * 16; q0 < nrows; q0 += 128) {
        bf16x8 Qf0, Qf1, Qf2, Qf3;
        { const bf16_t* qp = Q + (size_t)(q0 + fr) * ld + 8 * fq; Qf0 = *(const bf16x8*)(qp); Qf1 = *(const bf16x8*)(qp + 32); Qf2 = *(const bf16x8*)(qp + 64); Qf3 = *(const bf16x8*)(qp + 96); }
        f32x4 s[16];
#pragma unroll
        for (int a = 0; a < 16; ++a) {
            const LAS bf16_t* kp = KS + (16 * a + fr) * AT_KP + 8 * fq;
            f32x4 t = {0.f, 0.f, 0.f, 0.f};
            t = MFMA16(*(const LAS bf16x8*)(kp), Qf0, t); t = MFMA16(*(const LAS bf16x8*)(kp + 32), Qf1, t); t = MFMA16(*(const LAS bf16x8*)(kp + 64), Qf2, t); t = MFMA16(*(const LAS bf16x8*)(kp + 96), Qf3, t);
            s[a] = t;
            if ((a & 3) == 3) asm volatile("" ::: "memory");
        }
        float mx = -3.0e38f;
#pragma unroll
        for (int a = 0; a < 16; ++a) mx = fmaxf(fmaxf(mx, fmaxf(s[a][0], s[a][1])), fmaxf(s[a][2], s[a][3]));
        mx = fmaxf(mx, __shfl_xor(mx, 16)); mx = fmaxf(mx, __shfl_xor(mx, 32));
        float sum = 0.f; u32x2 pk[16];
#pragma unroll
        for (int a = 0; a < 16; ++a) { const float e0 = __expf((s[a][0] - mx) * sc), e1 = __expf((s[a][1] - mx) * sc), e2 = __expf((s[a][2] - mx) * sc), e3 = __expf((s[a][3] - mx) * sc);
            sum += (e0 + e1) + (e2 + e3); pk[a].x = pk2(e0, e1); pk[a].y = pk2(e2, e3); }
        sum += __shfl_xor(sum, 16); sum += __shfl_xor(sum, 32);
        const float inv = 1.0f / sum;
        f32x4 o[8];
#pragma unroll
        for (int dt = 0; dt < 8; ++dt) o[dt] = (f32x4){0.f, 0.f, 0.f, 0.f};
#pragma unroll
        for (int ap = 0; ap < 8; ++ap) {
            const u32x4 bv = {pk[2 * ap].x, pk[2 * ap].y, pk[2 * ap + 1].x, pk[2 * ap + 1].y};
            const bf16x8 B = __builtin_bit_cast(bf16x8, bv);
#pragma unroll
            for (int dt = 0; dt < 8; ++dt) {
                const u32x2 lo = *(const LAS u32x2*)(VT + (16 * dt + fr) * AT_PITCH + 32 * ap + 4 * fq), hi = *(const LAS u32x2*)(VT + (16 * dt + fr) * AT_PITCH + 32 * ap + 16 + 4 * fq);
                const u32x4 av = {lo.x, lo.y, hi.x, hi.y};
                o[dt] = MFMA16(__builtin_bit_cast(bf16x8, av), B, o[dt]);
            }
        }
#pragma unroll
        for (int dt = 0; dt < 8; ++dt) { u32x2 w; w.x = pk2(o[dt][0] * inv, o[dt][1] * inv); w.y = pk2(o[dt][2] * inv, o[dt][3] * inv);
            *(u32x2*)(Q + (size_t)(q0 + fr) * ld + 16 * dt + 4 * fq) = w; }
    }
    __syncthreads();
}

__device__ __forceinline__ void mixprep_phase(LAS unsigned char* lds, const Params& p, int layer) {
    const int j = layer >> 1, gla = layer & 1, w = lbid(), G = gridDim.x;
    bf16_t* proj = (bf16_t*)(p.ws + WS_PROJ);
    const int ld = gla ? GL_LD : HG_LD, nh = gla ? 4 : 8;
    bf16_t* ktb = (bf16_t*)(p.ws + WS_XN);
    float* vec = (float*)(p.ws + WS_VEC);
    const int xq = gla ? 3584 : 4096;
    for (int it = w; it < 256 + 64; it += G) {
        const bf16_t* Kb; const bf16_t* Vb; bf16_t* Qp; int nrows;
        if (it < 256) { const int bh = it >> 3, grp = it & 7, b = bh >> 2, h = bh & 3;
            Kb = (const bf16_t*)(p.ws + WS_MKB) + ((size_t)layer * 2048 + b * 256) * 512 + h * 128;
            Vb = (const bf16_t*)(p.ws + WS_MVB) + ((size_t)layer * 2048 + b * 256) * 512 + h * 128;
            Qp = proj + ((size_t)b * 8192 + grp * 1024) * ld + xq + h * 128; nrows = 1024;
        } else { const int bh = it - 256, b = bh >> 2, h = bh & 3;
            Kb = (const bf16_t*)(p.ws + WS_CKB) + ((size_t)layer * 4096 + b * 256) * 512 + h * 128;
            Vb = (const bf16_t*)(p.ws + WS_CVB) + ((size_t)layer * 4096 + b * 256) * 512 + h * 128;
            Qp = proj + ((size_t)MP + b * 64) * ld + xq + h * 128; nrows = 64;
        }
        mem_attn(lds, Kb, Vb, Qp, ld, nrows);
    }
    { const int h = w % nh;
      mixprep_loop(lds, proj, ld, h * 128, (gla ? 512 : 1024) + h * 128, gla ? 1024 + h * 128 : 0, gla,
                   gla ? nullptr : p.in[13] + h * 128, gla ? nullptr : p.in[13] + 1024 + h * 128, j, gla ? p.in[18] + j * 512 + h * 128 : nullptr,
                   ktb + (size_t)h * 8192, nh, vec + h * 128, w / nh, G / nh); }
}
__device__ __forceinline__ void chain_phase(LAS unsigned char* lds, const Params& p, int layer) {
    const int j = layer >> 1, gla = layer & 1, w = lbid(), G = gridDim.x;
    bf16_t* proj = (bf16_t*)(p.ws + WS_PROJ);
    const int ld = gla ? GL_LD : HG_LD;
    const int nvs = gla ? 8 : 4, nh = gla ? 4 : 8, vdim = gla ? 256 : 128;
    const bf16_t* ktb = (const bf16_t*)(p.ws + WS_XN);
    const float* vec = (const float*)(p.ws + WS_VEC);
    const int n_prompt = 8 * nh * nvs  , n_sample = 16 * nh * nvs  ;
    for (int it = w; it < n_prompt + n_sample; it += G) {
        const bool smp = it >= n_prompt; const int id = smp ? it - n_prompt : it;
        const int lo = id & 7, rest = id >> 3, vs = rest % nvs, hi = rest / nvs, bh = lo + 8 * hi, b = bh / nh, h = bh % nh;
        ChainArgs a;
        a.proj = proj; a.ld = ld;
        a.row0 = smp ? (size_t)MP + (size_t)b * 64 : (size_t)b * 8192; a.nchunks = smp ? 1 : 128;
        const int ci0 = smp ? 1024 + b : b * 128;
        if (gla) { a.qcol = h * 128; a.kcol = 512 + h * 128; a.vcol = 2560 + h * 256 + 32 * vs; }
        else { a.qcol = h * 128; a.kcol = 1024 + h * 128; a.vcol = 3072 + h * 128 + 32 * vs; }
        a.ktb = ktb + ((size_t)ci0 * nh + h) * 8192; a.ktb_stride = (size_t)nh * 8192;
        a.em = vec + (size_t)ci0 * 1024 + h * 128; a.el = a.em + (size_t)NCHUNK * 1024; a.elm = a.el + (size_t)NCHUNK * 1024; a.vec_stride = 1024;
        const size_t per_b = (size_t)nh * 128 * vdim, so = ((size_t)b * nh + h) * 128 * vdim + 32 * vs;
        if (smp) { a.s0 = (gla ? p.in[6] : p.in[5]) + (size_t)j * 16 * per_b + so; a.sout = p.out + (gla ? O_SGS : O_SHS) + (size_t)j * 16 * per_b + so; }
        else { a.s0 = nullptr; a.sout = p.out + (gla ? O_SGP : O_SHP) + (size_t)j * 8 * per_b + so; }
        a.sstride = vdim;
        mixer_chain(lds, a);
    }
}

#define XB_TMO      128
#define XB_XCNT(j)  (256  + 64 * (j))
#define XB_XSUB(j)  (1280 + 64 * (j))
#define XB_XGEN(j)  (2304 + 64 * (j))
#define XB_TOP      3328
#define XB_TOPGEN   3392
#define XCD_BAR_WORDS 3456
#define XB_SPIN_CAP (1u << 22)
__device__ __forceinline__ unsigned xb_ld(unsigned* p)              { return __hip_atomic_load(p, __ATOMIC_RELAXED, __HIP_MEMORY_SCOPE_AGENT); }
__device__ __forceinline__ unsigned xb_add(unsigned* p, unsigned v) { return __hip_atomic_fetch_add(p, v, __ATOMIC_RELAXED, __HIP_MEMORY_SCOPE_AGENT); }
__device__ __forceinline__ unsigned xb_xcc_id() { return (unsigned)__builtin_amdgcn_s_getreg((3 << 11) | 20) & 0xFu; }
#define XB_SPIN(cond, bar) do { unsigned _sp = 0; while (cond) { __builtin_amdgcn_s_sleep(1); \
    if ((++_sp & 255u) == 0u) { if (xb_ld(&(bar)[XB_TMO])) break; if (_sp > XB_SPIN_CAP) { atomicAdd(&(bar)[XB_TMO], 1u); break; } } } } while (0)
struct XcdBarrier { unsigned* bar; unsigned x; volatile LAS unsigned* st; };
__device__ __forceinline__ XcdBarrier xcd_barrier_post(unsigned* bar, volatile LAS unsigned* st) {
    XcdBarrier b; b.bar = bar; b.x = xb_xcc_id(); b.st = st;
    if (threadIdx.x == 0) (void)xb_add(&bar[XB_XCNT(b.x)], 1u);
    return b;
}
__device__ __forceinline__ void xcd_barrier_complete(unsigned* bar, unsigned x, unsigned& nloc, unsigned& nx) {
    const unsigned G = gridDim.x * gridDim.y * gridDim.z;
    unsigned sum, cnt, mine, sp = 0u;
    for (;;) {
        sum = 0u; cnt = 0u; mine = 0u;
#pragma unroll
        for (unsigned j = 0; j < 16; ++j) { const unsigned c = xb_ld(&bar[XB_XCNT(j)]); sum += c; cnt += (c > 0u) ? 1u : 0u; mine = (j == x) ? c : mine; }
        if (sum == G) break;
        __builtin_amdgcn_s_sleep(1);
        if ((++sp & 255u) == 0u) { if (xb_ld(&bar[XB_TMO])) break; if (sp > XB_SPIN_CAP) { atomicAdd(&bar[XB_TMO], 1u); break; } }
    }
    nloc = mine > 0u ? mine : 1u; nx = cnt > 0u ? cnt : 1u;
}
__device__ __forceinline__ void xcd_barrier(const XcdBarrier& b) {
    asm volatile("s_waitcnt vmcnt(0)" ::: "memory");
    __syncthreads();
    if (threadIdx.x == 0) {
        unsigned* bar = b.bar;
        __builtin_amdgcn_s_waitcnt(0);
        unsigned nloc = b.st[0], nx = b.st[1];
        if (nloc == 0u) { xcd_barrier_complete(bar, b.x, nloc, nx); b.st[0] = nloc; b.st[1] = nx; }
        const unsigned old = xb_add(&bar[XB_XSUB(b.x)], 1u);
        const unsigned gen = old / nloc;
        if (old + 1u == (gen + 1u) * nloc) {
            __builtin_amdgcn_fence(__ATOMIC_RELEASE, "agent");
            asm volatile("s_waitcnt vmcnt(0)" ::: "memory");
            const unsigned og = xb_add(&bar[XB_TOP], 1u);
            const unsigned tg = og / nx;
            if (og + 1u == (tg + 1u) * nx) xb_add(&bar[XB_TOPGEN], 1u);
            else XB_SPIN(xb_ld(&bar[XB_TOPGEN]) == tg, bar);
            __builtin_amdgcn_fence(__ATOMIC_ACQUIRE, "agent");
            xb_add(&bar[XB_XGEN(b.x)], 1u);
            asm volatile("s_waitcnt vmcnt(0)" ::: "memory");
        } else {
            XB_SPIN(xb_ld(&bar[XB_XGEN(b.x)]) == gen, bar);
            __builtin_amdgcn_fence(__ATOMIC_ACQUIRE, "agent");
            asm volatile("s_waitcnt vmcnt(0)" ::: "memory");
        }
    }
    __syncthreads();
}

constexpr int PPL = 9;
constexpr int NPHASE = 2 + 4 * PPL + 1;
#define WSB(off) ((bf16_t*)(p.ws + (off)))
#define STATS(li) ((float*)(p.ws + WS_STATS) + (size_t)(li) * MROWS * 2)
__global__ void __launch_bounds__(NTHR, 2) trunk_fwd(Params p) {
    extern __shared__ __attribute__((aligned(16))) unsigned char lds_raw[];
    LAS unsigned char* lds = (LAS unsigned char*)lds_raw;
    if (p.ph_hi - p.ph_lo > 1) {
        if (threadIdx.x < 4) ((LAS unsigned*)(lds + LDS_ST_OFF))[threadIdx.x] = 0u;
        __syncthreads();
        (void)xcd_barrier_post((unsigned*)(p.ws + WS_BAR), (volatile LAS unsigned*)(lds + LDS_ST_OFF));
    }
    for (int ph = p.ph_lo; ph < p.ph_hi; ++ph) {
        if (ph == 0) prep_phase(lds, p);
        else if (ph == 1) { }
        else if (false) { Epi E{EPI_MEMKV, nullptr, 0, nullptr, 0.f, p.out + O_MK, p.out + O_MV, WSB(WS_MKB), WSB(WS_MVB), nullptr, nullptr, nullptr, nullptr, nullptr};
            gemm_phase<EPI_MEMKV>(lds, WSB(WS_MEMP), 1024, WSB(WS_MEMW), 2048, 4096, 1024, E); }
        else if (ph == NPHASE - 1) ln_phase(p.out + O_Y, nullptr, p.in[10] + 11 * 1024, p.in[11] + 11 * 1024);
        else {
            const int layer = (ph - 2) / PPL, s = (ph - 2) % PPL, gla = layer & 1, j = layer >> 1;
            if (s == 0 || s == 7) {
                const int lf = layer * 2 + (s == 7), li = (s == 7) ? 3 * layer + 1 : 3 * layer - 1;
                const float* cv = (const float*)(p.ws + WS_CV_WGU) + (size_t)lf * 2 * 5632;
                Epi E{EPI_SWIGLU, WSB(WS_PROJ), FF, nullptr, 0.f, nullptr, nullptr, nullptr, nullptr, li >= 0 ? STATS(li) : nullptr, cv, cv + 5632, nullptr, nullptr};
                gemm_phase<EPI_SWIGLU>(lds, WSB(WS_XN), 1024, WSB(WS_WGU) + (size_t)lf * 5632 * 1024, MROWS, 5632, 1024, E);
                if (ph == 2) { Epi Em{EPI_MEMKV, nullptr, 0, nullptr, 0.f, p.out + O_MK, p.out + O_MV, WSB(WS_MKB), WSB(WS_MVB), nullptr, nullptr, nullptr, nullptr, nullptr};
                    gemm_phase<EPI_MEMKV>(lds, WSB(WS_MEMP), 1024, WSB(WS_MEMW), 2048, 4096, 1024, Em); } }
            else if (s == 1 || s == 8) {
                const int lf = layer * 2 + (s == 8), li_in = (s == 8) ? 3 * layer + 1 : 3 * layer - 1, li_out = (s == 8) ? 3 * layer + 2 : 3 * layer;
                Epi E{EPI_RES, nullptr, 0, p.out + O_Y, 0.5f, nullptr, nullptr, nullptr, nullptr, li_in >= 0 ? STATS(li_in) : nullptr,
                      li_in >= 0 ? p.in[10] + li_in * 1024 : nullptr, li_in >= 0 ? p.in[11] + li_in * 1024 : nullptr, STATS(li_out), WSB(WS_XN)};
                gemm_phase<EPI_RES>(lds, WSB(WS_PROJ), FF, WSB(WS_WD) + (size_t)lf * 1024 * FF, MP, 1024, FF, E);
                gemm_phase<EPI_RES, true>(lds, WSB(WS_PROJ), FF, WSB(WS_WD) + (size_t)lf * 1024 * FF, MP, 1024, FF, E); }

            else if (s == 2) {
                const int li = 3 * layer;
                const float* cv = gla ? (const float*)(p.ws + WS_CV_GWIN) + (size_t)j * 2 * 4096 : (const float*)(p.ws + WS_CV_HWIN) + (size_t)j * 2 * 4608;
                Epi E{EPI_BF16, WSB(WS_PROJ), gla ? GL_LD : HG_LD, nullptr, 0.f, nullptr, nullptr, nullptr, nullptr, STATS(li), cv, cv + (gla ? 4096 : 4608), nullptr, nullptr};
                if (gla) gemm_phase<EPI_BF16>(lds, WSB(WS_XN), 1024, WSB(WS_GWIN) + (size_t)j * 4096 * 1024, MROWS, 4096, 1024, E);
                else gemm_phase<EPI_BF16>(lds, WSB(WS_XN), 1024, WSB(WS_HWIN) + (size_t)j * 4608 * 1024, MROWS, 4608, 1024, E); }
            else if (s == 3) mixprep_phase(lds, p, layer);
            else if (s == 4) chain_phase(lds, p, layer);
            else if (s == 5) { if (gla) headnorm_phase(WSB(WS_PROJ), GL_LD, 2560, 1536, 32, p.in[19] + j * 1024); else headnorm_phase(WSB(WS_PROJ), HG_LD, 3072, 2048, 16, p.in[14] + j * 1024); }
            else if (s == 6) {
                const int li_in = 3 * layer;
                Epi E{EPI_RES, nullptr, 0, p.out + O_Y, 1.0f, nullptr, nullptr, nullptr, nullptr, STATS(li_in), p.in[10] + li_in * 1024, p.in[11] + li_in * 1024, STATS(li_in + 1), WSB(WS_XN)};
                gemm_phase<EPI_RES>(lds, WSB(WS_PROJ) + (gla ? 2560 : 3072), gla ? GL_LD : HG_LD, WSB(WS_WOUT) + (size_t)layer * 1024 * 1536, MP, 1024, 1536, E);
                gemm_phase<EPI_RES, true>(lds, WSB(WS_PROJ) + (gla ? 2560 : 3072), gla ? GL_LD : HG_LD, WSB(WS_WOUT) + (size_t)layer * 1024 * 1536, MP, 1024, 1536, E); }

        }
        if (ph + 1 < p.ph_hi && ph != 1) {
            if (ph == 0) cg::this_grid().sync();
            else { XcdBarrier bar; bar.bar = (unsigned*)(p.ws + WS_BAR); bar.x = xb_xcc_id(); bar.st = (volatile LAS unsigned*)(lds + LDS_ST_OFF); xcd_barrier(bar); }
        }
    }
}
#undef WSB
#undef STATS

extern "C" void kernel_launch(void* const* d_in, const int* in_sizes, int n_in, void* d_out, int out_size, void* d_ws, size_t ws_size, hipStream_t stream) {
    static int grid = 0;
    if (grid == 0) {
        if (n_in != 23 || ws_size < WS_END) { fprintf(stderr, "kernel_launch: need 23 inputs and %zu bytes of workspace; got %d, %zu\n", (size_t)WS_END, n_in, ws_size); grid = -1; return; }
        if (hipFuncSetAttribute((const void*)trunk_fwd, hipFuncAttributeMaxDynamicSharedMemorySize, LDS_BYTES) != hipSuccess) { fprintf(stderr, "kernel_launch: hipFuncSetAttribute failed\n"); grid = -1; return; }
        int dev = 0, cus = 0, per_cu = 0;
        (void)hipGetDevice(&dev); (void)hipDeviceGetAttribute(&cus, hipDeviceAttributeMultiprocessorCount, dev);
        (void)hipOccupancyMaxActiveBlocksPerMultiprocessor(&per_cu, (const void*)trunk_fwd, NTHR, LDS_BYTES);
        if (per_cu < 1) { fprintf(stderr, "kernel_launch: occupancy query says %d blocks per CU\n", per_cu); per_cu = 1; }
        (void)hipGetLastError();
        grid = cus;
    }
    if (grid < 0) return;
    Params p{};
    for (int i = 0; i < 23; ++i) p.in[i] = (const float*)d_in[i];
    p.out = (float*)d_out; p.ws = (unsigned char*)d_ws;
#if ONE_LAUNCH
    (void)hipMemsetAsync((unsigned char*)d_ws + WS_BAR, 0, WS_ZERO_END - WS_BAR, stream);
    p.ph_lo = 0; p.ph_hi = NPHASE;
    void* args[] = {&p};
    hipError_t e = hipLaunchCooperativeKernel((const void*)trunk_fwd, dim3(grid), dim3(NTHR), args, LDS_BYTES, stream);
    if (e != hipSuccess) fprintf(stderr, "cooperative launch failed: %s (grid %d)\n", hipGetErrorString(e), grid);
#else
    (void)hipMemsetAsync((unsigned char*)d_ws + WS_BAR, 0, WS_ZERO_END - WS_BAR, stream);
    for (int ph = 0; ph < NPHASE; ++ph) {
        p.ph_lo = ph; p.ph_hi = ph + 1;
        hipLaunchKernelGGL(trunk_fwd, dim3(grid), dim3(NTHR), LDS_BYTES, stream, p);
    }
#endif
}
```

```cpp
#include <hip/hip_runtime.h>
#include <hip/hip_cooperative_groups.h>
#include <cstdio>
namespace cg = cooperative_groups;

#ifndef ONE_LAUNCH
#define ONE_LAUNCH 1
#endif

#define LAS __attribute__((address_space(3)))
typedef unsigned short bf16_t;
typedef short bf16x8 __attribute__((ext_vector_type(8)));
typedef float f32x4 __attribute__((ext_vector_type(4)));
typedef float f32x2 __attribute__((ext_vector_type(2)));
typedef unsigned u32x4 __attribute__((ext_vector_type(4)));
typedef unsigned u32x2 __attribute__((ext_vector_type(2)));
typedef __bf16 nbf2 __attribute__((ext_vector_type(2)));

constexpr int D = 1024, MP = 65536, MS = 1024, MROWS = MP + MS, FF = 2816;
constexpr int HG_LD = 4608, GL_LD = 4096;
constexpr float ALPHA = 1.6817928305074292f;
constexpr int NTHR = 512;
constexpr int LDS_BYTES = 144 * 1024;
constexpr int LDS_ST_OFF = 143360;
constexpr int NCHUNK = MROWS / 64;
constexpr int LDS_X = 131072;

constexpr size_t O_Y = 0;
constexpr size_t O_SHP = (size_t)MROWS * D;
constexpr size_t O_SGP = O_SHP + 2u * 8 * 8 * 128 * 128;
constexpr size_t O_MK = O_SGP + 2u * 8 * 4 * 128 * 256;
constexpr size_t O_MV = O_MK + 4u * 2048 * 512;
constexpr size_t O_SHS = O_MV + 4u * 2048 * 512;
constexpr size_t O_SGS = O_SHS + 2u * 16 * 8 * 128 * 128;

constexpr size_t WS_WGU = 0;
constexpr size_t WS_WD = WS_WGU + 8ull * 5632 * 1024 * 2;
constexpr size_t WS_HWIN = WS_WD + 8ull * 1024 * 2816 * 2;
constexpr size_t WS_GWIN = WS_HWIN + 2ull * 4608 * 1024 * 2;
constexpr size_t WS_WOUT = WS_GWIN + 2ull * 4096 * 1024 * 2;
constexpr size_t WS_MEMW = WS_WOUT + 4ull * 1024 * 1536 * 2;
constexpr size_t WS_MEMP = WS_MEMW + 4096ull * 1024 * 2;
constexpr size_t WS_MKB = WS_MEMP + 2048ull * 1024 * 2;
constexpr size_t WS_MVB = WS_MKB + 4ull * 2048 * 512 * 2;
constexpr size_t WS_CKB = WS_MVB + 4ull * 2048 * 512 * 2;
constexpr size_t WS_CVB = WS_CKB + 4ull * 4096 * 512 * 2;
constexpr size_t WS_XN = WS_CVB + 4ull * 4096 * 512 * 2;
constexpr size_t WS_PROJ = WS_XN + (size_t)MROWS * 1024 * 2;
constexpr size_t WS_VEC = WS_PROJ + (size_t)MROWS * 4608 * 2;
constexpr size_t WS_BAR = WS_VEC + 3ull * (MROWS / 64) * 1024 * 4;
constexpr size_t WS_STATS = WS_BAR + 16384;
constexpr size_t WS_CV_WGU = WS_STATS + 12ull * MROWS * 8;
constexpr size_t WS_CV_HWIN = WS_CV_WGU + 8ull * 2 * 5632 * 4;
constexpr size_t WS_CV_GWIN = WS_CV_HWIN + 2ull * 2 * 4608 * 4;
constexpr size_t WS_ZERO_END = WS_CV_GWIN + 2ull * 2 * 4096 * 4;
constexpr size_t WS_END = WS_ZERO_END;

struct Params {
    const float* in[23];
    float* out;
    unsigned char* ws;
    int ph_lo, ph_hi;
};

__device__ __forceinline__ unsigned pk2(float lo, float hi) { f32x2 v = {lo, hi}; nbf2 b = __builtin_convertvector(v, nbf2); return __builtin_bit_cast(unsigned, b); }
__device__ __forceinline__ float bflo(unsigned u) { return __uint_as_float(u << 16); }
__device__ __forceinline__ float bfhi(unsigned u) { return __uint_as_float(u & 0xffff0000u); }
__device__ __forceinline__ bf16_t f2bf(float f) { unsigned u = pk2(f, 0.f); return (bf16_t)(u & 0xffffu); }
__device__ __forceinline__ float sigmoidf_(float x) { return __builtin_amdgcn_rcpf(1.0f + __expf(-x)); }
__device__ __forceinline__ int ltid() { int t = threadIdx.x; asm volatile("" : "+v"(t)); return t; }
__device__ __forceinline__ int lbid() { int t = blockIdx.x; asm volatile("" : "+s"(t)); return t; }
#define MFMA16(a, b, c) __builtin_amdgcn_mfma_f32_16x16x32_bf16((a), (b), (c), 0, 0, 0)

constexpr int BM = 256, BK = 64, HALF = 128, HTB = HALF * BK * 2, NXCD = 8, WGM = 8;
__device__ __forceinline__ int lds_byte(int r, int c) { const int st = (r >> 4) * 2 + (c >> 5), rr = r & 15, cc = c & 31, ob = rr * 64 + cc * 2; return st * 1024 + (ob ^ (((ob >> 9) & 1) << 5)); }
__device__ __forceinline__ void stage_rc(int b, int& R, int& C) { const int st = b / 1024, sb = b % 1024, swz = sb ^ (((sb >> 9) & 1) << 5); R = (st >> 1) * 16 + swz / 64; C = (st & 1) * 32 + (swz % 64) / 2; }
__device__ __forceinline__ int perm32(int rho) { const int n = rho >> 4, i = rho & 15; return 8 * (i >> 2) + 4 * n + (i & 3); }

struct Unit { int pm, pn; };
struct StaticOrder {
    int nM, nN, nwg, G, c; bool rev;
    __device__ __forceinline__ void init(int M, int N, int G_, int c_, bool rev_ = false) { nM = M / BM; nN = N / BM; nwg = nM * nN; G = G_; c = c_; rev = rev_; }
    __device__ __forceinline__ bool next(int i, Unit& u) const {
        const long L = (long)i * G + c; if (L >= nwg) return false;
        int wgid = (int)L; { const int q = nwg / NXCD, r = nwg % NXCD, xcd = wgid % NXCD, off = wgid / NXCD; wgid = (xcd < r ? xcd * (q + 1) : r * (q + 1) + (xcd - r) * q) + off; }
        const int nig = WGM * nN, gid = wgid / nig, fm = gid * WGM, gsz = (nM - fm) < WGM ? (nM - fm) : WGM;
        u.pm = fm + ((wgid % nig) % gsz); u.pn = (wgid % nig) / gsz; if (rev) u.pm = nM - 1 - u.pm; return true;
    }
};

enum { EPI_SWIGLU = 0, EPI_BF16 = 1, EPI_RES = 2, EPI_MEMKV = 3 };
struct Epi { int mode; bf16_t* ob; int ldo; float* xf; float scale; float* mk_out; float* mv_out; bf16_t* mkb; bf16_t* mvb;
             const float* st_in; const float* v1; const float* v2; float* st_out; bf16_t* ybf; };
__device__ __forceinline__ void row_mu_rstd(const LAS float* XS, bool has, int rl, float& mu, float& rstd) {
    if (has) { const f32x2 q = *(const LAS f32x2*)(XS + 2 * rl); mu = q.x * (1.0f / 1024.0f); rstd = __builtin_amdgcn_rsqf(fmaxf(q.y * (1.0f / 1024.0f) - mu * mu, 0.f) + 1e-5f); }
    else { mu = 0.f; rstd = 1.0f; }
}

template <int MODE, bool HALFM> __device__ __forceinline__ void gemm_epilogue(const f32x4 (&acc)[2][2][4][2], const Unit& u, int rb, int wr, int wc, int fr, int fq, const Epi& E, LAS unsigned char* lds) {
    const int row0 = rb + wr * 64 + fr;
    const LAS float* XS = (const LAS float*)(lds + LDS_X); const bool has = (E.st_in != nullptr); const int rl0 = wr * 64 + fr;
    if constexpr (MODE == EPI_SWIGLU) {
        const int col0 = u.pn * 128 + wc * 32 + 8 * fq;
        const int cl = wc * 32 + 8 * fq;
        f32x4 c1g[2], c2g[2], c1u[2], c2u[2];
#pragma unroll
        for (int n = 0; n < 2; ++n) {
            if (has) { c1g[n] = *(const LAS f32x4*)(XS + 512 + cl + 4 * n); c2g[n] = *(const LAS f32x4*)(XS + 768 + cl + 4 * n); c1u[n] = *(const LAS f32x4*)(XS + 512 + cl + 128 + 4 * n); c2u[n] = *(const LAS f32x4*)(XS + 768 + cl + 128 + 4 * n); }
            else { c1g[n] = c2g[n] = c1u[n] = c2u[n] = (f32x4){0.f, 0.f, 0.f, 0.f}; }
        }
        float mus[2][4], rstds[2][4];
#pragma unroll
        for (int ai = 0; ai < 2; ++ai)
#pragma unroll
            for (int m = 0; m < 4; ++m) row_mu_rstd(XS, has, rl0 + ai * HALF + m * 16, mus[ai][m], rstds[ai][m]);
#pragma unroll
        for (int ai = 0; ai < 2; ++ai)
#pragma unroll
            for (int m = 0; m < 4; ++m) {
                const int row = row0 + ai * HALF + m * 16;
                const float mu = mus[ai][m], rstd = rstds[ai][m];
                bf16_t* rowp = E.ob + (size_t)row * E.ldo + col0;
                float h[8];
#pragma unroll
                for (int n = 0; n < 2; ++n)
#pragma unroll
                    for (int j = 0; j < 4; ++j) { const float g = rstd * (acc[ai][0][m][n][j] - mu * c1g[n][j]) + c2g[n][j], up = rstd * (acc[ai][1][m][n][j] - mu * c1u[n][j]) + c2u[n][j];
                        h[n * 4 + j] = g * up * __builtin_amdgcn_rcpf(1.0f + __expf(-g)); }
                u32x4 w; w.x = pk2(h[0], h[1]); w.y = pk2(h[2], h[3]); w.z = pk2(h[4], h[5]); w.w = pk2(h[6], h[7]);
                *(u32x4*)rowp = w;
            }
    } else if constexpr (MODE == EPI_BF16) {
        const int col0 = u.pn * BM + wc * 32 + 8 * fq, cl = wc * 32 + 8 * fq;
        f32x4 c1[2][2], c2[2][2];
#pragma unroll
        for (int bj = 0; bj < 2; ++bj)
#pragma unroll
            for (int n = 0; n < 2; ++n) { c1[bj][n] = *(const LAS f32x4*)(XS + 512 + cl + bj * HALF + 4 * n); c2[bj][n] = *(const LAS f32x4*)(XS + 768 + cl + bj * HALF + 4 * n); }
#pragma unroll
        for (int ai = 0; ai < 2; ++ai)
#pragma unroll
            for (int m = 0; m < 4; ++m) {
                const int row = row0 + ai * HALF + m * 16;
                float mu, rstd; row_mu_rstd(XS, has, rl0 + ai * HALF + m * 16, mu, rstd);
                bf16_t* rowp = E.ob + (size_t)row * E.ldo + col0;
#pragma unroll
                for (int bj = 0; bj < 2; ++bj) {
                    const f32x4 v0 = (acc[ai][bj][m][0] - c1[bj][0] * mu) * rstd + c2[bj][0], v1 = (acc[ai][bj][m][1] - c1[bj][1] * mu) * rstd + c2[bj][1];
                    u32x4 w; w.x = pk2(v0[0], v0[1]); w.y = pk2(v0[2], v0[3]); w.z = pk2(v1[0], v1[1]); w.w = pk2(v1[2], v1[3]);
                    *(u32x4*)(rowp + bj * HALF) = w;
                }
            }
    } else if constexpr (MODE == EPI_RES) {
        const int col0 = u.pn * BM + wc * 32 + 4 * fq, cl = wc * 32 + 4 * fq;
        constexpr int NG = HALFM ? 4 : 8;
#pragma unroll
        for (int bt = 0; bt < (NG + 2) / 3; ++bt) {
            const int g0 = bt * 3, ng = (NG - g0) < 3 ? (NG - g0) : 3;
            f32x4 xv[3][2][2];
#pragma unroll
            for (int gi = 0; gi < 3; ++gi) if (gi < ng) { const int g = g0 + gi, ai = g >> 2, m = g & 3; const float* rowp = E.xf + (size_t)(row0 + ai * HALF + m * 16) * D + col0;
#pragma unroll
                for (int bj = 0; bj < 2; ++bj)
#pragma unroll
                    for (int n = 0; n < 2; ++n) xv[gi][bj][n] = *(const f32x4*)(rowp + bj * HALF + n * 16); }
#pragma unroll
            for (int gi = 0; gi < 3; ++gi) if (gi < ng) {
                const int g = g0 + gi, ai = g >> 2, m = g & 3;
                const int row = row0 + ai * HALF + m * 16;
                float mu, rstd; row_mu_rstd(XS, has, rl0 + ai * HALF + m * 16, mu, rstd);
                float* rowp = E.xf + (size_t)row * D + col0; bf16_t* rowb = E.ybf + (size_t)row * D + col0;
                float s1 = 0.f, s2 = 0.f;
#pragma unroll
                for (int bj = 0; bj < 2; ++bj)
#pragma unroll
                    for (int n = 0; n < 2; ++n) { f32x4 x = xv[gi][bj][n];
                        if (has) { const f32x4 gp = *(const LAS f32x4*)(XS + 512 + cl + bj * HALF + n * 16), bp = *(const LAS f32x4*)(XS + 768 + cl + bj * HALF + n * 16); x = (x - mu) * rstd * gp + bp; }
                        x = x * ALPHA + acc[ai][bj][m][n] * E.scale;
                        *(f32x4*)(rowp + bj * HALF + n * 16) = x;
                        u32x2 w; w.x = pk2(x[0], x[1]); w.y = pk2(x[2], x[3]); *(u32x2*)(rowb + bj * HALF + n * 16) = w;
                        s1 += (x[0] + x[1]) + (x[2] + x[3]); s2 += (x[0] * x[0] + x[1] * x[1]) + (x[2] * x[2] + x[3] * x[3]); }
                s1 += __shfl_xor(s1, 16); s1 += __shfl_xor(s1, 32); s2 += __shfl_xor(s2, 16); s2 += __shfl_xor(s2, 32);
                if (fq == 0) { atomicAdd(E.st_out + 2 * (size_t)row, s1); atomicAdd(E.st_out + 2 * (size_t)row + 1, s2); }
            }
            asm volatile("" ::: "memory");
        }
    } else {
        const int colt = u.pn * BM; const int l = colt >> 10, kv = (colt >> 9) & 1, cc0 = (colt & 511) + wc * 32 + 4 * fq;
        float* of = (kv ? E.mv_out : E.mk_out) + (size_t)l * 2048 * 512;
        bf16_t* ob = (kv ? E.mvb : E.mkb) + (size_t)l * 2048 * 512;
#pragma unroll
        for (int ai = 0; ai < 2; ++ai)
#pragma unroll
            for (int m = 0; m < 4; ++m) {
                const size_t ro = (size_t)(row0 + ai * HALF + m * 16) * 512 + cc0;
#pragma unroll
                for (int bj = 0; bj < 2; ++bj)
#pragma unroll
                    for (int n = 0; n < 2; ++n) { const f32x4 v = acc[ai][bj][m][n]; *(f32x4*)(of + ro + bj * HALF + n * 16) = v; u32x2 w; w.x = pk2(v[0], v[1]); w.y = pk2(v[2], v[3]); *(u32x2*)(ob + ro + bj * HALF + n * 16) = w; }
            }
    }
}

template <int MODE, bool HALFM = false> __device__ __forceinline__ void gemm_phase(LAS unsigned char* lds, const bf16_t* Ag, int lda, const bf16_t* Btg, int M, int N, int K, const Epi& E) {
    int tid_ = threadIdx.x; asm volatile("" : "+v"(tid_));
    const int tid = tid_, wid = __builtin_amdgcn_readfirstlane(tid >> 6), lane = tid & 63, wr = wid >> 2, wc = wid & 3, fr = lane & 15, fq = lane >> 4;
    const int nt = K / BK;
    constexpr bool PERM = (MODE == EPI_SWIGLU || MODE == EPI_BF16);
    StaticOrder S; { const int G_ = (int)gridDim.x; int c_ = lbid(); if (MODE == EPI_MEMKV) c_ = (c_ + G_ / 2) % G_; S.init(M, N, G_, c_, MODE == EPI_RES); }
    unsigned voffA[2], voffB[2];
#pragma unroll
    for (int i = 0; i < 2; ++i) { int R, C; stage_rc(tid * 16 + i * 8192, R, C); const int Rb = PERM ? ((R & ~31) + perm32(R & 31)) : R;
        voffA[i] = (unsigned)(R * lda + C) * 2u; voffB[i] = (unsigned)(Rb * K + C) * 2u; }
    const size_t kstep = (size_t)(BK * 2);
    const size_t hstepA = (size_t)HALF * lda * 2, hstepB = (size_t)HALF * K * 2;
    const size_t tstepA = 2 * hstepA, tstepB = 2 * hstepB;
    const size_t hA1 = HALFM ? 0 : hstepA;
    const unsigned ldsw = (unsigned)wid * 1024u;
    const int aoff = lds_byte(wr * 64 + fr, fq * 8), boff = lds_byte(wc * 32 + fr, fq * 8);
#define PG8_SA(b, h) (((b) * 2 + (h)) * HTB)
#define PG8_SB(b, h) ((4 + (b) * 2 + (h)) * HTB)
#define PG8_STAGE(bufoff, gbase, voff) do { _Pragma("unroll") for (int _i = 0; _i < 2; ++_i) \
        __builtin_amdgcn_global_load_lds((const unsigned*)((const char*)(gbase) + (voff)[_i]), (LAS unsigned*)(lds + (bufoff) + ldsw + _i * 8192), 16, 0, 0); } while (0)
#define PG8_LDA(dst, b, h) do { _Pragma("unroll") for (int m = 0; m < 4; ++m) _Pragma("unroll") for (int k = 0; k < 2; ++k) dst[m][k] = *(const LAS bf16x8*)(lds + PG8_SA(b, h) + aoff + m * 2048 + k * 1024); } while (0)
#define PG8_LDB(dst, b, h) do { _Pragma("unroll") for (int n = 0; n < 2; ++n) _Pragma("unroll") for (int k = 0; k < 2; ++k) dst[n][k] = *(const LAS bf16x8*)(lds + PG8_SB(b, h) + boff + n * 2048 + k * 1024); } while (0)
#define PG8_MMA(ai, bj, At, Bt) do { __builtin_amdgcn_s_setprio(1); _Pragma("unroll") for (int m = 0; m < 4; ++m) _Pragma("unroll") for (int n = 0; n < 2; ++n) _Pragma("unroll") for (int k = 0; k < 2; ++k) \
        acc[ai][bj][m][n] = __builtin_amdgcn_mfma_f32_16x16x32_bf16(Bt[n][k], At[m][k], acc[ai][bj][m][n], 0, 0, 0); __builtin_amdgcn_s_setprio(0); } while (0)
#define PG8_WAIT_V(n) asm volatile("s_waitcnt vmcnt(" #n ")" ::: "memory")
#define PG8_WAIT_L(n) asm volatile("s_waitcnt lgkmcnt(" #n ")" ::: "memory")
#define PG8_BAR __builtin_amdgcn_s_barrier()
#define PG8_SCHED __builtin_amdgcn_sched_barrier(0)
    Unit cur, nxt; int ui = 0; int rb;
    if constexpr (HALFM) { const int c_ = S.c; if (c_ >= 8 * (N / BM)) return; cur.pm = M / 128 + (c_ & 7); cur.pn = c_ >> 3; rb = cur.pm * 128; }
    else { if (!S.next(0, cur)) return; rb = cur.pm * BM; }
    f32x4 acc[2][2][4][2];
#pragma unroll
    for (int a = 0; a < 2; ++a)
#pragma unroll
        for (int b = 0; b < 2; ++b)
#pragma unroll
            for (int m = 0; m < 4; ++m)
#pragma unroll
                for (int n = 0; n < 2; ++n) acc[a][b][m][n] = (f32x4){0.f, 0.f, 0.f, 0.f};
    bf16x8 At[4][2], B0[2][2], B1[2][2];
    const char* cA = (const char*)Ag + (size_t)cur.pm * (HALFM ? hstepA : tstepA); const char* cB = (const char*)Btg + (size_t)cur.pn * tstepB;
    PG8_STAGE(PG8_SB(0, 0), cB, voffB); PG8_STAGE(PG8_SA(0, 0), cA, voffA); PG8_STAGE(PG8_SB(0, 1), cB + hstepB, voffB); PG8_STAGE(PG8_SA(0, 1), cA + hA1, voffA);
    if (wr == 1) PG8_BAR;
    PG8_WAIT_V(4); PG8_BAR;
    PG8_STAGE(PG8_SB(1, 0), cB + kstep, voffB); PG8_STAGE(PG8_SA(1, 0), cA + kstep, voffA); PG8_STAGE(PG8_SB(1, 1), cB + hstepB + kstep, voffB);
    PG8_WAIT_V(6); PG8_BAR;
    for (;;) {
        const bool has_next = HALFM ? false : S.next(ui + 1, nxt);
        const char* nA = has_next ? (const char*)Ag + (size_t)nxt.pm * tstepA : cA; const char* nB = has_next ? (const char*)Btg + (size_t)nxt.pn * tstepB : cB;
        for (int t = 0; t < nt; t += 2) {
            const bool last = (t == nt - 2);
            if (MODE != EPI_MEMKV && t == nt - 4 && E.st_in != nullptr && wid < 4) {
                const char* gsrc = wid < 2 ? (const char*)(E.st_in + 2 * ((size_t)rb + (HALFM ? 0 : wid * 128))) : (const char*)((wid == 2 ? E.v1 : E.v2) + cur.pn * BM);
                __builtin_amdgcn_global_load_lds((const unsigned*)(gsrc + lane * 16), (LAS unsigned*)(lds + LDS_X + wid * 1024), 16, 0, 0);
            }
            const char* a1 = cA + (size_t)(t + 1) * kstep;
            const char* a2 = last ? nA : cA + (size_t)(t + 2) * kstep; const char* b2 = last ? nB : cB + (size_t)(t + 2) * kstep;
            const char* a3 = a2 + kstep; const char* b3 = b2 + kstep;
            PG8_LDB(B0, 0, 0); PG8_SCHED; PG8_LDA(At, 0, 0); PG8_STAGE(PG8_SA(1, 1), a1 + hA1, voffA);
            PG8_WAIT_L(8); PG8_BAR; PG8_WAIT_L(0); PG8_MMA(0, 0, At, B0); PG8_BAR; PG8_SCHED;
            PG8_LDB(B1, 0, 1); PG8_STAGE(PG8_SB(0, 0), b2, voffB);
            PG8_BAR; PG8_WAIT_L(0); PG8_MMA(0, 1, At, B1); PG8_BAR;
            if constexpr (!HALFM) PG8_LDA(At, 0, 1); PG8_STAGE(PG8_SA(0, 0), a2, voffA);
            PG8_BAR; PG8_WAIT_L(0); if constexpr (!HALFM) PG8_MMA(1, 0, At, B0); PG8_BAR; PG8_SCHED;
            PG8_STAGE(PG8_SB(0, 1), b2 + hstepB, voffB);
            PG8_WAIT_V(6); PG8_BAR; if constexpr (!HALFM) PG8_MMA(1, 1, At, B1); PG8_BAR;
            PG8_LDB(B0, 1, 0); PG8_SCHED; PG8_LDA(At, 1, 0); PG8_STAGE(PG8_SA(0, 1), a2 + hA1, voffA);
            PG8_WAIT_L(8); PG8_BAR; PG8_WAIT_L(0); PG8_MMA(0, 0, At, B0); PG8_BAR; PG8_SCHED;
            PG8_LDB(B1, 1, 1); PG8_STAGE(PG8_SB(1, 0), b3, voffB);
            PG8_BAR; PG8_WAIT_L(0); PG8_MMA(0, 1, At, B1); PG8_BAR;
            if constexpr (!HALFM) PG8_LDA(At, 1, 1); PG8_STAGE(PG8_SA(1, 0), a3, voffA);
            PG8_BAR; PG8_WAIT_L(0); if constexpr (!HALFM) PG8_MMA(1, 0, At, B0); PG8_BAR; PG8_SCHED;
            PG8_STAGE(PG8_SB(1, 1), b3 + hstepB, voffB);
            PG8_WAIT_V(6); PG8_BAR; if constexpr (!HALFM) PG8_MMA(1, 1, At, B1); PG8_BAR;
        }
        gemm_epilogue<MODE, HALFM>(acc, cur, rb, wr, wc, fr, fq, E, lds);
        if (!has_next) break;
#pragma unroll
        for (int a = 0; a < 2; ++a)
#pragma unroll
            for (int b = 0; b < 2; ++b)
#pragma unroll
                for (int m = 0; m < 4; ++m)
#pragma unroll
                    for (int n = 0; n < 2; ++n) acc[a][b][m][n] = (f32x4){0.f, 0.f, 0.f, 0.f};
        cur = nxt; cA = nA; cB = nB; ++ui; rb = cur.pm * BM;
    }
    PG8_WAIT_V(0);
    if (wr == 0) PG8_BAR;
    PG8_BAR;
#undef PG8_SA
#undef PG8_SB
#undef PG8_STAGE
#undef PG8_LDA
#undef PG8_LDB
#undef PG8_MMA
#undef PG8_WAIT_V
#undef PG8_WAIT_L
#undef PG8_BAR
#undef PG8_SCHED
}

__device__ __forceinline__ void transpose_job(LAS unsigned char* lds, const float* src, int ld, int K, int c0, int ncols, bf16_t* dst, int rowmode, int drow0,
                                              const float* gk, const float* bk, float* c1, float* c2) {
    LAS float* tile = (LAS float*)lds;
    int tid_ = threadIdx.x; asm volatile("" : "+v"(tid_)); const int tid = tid_;
    const int nkt = K / 64, nct = ncols / 64, ntiles = nkt * nct;
    const int kr = tid >> 4, c4 = (tid & 15) * 4;
    f32x4 pv[2];
    { const int t = lbid(); if (t < ntiles) { const int k0 = (t % nkt) * 64, n0 = (t / nkt) * 64;
#pragma unroll
        for (int rr = 0; rr < 2; ++rr) pv[rr] = *(const f32x4*)(src + (size_t)(k0 + kr + 32 * rr) * ld + c0 + n0 + c4); } }
    for (int t = lbid(); t < ntiles; t += gridDim.x) {
        const int kt = t % nkt, ct = t / nkt;
        const int k0 = kt * 64, n0 = ct * 64;
#pragma unroll
        for (int rr = 0; rr < 2; ++rr) { const f32x4 v = pv[rr];
            tile[(kr + 32 * rr) * 65 + c4 + 0] = v[0]; tile[(kr + 32 * rr) * 65 + c4 + 1] = v[1]; tile[(kr + 32 * rr) * 65 + c4 + 2] = v[2]; tile[(kr + 32 * rr) * 65 + c4 + 3] = v[3]; }
        { const int tn = t + gridDim.x; if (tn < ntiles) { const int k1 = (tn % nkt) * 64, n1 = (tn / nkt) * 64;
#pragma unroll
            for (int rr = 0; rr < 2; ++rr) pv[rr] = *(const f32x4*)(src + (size_t)(k1 + kr + 32 * rr) * ld + c0 + n1 + c4); } }
        __syncthreads();
        { const int n = tid >> 3, k8 = (tid & 7) * 8; float v[8];
#pragma unroll
          for (int i = 0; i < 8; ++i) v[i] = tile[(k8 + i) * 65 + n];
          const int c = c0 + n0 + n; int drow;
          if (rowmode == 0) drow = drow0 + c; else drow = 256 * (c >> 7) + (c & 127) + (rowmode == 2 ? 128 : 0);
          u32x4 w;
          if (gk) {
              const f32x4 g0 = *(const f32x4*)(gk + k0 + k8), g1 = *(const f32x4*)(gk + k0 + k8 + 4), b0 = *(const f32x4*)(bk + k0 + k8), b1 = *(const f32x4*)(bk + k0 + k8 + 4);
              float s2 = 0.f;
#pragma unroll
              for (int i = 0; i < 4; ++i) { s2 += b0[i] * v[i] + b1[i] * v[4 + i]; v[i] *= g0[i]; v[4 + i] *= g1[i]; }
              w.x = pk2(v[0], v[1]); w.y = pk2(v[2], v[3]); w.z = pk2(v[4], v[5]); w.w = pk2(v[6], v[7]);
              float s1 = 0.f;
#pragma unroll
              for (int i = 0; i < 4; ++i) s1 += bflo(w[i]) + bfhi(w[i]);
              s1 += __shfl_xor(s1, 1); s1 += __shfl_xor(s1, 2); s1 += __shfl_xor(s1, 4);
              s2 += __shfl_xor(s2, 1); s2 += __shfl_xor(s2, 2); s2 += __shfl_xor(s2, 4);
              if ((tid & 7) == 0) { atomicAdd(c1 + drow, s1); atomicAdd(c2 + drow, s2); }
          } else { w.x = pk2(v[0], v[1]); w.y = pk2(v[2], v[3]); w.z = pk2(v[4], v[5]); w.w = pk2(v[6], v[7]); }
          *(u32x4*)(dst + (size_t)drow * K + k0 + k8) = w; }
        __syncthreads();
    }
}
__device__ __forceinline__ void convert_job(const float* src, bf16_t* dst, float* dstf, size_t n) {
    const size_t nv = n / 8, stride = (size_t)gridDim.x * NTHR;
    for (size_t i = (size_t)lbid() * NTHR + ltid(); i < nv; i += 2 * stride) {
        const size_t i2 = i + stride; const bool two = i2 < nv;
        const f32x4 a = *(const f32x4*)(src + i * 8), b = *(const f32x4*)(src + i * 8 + 4);
        f32x4 c = a, d = b; if (two) { c = *(const f32x4*)(src + i2 * 8); d = *(const f32x4*)(src + i2 * 8 + 4); }
        u32x4 w; w.x = pk2(a[0], a[1]); w.y = pk2(a[2], a[3]); w.z = pk2(b[0], b[1]); w.w = pk2(b[2], b[3]);
        *(u32x4*)(dst + i * 8) = w;
        if (dstf) { *(f32x4*)(dstf + i * 8) = a; *(f32x4*)(dstf + i * 8 + 4) = b; }
        if (two) { w.x = pk2(c[0], c[1]); w.y = pk2(c[2], c[3]); w.z = pk2(d[0], d[1]); w.w = pk2(d[2], d[3]);
            *(u32x4*)(dst + i2 * 8) = w;
            if (dstf) { *(f32x4*)(dstf + i2 * 8) = c; *(f32x4*)(dstf + i2 * 8 + 4) = d; } }
    }
}
__device__ __forceinline__ void prep_phase(LAS unsigned char* lds, const Params& p) {
    unsigned char* ws = p.ws;
    for (int jb = 0; jb < 52; ++jb) {
        const float* src; int ld, K, c0, ncols, rowmode, drow0; bf16_t* dst; int li = -1; float* cv = nullptr; int cvn = 0;
        if (jb < 24) { const int lf = jb / 3, t = jb % 3;
            if (t < 2) { src = (t == 0 ? p.in[7] : p.in[8]) + (size_t)lf * 1024 * FF; ld = FF; K = 1024; c0 = 0; ncols = FF; dst = (bf16_t*)(ws + WS_WGU) + (size_t)lf * 5632 * 1024; rowmode = 1 + t; drow0 = 0;
                if (lf > 0) { li = (lf & 1) ? 3 * (lf >> 1) + 1 : 3 * (lf >> 1) - 1; cv = (float*)(ws + WS_CV_WGU) + (size_t)lf * 2 * 5632; cvn = 5632; } }
            else { src = p.in[9] + (size_t)lf * FF * 1024; ld = 1024; K = FF; c0 = 0; ncols = 1024; dst = (bf16_t*)(ws + WS_WD) + (size_t)lf * 1024 * FF; rowmode = 0; drow0 = 0; }
        } else if (jb < 44) { const int j = (jb - 24) / 10, t = (jb - 24) % 10; rowmode = 0; K = 1024;
            if (t < 4) {
                src = p.in[12] + (size_t)j * 1024 * 4608; ld = 4608; dst = (bf16_t*)(ws + WS_HWIN) + (size_t)j * 4608 * 1024;
                c0 = t == 0 ? 0 : (t == 1 ? 3072 : (t == 2 ? 2048 : 4096)); ncols = t == 0 ? 2048 : (t == 3 ? 512 : 1024); drow0 = (t == 0 ? 0 : (t == 1 ? 2048 : (t == 2 ? 3072 : 4096))) - c0;
                li = 3 * (2 * j); cv = (float*)(ws + WS_CV_HWIN) + (size_t)j * 2 * 4608; cvn = 4608;
            } else if (t < 8) {
                src = p.in[16] + (size_t)j * 1024 * 3600; ld = 3600; dst = (bf16_t*)(ws + WS_GWIN) + (size_t)j * 4096 * 1024; const int u = t - 4;
                c0 = u == 0 ? 0 : (u == 1 ? 2048 : (u == 2 ? 1024 : 3088)); ncols = u == 3 ? 512 : 1024; drow0 = (u == 0 ? 0 : (u == 1 ? 1536 : (u == 2 ? 2560 : 3584))) - c0;
                li = 3 * (2 * j + 1); cv = (float*)(ws + WS_CV_GWIN) + (size_t)j * 2 * 4096; cvn = 4096;
            } else { src = (t == 8 ? p.in[15] : p.in[20]) + (size_t)j * 1536 * 1024; ld = 1024; K = 1536; c0 = 0; ncols = 1024; dst = (bf16_t*)(ws + WS_WOUT) + (size_t)(2 * j + (t - 8)) * 1024 * 1536; drow0 = 0; }
        } else { const int l = (jb - 44) >> 1, kv = (jb - 44) & 1; src = (kv ? p.in[22] : p.in[21]) + (size_t)l * 1024 * 512; ld = 512; K = 1024; c0 = 0; ncols = 512; dst = (bf16_t*)(ws + WS_MEMW); rowmode = 0; drow0 = l * 1024 + kv * 512; }
        const float* gk = li >= 0 ? p.in[10] + li * 1024 : nullptr; const float* bk = li >= 0 ? p.in[11] + li * 1024 : nullptr;
        transpose_job(lds, src, ld, K, c0, ncols, dst, rowmode, drow0, gk, bk, cv, cv + cvn);
    }
    for (int j = 0; j < 2; ++j) {
        const float* gs = p.in[16] + (size_t)j * 1024 * 3600; bf16_t* gd = (bf16_t*)(ws + WS_GWIN) + (size_t)j * 4096 * 1024;
        const float* w2 = p.in[17] + (size_t)j * 16 * 512;
        const int li = 3 * (2 * j + 1); const float* gk = p.in[10] + li * 1024; const float* bk = p.in[11] + li * 1024;
        float* c1 = (float*)(ws + WS_CV_GWIN) + (size_t)j * 2 * 4096; float* c2 = c1 + 4096;
        for (int i = lbid() * NTHR + ltid(); i < 512 * 1024; i += gridDim.x * NTHR) {
            const int c = i >> 10, kk = i & 1023; float sacc = 0.f;
#pragma unroll
            for (int r = 0; r < 16; ++r) sacc += gs[(size_t)kk * 3600 + 3072 + r] * w2[r * 512 + c];
            const bf16_t hv = f2bf(sacc * gk[kk]);
            gd[(size_t)(1024 + c) * 1024 + kk] = hv;
            float s1 = __uint_as_float(((unsigned)hv) << 16), s2 = sacc * bk[kk];
#pragma unroll
            for (int o = 32; o >= 1; o >>= 1) { s1 += __shfl_xor(s1, o); s2 += __shfl_xor(s2, o); }
            if ((kk & 63) == 0) { atomicAdd(c1 + 1024 + c, s1); atomicAdd(c2 + 1024 + c, s2); }
        }
    }
    for (int jb = 0; jb < 5; ++jb) {
        const float* src; bf16_t* dst; float* dstf = nullptr; size_t n;
        if (jb == 0) { src = p.in[0]; dst = (bf16_t*)(ws + WS_XN); dstf = p.out + O_Y; n = (size_t)MP * D; }
        else if (jb == 1) { src = p.in[1]; dst = (bf16_t*)(ws + WS_XN) + (size_t)MP * D; dstf = p.out + O_Y + (size_t)MP * D; n = (size_t)MS * D; }
        else if (jb == 2) { src = p.in[2]; dst = (bf16_t*)(ws + WS_MEMP); n = (size_t)2048 * 1024; }
        else if (jb == 3) { src = p.in[3]; dst = (bf16_t*)(ws + WS_CKB); n = (size_t)4 * 4096 * 512; }
        else { src = p.in[4]; dst = (bf16_t*)(ws + WS_CVB); n = (size_t)4 * 4096 * 512; }
        convert_job(src, dst, dstf, n);
    }
}

__device__ __forceinline__ void ln_phase(float* x, bf16_t* xn, const float* gain, const float* bias) {
    int tid_ = threadIdx.x; asm volatile("" : "+v"(tid_));
    const int lane = tid_ & 63, wv = tid_ >> 6;
    f32x4 g[4], b[4];
#pragma unroll
    for (int i = 0; i < 4; ++i) { g[i] = *(const f32x4*)(gain + 4 * lane + 256 * i); b[i] = *(const f32x4*)(bias + 4 * lane + 256 * i); }
    const int rstep = gridDim.x * 8;
    int row = lbid() * 8 + wv;
    f32x4 nv[4];
    if (row < MROWS) {
#pragma unroll
        for (int i = 0; i < 4; ++i) nv[i] = *(const f32x4*)(x + (size_t)row * D + 4 * lane + 256 * i); }
    for (; row < MROWS; row += rstep) {
        float* xr = x + (size_t)row * D; f32x4 v[4]; float s = 0.f;
#pragma unroll
        for (int i = 0; i < 4; ++i) { v[i] = nv[i]; s += (v[i][0] + v[i][1]) + (v[i][2] + v[i][3]); }
        if (row + rstep < MROWS) {
#pragma unroll
            for (int i = 0; i < 4; ++i) nv[i] = *(const f32x4*)(x + (size_t)(row + rstep) * D + 4 * lane + 256 * i); }
#pragma unroll
        for (int o = 32; o >= 1; o >>= 1) s += __shfl_xor(s, o);
        const float mu = s * (1.0f / 1024.0f); float q = 0.f;
#pragma unroll
        for (int i = 0; i < 4; ++i) { const f32x4 d = v[i] - mu; q += (d[0] * d[0] + d[1] * d[1]) + (d[2] * d[2] + d[3] * d[3]); }
#pragma unroll
        for (int o = 32; o >= 1; o >>= 1) q += __shfl_xor(q, o);
        const float rs = 1.0f / sqrtf(q * (1.0f / 1024.0f) + 1e-5f);
#pragma unroll
        for (int i = 0; i < 4; ++i) { const f32x4 o = (v[i] - mu) * rs * g[i] + b[i]; *(f32x4*)(xr + 4 * lane + 256 * i) = o;
            if (xn) { u32x2 w; w.x = pk2(o[0], o[1]); w.y = pk2(o[2], o[3]); *(u32x2*)(xn + (size_t)row * D + 4 * lane + 256 * i) = w; } }
    }
}

__device__ __forceinline__ void headnorm_phase(bf16_t* proj, int ld, int ocol, int gcol, int lanes_per_head  , const float* gain) {
    int tid_ = threadIdx.x; asm volatile("" : "+v"(tid_));
    const int lane = tid_ & 63, wv = tid_ >> 6;
    float gn[2][8];
#pragma unroll
    for (int hh = 0; hh < 2; ++hh)
#pragma unroll
        for (int i = 0; i < 8; ++i) gn[hh][i] = gain[hh * 512 + 8 * lane + i];
    const float invn = lanes_per_head == 16 ? (1.0f / 128.0f) : (1.0f / 256.0f);
    const int rstep = gridDim.x * 8;
    int row = lbid() * 8 + wv;
    u32x4 nov[2], ngv[2];
    if (row < MROWS) { const bf16_t* pr = proj + (size_t)row * ld;
#pragma unroll
        for (int hh = 0; hh < 2; ++hh) { nov[hh] = *(const u32x4*)(pr + ocol + hh * 512 + 8 * lane); ngv[hh] = *(const u32x4*)(pr + gcol + hh * 512 + 8 * lane); } }
    for (; row < MROWS; row += rstep) {
        bf16_t* pr = proj + (size_t)row * ld;
        u32x4 cov[2], cgv[2];
#pragma unroll
        for (int hh = 0; hh < 2; ++hh) { cov[hh] = nov[hh]; cgv[hh] = ngv[hh]; }
        if (row + rstep < MROWS) { const bf16_t* pn = proj + (size_t)(row + rstep) * ld;
#pragma unroll
            for (int hh = 0; hh < 2; ++hh) { nov[hh] = *(const u32x4*)(pn + ocol + hh * 512 + 8 * lane); ngv[hh] = *(const u32x4*)(pn + gcol + hh * 512 + 8 * lane); } }
#pragma unroll
        for (int hh = 0; hh < 2; ++hh) {
            const u32x4 ov = cov[hh], gv = cgv[hh];
            float o[8], g[8];
#pragma unroll
            for (int i = 0; i < 4; ++i) { o[2 * i] = bflo(ov[i]); o[2 * i + 1] = bfhi(ov[i]); g[2 * i] = bflo(gv[i]); g[2 * i + 1] = bfhi(gv[i]); }
            float s = 0.f;
#pragma unroll
            for (int i = 0; i < 8; ++i) s += o[i] * o[i];
            s += __shfl_xor(s, 1); s += __shfl_xor(s, 2); s += __shfl_xor(s, 4); s += __shfl_xor(s, 8);
            if (lanes_per_head == 32) s += __shfl_xor(s, 16);
            const float rs = __builtin_amdgcn_rsqf(s * invn + 1e-6f);
            float r[8];
#pragma unroll
            for (int i = 0; i < 8; ++i) r[i] = o[i] * rs * gn[hh][i] * g[i] * sigmoidf_(g[i]);
            u32x4 w; w.x = pk2(r[0], r[1]); w.y = pk2(r[2], r[3]); w.z = pk2(r[4], r[5]); w.w = pk2(r[6], r[7]);
            *(u32x4*)(pr + ocol + hh * 512 + 8 * lane) = w;
        }
    }
}

constexpr int MP_G = 0, MP_T = 32768, MP_KTT = 34816, MP_QT = MP_KTT + 128 * 72 * 2, MP_KT = MP_QT + 64 * 136 * 2, MP_END = MP_KT + 64 * 136 * 2;
static_assert(MP_END <= 131072, "prepass LDS");

__device__ __forceinline__ void mixprep_loop(LAS unsigned char* lds, bf16_t* proj, int ld, int qcol, int kcol, int gcol, int gla, const float* lb0, const float* lb1, int lbj, const float* bgate,
                                             bf16_t* ktb_h, int nh, float* vec_h, int ci0, int cstep) {
    int tid_ = threadIdx.x; asm volatile("" : "+v"(tid_));
    const int tid = tid_, wid = __builtin_amdgcn_readfirstlane(tid >> 6), lane = tid & 63, fr = lane & 15, fq = lane >> 4;
    LAS float* G = (LAS float*)(lds + MP_G); LAS float* T = (LAS float*)(lds + MP_T); LAS bf16_t* KTT = (LAS bf16_t*)(lds + MP_KTT);
    LAS bf16_t* QT = (LAS bf16_t*)(lds + MP_QT); LAS bf16_t* KT = (LAS bf16_t*)(lds + MP_KT);
    const int t0 = tid >> 4, cv = tid & 15, c8 = cv * 8;
    float cA[8], cB[8];
#pragma unroll
    for (int i = 0; i < 8; ++i) {
        if (gla) { cA[i] = bgate[c8 + i]; cB[i] = 0.f; }
        else { float lb = 0.f; if (lbj == 1) lb = sigmoidf_(lb1[c8 + i] - lb0[c8 + i]); cA[i] = lb; cB[i] = 1.0f - lb; }
    }
    const float qscale = 0.08838834764831845f;
    u32x4 rq[2], rk[2], rg[2];
    rg[0] = rg[1] = (u32x4){0u, 0u, 0u, 0u};
    auto issue_loads = [&](int ci) {
        const bf16_t* base = proj + (size_t)ci * 64 * ld;
#pragma unroll
        for (int rr = 0; rr < 2; ++rr) { const bf16_t* rp = base + (size_t)(t0 + 32 * rr) * ld + c8; rq[rr] = *(const u32x4*)(rp + qcol); rk[rr] = *(const u32x4*)(rp + kcol); if (gla) rg[rr] = *(const u32x4*)(rp + gcol); }
    };
    if (ci0 < NCHUNK) issue_loads(ci0);
    for (int ci = ci0; ci < NCHUNK; ci += cstep) {
        bf16_t* base = proj + (size_t)ci * 64 * ld;
        float qv[2][8], kv[2][8];
#pragma unroll
        for (int rr = 0; rr < 2; ++rr) {
            float gvv[8];
#pragma unroll
            for (int i = 0; i < 8; ++i) {
                const unsigned uq = rq[rr][i >> 1], uk = rk[rr][i >> 1], ug = rg[rr][i >> 1];
                const float q = (i & 1) ? bfhi(uq) : bflo(uq), k = (i & 1) ? bfhi(uk) : bflo(uk);
                if (gla) {
                    const float g = ((i & 1) ? bfhi(ug) : bflo(ug)) + cA[i];
                    qv[rr][i] = q * qscale; kv[rr][i] = k;
                    gvv[i] = (fminf(g, 0.f) - __logf(1.0f + __expf(-fabsf(g)))) * (1.0f / 16.0f);
                } else {
                    qv[rr][i] = q * sigmoidf_(q) * qscale;
                    const float e = __expf(-k), r = __builtin_amdgcn_rcpf(1.0f + e);
                    kv[rr][i] = cB[i] * e * r;
                    gvv[i] = __logf(fmaxf(cA[i] + cB[i] * r, 1e-6f));
                }
            }
            LAS float* gp = G + (t0 + 32 * rr) * 128 + c8;
            *(LAS f32x4*)gp = (f32x4){gvv[0], gvv[1], gvv[2], gvv[3]}; *(LAS f32x4*)(gp + 4) = (f32x4){gvv[4], gvv[5], gvv[6], gvv[7]};
        }
        if (ci + cstep < NCHUNK) issue_loads(ci + cstep);
        __syncthreads();
        { const int k = tid & 127, sg = tid >> 7; float run = 0.f;
#pragma unroll
          for (int i = 0; i < 16; ++i) { run += G[(16 * sg + i) * 128 + k]; G[(16 * sg + i) * 128 + k] = run; }
          T[sg * 128 + k] = run; }
        __syncthreads();
        {
            float tA[8], tB[8], tC[8], bmid[8], blast[8];
            { const f32x4 x0 = *(const LAS f32x4*)(T + c8), x1 = *(const LAS f32x4*)(T + c8 + 4), y0 = *(const LAS f32x4*)(T + 128 + c8), y1 = *(const LAS f32x4*)(T + 128 + c8 + 4),
                  z0 = *(const LAS f32x4*)(T + 256 + c8), z1 = *(const LAS f32x4*)(T + 256 + c8 + 4);
              const f32x4 m0 = *(const LAS f32x4*)(G + 31 * 128 + c8), m1 = *(const LAS f32x4*)(G + 31 * 128 + c8 + 4), l0 = *(const LAS f32x4*)(G + 63 * 128 + c8), l1 = *(const LAS f32x4*)(G + 63 * 128 + c8 + 4);
#pragma unroll
              for (int i = 0; i < 4; ++i) { tA[i] = x0[i]; tA[4 + i] = x1[i]; tB[i] = x0[i] + y0[i]; tB[4 + i] = x1[i] + y1[i]; tC[i] = tB[i] + z0[i]; tC[4 + i] = tB[4 + i] + z1[i];
                  bmid[i] = m0[i] + tA[i]; bmid[4 + i] = m1[i] + tA[4 + i]; blast[i] = l0[i] + tC[i]; blast[4 + i] = l1[i] + tC[4 + i]; } }
#pragma unroll
            for (int rr = 0; rr < 2; ++rr) {
                const int t = t0 + 32 * rr, sg = t >> 4;
                const f32x4 g0 = *(const LAS f32x4*)(G + t * 128 + c8), g1 = *(const LAS f32x4*)(G + t * 128 + c8 + 4);
                float qt[8], kt[8];
#pragma unroll
                for (int i = 0; i < 8; ++i) {
                    const float off = sg == 0 ? 0.f : (sg == 1 ? tA[i] : (sg == 2 ? tB[i] : tC[i]));
                    const float b = (i < 4 ? g0[i & 3] : g1[i & 3]) + off;
                    qt[i] = qv[rr][i] * __expf(fminf(b - bmid[i], 80.f));
                    kt[i] = kv[rr][i] * __expf(fminf(bmid[i] - b, 80.f));
                }
                bf16_t* rp = base + (size_t)t * ld + c8;
                u32x4 w;
                w.x = pk2(qt[0], qt[1]); w.y = pk2(qt[2], qt[3]); w.z = pk2(qt[4], qt[5]); w.w = pk2(qt[6], qt[7]); *(u32x4*)(rp + qcol) = w; *(LAS u32x4*)(QT + t * 136 + c8) = w;
                w.x = pk2(kt[0], kt[1]); w.y = pk2(kt[2], kt[3]); w.z = pk2(kt[4], kt[5]); w.w = pk2(kt[6], kt[7]); *(LAS u32x4*)(KT + t * 136 + c8) = w;
#pragma unroll
                for (int i = 0; i < 4; ++i) { KTT[(c8 + 2 * i) * 72 + t] = (bf16_t)(w[i] & 0xffffu); KTT[(c8 + 2 * i + 1) * 72 + t] = (bf16_t)(w[i] >> 16); }
            }
            if (t0 == 0) {
                float* em = vec_h + (size_t)ci * 1024; float* el = em + (size_t)NCHUNK * 1024; float* elm = el + (size_t)NCHUNK * 1024;
                f32x4 v0, v1;
#pragma unroll
                for (int i = 0; i < 4; ++i) { v0[i] = __expf(bmid[i]); v1[i] = __expf(bmid[4 + i]); }
                *(f32x4*)(em + c8) = v0; *(f32x4*)(em + c8 + 4) = v1;
#pragma unroll
                for (int i = 0; i < 4; ++i) { v0[i] = __expf(blast[i]); v1[i] = __expf(blast[4 + i]); }
                *(f32x4*)(el + c8) = v0; *(f32x4*)(el + c8 + 4) = v1;
#pragma unroll
                for (int i = 0; i < 4; ++i) { v0[i] = __expf(blast[i] - bmid[i]); v1[i] = __expf(blast[4 + i] - bmid[4 + i]); }
                *(f32x4*)(elm + c8) = v0; *(f32x4*)(elm + c8 + 4) = v1;
            }
        }
        __syncthreads();
        { const int k = tid >> 2, j = tid & 3; bf16_t* ktb = ktb_h + (size_t)ci * nh * 8192;
          const u32x4 w0 = *(const LAS u32x4*)(KTT + k * 72 + 16 * j), w1 = *(const LAS u32x4*)(KTT + k * 72 + 16 * j + 8);
          *(u32x4*)(ktb + k * 64 + 16 * j) = w0; *(u32x4*)(ktb + k * 64 + 16 * j + 8) = w1; }
        { const int ti = wid >> 1;
#pragma unroll
          for (int sh = 0; sh < 2; ++sh) { const int si = 2 * (wid & 1) + sh; f32x4 pa = {0.f, 0.f, 0.f, 0.f};
              if (si <= ti) {
#pragma unroll
                  for (int kk = 0; kk < 4; ++kk) { const bf16x8 A = *(const LAS bf16x8*)(KT + (16 * si + fr) * 136 + 32 * kk + 8 * fq), B = *(const LAS bf16x8*)(QT + (16 * ti + fr) * 136 + 32 * kk + 8 * fq); pa = MFMA16(A, B, pa); }
                  if (si == ti) {
#pragma unroll
                      for (int j = 0; j < 4; ++j) if (4 * fq + j > fr) pa[j] = 0.f; }
              }
              u32x2 w; w.x = pk2(pa[0], pa[1]); w.y = pk2(pa[2], pa[3]); *(u32x2*)(base + (size_t)(16 * ti + fr) * ld + kcol + 16 * si + 4 * fq) = w; } }
    }
    __syncthreads();
}

constexpr int MXB = 49664, MXB_QT = 0, MXB_KTT = 17408, MXB_VT = 35840, MXB_PP = 40448, MX_ST = 2 * MXB, MX_END = MX_ST + 2 * 8704;
static_assert(MX_END <= LDS_ST_OFF, "mixer LDS");

struct ChainArgs {
    bf16_t* proj; int ld; size_t row0; int nchunks;
    int qcol, kcol, vcol;
    const bf16_t* ktb;
    size_t ktb_stride;
    const float* em; const float* el; const float* elm; int vec_stride;
    const float* s0; float* sout; int sstride;
};

__device__ __forceinline__ void mixer_chain(LAS unsigned char* lds, const ChainArgs& a) {
    int tid_ = threadIdx.x; asm volatile("" : "+v"(tid_));
    const int tid = tid_, wid = __builtin_amdgcn_readfirstlane(tid >> 6), lane = tid & 63, fr = lane & 15, fq = lane >> 4;
    const int t0 = tid >> 4, c8 = (tid & 15) * 8;
    f32x4 Sacc[2];
#pragma unroll
    for (int vi = 0; vi < 2; ++vi)
#pragma unroll
        for (int j = 0; j < 4; ++j) Sacc[vi][j] = a.s0 ? a.s0[(size_t)(16 * wid + 4 * fq + j) * a.sstride + 16 * vi + fr] : 0.f;
    struct Regs { u32x4 rq[2], rkt[2], rp, rv; f32x4 vem, vel, velm; };
    Regs R0, R1;
    R0.rv = (u32x4){0u, 0u, 0u, 0u}; R1.rv = (u32x4){0u, 0u, 0u, 0u};
    auto issue_loads = [&](Regs& R, int c) {
        const bf16_t* base = a.proj + (a.row0 + (size_t)c * 64) * a.ld;
#pragma unroll
        for (int rr = 0; rr < 2; ++rr) R.rq[rr] = *(const u32x4*)(base + (size_t)(t0 + 32 * rr) * a.ld + c8 + a.qcol);
        R.rp = *(const u32x4*)(base + (size_t)(tid >> 3) * a.ld + a.kcol + 8 * (tid & 7));
        const bf16_t* kp = a.ktb + (size_t)c * a.ktb_stride + (tid >> 2) * 64 + 16 * (tid & 3);
        R.rkt[0] = *(const u32x4*)kp; R.rkt[1] = *(const u32x4*)(kp + 8);
        if (tid < 256) R.rv = *(const u32x4*)(base + (size_t)(tid >> 2) * a.ld + a.vcol + 8 * (tid & 3));
        const size_t vo = (size_t)c * a.vec_stride + 16 * wid + 4 * fq;
        R.vem = *(const f32x4*)(a.em + vo); R.vel = *(const f32x4*)(a.el + vo); R.velm = *(const f32x4*)(a.elm + vo);
    };
    f32x4 cel, celm;
    auto fill = [&](int b, const Regs& R) {
        LAS bf16_t* QT = (LAS bf16_t*)(lds + b * MXB + MXB_QT); LAS bf16_t* KTT = (LAS bf16_t*)(lds + b * MXB + MXB_KTT);
        LAS bf16_t* VT = (LAS bf16_t*)(lds + b * MXB + MXB_VT); LAS bf16_t* PP = (LAS bf16_t*)(lds + b * MXB + MXB_PP); LAS bf16_t* ST = (LAS bf16_t*)(lds + MX_ST + b * 8704);
#pragma unroll
        for (int rr = 0; rr < 2; ++rr) *(LAS u32x4*)(QT + (t0 + 32 * rr) * 136 + c8) = R.rq[rr];
        *(LAS u32x4*)(PP + (tid >> 3) * 72 + 8 * (tid & 7)) = R.rp;
        { LAS bf16_t* kp = KTT + (tid >> 2) * 72 + 16 * (tid & 3); *(LAS u32x4*)kp = R.rkt[0]; *(LAS u32x4*)(kp + 8) = R.rkt[1]; }
        if (tid < 256) { const int tv = tid >> 2, v8 = (tid & 3) * 8;
#pragma unroll
            for (int i = 0; i < 8; ++i) VT[(v8 + i) * 72 + tv] = (bf16_t)((i & 1) ? (R.rv[i >> 1] >> 16) : (R.rv[i >> 1] & 0xffffu)); }
#pragma unroll
        for (int vi = 0; vi < 2; ++vi) { u32x2 w; w.x = pk2(Sacc[vi][0] * R.vem[0], Sacc[vi][1] * R.vem[1]); w.y = pk2(Sacc[vi][2] * R.vem[2], Sacc[vi][3] * R.vem[3]); *(LAS u32x2*)(ST + (16 * vi + fr) * 136 + 16 * wid + 4 * fq) = w; }
        cel = R.vel; celm = R.velm;
    };
    auto compute = [&](int b, int c) {
        const LAS bf16_t* QT = (const LAS bf16_t*)(lds + b * MXB + MXB_QT); const LAS bf16_t* KTT = (const LAS bf16_t*)(lds + b * MXB + MXB_KTT);
        const LAS bf16_t* VT = (const LAS bf16_t*)(lds + b * MXB + MXB_VT); const LAS bf16_t* PP = (const LAS bf16_t*)(lds + b * MXB + MXB_PP); const LAS bf16_t* ST = (const LAS bf16_t*)(lds + MX_ST + b * 8704);
        { const int ti = wid >> 1, vi = wid & 1; f32x4 o = {0.f, 0.f, 0.f, 0.f};
#pragma unroll
          for (int kk = 0; kk < 2; ++kk) { const bf16x8 A = *(const LAS bf16x8*)(VT + (16 * vi + fr) * 72 + 32 * kk + 8 * fq), B = *(const LAS bf16x8*)(PP + (16 * ti + fr) * 72 + 32 * kk + 8 * fq); o = MFMA16(A, B, o); }
#pragma unroll
          for (int kk = 0; kk < 4; ++kk) { const bf16x8 A = *(const LAS bf16x8*)(ST + (16 * vi + fr) * 136 + 32 * kk + 8 * fq), B = *(const LAS bf16x8*)(QT + (16 * ti + fr) * 136 + 32 * kk + 8 * fq); o = MFMA16(A, B, o); }
          u32x2 w; w.x = pk2(o[0], o[1]); w.y = pk2(o[2], o[3]);
          *(u32x2*)(a.proj + (a.row0 + (size_t)c * 64 + 16 * ti + fr) * a.ld + a.vcol + 16 * vi + 4 * fq) = w; }
#pragma unroll
        for (int vi = 0; vi < 2; ++vi) { f32x4 u = {0.f, 0.f, 0.f, 0.f};
#pragma unroll
            for (int kk = 0; kk < 2; ++kk) { const bf16x8 A = *(const LAS bf16x8*)(KTT + (16 * wid + fr) * 72 + 32 * kk + 8 * fq), B = *(const LAS bf16x8*)(VT + (16 * vi + fr) * 72 + 32 * kk + 8 * fq); u = MFMA16(A, B, u); }
            Sacc[vi] = Sacc[vi] * cel + u * celm; }
    };
    const int n = a.nchunks;
    issue_loads(R0, 0);
    if (n > 1) issue_loads(R1, 1);
    fill(0, R0);
    if (n > 2) issue_loads(R0, 2);
    for (int c = 0; c < n; c += 2) {
        __syncthreads();
        compute(0, c);
        if (c + 1 < n) { fill(1, R1); if (c + 3 < n) issue_loads(R1, c + 3); }
        if (c + 1 < n) {
            __syncthreads();
            compute(1, c + 1);
            if (c + 2 < n) { fill(0, R0); if (c + 4 < n) issue_loads(R0, c + 4); }
        }
    }
#pragma unroll
    for (int vi = 0; vi < 2; ++vi)
#pragma unroll
        for (int j = 0; j < 4; ++j) a.sout[(size_t)(16 * wid + 4 * fq + j) * a.sstride + 16 * vi + fr] = Sacc[vi][j];
    __syncthreads();
}

constexpr int AT_PITCH = 264, AT_KOFF = 128 * AT_PITCH * 2, AT_KP = 136;
static_assert(AT_KOFF + 256 * AT_KP * 2 <= LDS_ST_OFF, "attention LDS");
__device__ __forceinline__ void mem_attn(LAS unsigned char* lds, const bf16_t* Kb, const bf16_t* Vb, bf16_t* Q, int ld, int nrows) {
    int tid_ = threadIdx.x; asm volatile("" : "+v"(tid_));
    const int tid = tid_, wid = __builtin_amdgcn_readfirstlane(tid >> 6), lane = tid & 63, fr = lane & 15, fq = lane >> 4;
    LAS bf16_t* VT = (LAS bf16_t*)lds;
    LAS bf16_t* KS = (LAS bf16_t*)(lds + AT_KOFF);
#pragma unroll
    for (int it = 0; it < 8; ++it) { const int idx = tid + NTHR * it, key = idx >> 4, v8 = (idx & 15) * 8; const u32x4 v = *(const u32x4*)(Vb + (size_t)key * 512 + v8), kx = *(const u32x4*)(Kb + (size_t)key * 512 + v8);
        *(LAS u32x4*)(KS + key * AT_KP + v8) = kx;
#pragma unroll
        for (int i = 0; i < 8; ++i) VT[(v8 + i) * AT_PITCH + key] = (bf16_t)((i & 1) ? (v[i >> 1] >> 16) : (v[i >> 1] & 0xffffu)); }
    __syncthreads();
    const float sc = 0.08838834764831845f;
    for (int q0 = wid * 16; q0 < nrows; q0 += 128) {
        bf16x8 Qf0, Qf1, Qf2, Qf3;
        { const bf16_t* qp = Q + (size_t)(q0 + fr) * ld + 8 * fq; Qf0 = *(const bf16x8*)(qp); Qf1 = *(const bf16x8*)(qp + 32); Qf2 = *(const bf16x8*)(qp + 64); Qf3 = *(const bf16x8*)(qp + 96); }
        f32x4 s[16];
#pragma unroll
        for (int a = 0; a < 16; ++a) {
            const LAS bf16_t* kp = KS + (16 * a + fr) * AT_KP + 8 * fq;
            f32x4 t = {0.f, 0.f, 0.f, 0.f};
            t = MFMA16(*(const LAS bf16x8*)(kp), Qf0, t); t = MFMA16(*(const LAS bf16x8*)(kp + 32), Qf1, t); t = MFMA16(*(const LAS bf16x8*)(kp + 64), Qf2, t); t = MFMA16(*(const LAS bf16x8*)(kp + 96), Qf3, t);
            s[a] = t;
            if ((a & 3) == 3) asm volatile("" ::: "memory");
        }
        float mx = -3.0e38f;
#pragma unroll
        for (int a = 0; a < 16; ++a) mx = fmaxf(fmaxf(mx, fmaxf(s[a][0], s[a][1])), fmaxf(s[a][2], s[a][3]));
        mx = fmaxf(mx, __shfl_xor(mx, 16)); mx = fmaxf(mx, __shfl_xor(mx, 32));
        float sum = 0.f; u32x2 pk[16];
#pragma unroll
        for (int a = 0; a < 16; ++a) { const float e0 = __expf((s[a][0] - mx) * sc), e1 = __expf((s[a][1] - mx) * sc), e2 = __expf((s[a][2] - mx) * sc), e3 = __expf((s[a][3] - mx) * sc);
            sum += (e0 + e1) + (e2 + e3); pk[a].x = pk2(e0, e1); pk[a].y = pk2(e2, e3); }
        sum += __shfl_xor(sum, 16); sum += __shfl_xor(sum, 32);
        const float inv = 1.0f / sum;
        f32x4 o[8];
#pragma unroll
        for (int dt = 0; dt < 8; ++dt) o[dt] = (f32x4){0.f, 0.f, 0.f, 0.f};
#pragma unroll
        for (int ap = 0; ap < 8; ++ap) {
            const u32x4 bv = {pk[2 * ap].x, pk[2 * ap].y, pk[2 * ap + 1].x, pk[2 * ap + 1].y};
            const bf16x8 B = __builtin_bit_cast(bf16x8, bv);
#pragma unroll
            for (int dt = 0; dt < 8; ++dt) {
                const u32x2 lo = *(const LAS u32x2*)(VT + (16 * dt + fr) * AT_PITCH + 32 * ap + 4 * fq), hi = *(const LAS u32x2*)(VT + (16 * dt + fr) * AT_PITCH + 32 * ap + 16 + 4 * fq);
                const u32x4 av = {lo.x, lo.y, hi.x, hi.y};
                o[dt] = MFMA16(__builtin_bit_cast(bf16x8, av), B, o[dt]);
            }
        }
#pragma unroll
        for (int dt = 0; dt < 8; ++dt) { u32x2 w; w.x = pk2(o[dt][0] * inv, o[dt][1] * inv); w.y = pk2(o[dt][2] * inv, o[dt][3] * inv);
            *(u32x2*)(Q + (size_t)(q0 + fr) * ld + 16 * dt + 4 * fq) = w; }
    }
    __syncthreads();
}

__device__ __forceinline__ void mixprep_phase(LAS unsigned char* lds, const Params& p, int layer) {
    const int j = layer >> 1, gla = layer & 1, w = lbid(), G = gridDim.x;
    bf16_t* proj = (bf16_t*)(p.ws + WS_PROJ);
    const int ld = gla ? GL_LD : HG_LD, nh = gla ? 4 : 8;
    bf16_t* ktb = (bf16_t*)(p.ws + WS_XN);
    float* vec = (float*)(p.ws + WS_VEC);
    const int xq = gla ? 3584 : 4096;
    for (int it = w; it < 256 + 64; it += G) {
        const bf16_t* Kb; const bf16_t* Vb; bf16_t* Qp; int nrows;
        if (it < 256) { const int bh = it >> 3, grp = it & 7, b = bh >> 2, h = bh & 3;
            Kb = (const bf16_t*)(p.ws + WS_MKB) + ((size_t)layer * 2048 + b * 256) * 512 + h * 128;
            Vb = (const bf16_t*)(p.ws + WS_MVB) + ((size_t)layer * 2048 + b * 256) * 512 + h * 128;
            Qp = proj + ((size_t)b * 8192 + grp * 1024) * ld + xq + h * 128; nrows = 1024;
        } else { const int bh = it - 256, b = bh >> 2, h = bh & 3;
            Kb = (const bf16_t*)(p.ws + WS_CKB) + ((size_t)layer * 4096 + b * 256) * 512 + h * 128;
            Vb = (const bf16_t*)(p.ws + WS_CVB) + ((size_t)layer * 4096 + b * 256) * 512 + h * 128;
            Qp = proj + ((size_t)MP + b * 64) * ld + xq + h * 128; nrows = 64;
        }
        mem_attn(lds, Kb, Vb, Qp, ld, nrows);
    }
    { const int h = w % nh;
      mixprep_loop(lds, proj, ld, h * 128, (gla ? 512 : 1024) + h * 128, gla ? 1024 + h * 128 : 0, gla,
                   gla ? nullptr : p.in[13] + h * 128, gla ? nullptr : p.in[13] + 1024 + h * 128, j, gla ? p.in[18] + j * 512 + h * 128 : nullptr,
                   ktb + (size_t)h * 8192, nh, vec + h * 128, w / nh, G / nh); }
}
__device__ __forceinline__ void chain_phase(LAS unsigned char* lds, const Params& p, int layer) {
    const int j = layer >> 1, gla = layer & 1, w = lbid(), G = gridDim.x;
    bf16_t* proj = (bf16_t*)(p.ws + WS_PROJ);
    const int ld = gla ? GL_LD : HG_LD;
    const int nvs = gla ? 8 : 4, nh = gla ? 4 : 8, vdim = gla ? 256 : 128;
    const bf16_t* ktb = (const bf16_t*)(p.ws + WS_XN);
    const float* vec = (const float*)(p.ws + WS_VEC);
    const int n_prompt = 8 * nh * nvs  , n_sample = 16 * nh * nvs  ;
    for (int it = w; it < n_prompt + n_sample; it += G) {
        const bool smp = it >= n_prompt; const int id = smp ? it - n_prompt : it;
        const int lo = id & 7, rest = id >> 3, vs = rest % nvs, hi = rest / nvs, bh = lo + 8 * hi, b = bh / nh, h = bh % nh;
        ChainArgs a;
        a.proj = proj; a.ld = ld;
        a.row0 = smp ? (size_t)MP + (size_t)b * 64 : (size_t)b * 8192; a.nchunks = smp ? 1 : 128;
        const int ci0 = smp ? 1024 + b : b * 128;
        if (gla) { a.qcol = h * 128; a.kcol = 512 + h * 128; a.vcol = 2560 + h * 256 + 32 * vs; }
        else { a.qcol = h * 128; a.kcol = 1024 + h * 128; a.vcol = 3072 + h * 128 + 32 * vs; }
        a.ktb = ktb + ((size_t)ci0 * nh + h) * 8192; a.ktb_stride = (size_t)nh * 8192;
        a.em = vec + (size_t)ci0 * 1024 + h * 128; a.el = a.em + (size_t)NCHUNK * 1024; a.elm = a.el + (size_t)NCHUNK * 1024; a.vec_stride = 1024;
        const size_t per_b = (size_t)nh * 128 * vdim, so = ((size_t)b * nh + h) * 128 * vdim + 32 * vs;
        if (smp) { a.s0 = (gla ? p.in[6] : p.in[5]) + (size_t)j * 16 * per_b + so; a.sout = p.out + (gla ? O_SGS : O_SHS) + (size_t)j * 16 * per_b + so; }
        else { a.s0 = nullptr; a.sout = p.out + (gla ? O_SGP : O_SHP) + (size_t)j * 8 * per_b + so; }
        a.sstride = vdim;
        mixer_chain(lds, a);
    }
}

#define XB_TMO      128
#define XB_XCNT(j)  (256  + 64 * (j))
#define XB_XSUB(j)  (1280 + 64 * (j))
#define XB_XGEN(j)  (2304 + 64 * (j))
#define XB_TOP      3328
#define XB_TOPGEN   3392
#define XCD_BAR_WORDS 3456
#define XB_SPIN_CAP (1u << 22)
__device__ __forceinline__ unsigned xb_ld(unsigned* p)              { return __hip_atomic_load(p, __ATOMIC_RELAXED, __HIP_MEMORY_SCOPE_AGENT); }
__device__ __forceinline__ unsigned xb_add(unsigned* p, unsigned v) { return __hip_atomic_fetch_add(p, v, __ATOMIC_RELAXED, __HIP_MEMORY_SCOPE_AGENT); }
__device__ __forceinline__ unsigned xb_xcc_id() { return (unsigned)__builtin_amdgcn_s_getreg((3 << 11) | 20) & 0xFu; }
#define XB_SPIN(cond, bar) do { unsigned _sp = 0; while (cond) { __builtin_amdgcn_s_sleep(1); \
    if ((++_sp & 255u) == 0u) { if (xb_ld(&(bar)[XB_TMO])) break; if (_sp > XB_SPIN_CAP) { atomicAdd(&(bar)[XB_TMO], 1u); break; } } } } while (0)
struct XcdBarrier { unsigned* bar; unsigned x; volatile LAS unsigned* st; };
__device__ __forceinline__ XcdBarrier xcd_barrier_post(unsigned* bar, volatile LAS unsigned* st) {
    XcdBarrier b; b.bar = bar; b.x = xb_xcc_id(); b.st = st;
    if (threadIdx.x == 0) (void)xb_add(&bar[XB_XCNT(b.x)], 1u);
    return b;
}
__device__ __forceinline__ void xcd_barrier_complete(unsigned* bar, unsigned x, unsigned& nloc, unsigned& nx) {
    const unsigned G = gridDim.x * gridDim.y * gridDim.z;
    unsigned sum, cnt, mine, sp = 0u;
    for (;;) {
        sum = 0u; cnt = 0u; mine = 0u;
#pragma unroll
        for (unsigned j = 0; j < 16; ++j) { const unsigned c = xb_ld(&bar[XB_XCNT(j)]); sum += c; cnt += (c > 0u) ? 1u : 0u; mine = (j == x) ? c : mine; }
        if (sum == G) break;
        __builtin_amdgcn_s_sleep(1);
        if ((++sp & 255u) == 0u) { if (xb_ld(&bar[XB_TMO])) break; if (sp > XB_SPIN_CAP) { atomicAdd(&bar[XB_TMO], 1u); break; } }
    }
    nloc = mine > 0u ? mine : 1u; nx = cnt > 0u ? cnt : 1u;
}
__device__ __forceinline__ void xcd_barrier(const XcdBarrier& b) {
    asm volatile("s_waitcnt vmcnt(0)" ::: "memory");
    __syncthreads();
    if (threadIdx.x == 0) {
        unsigned* bar = b.bar;
        __builtin_amdgcn_s_waitcnt(0);
        unsigned nloc = b.st[0], nx = b.st[1];
        if (nloc == 0u) { xcd_barrier_complete(bar, b.x, nloc, nx); b.st[0] = nloc; b.st[1] = nx; }
        const unsigned old = xb_add(&bar[XB_XSUB(b.x)], 1u);
        const unsigned gen = old / nloc;
        if (old + 1u == (gen + 1u) * nloc) {
            __builtin_amdgcn_fence(__ATOMIC_RELEASE, "agent");
            asm volatile("s_waitcnt vmcnt(0)" ::: "memory");
            const unsigned og = xb_add(&bar[XB_TOP], 1u);
            const unsigned tg = og / nx;
            if (og + 1u == (tg + 1u) * nx) xb_add(&bar[XB_TOPGEN], 1u);
            else XB_SPIN(xb_ld(&bar[XB_TOPGEN]) == tg, bar);
            __builtin_amdgcn_fence(__ATOMIC_ACQUIRE, "agent");
            xb_add(&bar[XB_XGEN(b.x)], 1u);
            asm volatile("s_waitcnt vmcnt(0)" ::: "memory");
        } else {
            XB_SPIN(xb_ld(&bar[XB_XGEN(b.x)]) == gen, bar);
            __builtin_amdgcn_fence(__ATOMIC_ACQUIRE, "agent");
            asm volatile("s_waitcnt vmcnt(0)" ::: "memory");
        }
    }
    __syncthreads();
}

constexpr int PPL = 9;
constexpr int NPHASE = 2 + 4 * PPL + 1;
#define WSB(off) ((bf16_t*)(p.ws + (off)))
#define STATS(li) ((float*)(p.ws + WS_STATS) + (size_t)(li) * MROWS * 2)
__global__ void __launch_bounds__(NTHR, 2) trunk_fwd(Params p) {
    extern __shared__ __attribute__((aligned(16))) unsigned char lds_raw[];
    LAS unsigned char* lds = (LAS unsigned char*)lds_raw;
    if (p.ph_hi - p.ph_lo > 1) {
        if (threadIdx.x < 4) ((LAS unsigned*)(lds + LDS_ST_OFF))[threadIdx.x] = 0u;
        __syncthreads();
        (void)xcd_barrier_post((unsigned*)(p.ws + WS_BAR), (volatile LAS unsigned*)(lds + LDS_ST_OFF));
    }
    for (int ph = p.ph_lo; ph < p.ph_hi; ++ph) {
        if (ph == 0) prep_phase(lds, p);
        else if (ph == 1) { }
        else if (false) { Epi E{EPI_MEMKV, nullptr, 0, nullptr, 0.f, p.out + O_MK, p.out + O_MV, WSB(WS_MKB), WSB(WS_MVB), nullptr, nullptr, nullptr, nullptr, nullptr};
            gemm_phase<EPI_MEMKV>(lds, WSB(WS_MEMP), 1024, WSB(WS_MEMW), 2048, 4096, 1024, E); }
        else if (ph == NPHASE - 1) ln_phase(p.out + O_Y, nullptr, p.in[10] + 11 * 1024, p.in[11] + 11 * 1024);
        else {
            const int layer = (ph - 2) / PPL, s = (ph - 2) % PPL, gla = layer & 1, j = layer >> 1;
            if (s == 0 || s == 7) {
                const int lf = layer * 2 + (s == 7), li = (s == 7) ? 3 * layer + 1 : 3 * layer - 1;
                const float* cv = (const float*)(p.ws + WS_CV_WGU) + (size_t)lf * 2 * 5632;
                Epi E{EPI_SWIGLU, WSB(WS_PROJ), FF, nullptr, 0.f, nullptr, nullptr, nullptr, nullptr, li >= 0 ? STATS(li) : nullptr, cv, cv + 5632, nullptr, nullptr};
                gemm_phase<EPI_SWIGLU>(lds, WSB(WS_XN), 1024, WSB(WS_WGU) + (size_t)lf * 5632 * 1024, MROWS, 5632, 1024, E);
                if (ph == 2) { Epi Em{EPI_MEMKV, nullptr, 0, nullptr, 0.f, p.out + O_MK, p.out + O_MV, WSB(WS_MKB), WSB(WS_MVB), nullptr, nullptr, nullptr, nullptr, nullptr};
                    gemm_phase<EPI_MEMKV>(lds, WSB(WS_MEMP), 1024, WSB(WS_MEMW), 2048, 4096, 1024, Em); } }
            else if (s == 1 || s == 8) {
                const int lf = layer * 2 + (s == 8), li_in = (s == 8) ? 3 * layer + 1 : 3 * layer - 1, li_out = (s == 8) ? 3 * layer + 2 : 3 * layer;
                Epi E{EPI_RES, nullptr, 0, p.out + O_Y, 0.5f, nullptr, nullptr, nullptr, nullptr, li_in >= 0 ? STATS(li_in) : nullptr,
                      li_in >= 0 ? p.in[10] + li_in * 1024 : nullptr, li_in >= 0 ? p.in[11] + li_in * 1024 : nullptr, STATS(li_out), WSB(WS_XN)};
                gemm_phase<EPI_RES>(lds, WSB(WS_PROJ), FF, WSB(WS_WD) + (size_t)lf * 1024 * FF, MP, 1024, FF, E);
                gemm_phase<EPI_RES, true>(lds, WSB(WS_PROJ), FF, WSB(WS_WD) + (size_t)lf * 1024 * FF, MP, 1024, FF, E); }

            else if (s == 2) {
                const int li = 3 * layer;
                const float* cv = gla ? (const float*)(p.ws + WS_CV_GWIN) + (size_t)j * 2 * 4096 : (const float*)(p.ws + WS_CV_HWIN) + (size_t)j * 2 * 4608;
                Epi E{EPI_BF16, WSB(WS_PROJ), gla ? GL_LD : HG_LD, nullptr, 0.f, nullptr, nullptr, nullptr, nullptr, STATS(li), cv, cv + (gla ? 4096 : 4608), nullptr, nullptr};
                if (gla) gemm_phase<EPI_BF16>(lds, WSB(WS_XN), 1024, WSB(WS_GWIN) + (size_t)j * 4096 * 1024, MROWS, 4096, 1024, E);
                else gemm_phase<EPI_BF16>(lds, WSB(WS_XN), 1024, WSB(WS_HWIN) + (size_t)j * 4608 * 1024, MROWS, 4608, 1024, E); }
            else if (s == 3) mixprep_phase(lds, p, layer);
            else if (s == 4) chain_phase(lds, p, layer);
            else if (s == 5) { if (gla) headnorm_phase(WSB(WS_PROJ), GL_LD, 2560, 1536, 32, p.in[19] + j * 1024); else headnorm_phase(WSB(WS_PROJ), HG_LD, 3072, 2048, 16, p.in[14] + j * 1024); }
            else if (s == 6) {
                const int li_in = 3 * layer;
                Epi E{EPI_RES, nullptr, 0, p.out + O_Y, 1.0f, nullptr, nullptr, nullptr, nullptr, STATS(li_in), p.in[10] + li_in * 1024, p.in[11] + li_in * 1024, STATS(li_in + 1), WSB(WS_XN)};
                gemm_phase<EPI_RES>(lds, WSB(WS_PROJ) + (gla ? 2560 : 3072), gla ? GL_LD : HG_LD, WSB(WS_WOUT) + (size_t)layer * 1024 * 1536, MP, 1024, 1536, E);
                gemm_phase<EPI_RES, true>(lds, WSB(WS_PROJ) + (gla ? 2560 : 3072), gla ? GL_LD : HG_LD, WSB(WS_WOUT) + (size_t)layer * 1024 * 1536, MP, 1024, 1536, E); }

        }
        if (ph + 1 < p.ph_hi && ph != 1) {
            if (ph == 0) cg::this_grid().sync();
            else { XcdBarrier bar; bar.bar = (unsigned*)(p.ws + WS_BAR); bar.x = xb_xcc_id(); bar.st = (volatile LAS unsigned*)(lds + LDS_ST_OFF); xcd_barrier(bar); }
        }
    }
}
#undef WSB
#undef STATS

extern "C" void kernel_launch(void* const* d_in, const int* in_sizes, int n_in, void* d_out, int out_size, void* d_ws, size_t ws_size, hipStream_t stream) {
    static int grid = 0;
    if (grid == 0) {
        if (n_in != 23 || ws_size < WS_END) { fprintf(stderr, "kernel_launch: need 23 inputs and %zu bytes of workspace; got %d, %zu\n", (size_t)WS_END, n_in, ws_size); grid = -1; return; }
        if (hipFuncSetAttribute((const void*)trunk_fwd, hipFuncAttributeMaxDynamicSharedMemorySize, LDS_BYTES) != hipSuccess) { fprintf(stderr, "kernel_launch: hipFuncSetAttribute failed\n"); grid = -1; return; }
        int dev = 0, cus = 0, per_cu = 0;
        (void)hipGetDevice(&dev); (void)hipDeviceGetAttribute(&cus, hipDeviceAttributeMultiprocessorCount, dev);
        (void)hipOccupancyMaxActiveBlocksPerMultiprocessor(&per_cu, (const void*)trunk_fwd, NTHR, LDS_BYTES);
        if (per_cu < 1) { fprintf(stderr, "kernel_launch: occupancy query says %d blocks per CU\n", per_cu); per_cu = 1; }
        (void)hipGetLastError();
        grid = cus;
    }
    if (grid < 0) return;
    Params p{};
    for (int i = 0; i < 23; ++i) p.in[i] = (const float*)d_in[i];
    p.out = (float*)d_out; p.ws = (unsigned char*)d_ws;
#if ONE_LAUNCH
    (void)hipMemsetAsync((unsigned char*)d_ws + WS_BAR, 0, WS_ZERO_END - WS_BAR, stream);
    p.ph_lo = 0; p.ph_hi = NPHASE;
    void* args[] = {&p};
    hipError_t e = hipLaunchCooperativeKernel((const void*)trunk_fwd, dim3(grid), dim3(NTHR), args, LDS_BYTES, stream);
    if (e != hipSuccess) fprintf(stderr, "cooperative launch failed: %s (grid %d)\n", hipGetErrorString(e), grid);
#else
    (void)hipMemsetAsync((unsigned char*)d_ws + WS_BAR, 0, WS_ZERO_END - WS_BAR, stream);
    for (int ph = 0; ph < NPHASE; ++ph) {
        p.ph_lo = ph; p.ph_hi = ph + 1;
        hipLaunchKernelGGL(trunk_fwd, dim3(grid), dim3(NTHR), LDS_BYTES, stream, p);
    }
#endif
}
```

```cpp
#include <hip/hip_runtime.h>
#include <hip/hip_cooperative_groups.h>
#include <cstdio>
namespace cg = cooperative_groups;

#ifndef ONE_LAUNCH
#define ONE_LAUNCH 1
#endif

#define LAS __attribute__((address_space(3)))
typedef unsigned short bf16_t;
typedef short bf16x8 __attribute__((ext_vector_type(8)));
typedef float f32x4 __attribute__((ext_vector_type(4)));
typedef float f32x2 __attribute__((ext_vector_type(2)));
typedef unsigned u32x4 __attribute__((ext_vector_type(4)));
typedef unsigned u32x2 __attribute__((ext_vector_type(2)));
typedef __bf16 nbf2 __attribute__((ext_vector_type(2)));

constexpr int D = 1024, MP = 65536, MS = 1024, MROWS = MP + MS, FF = 2816;
constexpr int HG_LD = 4608, GL_LD = 4096;
constexpr float ALPHA = 1.6817928305074292f;
constexpr int NTHR = 512;
constexpr int LDS_BYTES = 144 * 1024;
constexpr int LDS_ST_OFF = 143360;
constexpr int NCHUNK = MROWS / 64;
constexpr int LDS_X = 131072;

constexpr size_t O_Y = 0;
constexpr size_t O_SHP = (size_t)MROWS * D;
constexpr size_t O_SGP = O_SHP + 2u * 8 * 8 * 128 * 128;
constexpr size_t O_MK = O_SGP + 2u * 8 * 4 * 128 * 256;
constexpr size_t O_MV = O_MK + 4u * 2048 * 512;
constexpr size_t O_SHS = O_MV + 4u * 2048 * 512;
constexpr size_t O_SGS = O_SHS + 2u * 16 * 8 * 128 * 128;

constexpr size_t WS_WGU = 0;
constexpr size_t WS_WD = WS_WGU + 8ull * 5632 * 1024 * 2;
constexpr size_t WS_HWIN = WS_WD + 8ull * 1024 * 2816 * 2;
constexpr size_t WS_GWIN = WS_HWIN + 2ull * 4608 * 1024 * 2;
constexpr size_t WS_WOUT = WS_GWIN + 2ull * 4096 * 1024 * 2;
constexpr size_t WS_MEMW = WS_WOUT + 4ull * 1024 * 1536 * 2;
constexpr size_t WS_MEMP = WS_MEMW + 4096ull * 1024 * 2;
constexpr size_t WS_MKB = WS_MEMP + 2048ull * 1024 * 2;
constexpr size_t WS_MVB = WS_MKB + 4ull * 2048 * 512 * 2;
constexpr size_t WS_CKB = WS_MVB + 4ull * 2048 * 512 * 2;
constexpr size_t WS_CVB = WS_CKB + 4ull * 4096 * 512 * 2;
constexpr size_t WS_XN = WS_CVB + 4ull * 4096 * 512 * 2;
constexpr size_t WS_PROJ = WS_XN + (size_t)MROWS * 1024 * 2;
constexpr size_t WS_VEC = WS_PROJ + (size_t)MROWS * 4608 * 2;
constexpr size_t WS_BAR = WS_VEC + 3ull * (MROWS / 64) * 1024 * 4;
constexpr size_t WS_STATS = WS_BAR + 16384;
constexpr size_t WS_CV_WGU = WS_STATS + 12ull * MROWS * 8;
constexpr size_t WS_CV_HWIN = WS_CV_WGU + 8ull * 2 * 5632 * 4;
constexpr size_t WS_CV_GWIN = WS_CV_HWIN + 2ull * 2 * 4608 * 4;
constexpr size_t WS_ZERO_END = WS_CV_GWIN + 2ull * 2 * 4096 * 4;
constexpr size_t WS_END = WS_ZERO_END;

struct Params {
    const float* in[23];
    float* out;
    unsigned char* ws;
    int ph_lo, ph_hi;
};

__device__ __forceinline__ unsigned pk2(float lo, float hi) { f32x2 v = {lo, hi}; nbf2 b = __builtin_convertvector(v, nbf2); return __builtin_bit_cast(unsigned, b); }
__device__ __forceinline__ float bflo(unsigned u) { return __uint_as_float(u << 16); }
__device__ __forceinline__ float bfhi(unsigned u) { return __uint_as_float(u & 0xffff0000u); }
__device__ __forceinline__ bf16_t f2bf(float f) { unsigned u = pk2(f, 0.f); return (bf16_t)(u & 0xffffu); }
__device__ __forceinline__ float sigmoidf_(float x) { return __builtin_amdgcn_rcpf(1.0f + __expf(-x)); }
__device__ __forceinline__ int ltid() { int t = threadIdx.x; asm volatile("" : "+v"(t)); return t; }
__device__ __forceinline__ int lbid() { int t = blockIdx.x; asm volatile("" : "+s"(t)); return t; }
#define MFMA16(a, b, c) __builtin_amdgcn_mfma_f32_16x16x32_bf16((a), (b), (c), 0, 0, 0)

constexpr int BM = 256, BK = 64, HALF = 128, HTB = HALF * BK * 2, NXCD = 8, WGM = 8;
__device__ __forceinline__ int lds_byte(int r, int c) { const int st = (r >> 4) * 2 + (c >> 5), rr = r & 15, cc = c & 31, ob = rr * 64 + cc * 2; return st * 1024 + (ob ^ (((ob >> 9) & 1) << 5)); }
__device__ __forceinline__ void stage_rc(int b, int& R, int& C) { const int st = b / 1024, sb = b % 1024, swz = sb ^ (((sb >> 9) & 1) << 5); R = (st >> 1) * 16 + swz / 64; C = (st & 1) * 32 + (swz % 64) / 2; }
__device__ __forceinline__ int perm32(int rho) { const int n = rho >> 4, i = rho & 15; return 8 * (i >> 2) + 4 * n + (i & 3); }

struct Unit { int pm, pn; };
struct StaticOrder {
    int nM, nN, nwg, G, c; bool rev;
    __device__ __forceinline__ void init(int M, int N, int G_, int c_, bool rev_ = false) { nM = M / BM; nN = N / BM; nwg = nM * nN; G = G_; c = c_; rev = rev_; }
    __device__ __forceinline__ bool next(int i, Unit& u) const {
        const long L = (long)i * G + c; if (L >= nwg) return false;
        int wgid = (int)L; { const int q = nwg / NXCD, r = nwg % NXCD, xcd = wgid % NXCD, off = wgid / NXCD; wgid = (xcd < r ? xcd * (q + 1) : r * (q + 1) + (xcd - r) * q) + off; }
        const int nig = WGM * nN, gid = wgid / nig, fm = gid * WGM, gsz = (nM - fm) < WGM ? (nM - fm) : WGM;
        u.pm = fm + ((wgid % nig) % gsz); u.pn = (wgid % nig) / gsz; if (rev) u.pm = nM - 1 - u.pm; return true;
    }
};

enum { EPI_SWIGLU = 0, EPI_BF16 = 1, EPI_RES = 2, EPI_MEMKV = 3 };
struct Epi { int mode; bf16_t* ob; int ldo; float* xf; float scale; float* mk_out; float* mv_out; bf16_t* mkb; bf16_t* mvb;
             const float* st_in; const float* v1; const float* v2; float* st_out; bf16_t* ybf; };
__device__ __forceinline__ void row_mu_rstd(const LAS float* XS, bool has, int rl, float& mu, float& rstd) {
    if (has) { const f32x2 q = *(const LAS f32x2*)(XS + 2 * rl); mu = q.x * (1.0f / 1024.0f); rstd = __builtin_amdgcn_rsqf(fmaxf(q.y * (1.0f / 1024.0f) - mu * mu, 0.f) + 1e-5f); }
    else { mu = 0.f; rstd = 1.0f; }
}

template <int MODE, bool HALFM> __device__ __forceinline__ void gemm_epilogue(const f32x4 (&acc)[2][2][4][2], const Unit& u, int rb, int wr, int wc, int fr, int fq, const Epi& E, LAS unsigned char* lds) {
    const int row0 = rb + wr * 64 + fr;
    const LAS float* XS = (const LAS float*)(lds + LDS_X); const bool has = (E.st_in != nullptr); const int rl0 = wr * 64 + fr;
    if constexpr (MODE == EPI_SWIGLU) {
        const int col0 = u.pn * 128 + wc * 32 + 8 * fq;
        const int cl = wc * 32 + 8 * fq;
        f32x4 c1g[2], c2g[2], c1u[2], c2u[2];
#pragma unroll
        for (int n = 0; n < 2; ++n) {
            if (has) { c1g[n] = *(const LAS f32x4*)(XS + 512 + cl + 4 * n); c2g[n] = *(const LAS f32x4*)(XS + 768 + cl + 4 * n); c1u[n] = *(const LAS f32x4*)(XS + 512 + cl + 128 + 4 * n); c2u[n] = *(const LAS f32x4*)(XS + 768 + cl + 128 + 4 * n); }
            else { c1g[n] = c2g[n] = c1u[n] = c2u[n] = (f32x4){0.f, 0.f, 0.f, 0.f}; }
        }
        float mus[2][4], rstds[2][4];
#pragma unroll
        for (int ai = 0; ai < 2; ++ai)
#pragma unroll
            for (int m = 0; m < 4; ++m) row_mu_rstd(XS, has, rl0 + ai * HALF + m * 16, mus[ai][m], rstds[ai][m]);
#pragma unroll
        for (int ai = 0; ai < 2; ++ai)
#pragma unroll
            for (int m = 0; m < 4; ++m) {
                const int row = row0 + ai * HALF + m * 16;
                const float mu = mus[ai][m], rstd = rstds[ai][m];
                bf16_t* rowp = E.ob + (size_t)row * E.ldo + col0;
                float h[8];
#pragma unroll
                for (int n = 0; n < 2; ++n)
#pragma unroll
                    for (int j = 0; j < 4; ++j) { const float g = rstd * (acc[ai][0][m][n][j] - mu * c1g[n][j]) + c2g[n][j], up = rstd * (acc[ai][1][m][n][j] - mu * c1u[n][j]) + c2u[n][j];
                        h[n * 4 + j] = g * up * __builtin_amdgcn_rcpf(1.0f + __expf(-g)); }
                u32x4 w; w.x = pk2(h[0], h[1]); w.y = pk2(h[2], h[3]); w.z = pk2(h[4], h[5]); w.w = pk2(h[6], h[7]);
                *(u32x4*)rowp = w;
            }
    } else if constexpr (MODE == EPI_BF16) {
        const int col0 = u.pn * BM + wc * 32 + 8 * fq, cl = wc * 32 + 8 * fq;
        f32x4 c1[2][2], c2[2][2];
#pragma unroll
        for (int bj = 0; bj < 2; ++bj)
#pragma unroll
            for (int n = 0; n < 2; ++n) { c1[bj][n] = *(const LAS f32x4*)(XS + 512 + cl + bj * HALF + 4 * n); c2[bj][n] = *(const LAS f32x4*)(XS + 768 + cl + bj * HALF + 4 * n); }
#pragma unroll
        for (int ai = 0; ai < 2; ++ai)
#pragma unroll
            for (int m = 0; m < 4; ++m) {
                const int row = row0 + ai * HALF + m * 16;
                float mu, rstd; row_mu_rstd(XS, has, rl0 + ai * HALF + m * 16, mu, rstd);
                bf16_t* rowp = E.ob + (size_t)row * E.ldo + col0;
#pragma unroll
                for (int bj = 0; bj < 2; ++bj) {
                    const f32x4 v0 = (acc[ai][bj][m][0] - c1[bj][0] * mu) * rstd + c2[bj][0], v1 = (acc[ai][bj][m][1] - c1[bj][1] * mu) * rstd + c2[bj][1];
                    u32x4 w; w.x = pk2(v0[0], v0[1]); w.y = pk2(v0[2], v0[3]); w.z = pk2(v1[0], v1[1]); w.w = pk2(v1[2], v1[3]);
                    *(u32x4*)(rowp + bj * HALF) = w;
                }
            }
    } else if constexpr (MODE == EPI_RES) {
        const int col0 = u.pn * BM + wc * 32 + 4 * fq, cl = wc * 32 + 4 * fq;
        constexpr int NG = HALFM ? 4 : 8;
#pragma unroll
        for (int bt = 0; bt < (NG + 2) / 3; ++bt) {
            const int g0 = bt * 3, ng = (NG - g0) < 3 ? (NG - g0) : 3;
            f32x4 xv[3][2][2];
#pragma unroll
            for (int gi = 0; gi < 3; ++gi) if (gi < ng) { const int g = g0 + gi, ai = g >> 2, m = g & 3; const float* rowp = E.xf + (size_t)(row0 + ai * HALF + m * 16) * D + col0;
#pragma unroll
                for (int bj = 0; bj < 2; ++bj)
#pragma unroll
                    for (int n = 0; n < 2; ++n) xv[gi][bj][n] = *(const f32x4*)(rowp + bj * HALF + n * 16); }
#pragma unroll
            for (int gi = 0; gi < 3; ++gi) if (gi < ng) {
                const int g = g0 + gi, ai = g >> 2, m = g & 3;
                const int row = row0 + ai * HALF + m * 16;
                float mu, rstd; row_mu_rstd(XS, has, rl0 + ai * HALF + m * 16, mu, rstd);
                float* rowp = E.xf + (size_t)row * D + col0; bf16_t* rowb = E.ybf + (size_t)row * D + col0;
                float s1 = 0.f, s2 = 0.f;
#pragma unroll
                for (int bj = 0; bj < 2; ++bj)
#pragma unroll
                    for (int n = 0; n < 2; ++n) { f32x4 x = xv[gi][bj][n];
                        if (has) { const f32x4 gp = *(const LAS f32x4*)(XS + 512 + cl + bj * HALF + n * 16), bp = *(const LAS f32x4*)(XS + 768 + cl + bj * HALF + n * 16); x = (x - mu) * rstd * gp + bp; }
                        x = x * ALPHA + acc[ai][bj][m][n] * E.scale;
                        *(f32x4*)(rowp + bj * HALF + n * 16) = x;
                        u32x2 w; w.x = pk2(x[0], x[1]); w.y = pk2(x[2], x[3]); *(u32x2*)(rowb + bj * HALF + n * 16) = w;
                        s1 += (x[0] + x[1]) + (x[2] + x[3]); s2 += (x[0] * x[0] + x[1] * x[1]) + (x[2] * x[2] + x[3] * x[3]); }
                s1 += __shfl_xor(s1, 16); s1 += __shfl_xor(s1, 32); s2 += __shfl_xor(s2, 16); s2 += __shfl_xor(s2, 32);
                if (fq == 0) { atomicAdd(E.st_out + 2 * (size_t)row, s1); atomicAdd(E.st_out + 2 * (size_t)row + 1, s2); }
            }
            asm volatile("" ::: "memory");
        }
    } else {
        const int colt = u.pn * BM; const int l = colt >> 10, kv = (colt >> 9) & 1, cc0 = (colt & 511) + wc * 32 + 4 * fq;
        float* of = (kv ? E.mv_out : E.mk_out) + (size_t)l * 2048 * 512;
        bf16_t* ob = (kv ? E.mvb : E.mkb) + (size_t)l * 2048 * 512;
#pragma unroll
        for (int ai = 0; ai < 2; ++ai)
#pragma unroll
            for (int m = 0; m < 4; ++m) {
                const size_t ro = (size_t)(row0 + ai * HALF + m * 16) * 512 + cc0;
#pragma unroll
                for (int bj = 0; bj < 2; ++bj)
#pragma unroll
                    for (int n = 0; n < 2; ++n) { const f32x4 v = acc[ai][bj][m][n]; *(f32x4*)(of + ro + bj * HALF + n * 16) = v; u32x2 w; w.x = pk2(v[0], v[1]); w.y = pk2(v[2], v[3]); *(u32x2*)(ob + ro + bj * HALF + n * 16) = w; }
            }
    }
}

template <int MODE, bool HALFM = false> __device__ __forceinline__ void gemm_phase(LAS unsigned char* lds, const bf16_t* Ag, int lda, const bf16_t* Btg, int M, int N, int K, const Epi& E) {
    int tid_ = threadIdx.x; asm volatile("" : "+v"(tid_));
    const int tid = tid_, wid = __builtin_amdgcn_readfirstlane(tid >> 6), lane = tid & 63, wr = wid >> 2, wc = wid & 3, fr = lane & 15, fq = lane >> 4;
    const int nt = K / BK;
    constexpr bool PERM = (MODE == EPI_SWIGLU || MODE == EPI_BF16);
    StaticOrder S; { const int G_ = (int)gridDim.x; int c_ = lbid(); if (MODE == EPI_MEMKV) c_ = (c_ + G_ / 2) % G_; S.init(M, N, G_, c_, MODE == EPI_RES); }
    unsigned voffA[2], voffB[2];
#pragma unroll
    for (int i = 0; i < 2; ++i) { int R, C; stage_rc(tid * 16 + i * 8192, R, C); const int Rb = PERM ? ((R & ~31) + perm32(R & 31)) : R;
        voffA[i] = (unsigned)(R * lda + C) * 2u; voffB[i] = (unsigned)(Rb * K + C) * 2u; }
    const size_t kstep = (size_t)(BK * 2);
    const size_t hstepA = (size_t)HALF * lda * 2, hstepB = (size_t)HALF * K * 2;
    const size_t tstepA = 2 * hstepA, tstepB = 2 * hstepB;
    const size_t hA1 = HALFM ? 0 : hstepA;
    const unsigned ldsw = (unsigned)wid * 1024u;
    const int aoff = lds_byte(wr * 64 + fr, fq * 8), boff = lds_byte(wc * 32 + fr, fq * 8);
#define PG8_SA(b, h) (((b) * 2 + (h)) * HTB)
#define PG8_SB(b, h) ((4 + (b) * 2 + (h)) * HTB)
#define PG8_STAGE(bufoff, gbase, voff) do { _Pragma("unroll") for (int _i = 0; _i < 2; ++_i) \
        __builtin_amdgcn_global_load_lds((const unsigned*)((const char*)(gbase) + (voff)[_i]), (LAS unsigned*)(lds + (bufoff) + ldsw + _i * 8192), 16, 0, 0); } while (0)
#define PG8_LDA(dst, b, h) do { _Pragma("unroll") for (int m = 0; m < 4; ++m) _Pragma("unroll") for (int k = 0; k < 2; ++k) dst[m][k] = *(const LAS bf16x8*)(lds + PG8_SA(b, h) + aoff + m * 2048 + k * 1024); } while (0)
#define PG8_LDB(dst, b, h) do { _Pragma("unroll") for (int n = 0; n < 2; ++n) _Pragma("unroll") for (int k = 0; k < 2; ++k) dst[n][k] = *(const LAS bf16x8*)(lds + PG8_SB(b, h) + boff + n * 2048 + k * 1024); } while (0)
#define PG8_MMA(ai, bj, At, Bt) do { __builtin_amdgcn_s_setprio(1); _Pragma("unroll") for (int m = 0; m < 4; ++m) _Pragma("unroll") for (int n = 0; n < 2; ++n) _Pragma("unroll") for (int k = 0; k < 2; ++k) \
        acc[ai][bj][m][n] = __builtin_amdgcn_mfma_f32_16x16x32_bf16(Bt[n][k], At[m][k], acc[ai][bj][m][n], 0, 0, 0); __builtin_amdgcn_s_setprio(0); } while (0)
#define PG8_WAIT_V(n) asm volatile("s_waitcnt vmcnt(" #n ")" ::: "memory")
#define PG8_WAIT_L(n) asm volatile("s_waitcnt lgkmcnt(" #n ")" ::: "memory")
#define PG8_BAR __builtin_amdgcn_s_barrier()
#define PG8_SCHED __builtin_amdgcn_sched_barrier(0)
    Unit cur, nxt; int ui = 0; int rb;
    if constexpr (HALFM) { const int c_ = S.c; if (c_ >= 8 * (N / BM)) return; cur.pm = M / 128 + (c_ & 7); cur.pn = c_ >> 3; rb = cur.pm * 128; }
    else { if (!S.next(0, cur)) return; rb = cur.pm * BM; }
    f32x4 acc[2][2][4][2];
#pragma unroll
    for (int a = 0; a < 2; ++a)
#pragma unroll
        for (int b = 0; b < 2; ++b)
#pragma unroll
            for (int m = 0; m < 4; ++m)
#pragma unroll
                for (int n = 0; n < 2; ++n) acc[a][b][m][n] = (f32x4){0.f, 0.f, 0.f, 0.f};
    bf16x8 At[4][2], B0[2][2], B1[2][2];
    const char* cA = (const char*)Ag + (size_t)cur.pm * (HALFM ? hstepA : tstepA); const char* cB = (const char*)Btg + (size_t)cur.pn * tstepB;
    PG8_STAGE(PG8_SB(0, 0), cB, voffB); PG8_STAGE(PG8_SA(0, 0), cA, voffA); PG8_STAGE(PG8_SB(0, 1), cB + hstepB, voffB); PG8_STAGE(PG8_SA(0, 1), cA + hA1, voffA);
    if (wr == 1) PG8_BAR;
    PG8_WAIT_V(4); PG8_BAR;
    PG8_STAGE(PG8_SB(1, 0), cB + kstep, voffB); PG8_STAGE(PG8_SA(1, 0), cA + kstep, voffA); PG8_STAGE(PG8_SB(1, 1), cB + hstepB + kstep, voffB);
    PG8_WAIT_V(6); PG8_BAR;
    for (;;) {
        const bool has_next = HALFM ? false : S.next(ui + 1, nxt);
        const char* nA = has_next ? (const char*)Ag + (size_t)nxt.pm * tstepA : cA; const char* nB = has_next ? (const char*)Btg + (size_t)nxt.pn * tstepB : cB;
        for (int t = 0; t < nt; t += 2) {
            const bool last = (t == nt - 2);
            if (MODE != EPI_MEMKV && t == nt - 4 && E.st_in != nullptr && wid < 4) {
                const char* gsrc = wid < 2 ? (const char*)(E.st_in + 2 * ((size_t)rb + (HALFM ? 0 : wid * 128))) : (const char*)((wid == 2 ? E.v1 : E.v2) + cur.pn * BM);
                __builtin_amdgcn_global_load_lds((const unsigned*)(gsrc + lane * 16), (LAS unsigned*)(lds + LDS_X + wid * 1024), 16, 0, 0);
            }
            const char* a1 = cA + (size_t)(t + 1) * kstep;
            const char* a2 = last ? nA : cA + (size_t)(t + 2) * kstep; const char* b2 = last ? nB : cB + (size_t)(t + 2) * kstep;
            const char* a3 = a2 + kstep; const char* b3 = b2 + kstep;
            PG8_LDB(B0, 0, 0); PG8_SCHED; PG8_LDA(At, 0, 0); PG8_STAGE(PG8_SA(1, 1), a1 + hA1, voffA);
            PG8_WAIT_L(8); PG8_BAR; PG8_WAIT_L(0); PG8_MMA(0, 0, At, B0); PG8_BAR; PG8_SCHED;
            PG8_LDB(B1, 0, 1); PG8_STAGE(PG8_SB(0, 0), b2, voffB);
            PG8_BAR; PG8_WAIT_L(0); PG8_MMA(0, 1, At, B1); PG8_BAR;
            if constexpr (!HALFM) PG8_LDA(At, 0, 1); PG8_STAGE(PG8_SA(0, 0), a2, voffA);
            PG8_BAR; PG8_WAIT_L(0); if constexpr (!HALFM) PG8_MMA(1, 0, At, B0); PG8_BAR; PG8_SCHED;
            PG8_STAGE(PG8_SB(0, 1), b2 + hstepB, voffB);
            PG8_WAIT_V(6); PG8_BAR; if constexpr (!HALFM) PG8_MMA(1, 1, At, B1); PG8_BAR;
            PG8_LDB(B0, 1, 0); PG8_SCHED; PG8_LDA(At, 1, 0); PG8_STAGE(PG8_SA(0, 1), a2 + hA1, voffA);
            PG8_WAIT_L(8); PG8_BAR; PG8_WAIT_L(0); PG8_MMA(0, 0, At, B0); PG8_BAR; PG8_SCHED;
            PG8_LDB(B1, 1, 1); PG8_STAGE(PG8_SB(1, 0), b3, voffB);
            PG8_BAR; PG8_WAIT_L(0); PG8_MMA(0, 1, At, B1); PG8_BAR;
            if constexpr (!HALFM) PG8_LDA(At, 1, 1); PG8_STAGE(PG8_SA(1, 0), a3, voffA);
            PG8_BAR; PG8_WAIT_L(0); if constexpr (!HALFM) PG8_MMA(1, 0, At, B0); PG8_BAR; PG8_SCHED;
            PG8_STAGE(PG8_SB(1, 1), b3 + hstepB, voffB);
            PG8_WAIT_V(6); PG8_BAR; if constexpr (!HALFM) PG8_MMA(1, 1, At, B1); PG8_BAR;
        }
        gemm_epilogue<MODE, HALFM>(acc, cur, rb, wr, wc, fr, fq, E, lds);
        if (!has_next) break;
#pragma unroll
        for (int a = 0; a < 2; ++a)
#pragma unroll
            for (int b = 0; b < 2; ++b)
#pragma unroll
                for (int m = 0; m < 4; ++m)
#pragma unroll
                    for (int n = 0; n < 2; ++n) acc[a][b][m][n] = (f32x4){0.f, 0.f, 0.f, 0.f};
        cur = nxt; cA = nA; cB = nB; ++ui; rb = cur.pm * BM;
    }
    PG8_WAIT_V(0);
    if (wr == 0) PG8_BAR;
    PG8_BAR;
#undef PG8_SA
#undef PG8_SB
#undef PG8_STAGE
#undef PG8_LDA
#undef PG8_LDB
#undef PG8_MMA
#undef PG8_WAIT_V
#undef PG8_WAIT_L
#undef PG8_BAR
#undef PG8_SCHED
}

__device__ __forceinline__ void transpose_job(LAS unsigned char* lds, const float* src, int ld, int K, int c0, int ncols, bf16_t* dst, int rowmode, int drow0,
                                              const float* gk, const float* bk, float* c1, float* c2) {
    LAS float* tile = (LAS float*)lds;
    int tid_ = threadIdx.x; asm volatile("" : "+v"(tid_)); const int tid = tid_;
    const int nkt = K / 64, nct = ncols / 64, ntiles = nkt * nct;
    const int kr = tid >> 4, c4 = (tid & 15) * 4;
    f32x4 pv[2];
    { const int t = lbid(); if (t < ntiles) { const int k0 = (t % nkt) * 64, n0 = (t / nkt) * 64;
#pragma unroll
        for (int rr = 0; rr < 2; ++rr) pv[rr] = *(const f32x4*)(src + (size_t)(k0 + kr + 32 * rr) * ld + c0 + n0 + c4); } }
    for (int t = lbid(); t < ntiles; t += gridDim.x) {
        const int kt = t % nkt, ct = t / nkt;
        const int k0 = kt * 64, n0 = ct * 64;
#pragma unroll
        for (int rr = 0; rr < 2; ++rr) { const f32x4 v = pv[rr];
            tile[(kr + 32 * rr) * 65 + c4 + 0] = v[0]; tile[(kr + 32 * rr) * 65 + c4 + 1] = v[1]; tile[(kr + 32 * rr) * 65 + c4 + 2] = v[2]; tile[(kr + 32 * rr) * 65 + c4 + 3] = v[3]; }
        { const int tn = t + gridDim.x; if (tn < ntiles) { const int k1 = (tn % nkt) * 64, n1 = (tn / nkt) * 64;
#pragma unroll
            for (int rr = 0; rr < 2; ++rr) pv[rr] = *(const f32x4*)(src + (size_t)(k1 + kr + 32 * rr) * ld + c0 + n1 + c4); } }
        __syncthreads();
        { const int n = tid >> 3, k8 = (tid & 7) * 8; float v[8];
#pragma unroll
          for (int i = 0; i < 8; ++i) v[i] = tile[(k8 + i) * 65 + n];
          const int c = c0 + n0 + n; int drow;
          if (rowmode == 0) drow = drow0 + c; else drow = 256 * (c >> 7) + (c & 127) + (rowmode == 2 ? 128 : 0);
          u32x4 w;
          if (gk) {
              const f32x4 g0 = *(const f32x4*)(gk + k0 + k8), g1 = *(const f32x4*)(gk + k0 + k8 + 4), b0 = *(const f32x4*)(bk + k0 + k8), b1 = *(const f32x4*)(bk + k0 + k8 + 4);
              float s2 = 0.f;
#pragma unroll
              for (int i = 0; i < 4; ++i) { s2 += b0[i] * v[i] + b1[i] * v[4 + i]; v[i] *= g0[i]; v[4 + i] *= g1[i]; }
              w.x = pk2(v[0], v[1]); w.y = pk2(v[2], v[3]); w.z = pk2(v[4], v[5]); w.w = pk2(v[6], v[7]);
              float s1 = 0.f;
#pragma unroll
              for (int i = 0; i < 4; ++i) s1 += bflo(w[i]) + bfhi(w[i]);
              s1 += __shfl_xor(s1, 1); s1 += __shfl_xor(s1, 2); s1 += __shfl_xor(s1, 4);
              s2 += __shfl_xor(s2, 1); s2 += __shfl_xor(s2, 2); s2 += __shfl_xor(s2, 4);
              if ((tid & 7) == 0) { atomicAdd(c1 + drow, s1); atomicAdd(c2 + drow, s2); }
          } else { w.x = pk2(v[0], v[1]); w.y = pk2(v[2], v[3]); w.z = pk2(v[4], v[5]); w.w = pk2(v[6], v[7]); }
          *(u32x4*)(dst + (size_t)drow * K + k0 + k8) = w; }
        __syncthreads();
    }
}
__device__ __forceinline__ void convert_job(const float* src, bf16_t* dst, float* dstf, size_t n) {
    const size_t nv = n / 8, stride = (size_t)gridDim.x * NTHR;
    for (size_t i = (size_t)lbid() * NTHR + ltid(); i < nv; i += 2 * stride) {
        const size_t i2 = i + stride; const bool two = i2 < nv;
        const f32x4 a = *(const f32x4*)(src + i * 8), b = *(const f32x4*)(src + i * 8 + 4);
        f32x4 c = a, d = b; if (two) { c = *(const f32x4*)(src + i2 * 8); d = *(const f32x4*)(src + i2 * 8 + 4); }
        u32x4 w; w.x = pk2(a[0], a[1]); w.y = pk2(a[2], a[3]); w.z = pk2(b[0], b[1]); w.w = pk2(b[2], b[3]);
        *(u32x4*)(dst + i * 8) = w;
        if (dstf) { *(f32x4*)(dstf + i * 8) = a; *(f32x4*)(dstf + i * 8 + 4) = b; }
        if (two) { w.x = pk2(c[0], c[1]); w.y = pk2(c[2], c[3]); w.z = pk2(d[0], d[1]); w.w = pk2(d[2], d[3]);
            *(u32x4*)(dst + i2 * 8) = w;
            if (dstf) { *(f32x4*)(dstf + i2 * 8) = c; *(f32x4*)(dstf + i2 * 8 + 4) = d; } }
    }
}
__device__ __forceinline__ void prep_phase(LAS unsigned char* lds, const Params& p) {
    unsigned char* ws = p.ws;
    for (int jb = 0; jb < 52; ++jb) {
        const float* src; int ld, K, c0, ncols, rowmode, drow0; bf16_t* dst; int li = -1; float* cv = nullptr; int cvn = 0;
        if (jb < 24) { const int lf = jb / 3, t = jb % 3;
            if (t < 2) { src = (t == 0 ? p.in[7] : p.in[8]) + (size_t)lf * 1024 * FF; ld = FF; K = 1024; c0 = 0; ncols = FF; dst = (bf16_t*)(ws + WS_WGU) + (size_t)lf * 5632 * 1024; rowmode = 1 + t; drow0 = 0;
                if (lf > 0) { li = (lf & 1) ? 3 * (lf >> 1) + 1 : 3 * (lf >> 1) - 1; cv = (float*)(ws + WS_CV_WGU) + (size_t)lf * 2 * 5632; cvn = 5632; } }
            else { src = p.in[9] + (size_t)lf * FF * 1024; ld = 1024; K = FF; c0 = 0; ncols = 1024; dst = (bf16_t*)(ws + WS_WD) + (size_t)lf * 1024 * FF; rowmode = 0; drow0 = 0; }
        } else if (jb < 44) { const int j = (jb - 24) / 10, t = (jb - 24) % 10; rowmode = 0; K = 1024;
            if (t < 4) {
                src = p.in[12] + (size_t)j * 1024 * 4608; ld = 4608; dst = (bf16_t*)(ws + WS_HWIN) + (size_t)j * 4608 * 1024;
                c0 = t == 0 ? 0 : (t == 1 ? 3072 : (t == 2 ? 2048 : 4096)); ncols = t == 0 ? 2048 : (t == 3 ? 512 : 1024); drow0 = (t == 0 ? 0 : (t == 1 ? 2048 : (t == 2 ? 3072 : 4096))) - c0;
                li = 3 * (2 * j); cv = (float*)(ws + WS_CV_HWIN) + (size_t)j * 2 * 4608; cvn = 4608;
            } else if (t < 8) {
                src = p.in[16] + (size_t)j * 1024 * 3600; ld = 3600; dst = (bf16_t*)(ws + WS_GWIN) + (size_t)j * 4096 * 1024; const int u = t - 4;
                c0 = u == 0 ? 0 : (u == 1 ? 2048 : (u == 2 ? 1024 : 3088)); ncols = u == 3 ? 512 : 1024; drow0 = (u == 0 ? 0 : (u == 1 ? 1536 : (u == 2 ? 2560 : 3584))) - c0;
                li = 3 * (2 * j + 1); cv = (float*)(ws + WS_CV_GWIN) + (size_t)j * 2 * 4096; cvn = 4096;
            } else { src = (t == 8 ? p.in[15] : p.in[20]) + (size_t)j * 1536 * 1024; ld = 1024; K = 1536; c0 = 0; ncols = 1024; dst = (bf16_t*)(ws + WS_WOUT) + (size_t)(2 * j + (t - 8)) * 1024 * 1536; drow0 = 0; }
        } else { const int l = (jb - 44) >> 1, kv = (jb - 44) & 1; src = (kv ? p.in[22] : p.in[21]) + (size_t)l * 1024 * 512; ld = 512; K = 1024; c0 = 0; ncols = 512; dst = (bf16_t*)(ws + WS_MEMW); rowmode = 0; drow0 = l * 1024 + kv * 512; }
        const float* gk = li >= 0 ? p.in[10] + li * 1024 : nullptr; const float* bk = li >= 0 ? p.in[11] + li * 1024 : nullptr;
        transpose_job(lds, src, ld, K, c0, ncols, dst, rowmode, drow0, gk, bk, cv, cv + cvn);
    }
    for (int j = 0; j < 2; ++j) {
        const float* gs = p.in[16] + (size_t)j * 1024 * 3600; bf16_t* gd = (bf16_t*)(ws + WS_GWIN) + (size_t)j * 4096 * 1024;
        const float* w2 = p.in[17] + (size_t)j * 16 * 512;
        const int li = 3 * (2 * j + 1); const float* gk = p.in[10] + li * 1024; const float* bk = p.in[11] + li * 1024;
        float* c1 = (float*)(ws + WS_CV_GWIN) + (size_t)j * 2 * 4096; float* c2 = c1 + 4096;
        for (int i = lbid() * NTHR + ltid(); i < 512 * 1024; i += gridDim.x * NTHR) {
            const int c = i >> 10, kk = i & 1023; float sacc = 0.f;
#pragma unroll
            for (int r = 0; r < 16; ++r) sacc += gs[(size_t)kk * 3600 + 3072 + r] * w2[r * 512 + c];
            const bf16_t hv = f2bf(sacc * gk[kk]);
            gd[(size_t)(1024 + c) * 1024 + kk] = hv;
            float s1 = __uint_as_float(((unsigned)hv) << 16), s2 = sacc * bk[kk];
#pragma unroll
            for (int o = 32; o >= 1; o >>= 1) { s1 += __shfl_xor(s1, o); s2 += __shfl_xor(s2, o); }
            if ((kk & 63) == 0) { atomicAdd(c1 + 1024 + c, s1); atomicAdd(c2 + 1024 + c, s2); }
        }
    }
    for (int jb = 0; jb < 5; ++jb) {
        const float* src; bf16_t* dst; float* dstf = nullptr; size_t n;
        if (jb == 0) { src = p.in[0]; dst = (bf16_t*)(ws + WS_XN); dstf = p.out + O_Y; n = (size_t)MP * D; }
        else if (jb == 1) { src = p.in[1]; dst = (bf16_t*)(ws + WS_XN) + (size_t)MP * D; dstf = p.out + O_Y + (size_t)MP * D; n = (size_t)MS * D; }
        else if (jb == 2) { src = p.in[2]; dst = (bf16_t*)(ws + WS_MEMP); n = (size_t)2048 * 1024; }
        else if (jb == 3) { src = p.in[3]; dst = (bf16_t*)(ws + WS_CKB); n = (size_t)4 * 4096 * 512; }
        else { src = p.in[4]; dst = (bf16_t*)(ws + WS_CVB); n = (size_t)4 * 4096 * 512; }
        convert_job(src, dst, dstf, n);
    }
}

__device__ __forceinline__ void ln_phase(float* x, bf16_t* xn, const float* gain, const float* bias) {
    int tid_ = threadIdx.x; asm volatile("" : "+v"(tid_));
    const int lane = tid_ & 63, wv = tid_ >> 6;
    f32x4 g[4], b[4];
#pragma unroll
    for (int i = 0; i < 4; ++i) { g[i] = *(const f32x4*)(gain + 4 * lane + 256 * i); b[i] = *(const f32x4*)(bias + 4 * lane + 256 * i); }
    const int rstep = gridDim.x * 8;
    int row = lbid() * 8 + wv;
    f32x4 nv[4];
    if (row < MROWS) {
#pragma unroll
        for (int i = 0; i < 4; ++i) nv[i] = *(const f32x4*)(x + (size_t)row * D + 4 * lane + 256 * i); }
    for (; row < MROWS; row += rstep) {
        float* xr = x + (size_t)row * D; f32x4 v[4]; float s = 0.f;
#pragma unroll
        for (int i = 0; i < 4; ++i) { v[i] = nv[i]; s += (v[i][0] + v[i][1]) + (v[i][2] + v[i][3]); }
        if (row + rstep < MROWS) {
#pragma unroll
            for (int i = 0; i < 4; ++i) nv[i] = *(const f32x4*)(x + (size_t)(row + rstep) * D + 4 * lane + 256 * i); }
#pragma unroll
        for (int o = 32; o >= 1; o >>= 1) s += __shfl_xor(s, o);
        const float mu = s * (1.0f / 1024.0f); float q = 0.f;
#pragma unroll
        for (int i = 0; i < 4; ++i) { const f32x4 d = v[i] - mu; q += (d[0] * d[0] + d[1] * d[1]) + (d[2] * d[2] + d[3] * d[3]); }
#pragma unroll
        for (int o = 32; o >= 1; o >>= 1) q += __shfl_xor(q, o);
        const float rs = 1.0f / sqrtf(q * (1.0f / 1024.0f) + 1e-5f);
#pragma unroll
        for (int i = 0; i < 4; ++i) { const f32x4 o = (v[i] - mu) * rs * g[i] + b[i]; *(f32x4*)(xr + 4 * lane + 256 * i) = o;
            if (xn) { u32x2 w; w.x = pk2(o[0], o[1]); w.y = pk2(o[2], o[3]); *(u32x2*)(xn + (size_t)row * D + 4 * lane + 256 * i) = w; } }
    }
}

__device__ __forceinline__ void headnorm_phase(bf16_t* proj, int ld, int ocol, int gcol, int lanes_per_head  , const float* gain) {
    int tid_ = threadIdx.x; asm volatile("" : "+v"(tid_));
    const int lane = tid_ & 63, wv = tid_ >> 6;
    float gn[2][8];
#pragma unroll
    for (int hh = 0; hh < 2; ++hh)
#pragma unroll
        for (int i = 0; i < 8; ++i) gn[hh][i] = gain[hh * 512 + 8 * lane + i];
    const float invn = lanes_per_head == 16 ? (1.0f / 128.0f) : (1.0f / 256.0f);
    const int rstep = gridDim.x * 8;
    int row = lbid() * 8 + wv;
    u32x4 nov[2], ngv[2];
    if (row < MROWS) { const bf16_t* pr = proj + (size_t)row * ld;
#pragma unroll
        for (int hh = 0; hh < 2; ++hh) { nov[hh] = *(const u32x4*)(pr + ocol + hh * 512 + 8 * lane); ngv[hh] = *(const u32x4*)(pr + gcol + hh * 512 + 8 * lane); } }
    for (; row < MROWS; row += rstep) {
        bf16_t* pr = proj + (size_t)row * ld;
        u32x4 cov[2], cgv[2];
#pragma unroll
        for (int hh = 0; hh < 2; ++hh) { cov[hh] = nov[hh]; cgv[hh] = ngv[hh]; }
        if (row + rstep < MROWS) { const bf16_t* pn = proj + (size_t)(row + rstep) * ld;
#pragma unroll
            for (int hh = 0; hh < 2; ++hh) { nov[hh] = *(const u32x4*)(pn + ocol + hh * 512 + 8 * lane); ngv[hh] = *(const u32x4*)(pn + gcol + hh * 512 + 8 * lane); } }
#pragma unroll
        for (int hh = 0; hh < 2; ++hh) {
            const u32x4 ov = cov[hh], gv = cgv[hh];
            float o[8], g[8];
#pragma unroll
            for (int i = 0; i < 4; ++i) { o[2 * i] = bflo(ov[i]); o[2 * i + 1] = bfhi(ov[i]); g[2 * i] = bflo(gv[i]); g[2 * i + 1] = bfhi(gv[i]); }
            float s = 0.f;
#pragma unroll
            for (int i = 0; i < 8; ++i) s += o[i] * o[i];
            s += __shfl_xor(s, 1); s += __shfl_xor(s, 2); s += __shfl_xor(s, 4); s += __shfl_xor(s, 8);
            if (lanes_per_head == 32) s += __shfl_xor(s, 16);
            const float rs = __builtin_amdgcn_rsqf(s * invn + 1e-6f);
            float r[8];
#pragma unroll
            for (int i = 0; i < 8; ++i) r[i] = o[i] * rs * gn[hh][i] * g[i] * sigmoidf_(g[i]);
            u32x4 w; w.x = pk2(r[0], r[1]); w.y = pk2(r[2], r[3]); w.z = pk2(r[4], r[5]); w.w = pk2(r[6], r[7]);
            *(u32x4*)(pr + ocol + hh * 512 + 8 * lane) = w;
        }
    }
}

constexpr int MP_G = 0, MP_T = 32768, MP_KTT = 34816, MP_QT = MP_KTT + 128 * 72 * 2, MP_KT = MP_QT + 64 * 136 * 2, MP_END = MP_KT + 64 * 136 * 2;
static_assert(MP_END <= 131072, "prepass LDS");

__device__ __forceinline__ void mixprep_loop(LAS unsigned char* lds, bf16_t* proj, int ld, int qcol, int kcol, int gcol, int gla, const float* lb0, const float* lb1, int lbj, const float* bgate,
                                             bf16_t* ktb_h, int nh, float* vec_h, int ci0, int cstep) {
    int tid_ = threadIdx.x; asm volatile("" : "+v"(tid_));
    const int tid = tid_, wid = __builtin_amdgcn_readfirstlane(tid >> 6), lane = tid & 63, fr = lane & 15, fq = lane >> 4;
    LAS float* G = (LAS float*)(lds + MP_G); LAS float* T = (LAS float*)(lds + MP_T); LAS bf16_t* KTT = (LAS bf16_t*)(lds + MP_KTT);
    LAS bf16_t* QT = (LAS bf16_t*)(lds + MP_QT); LAS bf16_t* KT = (LAS bf16_t*)(lds + MP_KT);
    const int t0 = tid >> 4, cv = tid & 15, c8 = cv * 8;
    float cA[8], cB[8];
#pragma unroll
    for (int i = 0; i < 8; ++i) {
        if (gla) { cA[i] = bgate[c8 + i]; cB[i] = 0.f; }
        else { float lb = 0.f; if (lbj == 1) lb = sigmoidf_(lb1[c8 + i] - lb0[c8 + i]); cA[i] = lb; cB[i] = 1.0f - lb; }
    }
    const float qscale = 0.08838834764831845f;
    u32x4 rq[2], rk[2], rg[2];
    rg[0] = rg[1] = (u32x4){0u, 0u, 0u, 0u};
    auto issue_loads = [&](int ci) {
        const bf16_t* base = proj + (size_t)ci * 64 * ld;
#pragma unroll
        for (int rr = 0; rr < 2; ++rr) { const bf16_t* rp = base + (size_t)(t0 + 32 * rr) * ld + c8; rq[rr] = *(const u32x4*)(rp + qcol); rk[rr] = *(const u32x4*)(rp + kcol); if (gla) rg[rr] = *(const u32x4*)(rp + gcol); }
    };
    if (ci0 < NCHUNK) issue_loads(ci0);
    for (int ci = ci0; ci < NCHUNK; ci += cstep) {
        bf16_t* base = proj + (size_t)ci * 64 * ld;
        float qv[2][8], kv[2][8], gvv[2][8];
        constexpr float LN2 = 0.6931471805599453f, L2E = 1.4426950408889634f;
        if (gla) {
#pragma unroll
            for (int rr = 0; rr < 2; ++rr)
#pragma unroll
                for (int i = 0; i < 8; ++i) {
                    const unsigned uq = rq[rr][i >> 1], uk = rk[rr][i >> 1], ug = rg[rr][i >> 1];
                    const float q = (i & 1) ? bfhi(uq) : bflo(uq), k = (i & 1) ? bfhi(uk) : bflo(uk);
                    const float g = ((i & 1) ? bfhi(ug) : bflo(ug)) + cA[i];
                    qv[rr][i] = q * qscale; kv[rr][i] = k;
                    gvv[rr][i] = (fminf(g, 0.f) - LN2 * __builtin_amdgcn_logf(1.0f + __builtin_amdgcn_exp2f(-L2E * fabsf(g)))) * (1.0f / 16.0f);
                }
        } else {
#pragma unroll
            for (int rr = 0; rr < 2; ++rr)
#pragma unroll
                for (int i = 0; i < 8; ++i) {
                    const unsigned uq = rq[rr][i >> 1], uk = rk[rr][i >> 1];
                    const float q = (i & 1) ? bfhi(uq) : bflo(uq), k = (i & 1) ? bfhi(uk) : bflo(uk);
                    qv[rr][i] = q * qscale * __builtin_amdgcn_rcpf(1.0f + __builtin_amdgcn_exp2f(-L2E * q));
                    const float e = __builtin_amdgcn_exp2f(-L2E * k), r = __builtin_amdgcn_rcpf(1.0f + e);
                    kv[rr][i] = cB[i] * e * r;
                    gvv[rr][i] = LN2 * __builtin_amdgcn_logf(fmaxf(cA[i] + cB[i] * r, 1e-6f));
                }
        }
#pragma unroll
        for (int rr = 0; rr < 2; ++rr) {
            LAS float* gp = G + (t0 + 32 * rr) * 128 + c8;
            *(LAS f32x4*)gp = (f32x4){gvv[rr][0], gvv[rr][1], gvv[rr][2], gvv[rr][3]}; *(LAS f32x4*)(gp + 4) = (f32x4){gvv[rr][4], gvv[rr][5], gvv[rr][6], gvv[rr][7]};
        }
        if (ci + cstep < NCHUNK) issue_loads(ci + cstep);
        __syncthreads();
        { const int k = tid & 127, sg = tid >> 7; float run = 0.f;
#pragma unroll
          for (int i = 0; i < 16; ++i) { run += G[(16 * sg + i) * 128 + k]; G[(16 * sg + i) * 128 + k] = run; }
          T[sg * 128 + k] = run; }
        __syncthreads();
        {
            float tA[8], tB[8], tC[8], bmid[8], blast[8];
            { const f32x4 x0 = *(const LAS f32x4*)(T + c8), x1 = *(const LAS f32x4*)(T + c8 + 4), y0 = *(const LAS f32x4*)(T + 128 + c8), y1 = *(const LAS f32x4*)(T + 128 + c8 + 4),
                  z0 = *(const LAS f32x4*)(T + 256 + c8), z1 = *(const LAS f32x4*)(T + 256 + c8 + 4);
              const f32x4 m0 = *(const LAS f32x4*)(G + 31 * 128 + c8), m1 = *(const LAS f32x4*)(G + 31 * 128 + c8 + 4), l0 = *(const LAS f32x4*)(G + 63 * 128 + c8), l1 = *(const LAS f32x4*)(G + 63 * 128 + c8 + 4);
#pragma unroll
              for (int i = 0; i < 4; ++i) { tA[i] = x0[i]; tA[4 + i] = x1[i]; tB[i] = x0[i] + y0[i]; tB[4 + i] = x1[i] + y1[i]; tC[i] = tB[i] + z0[i]; tC[4 + i] = tB[4 + i] + z1[i];
                  bmid[i] = m0[i] + tA[i]; bmid[4 + i] = m1[i] + tA[4 + i]; blast[i] = l0[i] + tC[i]; blast[4 + i] = l1[i] + tC[4 + i]; } }
#pragma unroll
            for (int rr = 0; rr < 2; ++rr) {
                const int t = t0 + 32 * rr, sg = t >> 4;
                const f32x4 g0 = *(const LAS f32x4*)(G + t * 128 + c8), g1 = *(const LAS f32x4*)(G + t * 128 + c8 + 4);
                float qt[8], kt[8];
#pragma unroll
                for (int i = 0; i < 8; ++i) {
                    const float off = sg == 0 ? 0.f : (sg == 1 ? tA[i] : (sg == 2 ? tB[i] : tC[i]));
                    const float b = (i < 4 ? g0[i & 3] : g1[i & 3]) + off;
                    qt[i] = qv[rr][i] * __expf(fminf(b - bmid[i], 80.f));
                    kt[i] = kv[rr][i] * __expf(fminf(bmid[i] - b, 80.f));
                }
                bf16_t* rp = base + (size_t)t * ld + c8;
                u32x4 w;
                w.x = pk2(qt[0], qt[1]); w.y = pk2(qt[2], qt[3]); w.z = pk2(qt[4], qt[5]); w.w = pk2(qt[6], qt[7]); *(u32x4*)(rp + qcol) = w; *(LAS u32x4*)(QT + t * 136 + c8) = w;
                w.x = pk2(kt[0], kt[1]); w.y = pk2(kt[2], kt[3]); w.z = pk2(kt[4], kt[5]); w.w = pk2(kt[6], kt[7]); *(LAS u32x4*)(KT + t * 136 + c8) = w;
#pragma unroll
                for (int i = 0; i < 4; ++i) { KTT[(c8 + 2 * i) * 72 + t] = (bf16_t)(w[i] & 0xffffu); KTT[(c8 + 2 * i + 1) * 72 + t] = (bf16_t)(w[i] >> 16); }
            }
            if (t0 == 0) {
                float* em = vec_h + (size_t)ci * 1024; float* el = em + (size_t)NCHUNK * 1024; float* elm = el + (size_t)NCHUNK * 1024;
                f32x4 v0, v1;
#pragma unroll
                for (int i = 0; i < 4; ++i) { v0[i] = __expf(bmid[i]); v1[i] = __expf(bmid[4 + i]); }
                *(f32x4*)(em + c8) = v0; *(f32x4*)(em + c8 + 4) = v1;
#pragma unroll
                for (int i = 0; i < 4; ++i) { v0[i] = __expf(blast[i]); v1[i] = __expf(blast[4 + i]); }
                *(f32x4*)(el + c8) = v0; *(f32x4*)(el + c8 + 4) = v1;
#pragma unroll
                for (int i = 0; i < 4; ++i) { v0[i] = __expf(blast[i] - bmid[i]); v1[i] = __expf(blast[4 + i] - bmid[4 + i]); }
                *(f32x4*)(elm + c8) = v0; *(f32x4*)(elm + c8 + 4) = v1;
            }
        }
        __syncthreads();
        { const int k = tid >> 2, j = tid & 3; bf16_t* ktb = ktb_h + (size_t)ci * nh * 8192;
          const u32x4 w0 = *(const LAS u32x4*)(KTT + k * 72 + 16 * j), w1 = *(const LAS u32x4*)(KTT + k * 72 + 16 * j + 8);
          *(u32x4*)(ktb + k * 64 + 16 * j) = w0; *(u32x4*)(ktb + k * 64 + 16 * j + 8) = w1; }
        { const int ti = wid >> 1;
#pragma unroll
          for (int sh = 0; sh < 2; ++sh) { const int si = 2 * (wid & 1) + sh; f32x4 pa = {0.f, 0.f, 0.f, 0.f};
              if (si <= ti) {
#pragma unroll
                  for (int kk = 0; kk < 4; ++kk) { const bf16x8 A = *(const LAS bf16x8*)(KT + (16 * si + fr) * 136 + 32 * kk + 8 * fq), B = *(const LAS bf16x8*)(QT + (16 * ti + fr) * 136 + 32 * kk + 8 * fq); pa = MFMA16(A, B, pa); }
                  if (si == ti) {
#pragma unroll
                      for (int j = 0; j < 4; ++j) if (4 * fq + j > fr) pa[j] = 0.f; }
              }
              u32x2 w; w.x = pk2(pa[0], pa[1]); w.y = pk2(pa[2], pa[3]); *(u32x2*)(base + (size_t)(16 * ti + fr) * ld + kcol + 16 * si + 4 * fq) = w; } }
    }
    __syncthreads();
}

constexpr int MXB = 49664, MXB_QT = 0, MXB_KTT = 17408, MXB_VT = 35840, MXB_PP = 40448, MX_ST = 2 * MXB, MX_END = MX_ST + 2 * 8704;
static_assert(MX_END <= LDS_ST_OFF, "mixer LDS");

struct ChainArgs {
    bf16_t* proj; int ld; size_t row0; int nchunks;
    int qcol, kcol, vcol;
    const bf16_t* ktb;
    size_t ktb_stride;
    const float* em; const float* el; const float* elm; int vec_stride;
    const float* s0; float* sout; int sstride;
};

__device__ __forceinline__ void mixer_chain(LAS unsigned char* lds, const ChainArgs& a) {
    int tid_ = threadIdx.x; asm volatile("" : "+v"(tid_));
    const int tid = tid_, wid = __builtin_amdgcn_readfirstlane(tid >> 6), lane = tid & 63, fr = lane & 15, fq = lane >> 4;
    const int t0 = tid >> 4, c8 = (tid & 15) * 8;
    f32x4 Sacc[2];
#pragma unroll
    for (int vi = 0; vi < 2; ++vi)
#pragma unroll
        for (int j = 0; j < 4; ++j) Sacc[vi][j] = a.s0 ? a.s0[(size_t)(16 * wid + 4 * fq + j) * a.sstride + 16 * vi + fr] : 0.f;
    struct Regs { u32x4 rq[2], rkt[2], rp, rv; f32x4 vem, vel, velm; };
    Regs R0, R1;
    R0.rv = (u32x4){0u, 0u, 0u, 0u}; R1.rv = (u32x4){0u, 0u, 0u, 0u};
    auto issue_loads = [&](Regs& R, int c) {
        const bf16_t* base = a.proj + (a.row0 + (size_t)c * 64) * a.ld;
#pragma unroll
        for (int rr = 0; rr < 2; ++rr) R.rq[rr] = *(const u32x4*)(base + (size_t)(t0 + 32 * rr) * a.ld + c8 + a.qcol);
        R.rp = *(const u32x4*)(base + (size_t)(tid >> 3) * a.ld + a.kcol + 8 * (tid & 7));
        const bf16_t* kp = a.ktb + (size_t)c * a.ktb_stride + (tid >> 2) * 64 + 16 * (tid & 3);
        R.rkt[0] = *(const u32x4*)kp; R.rkt[1] = *(const u32x4*)(kp + 8);
        if (tid < 256) R.rv = *(const u32x4*)(base + (size_t)(tid >> 2) * a.ld + a.vcol + 8 * (tid & 3));
        const size_t vo = (size_t)c * a.vec_stride + 16 * wid + 4 * fq;
        R.vem = *(const f32x4*)(a.em + vo); R.vel = *(const f32x4*)(a.el + vo); R.velm = *(const f32x4*)(a.elm + vo);
    };
    f32x4 cel, celm;
    auto fill = [&](int b, const Regs& R) {
        LAS bf16_t* QT = (LAS bf16_t*)(lds + b * MXB + MXB_QT); LAS bf16_t* KTT = (LAS bf16_t*)(lds + b * MXB + MXB_KTT);
        LAS bf16_t* VT = (LAS bf16_t*)(lds + b * MXB + MXB_VT); LAS bf16_t* PP = (LAS bf16_t*)(lds + b * MXB + MXB_PP); LAS bf16_t* ST = (LAS bf16_t*)(lds + MX_ST + b * 8704);
#pragma unroll
        for (int rr = 0; rr < 2; ++rr) *(LAS u32x4*)(QT + (t0 + 32 * rr) * 136 + c8) = R.rq[rr];
        *(LAS u32x4*)(PP + (tid >> 3) * 72 + 8 * (tid & 7)) = R.rp;
        { LAS bf16_t* kp = KTT + (tid >> 2) * 72 + 16 * (tid & 3); *(LAS u32x4*)kp = R.rkt[0]; *(LAS u32x4*)(kp + 8) = R.rkt[1]; }
        if (tid < 256) { const int tv = tid >> 2, v8 = (tid & 3) * 8;
#pragma unroll
            for (int i = 0; i < 8; ++i) VT[(v8 + i) * 72 + tv] = (bf16_t)((i & 1) ? (R.rv[i >> 1] >> 16) : (R.rv[i >> 1] & 0xffffu)); }
#pragma unroll
        for (int vi = 0; vi < 2; ++vi) { u32x2 w; w.x = pk2(Sacc[vi][0] * R.vem[0], Sacc[vi][1] * R.vem[1]); w.y = pk2(Sacc[vi][2] * R.vem[2], Sacc[vi][3] * R.vem[3]); *(LAS u32x2*)(ST + (16 * vi + fr) * 136 + 16 * wid + 4 * fq) = w; }
        cel = R.vel; celm = R.velm;
    };
    auto compute = [&](int b, int c) {
        const LAS bf16_t* QT = (const LAS bf16_t*)(lds + b * MXB + MXB_QT); const LAS bf16_t* KTT = (const LAS bf16_t*)(lds + b * MXB + MXB_KTT);
        const LAS bf16_t* VT = (const LAS bf16_t*)(lds + b * MXB + MXB_VT); const LAS bf16_t* PP = (const LAS bf16_t*)(lds + b * MXB + MXB_PP); const LAS bf16_t* ST = (const LAS bf16_t*)(lds + MX_ST + b * 8704);
        { const int ti = wid >> 1, vi = wid & 1; f32x4 o = {0.f, 0.f, 0.f, 0.f};
#pragma unroll
          for (int kk = 0; kk < 2; ++kk) { const bf16x8 A = *(const LAS bf16x8*)(VT + (16 * vi + fr) * 72 + 32 * kk + 8 * fq), B = *(const LAS bf16x8*)(PP + (16 * ti + fr) * 72 + 32 * kk + 8 * fq); o = MFMA16(A, B, o); }
#pragma unroll
          for (int kk = 0; kk < 4; ++kk) { const bf16x8 A = *(const LAS bf16x8*)(ST + (16 * vi + fr) * 136 + 32 * kk + 8 * fq), B = *(const LAS bf16x8*)(QT + (16 * ti + fr) * 136 + 32 * kk + 8 * fq); o = MFMA16(A, B, o); }
          u32x2 w; w.x = pk2(o[0], o[1]); w.y = pk2(o[2], o[3]);
          *(u32x2*)(a.proj + (a.row0 + (size_t)c * 64 + 16 * ti + fr) * a.ld + a.vcol + 16 * vi + 4 * fq) = w; }
#pragma unroll
        for (int vi = 0; vi < 2; ++vi) { f32x4 u = {0.f, 0.f, 0.f, 0.f};
#pragma unroll
            for (int kk = 0; kk < 2; ++kk) { const bf16x8 A = *(const LAS bf16x8*)(KTT + (16 * wid + fr) * 72 + 32 * kk + 8 * fq), B = *(const LAS bf16x8*)(VT + (16 * vi + fr) * 72 + 32 * kk + 8 * fq); u = MFMA16(A, B, u); }
            Sacc[vi] = Sacc[vi] * cel + u * celm; }
    };
    const int n = a.nchunks;
    issue_loads(R0, 0);
    if (n > 1) issue_loads(R1, 1);
    fill(0, R0);
    if (n > 2) issue_loads(R0, 2);
    for (int c = 0; c < n; c += 2) {
        __syncthreads();
        compute(0, c);
        if (c + 1 < n) { fill(1, R1); if (c + 3 < n) issue_loads(R1, c + 3); }
        if (c + 1 < n) {
            __syncthreads();
            compute(1, c + 1);
            if (c + 2 < n) { fill(0, R0); if (c + 4 < n) issue_loads(R0, c + 4); }
        }
    }
#pragma unroll
    for (int vi = 0; vi < 2; ++vi)
#pragma unroll
        for (int j = 0; j < 4; ++j) a.sout[(size_t)(16 * wid + 4 * fq + j) * a.sstride + 16 * vi + fr] = Sacc[vi][j];
    __syncthreads();
}

constexpr int AT_PITCH = 264, AT_KOFF = 128 * AT_PITCH * 2, AT_KP = 136;
static_assert(AT_KOFF + 256 * AT_KP * 2 <= LDS_ST_OFF, "attention LDS");
__device__ __forceinline__ void mem_attn(LAS unsigned char* lds, const bf16_t* Kb, const bf16_t* Vb, bf16_t* Q, int ld, int nrows) {
    int tid_ = threadIdx.x; asm volatile("" : "+v"(tid_));
    const int tid = tid_, wid = __builtin_amdgcn_readfirstlane(tid >> 6), lane = tid & 63, fr = lane & 15, fq = lane >> 4;
    LAS bf16_t* VT = (LAS bf16_t*)lds;
    LAS bf16_t* KS = (LAS bf16_t*)(lds + AT_KOFF);
#pragma unroll
    for (int it = 0; it < 8; ++it) { const int idx = tid + NTHR * it, key = idx >> 4, v8 = (idx & 15) * 8; const u32x4 v = *(const u32x4*)(Vb + (size_t)key * 512 + v8), kx = *(const u32x4*)(Kb + (size_t)key * 512 + v8);
        *(LAS u32x4*)(KS + key * AT_KP + v8) = kx;
#pragma unroll
        for (int i = 0; i < 8; ++i) VT[(v8 + i) * AT_PITCH + key] = (bf16_t)((i & 1) ? (v[i >> 1] >> 16) : (v[i >> 1] & 0xffffu)); }
    __syncthreads();
    const float sc = 0.08838834764831845f;
    for (int q0 = wid * 16; q0 < nrows; q0 += 128) {
        bf16x8 Qf0, Qf1, Qf2, Qf3;
        { const bf16_t* qp = Q + (size_t)(q0 + fr) * ld + 8 * fq; Qf0 = *(const bf16x8*)(qp); Qf1 = *(const bf16x8*)(qp + 32); Qf2 = *(const bf16x8*)(qp + 64); Qf3 = *(const bf16x8*)(qp + 96); }
        f32x4 s[16];
#pragma unroll
        for (int a = 0; a < 16; ++a) {
            const LAS bf16_t* kp = KS + (16 * a + fr) * AT_KP + 8 * fq;
            f32x4 t = {0.f, 0.f, 0.f, 0.f};
            t = MFMA16(*(const LAS bf16x8*)(kp), Qf0, t); t = MFMA16(*(const LAS bf16x8*)(kp + 32), Qf1, t); t = MFMA16(*(const LAS bf16x8*)(kp + 64), Qf2, t); t = MFMA16(*(const LAS bf16x8*)(kp + 96), Qf3, t);
            s[a] = t;
            if ((a & 3) == 3) asm volatile("" ::: "memory");
        }
        float mx = -3.0e38f;
#pragma unroll
        for (int a = 0; a < 16; ++a) mx = fmaxf(fmaxf(mx, fmaxf(s[a][0], s[a][1])), fmaxf(s[a][2], s[a][3]));
        mx = fmaxf(mx, __shfl_xor(mx, 16)); mx = fmaxf(mx, __shfl_xor(mx, 32));
        float sum = 0.f; u32x2 pk[16];
#pragma unroll
        for (int a = 0; a < 16; ++a) { const float e0 = __expf((s[a][0] - mx) * sc), e1 = __expf((s[a][1] - mx) * sc), e2 = __expf((s[a][2] - mx) * sc), e3 = __expf((s[a][3] - mx) * sc);
            sum += (e0 + e1) + (e2 + e3); pk[a].x = pk2(e0, e1); pk[a].y = pk2(e2, e3); }
        sum += __shfl_xor(sum, 16); sum += __shfl_xor(sum, 32);
        const float inv = 1.0f / sum;
        f32x4 o[8];
#pragma unroll
        for (int dt = 0; dt < 8; ++dt) o[dt] = (f32x4){0.f, 0.f, 0.f, 0.f};
#pragma unroll
        for (int ap = 0; ap < 8; ++ap) {
            const u32x4 bv = {pk[2 * ap].x, pk[2 * ap].y, pk[2 * ap + 1].x, pk[2 * ap + 1].y};
            const bf16x8 B = __builtin_bit_cast(bf16x8, bv);
#pragma unroll
            for (int dt = 0; dt < 8; ++dt) {
                const u32x2 lo = *(const LAS u32x2*)(VT + (16 * dt + fr) * AT_PITCH + 32 * ap + 4 * fq), hi = *(const LAS u32x2*)(VT + (16 * dt + fr) * AT_PITCH + 32 * ap + 16 + 4 * fq);
                const u32x4 av = {lo.x, lo.y, hi.x, hi.y};
                o[dt] = MFMA16(__builtin_bit_cast(bf16x8, av), B, o[dt]);
            }
        }
#pragma unroll
        for (int dt = 0; dt < 8; ++dt) { u32x2 w; w.x = pk2(o[dt][0] * inv, o[dt][1] * inv); w.y = pk2(o[dt][2] * inv, o[dt][3] * inv);
            *(u32x2*)(Q + (size_t)(q0 + fr) * ld + 16 * dt + 4 * fq) = w; }
    }
    __syncthreads();
}

__device__ __forceinline__ void mixprep_phase(LAS unsigned char* lds, const Params& p, int layer) {
    const int j = layer >> 1, gla = layer & 1, w = lbid(), G = gridDim.x;
    bf16_t* proj = (bf16_t*)(p.ws + WS_PROJ);
    const int ld = gla ? GL_LD : HG_LD, nh = gla ? 4 : 8;
    bf16_t* ktb = (bf16_t*)(p.ws + WS_XN);
    float* vec = (float*)(p.ws + WS_VEC);
    const int xq = gla ? 3584 : 4096;
    for (int it = w; it < 256 + 64; it += G) {
        const bf16_t* Kb; const bf16_t* Vb; bf16_t* Qp; int nrows;
        if (it < 256) { const int bh = it >> 3, grp = it & 7, b = bh >> 2, h = bh & 3;
            Kb = (const bf16_t*)(p.ws + WS_MKB) + ((size_t)layer * 2048 + b * 256) * 512 + h * 128;
            Vb = (const bf16_t*)(p.ws + WS_MVB) + ((size_t)layer * 2048 + b * 256) * 512 + h * 128;
            Qp = proj + ((size_t)b * 8192 + grp * 1024) * ld + xq + h * 128; nrows = 1024;
        } else { const int bh = it - 256, b = bh >> 2, h = bh & 3;
            Kb = (const bf16_t*)(p.ws + WS_CKB) + ((size_t)layer * 4096 + b * 256) * 512 + h * 128;
            Vb = (const bf16_t*)(p.ws + WS_CVB) + ((size_t)layer * 4096 + b * 256) * 512 + h * 128;
            Qp = proj + ((size_t)MP + b * 64) * ld + xq + h * 128; nrows = 64;
        }
        mem_attn(lds, Kb, Vb, Qp, ld, nrows);
    }
    { const int h = w % nh;
      mixprep_loop(lds, proj, ld, h * 128, (gla ? 512 : 1024) + h * 128, gla ? 1024 + h * 128 : 0, gla,
                   gla ? nullptr : p.in[13] + h * 128, gla ? nullptr : p.in[13] + 1024 + h * 128, j, gla ? p.in[18] + j * 512 + h * 128 : nullptr,
                   ktb + (size_t)h * 8192, nh, vec + h * 128, w / nh, G / nh); }
}
__device__ __forceinline__ void chain_phase(LAS unsigned char* lds, const Params& p, int layer) {
    const int j = layer >> 1, gla = layer & 1, w = lbid(), G = gridDim.x;
    bf16_t* proj = (bf16_t*)(p.ws + WS_PROJ);
    const int ld = gla ? GL_LD : HG_LD;
    const int nvs = gla ? 8 : 4, nh = gla ? 4 : 8, vdim = gla ? 256 : 128;
    const bf16_t* ktb = (const bf16_t*)(p.ws + WS_XN);
    const float* vec = (const float*)(p.ws + WS_VEC);
    const int n_prompt = 8 * nh * nvs  , n_sample = 16 * nh * nvs  ;
    for (int it = w; it < n_prompt + n_sample; it += G) {
        const bool smp = it >= n_prompt; const int id = smp ? it - n_prompt : it;
        const int lo = id & 7, rest = id >> 3, vs = rest % nvs, hi = rest / nvs, bh = lo + 8 * hi, b = bh / nh, h = bh % nh;
        ChainArgs a;
        a.proj = proj; a.ld = ld;
        a.row0 = smp ? (size_t)MP + (size_t)b * 64 : (size_t)b * 8192; a.nchunks = smp ? 1 : 128;
        const int ci0 = smp ? 1024 + b : b * 128;
        if (gla) { a.qcol = h * 128; a.kcol = 512 + h * 128; a.vcol = 2560 + h * 256 + 32 * vs; }
        else { a.qcol = h * 128; a.kcol = 1024 + h * 128; a.vcol = 3072 + h * 128 + 32 * vs; }
        a.ktb = ktb + ((size_t)ci0 * nh + h) * 8192; a.ktb_stride = (size_t)nh * 8192;
        a.em = vec + (size_t)ci0 * 1024 + h * 128; a.el = a.em + (size_t)NCHUNK * 1024; a.elm = a.el + (size_t)NCHUNK * 1024; a.vec_stride = 1024;
        const size_t per_b = (size_t)nh * 128 * vdim, so = ((size_t)b * nh + h) * 128 * vdim + 32 * vs;
        if (smp) { a.s0 = (gla ? p.in[6] : p.in[5]) + (size_t)j * 16 * per_b + so; a.sout = p.out + (gla ? O_SGS : O_SHS) + (size_t)j * 16 * per_b + so; }
        else { a.s0 = nullptr; a.sout = p.out + (gla ? O_SGP : O_SHP) + (size_t)j * 8 * per_b + so; }
        a.sstride = vdim;
        mixer_chain(lds, a);
    }
}

#define XB_TMO      128
#define XB_XCNT(j)  (256  + 64 * (j))
#define XB_XSUB(j)  (1280 + 64 * (j))
#define XB_XGEN(j)  (2304 + 64 * (j))
#define XB_TOP      3328
#define XB_TOPGEN   3392
#define XCD_BAR_WORDS 3456
#define XB_SPIN_CAP (1u << 22)
__device__ __forceinline__ unsigned xb_ld(unsigned* p)              { return __hip_atomic_load(p, __ATOMIC_RELAXED, __HIP_MEMORY_SCOPE_AGENT); }
__device__ __forceinline__ unsigned xb_add(unsigned* p, unsigned v) { return __hip_atomic_fetch_add(p, v, __ATOMIC_RELAXED, __HIP_MEMORY_SCOPE_AGENT); }
__device__ __forceinline__ unsigned xb_xcc_id() { return (unsigned)__builtin_amdgcn_s_getreg((3 << 11) | 20) & 0xFu; }
#define XB_SPIN(cond, bar) do { unsigned _sp = 0; while (cond) { __builtin_amdgcn_s_sleep(1); \
    if ((++_sp & 255u) == 0u) { if (xb_ld(&(bar)[XB_TMO])) break; if (_sp > XB_SPIN_CAP) { atomicAdd(&(bar)[XB_TMO], 1u); break; } } } } while (0)
struct XcdBarrier { unsigned* bar; unsigned x; volatile LAS unsigned* st; };
__device__ __forceinline__ XcdBarrier xcd_barrier_post(unsigned* bar, volatile LAS unsigned* st) {
    XcdBarrier b; b.bar = bar; b.x = xb_xcc_id(); b.st = st;
    if (threadIdx.x == 0) (void)xb_add(&bar[XB_XCNT(b.x)], 1u);
    return b;
}
__device__ __forceinline__ void xcd_barrier_complete(unsigned* bar, unsigned x, unsigned& nloc, unsigned& nx) {
    const unsigned G = gridDim.x * gridDim.y * gridDim.z;
    unsigned sum, cnt, mine, sp = 0u;
    for (;;) {
        sum = 0u; cnt = 0u; mine = 0u;
#pragma unroll
        for (unsigned j = 0; j < 16; ++j) { const unsigned c = xb_ld(&bar[XB_XCNT(j)]); sum += c; cnt += (c > 0u) ? 1u : 0u; mine = (j == x) ? c : mine; }
        if (sum == G) break;
        __builtin_amdgcn_s_sleep(1);
        if ((++sp & 255u) == 0u) { if (xb_ld(&bar[XB_TMO])) break; if (sp > XB_SPIN_CAP) { atomicAdd(&bar[XB_TMO], 1u); break; } }
    }
    nloc = mine > 0u ? mine : 1u; nx = cnt > 0u ? cnt : 1u;
}
__device__ __forceinline__ void xcd_barrier(const XcdBarrier& b) {
    asm volatile("s_waitcnt vmcnt(0)" ::: "memory");
    __syncthreads();
    if (threadIdx.x == 0) {
        unsigned* bar = b.bar;
        __builtin_amdgcn_s_waitcnt(0);
        unsigned nloc = b.st[0], nx = b.st[1];
        if (nloc == 0u) { xcd_barrier_complete(bar, b.x, nloc, nx); b.st[0] = nloc; b.st[1] = nx; }
        const unsigned old = xb_add(&bar[XB_XSUB(b.x)], 1u);
        const unsigned gen = old / nloc;
        if (old + 1u == (gen + 1u) * nloc) {
            __builtin_amdgcn_fence(__ATOMIC_RELEASE, "agent");
            asm volatile("s_waitcnt vmcnt(0)" ::: "memory");
            const unsigned og = xb_add(&bar[XB_TOP], 1u);
            const unsigned tg = og / nx;
            if (og + 1u == (tg + 1u) * nx) xb_add(&bar[XB_TOPGEN], 1u);
            else XB_SPIN(xb_ld(&bar[XB_TOPGEN]) == tg, bar);
            __builtin_amdgcn_fence(__ATOMIC_ACQUIRE, "agent");
            xb_add(&bar[XB_XGEN(b.x)], 1u);
            asm volatile("s_waitcnt vmcnt(0)" ::: "memory");
        } else {
            XB_SPIN(xb_ld(&bar[XB_XGEN(b.x)]) == gen, bar);
            __builtin_amdgcn_fence(__ATOMIC_ACQUIRE, "agent");
            asm volatile("s_waitcnt vmcnt(0)" ::: "memory");
        }
    }
    __syncthreads();
}

constexpr int PPL = 9;
constexpr int NPHASE = 2 + 4 * PPL + 1;
#define WSB(off) ((bf16_t*)(p.ws + (off)))
#define STATS(li) ((float*)(p.ws + WS_STATS) + (size_t)(li) * MROWS * 2)
__global__ void __launch_bounds__(NTHR, 2) trunk_fwd(Params p) {
    extern __shared__ __attribute__((aligned(16))) unsigned char lds_raw[];
    LAS unsigned char* lds = (LAS unsigned char*)lds_raw;
    if (p.ph_hi - p.ph_lo > 1) {
        if (threadIdx.x < 4) ((LAS unsigned*)(lds + LDS_ST_OFF))[threadIdx.x] = 0u;
        __syncthreads();
        (void)xcd_barrier_post((unsigned*)(p.ws + WS_BAR), (volatile LAS unsigned*)(lds + LDS_ST_OFF));
    }
    for (int ph = p.ph_lo; ph < p.ph_hi; ++ph) {
        if (ph == 0) prep_phase(lds, p);
        else if (ph == 1) { }
        else if (false) { Epi E{EPI_MEMKV, nullptr, 0, nullptr, 0.f, p.out + O_MK, p.out + O_MV, WSB(WS_MKB), WSB(WS_MVB), nullptr, nullptr, nullptr, nullptr, nullptr};
            gemm_phase<EPI_MEMKV>(lds, WSB(WS_MEMP), 1024, WSB(WS_MEMW), 2048, 4096, 1024, E); }
        else if (ph == NPHASE - 1) ln_phase(p.out + O_Y, nullptr, p.in[10] + 11 * 1024, p.in[11] + 11 * 1024);
        else {
            const int layer = (ph - 2) / PPL, s = (ph - 2) % PPL, gla = layer & 1, j = layer >> 1;
            if (s == 0 || s == 7) {
                const int lf = layer * 2 + (s == 7), li = (s == 7) ? 3 * layer + 1 : 3 * layer - 1;
                const float* cv = (const float*)(p.ws + WS_CV_WGU) + (size_t)lf * 2 * 5632;
                Epi E{EPI_SWIGLU, WSB(WS_PROJ), FF, nullptr, 0.f, nullptr, nullptr, nullptr, nullptr, li >= 0 ? STATS(li) : nullptr, cv, cv + 5632, nullptr, nullptr};
                gemm_phase<EPI_SWIGLU>(lds, WSB(WS_XN), 1024, WSB(WS_WGU) + (size_t)lf * 5632 * 1024, MROWS, 5632, 1024, E);
                if (ph == 2) { Epi Em{EPI_MEMKV, nullptr, 0, nullptr, 0.f, p.out + O_MK, p.out + O_MV, WSB(WS_MKB), WSB(WS_MVB), nullptr, nullptr, nullptr, nullptr, nullptr};
                    gemm_phase<EPI_MEMKV>(lds, WSB(WS_MEMP), 1024, WSB(WS_MEMW), 2048, 4096, 1024, Em); } }
            else if (s == 1 || s == 8) {
                const int lf = layer * 2 + (s == 8), li_in = (s == 8) ? 3 * layer + 1 : 3 * layer - 1, li_out = (s == 8) ? 3 * layer + 2 : 3 * layer;
                Epi E{EPI_RES, nullptr, 0, p.out + O_Y, 0.5f, nullptr, nullptr, nullptr, nullptr, li_in >= 0 ? STATS(li_in) : nullptr,
                      li_in >= 0 ? p.in[10] + li_in * 1024 : nullptr, li_in >= 0 ? p.in[11] + li_in * 1024 : nullptr, STATS(li_out), WSB(WS_XN)};
                gemm_phase<EPI_RES>(lds, WSB(WS_PROJ), FF, WSB(WS_WD) + (size_t)lf * 1024 * FF, MP, 1024, FF, E);
                gemm_phase<EPI_RES, true>(lds, WSB(WS_PROJ), FF, WSB(WS_WD) + (size_t)lf * 1024 * FF, MP, 1024, FF, E); }

            else if (s == 2) {
                const int li = 3 * layer;
                const float* cv = gla ? (const float*)(p.ws + WS_CV_GWIN) + (size_t)j * 2 * 4096 : (const float*)(p.ws + WS_CV_HWIN) + (size_t)j * 2 * 4608;
                Epi E{EPI_BF16, WSB(WS_PROJ), gla ? GL_LD : HG_LD, nullptr, 0.f, nullptr, nullptr, nullptr, nullptr, STATS(li), cv, cv + (gla ? 4096 : 4608), nullptr, nullptr};
                if (gla) gemm_phase<EPI_BF16>(lds, WSB(WS_XN), 1024, WSB(WS_GWIN) + (size_t)j * 4096 * 1024, MROWS, 4096, 1024, E);
                else gemm_phase<EPI_BF16>(lds, WSB(WS_XN), 1024, WSB(WS_HWIN) + (size_t)j * 4608 * 1024, MROWS, 4608, 1024, E); }
            else if (s == 3) mixprep_phase(lds, p, layer);
            else if (s == 4) chain_phase(lds, p, layer);
            else if (s == 5) { if (gla) headnorm_phase(WSB(WS_PROJ), GL_LD, 2560, 1536, 32, p.in[19] + j * 1024); else headnorm_phase(WSB(WS_PROJ), HG_LD, 3072, 2048, 16, p.in[14] + j * 1024); }
            else if (s == 6) {
                const int li_in = 3 * layer;
                Epi E{EPI_RES, nullptr, 0, p.out + O_Y, 1.0f, nullptr, nullptr, nullptr, nullptr, STATS(li_in), p.in[10] + li_in * 1024, p.in[11] + li_in * 1024, STATS(li_in + 1), WSB(WS_XN)};
                gemm_phase<EPI_RES>(lds, WSB(WS_PROJ) + (gla ? 2560 : 3072), gla ? GL_LD : HG_LD, WSB(WS_WOUT) + (size_t)layer * 1024 * 1536, MP, 1024, 1536, E);
                gemm_phase<EPI_RES, true>(lds, WSB(WS_PROJ) + (gla ? 2560 : 3072), gla ? GL_LD : HG_LD, WSB(WS_WOUT) + (size_t)layer * 1024 * 1536, MP, 1024, 1536, E); }

        }
        if (ph + 1 < p.ph_hi && ph != 1) {
            if (ph == 0) cg::this_grid().sync();
            else { XcdBarrier bar; bar.bar = (unsigned*)(p.ws + WS_BAR); bar.x = xb_xcc_id(); bar.st = (volatile LAS unsigned*)(lds + LDS_ST_OFF); xcd_barrier(bar); }
        }
    }
}
#undef WSB
#undef STATS

extern "C" void kernel_launch(void* const* d_in, const int* in_sizes, int n_in, void* d_out, int out_size, void* d_ws, size_t ws_size, hipStream_t stream) {
    static int grid = 0;
    if (grid == 0) {
        if (n_in != 23 || ws_size < WS_END) { fprintf(stderr, "kernel_launch: need 23 inputs and %zu bytes of workspace; got %d, %zu\n", (size_t)WS_END, n_in, ws_size); grid = -1; return; }
        if (hipFuncSetAttribute((const void*)trunk_fwd, hipFuncAttributeMaxDynamicSharedMemorySize, LDS_BYTES) != hipSuccess) { fprintf(stderr, "kernel_launch: hipFuncSetAttribute failed\n"); grid = -1; return; }
        int dev = 0, cus = 0, per_cu = 0;
        (void)hipGetDevice(&dev); (void)hipDeviceGetAttribute(&cus, hipDeviceAttributeMultiprocessorCount, dev);
        (void)hipOccupancyMaxActiveBlocksPerMultiprocessor(&per_cu, (const void*)trunk_fwd, NTHR, LDS_BYTES);
        if (per_cu < 1) { fprintf(stderr, "kernel_launch: occupancy query says %d blocks per CU\n", per_cu); per_cu = 1; }
        (void)hipGetLastError();
        grid = cus;
    }
    if (grid < 0) return;
    Params p{};
    for (int i = 0; i < 23; ++i) p.in[i] = (const float*)d_in[i];
    p.out = (float*)d_out; p.ws = (unsigned char*)d_ws;
#if ONE_LAUNCH
    (void)hipMemsetAsync((unsigned char*)d_ws + WS_BAR, 0, WS_ZERO_END - WS_BAR, stream);
    p.ph_lo = 0; p.ph_hi = NPHASE;
    void* args[] = {&p};
    hipError_t e = hipLaunchCooperativeKernel((const void*)trunk_fwd, dim3(grid), dim3(NTHR), args, LDS_BYTES, stream);
    if (e != hipSuccess) fprintf(stderr, "cooperative launch failed: %s (grid %d)\n", hipGetErrorString(e), grid);
#else
    (void)hipMemsetAsync((unsigned char*)d_ws + WS_BAR, 0, WS_ZERO_END - WS_BAR, stream);
    for (int ph = 0; ph < NPHASE; ++ph) {
        p.ph_lo = ph; p.ph_hi = ph + 1;
        hipLaunchKernelGGL(trunk_fwd, dim3(grid), dim3(NTHR), LDS_BYTES, stream, p);
    }
#endif
}
```

```cpp
#include <hip/hip_runtime.h>
#include <hip/hip_cooperative_groups.h>
#include <cstdio>
namespace cg = cooperative_groups;

#ifndef ONE_LAUNCH
#define ONE_LAUNCH 1
#endif

#define LAS __attribute__((address_space(3)))
typedef unsigned short bf16_t;
typedef short bf16x8 __attribute__((ext_vector_type(8)));
typedef float f32x4 __attribute__((ext_vector_type(4)));
typedef float f32x2 __attribute__((ext_vector_type(2)));
typedef unsigned u32x4 __attribute__((ext_vector_type(4)));
typedef unsigned u32x2 __attribute__((ext_vector_type(2)));
typedef __bf16 nbf2 __attribute__((ext_vector_type(2)));

constexpr int D = 1024, MP = 65536, MS = 1024, MROWS = MP + MS, FF = 2816;
constexpr int HG_LD = 4608, GL_LD = 4096;
constexpr float ALPHA = 1.6817928305074292f;
constexpr int NTHR = 512;
constexpr int LDS_BYTES = 144 * 1024;
constexpr int LDS_ST_OFF = 143360;
constexpr int NCHUNK = MROWS / 64;
constexpr int LDS_X = 131072;

constexpr size_t O_Y = 0;
constexpr size_t O_SHP = (size_t)MROWS * D;
constexpr size_t O_SGP = O_SHP + 2u * 8 * 8 * 128 * 128;
constexpr size_t O_MK = O_SGP + 2u * 8 * 4 * 128 * 256;
constexpr size_t O_MV = O_MK + 4u * 2048 * 512;
constexpr size_t O_SHS = O_MV + 4u * 2048 * 512;
constexpr size_t O_SGS = O_SHS + 2u * 16 * 8 * 128 * 128;

constexpr size_t WS_WGU = 0;
constexpr size_t WS_WD = WS_WGU + 8ull * 5632 * 1024 * 2;
constexpr size_t WS_HWIN = WS_WD + 8ull * 1024 * 2816 * 2;
constexpr size_t WS_GWIN = WS_HWIN + 2ull * 4608 * 1024 * 2;
constexpr size_t WS_WOUT = WS_GWIN + 2ull * 4096 * 1024 * 2;
constexpr size_t WS_MEMW = WS_WOUT + 4ull * 1024 * 1536 * 2;
constexpr size_t WS_MEMP = WS_MEMW + 4096ull * 1024 * 2;
constexpr size_t WS_MKB = WS_MEMP + 2048ull * 1024 * 2;
constexpr size_t WS_MVB = WS_MKB + 4ull * 2048 * 512 * 2;
constexpr size_t WS_CKB = WS_MVB + 4ull * 2048 * 512 * 2;
constexpr size_t WS_CVB = WS_CKB + 4ull * 4096 * 512 * 2;
constexpr size_t WS_XN = WS_CVB + 4ull * 4096 * 512 * 2;
constexpr size_t WS_PROJ = WS_XN + (size_t)MROWS * 1024 * 2;
constexpr size_t WS_VEC = WS_PROJ + (size_t)MROWS * 4608 * 2;
constexpr size_t WS_BAR = WS_VEC + 3ull * (MROWS / 64) * 1024 * 4;
constexpr size_t WS_STATS = WS_BAR + 16384;
constexpr size_t WS_CV_WGU = WS_STATS + 12ull * MROWS * 8;
constexpr size_t WS_CV_HWIN = WS_CV_WGU + 8ull * 2 * 5632 * 4;
constexpr size_t WS_CV_GWIN = WS_CV_HWIN + 2ull * 2 * 4608 * 4;
constexpr size_t WS_ZERO_END = WS_CV_GWIN + 2ull * 2 * 4096 * 4;
constexpr size_t WS_IDST = WS_ZERO_END;
constexpr size_t WS_ONES = WS_IDST + (size_t)MROWS * 8;
constexpr size_t WS_END = WS_ONES + 4096;

struct Params {
    const float* in[23];
    float* out;
    unsigned char* ws;
    int ph_lo, ph_hi;
};

__device__ __forceinline__ unsigned pk2(float lo, float hi) { f32x2 v = {lo, hi}; nbf2 b = __builtin_convertvector(v, nbf2); return __builtin_bit_cast(unsigned, b); }
__device__ __forceinline__ float bflo(unsigned u) { return __uint_as_float(u << 16); }
__device__ __forceinline__ float bfhi(unsigned u) { return __uint_as_float(u & 0xffff0000u); }
__device__ __forceinline__ bf16_t f2bf(float f) { unsigned u = pk2(f, 0.f); return (bf16_t)(u & 0xffffu); }
__device__ __forceinline__ float sigmoidf_(float x) { return __builtin_amdgcn_rcpf(1.0f + __builtin_amdgcn_exp2f(-1.4426950408889634f * x)); }
__device__ __forceinline__ int ltid() { int t = threadIdx.x; asm volatile("" : "+v"(t)); return t; }
__device__ __forceinline__ int lbid() { int t = blockIdx.x; asm volatile("" : "+s"(t)); return t; }
#define MFMA16(a, b, c) __builtin_amdgcn_mfma_f32_16x16x32_bf16((a), (b), (c), 0, 0, 0)

constexpr int BM = 256, BK = 64, HALF = 128, HTB = HALF * BK * 2, NXCD = 8, WGM = 8;
__device__ __forceinline__ int lds_byte(int r, int c) { const int st = (r >> 4) * 2 + (c >> 5), rr = r & 15, cc = c & 31, ob = rr * 64 + cc * 2; return st * 1024 + (ob ^ (((ob >> 9) & 1) << 5)); }
__device__ __forceinline__ void stage_rc(int b, int& R, int& C) { const int st = b / 1024, sb = b % 1024, swz = sb ^ (((sb >> 9) & 1) << 5); R = (st >> 1) * 16 + swz / 64; C = (st & 1) * 32 + (swz % 64) / 2; }
__device__ __forceinline__ int perm32(int rho) { const int n = rho >> 4, i = rho & 15; return 8 * (i >> 2) + 4 * n + (i & 3); }

struct Unit { int pm, pn; };
struct StaticOrder {
    int nM, nN, nwg, G, c; bool rev;
    __device__ __forceinline__ void init(int M, int N, int G_, int c_, bool rev_ = false) { nM = M / BM; nN = N / BM; nwg = nM * nN; G = G_; c = c_; rev = rev_; }
    __device__ __forceinline__ bool next(int i, Unit& u) const {
        const long L = (long)i * G + c; if (L >= nwg) return false;
        int wgid = (int)L; { const int q = nwg / NXCD, r = nwg % NXCD, xcd = wgid % NXCD, off = wgid / NXCD; wgid = (xcd < r ? xcd * (q + 1) : r * (q + 1) + (xcd - r) * q) + off; }
        const int nig = WGM * nN, gid = wgid / nig, fm = gid * WGM, gsz = (nM - fm) < WGM ? (nM - fm) : WGM;
        u.pm = fm + ((wgid % nig) % gsz); u.pn = (wgid % nig) / gsz; if (rev) u.pm = nM - 1 - u.pm; return true;
    }
};

enum { EPI_SWIGLU = 0, EPI_BF16 = 1, EPI_RES = 2, EPI_MEMKV = 3 };
struct Epi { int mode; bf16_t* ob; int ldo; float* xf; float scale; float* mk_out; float* mv_out; bf16_t* mkb; bf16_t* mvb;
             const float* st_in; const float* v1; const float* v2; float* st_out; bf16_t* ybf; };
__device__ __forceinline__ void row_mu_rstd(const LAS float* XS, int rl, float& mu, float& rstd) {
    const f32x2 q = *(const LAS f32x2*)(XS + 2 * rl); mu = q.x * (1.0f / 1024.0f); rstd = __builtin_amdgcn_rsqf(fmaxf(q.y * (1.0f / 1024.0f) - mu * mu, 0.f) + 1e-5f);
}

template <int MODE, bool HALFM> __device__ __forceinline__ void gemm_epilogue(const f32x4 (&acc)[2][2][4][2], const Unit& u, int rb, int wr, int wc, int fr, int fq, const Epi& E, LAS unsigned char* lds) {
    const int row0 = rb + wr * 64 + fr;
    const LAS float* XS = (const LAS float*)(lds + LDS_X); const int rl0 = wr * 64 + fr;
    if constexpr (MODE == EPI_SWIGLU) {
        const int col0 = u.pn * 128 + wc * 32 + 8 * fq;
        const int cl = wc * 32 + 8 * fq;
        f32x4 c1g[2], c2g[2], c1u[2], c2u[2];
#pragma unroll
        for (int n = 0; n < 2; ++n) {
            c1g[n] = *(const LAS f32x4*)(XS + 512 + cl + 4 * n); c2g[n] = *(const LAS f32x4*)(XS + 768 + cl + 4 * n); c1u[n] = *(const LAS f32x4*)(XS + 512 + cl + 128 + 4 * n); c2u[n] = *(const LAS f32x4*)(XS + 768 + cl + 128 + 4 * n);
        }
        float mus[2][4], rstds[2][4];
#pragma unroll
        for (int ai = 0; ai < 2; ++ai)
#pragma unroll
            for (int m = 0; m < 4; ++m) row_mu_rstd(XS, rl0 + ai * HALF + m * 16, mus[ai][m], rstds[ai][m]);
#pragma unroll
        for (int ai = 0; ai < 2; ++ai)
#pragma unroll
            for (int m = 0; m < 4; ++m) {
                const int row = row0 + ai * HALF + m * 16;
                const float mu = mus[ai][m], rstd = rstds[ai][m];
                bf16_t* rowp = E.ob + (size_t)row * E.ldo + col0;
                float h[8];
#pragma unroll
                for (int n = 0; n < 2; ++n)
#pragma unroll
                    for (int j = 0; j < 4; ++j) { const float g = rstd * (acc[ai][0][m][n][j] - mu * c1g[n][j]) + c2g[n][j], up = rstd * (acc[ai][1][m][n][j] - mu * c1u[n][j]) + c2u[n][j];
                        h[n * 4 + j] = g * up * __builtin_amdgcn_rcpf(1.0f + __builtin_amdgcn_exp2f(-1.4426950408889634f * g)); }
                u32x4 w; w.x = pk2(h[0], h[1]); w.y = pk2(h[2], h[3]); w.z = pk2(h[4], h[5]); w.w = pk2(h[6], h[7]);
                *(u32x4*)rowp = w;
            }
    } else if constexpr (MODE == EPI_BF16) {
        const int col0 = u.pn * BM + wc * 32 + 8 * fq, cl = wc * 32 + 8 * fq;
        f32x4 c1[2][2], c2[2][2];
#pragma unroll
        for (int bj = 0; bj < 2; ++bj)
#pragma unroll
            for (int n = 0; n < 2; ++n) { c1[bj][n] = *(const LAS f32x4*)(XS + 512 + cl + bj * HALF + 4 * n); c2[bj][n] = *(const LAS f32x4*)(XS + 768 + cl + bj * HALF + 4 * n); }
#pragma unroll
        for (int ai = 0; ai < 2; ++ai)
#pragma unroll
            for (int m = 0; m < 4; ++m) {
                const int row = row0 + ai * HALF + m * 16;
                float mu, rstd; row_mu_rstd(XS, rl0 + ai * HALF + m * 16, mu, rstd);
                bf16_t* rowp = E.ob + (size_t)row * E.ldo + col0;
#pragma unroll
                for (int bj = 0; bj < 2; ++bj) {
                    const f32x4 v0 = (acc[ai][bj][m][0] - c1[bj][0] * mu) * rstd + c2[bj][0], v1 = (acc[ai][bj][m][1] - c1[bj][1] * mu) * rstd + c2[bj][1];
                    u32x4 w; w.x = pk2(v0[0], v0[1]); w.y = pk2(v0[2], v0[3]); w.z = pk2(v1[0], v1[1]); w.w = pk2(v1[2], v1[3]);
                    *(u32x4*)(rowp + bj * HALF) = w;
                }
            }
    } else if constexpr (MODE == EPI_RES) {
        const int col0 = u.pn * BM + wc * 32 + 4 * fq, cl = wc * 32 + 4 * fq;
        constexpr int NG = HALFM ? 4 : 8;
#pragma unroll
        for (int bt = 0; bt < (NG + 2) / 3; ++bt) {
            const int g0 = bt * 3, ng = (NG - g0) < 3 ? (NG - g0) : 3;
            f32x4 xv[3][2][2];
#pragma unroll
            for (int gi = 0; gi < 3; ++gi) if (gi < ng) { const int g = g0 + gi, ai = g >> 2, m = g & 3; const float* rowp = E.xf + (size_t)(row0 + ai * HALF + m * 16) * D + col0;
#pragma unroll
                for (int bj = 0; bj < 2; ++bj)
#pragma unroll
                    for (int n = 0; n < 2; ++n) xv[gi][bj][n] = *(const f32x4*)(rowp + bj * HALF + n * 16); }
#pragma unroll
            for (int gi = 0; gi < 3; ++gi) if (gi < ng) {
                const int g = g0 + gi, ai = g >> 2, m = g & 3;
                const int row = row0 + ai * HALF + m * 16;
                float mu, rstd; row_mu_rstd(XS, rl0 + ai * HALF + m * 16, mu, rstd);
                float* rowp = E.xf + (size_t)row * D + col0; bf16_t* rowb = E.ybf + (size_t)row * D + col0;
                float s1 = 0.f, s2 = 0.f;
#pragma unroll
                for (int bj = 0; bj < 2; ++bj)
#pragma unroll
                    for (int n = 0; n < 2; ++n) { f32x4 x = xv[gi][bj][n];
                        { const f32x4 gp = *(const LAS f32x4*)(XS + 512 + cl + bj * HALF + n * 16), bp = *(const LAS f32x4*)(XS + 768 + cl + bj * HALF + n * 16); x = (x - mu) * rstd * gp + bp; }
                        x = x * ALPHA + acc[ai][bj][m][n] * E.scale;
                        *(f32x4*)(rowp + bj * HALF + n * 16) = x;
                        u32x2 w; w.x = pk2(x[0], x[1]); w.y = pk2(x[2], x[3]); *(u32x2*)(rowb + bj * HALF + n * 16) = w;
                        s1 += (x[0] + x[1]) + (x[2] + x[3]); s2 += (x[0] * x[0] + x[1] * x[1]) + (x[2] * x[2] + x[3] * x[3]); }
                s1 += __shfl_xor(s1, 16); s1 += __shfl_xor(s1, 32); s2 += __shfl_xor(s2, 16); s2 += __shfl_xor(s2, 32);
                if (fq == 0) { atomicAdd(E.st_out + 2 * (size_t)row, s1); atomicAdd(E.st_out + 2 * (size_t)row + 1, s2); }
            }
            asm volatile("" ::: "memory");
        }
    } else {
        const int colt = u.pn * BM; const int l = colt >> 10, kv = (colt >> 9) & 1, cc0 = (colt & 511) + wc * 32 + 4 * fq;
        float* of = (kv ? E.mv_out : E.mk_out) + (size_t)l * 2048 * 512;
        bf16_t* ob = (kv ? E.mvb : E.mkb) + (size_t)l * 2048 * 512;
#pragma unroll
        for (int ai = 0; ai < 2; ++ai)
#pragma unroll
            for (int m = 0; m < 4; ++m) {
                const size_t ro = (size_t)(row0 + ai * HALF + m * 16) * 512 + cc0;
#pragma unroll
                for (int bj = 0; bj < 2; ++bj)
#pragma unroll
                    for (int n = 0; n < 2; ++n) { const f32x4 v = acc[ai][bj][m][n]; *(f32x4*)(of + ro + bj * HALF + n * 16) = v; u32x2 w; w.x = pk2(v[0], v[1]); w.y = pk2(v[2], v[3]); *(u32x2*)(ob + ro + bj * HALF + n * 16) = w; }
            }
    }
}

template <int MODE, bool HALFM = false> __device__ __forceinline__ void gemm_phase(LAS unsigned char* lds, const bf16_t* Ag, int lda, const bf16_t* Btg, int M, int N, int K, const Epi& E) {
    int tid_ = threadIdx.x; asm volatile("" : "+v"(tid_));
    const int tid = tid_, wid = __builtin_amdgcn_readfirstlane(tid >> 6), lane = tid & 63, wr = wid >> 2, wc = wid & 3, fr = lane & 15, fq = lane >> 4;
    const int nt = K / BK;
    constexpr bool PERM = (MODE == EPI_SWIGLU || MODE == EPI_BF16);
    StaticOrder S; { const int G_ = (int)gridDim.x; int c_ = lbid(); if (MODE == EPI_MEMKV) c_ = (c_ + G_ / 2) % G_; S.init(M, N, G_, c_, MODE == EPI_RES); }
    unsigned voffA[2], voffB[2];
#pragma unroll
    for (int i = 0; i < 2; ++i) { int R, C; stage_rc(tid * 16 + i * 8192, R, C); const int Rb = PERM ? ((R & ~31) + perm32(R & 31)) : R;
        voffA[i] = (unsigned)(R * lda + C) * 2u; voffB[i] = (unsigned)(Rb * K + C) * 2u; }
    const size_t kstep = (size_t)(BK * 2);
    const size_t hstepA = (size_t)HALF * lda * 2, hstepB = (size_t)HALF * K * 2;
    const size_t tstepA = 2 * hstepA, tstepB = 2 * hstepB;
    const size_t hA1 = HALFM ? 0 : hstepA;
    const unsigned ldsw = (unsigned)wid * 1024u;
    const int aoff = lds_byte(wr * 64 + fr, fq * 8), boff = lds_byte(wc * 32 + fr, fq * 8);
#define PG8_SA(b, h) (((b) * 2 + (h)) * HTB)
#define PG8_SB(b, h) ((4 + (b) * 2 + (h)) * HTB)
#define PG8_STAGE(bufoff, gbase, voff) do { _Pragma("unroll") for (int _i = 0; _i < 2; ++_i) \
        __builtin_amdgcn_global_load_lds((const unsigned*)((const char*)(gbase) + (voff)[_i]), (LAS unsigned*)(lds + (bufoff) + ldsw + _i * 8192), 16, 0, 0); } while (0)
#define PG8_LDA(dst, b, h) do { _Pragma("unroll") for (int m = 0; m < 4; ++m) _Pragma("unroll") for (int k = 0; k < 2; ++k) dst[m][k] = *(const LAS bf16x8*)(lds + PG8_SA(b, h) + aoff + m * 2048 + k * 1024); } while (0)
#define PG8_LDB(dst, b, h) do { _Pragma("unroll") for (int n = 0; n < 2; ++n) _Pragma("unroll") for (int k = 0; k < 2; ++k) dst[n][k] = *(const LAS bf16x8*)(lds + PG8_SB(b, h) + boff + n * 2048 + k * 1024); } while (0)
#define PG8_MMA(ai, bj, At, Bt) do { __builtin_amdgcn_s_setprio(1); _Pragma("unroll") for (int m = 0; m < 4; ++m) _Pragma("unroll") for (int n = 0; n < 2; ++n) _Pragma("unroll") for (int k = 0; k < 2; ++k) \
        acc[ai][bj][m][n] = __builtin_amdgcn_mfma_f32_16x16x32_bf16(Bt[n][k], At[m][k], acc[ai][bj][m][n], 0, 0, 0); __builtin_amdgcn_s_setprio(0); } while (0)
#define PG8_WAIT_V(n) asm volatile("s_waitcnt vmcnt(" #n ")" ::: "memory")
#define PG8_WAIT_L(n) asm volatile("s_waitcnt lgkmcnt(" #n ")" ::: "memory")
#define PG8_BAR __builtin_amdgcn_s_barrier()
#define PG8_SCHED __builtin_amdgcn_sched_barrier(0)
    Unit cur, nxt; int ui = 0; int rb;
    if constexpr (HALFM) { const int c_ = S.c; if (c_ >= 8 * (N / BM)) return; cur.pm = M / 128 + (c_ & 7); cur.pn = c_ >> 3; rb = cur.pm * 128; }
    else { if (!S.next(0, cur)) return; rb = cur.pm * BM; }
    f32x4 acc[2][2][4][2];
#pragma unroll
    for (int a = 0; a < 2; ++a)
#pragma unroll
        for (int b = 0; b < 2; ++b)
#pragma unroll
            for (int m = 0; m < 4; ++m)
#pragma unroll
                for (int n = 0; n < 2; ++n) acc[a][b][m][n] = (f32x4){0.f, 0.f, 0.f, 0.f};
    bf16x8 At[4][2], B0[2][2], B1[2][2];
    const char* cA = (const char*)Ag + (size_t)cur.pm * (HALFM ? hstepA : tstepA); const char* cB = (const char*)Btg + (size_t)cur.pn * tstepB;
    PG8_STAGE(PG8_SB(0, 0), cB, voffB); PG8_STAGE(PG8_SA(0, 0), cA, voffA); PG8_STAGE(PG8_SB(0, 1), cB + hstepB, voffB); PG8_STAGE(PG8_SA(0, 1), cA + hA1, voffA);
    if (wr == 1) PG8_BAR;
    PG8_WAIT_V(4); PG8_BAR;
    PG8_STAGE(PG8_SB(1, 0), cB + kstep, voffB); PG8_STAGE(PG8_SA(1, 0), cA + kstep, voffA); PG8_STAGE(PG8_SB(1, 1), cB + hstepB + kstep, voffB);
    PG8_WAIT_V(6); PG8_BAR;
    for (;;) {
        const bool has_next = HALFM ? false : S.next(ui + 1, nxt);
        const char* nA = has_next ? (const char*)Ag + (size_t)nxt.pm * tstepA : cA; const char* nB = has_next ? (const char*)Btg + (size_t)nxt.pn * tstepB : cB;
        for (int t = 0; t < nt; t += 2) {
            const bool last = (t == nt - 2);
            if (MODE != EPI_MEMKV && t == nt - 4 && wid < 4) {
                const char* gsrc = wid < 2 ? (const char*)(E.st_in + 2 * ((size_t)rb + (HALFM ? 0 : wid * 128))) : (const char*)((wid == 2 ? E.v1 : E.v2) + cur.pn * BM);
                __builtin_amdgcn_global_load_lds((const unsigned*)(gsrc + lane * 16), (LAS unsigned*)(lds + LDS_X + wid * 1024), 16, 0, 0);
            }
            const char* a1 = cA + (size_t)(t + 1) * kstep;
            const char* a2 = last ? nA : cA + (size_t)(t + 2) * kstep; const char* b2 = last ? nB : cB + (size_t)(t + 2) * kstep;
            const char* a3 = a2 + kstep; const char* b3 = b2 + kstep;
            PG8_LDB(B0, 0, 0); PG8_SCHED; PG8_LDA(At, 0, 0); PG8_STAGE(PG8_SA(1, 1), a1 + hA1, voffA);
            PG8_WAIT_L(8); PG8_BAR; PG8_WAIT_L(0); PG8_MMA(0, 0, At, B0); PG8_BAR; PG8_SCHED;
            PG8_LDB(B1, 0, 1); PG8_STAGE(PG8_SB(0, 0), b2, voffB);
            PG8_BAR; PG8_WAIT_L(0); PG8_MMA(0, 1, At, B1); PG8_BAR;
            if constexpr (!HALFM) PG8_LDA(At, 0, 1); PG8_STAGE(PG8_SA(0, 0), a2, voffA);
            PG8_BAR; PG8_WAIT_L(0); if constexpr (!HALFM) PG8_MMA(1, 0, At, B0); PG8_BAR; PG8_SCHED;
            PG8_STAGE(PG8_SB(0, 1), b2 + hstepB, voffB);
            PG8_WAIT_V(6); PG8_BAR; if constexpr (!HALFM) PG8_MMA(1, 1, At, B1); PG8_BAR;
            PG8_LDB(B0, 1, 0); PG8_SCHED; PG8_LDA(At, 1, 0); PG8_STAGE(PG8_SA(0, 1), a2 + hA1, voffA);
            PG8_WAIT_L(8); PG8_BAR; PG8_WAIT_L(0); PG8_MMA(0, 0, At, B0); PG8_BAR; PG8_SCHED;
            PG8_LDB(B1, 1, 1); PG8_STAGE(PG8_SB(1, 0), b3, voffB);
            PG8_BAR; PG8_WAIT_L(0); PG8_MMA(0, 1, At, B1); PG8_BAR;
            if constexpr (!HALFM) PG8_LDA(At, 1, 1); PG8_STAGE(PG8_SA(1, 0), a3, voffA);
            PG8_BAR; PG8_WAIT_L(0); if constexpr (!HALFM) PG8_MMA(1, 0, At, B0); PG8_BAR; PG8_SCHED;
            PG8_STAGE(PG8_SB(1, 1), b3 + hstepB, voffB);
            PG8_WAIT_V(6); PG8_BAR; if constexpr (!HALFM) PG8_MMA(1, 1, At, B1); PG8_BAR;
        }
        gemm_epilogue<MODE, HALFM>(acc, cur, rb, wr, wc, fr, fq, E, lds);
        if (!has_next) break;
#pragma unroll
        for (int a = 0; a < 2; ++a)
#pragma unroll
            for (int b = 0; b < 2; ++b)
#pragma unroll
                for (int m = 0; m < 4; ++m)
#pragma unroll
                    for (int n = 0; n < 2; ++n) acc[a][b][m][n] = (f32x4){0.f, 0.f, 0.f, 0.f};
        cur = nxt; cA = nA; cB = nB; ++ui; rb = cur.pm * BM;
    }
    PG8_WAIT_V(0);
    if (wr == 0) PG8_BAR;
    PG8_BAR;
#undef PG8_SA
#undef PG8_SB
#undef PG8_STAGE
#undef PG8_LDA
#undef PG8_LDB
#undef PG8_MMA
#undef PG8_WAIT_V
#undef PG8_WAIT_L
#undef PG8_BAR
#undef PG8_SCHED
}

__device__ __forceinline__ void transpose_job(LAS unsigned char* lds, const float* src, int ld, int K, int c0, int ncols, bf16_t* dst, int rowmode, int drow0,
                                              const float* gk, const float* bk, float* c1, float* c2) {
    LAS float* tile = (LAS float*)lds;
    int tid_ = threadIdx.x; asm volatile("" : "+v"(tid_)); const int tid = tid_;
    const int nkt = K / 64, nct = ncols / 64, ntiles = nkt * nct;
    const int kr = tid >> 4, c4 = (tid & 15) * 4;
    f32x4 pv[2];
    { const int t = lbid(); if (t < ntiles) { const int k0 = (t % nkt) * 64, n0 = (t / nkt) * 64;
#pragma unroll
        for (int rr = 0; rr < 2; ++rr) pv[rr] = *(const f32x4*)(src + (size_t)(k0 + kr + 32 * rr) * ld + c0 + n0 + c4); } }
    for (int t = lbid(); t < ntiles; t += gridDim.x) {
        const int kt = t % nkt, ct = t / nkt;
        const int k0 = kt * 64, n0 = ct * 64;
#pragma unroll
        for (int rr = 0; rr < 2; ++rr) { const f32x4 v = pv[rr];
            tile[(kr + 32 * rr) * 65 + c4 + 0] = v[0]; tile[(kr + 32 * rr) * 65 + c4 + 1] = v[1]; tile[(kr + 32 * rr) * 65 + c4 + 2] = v[2]; tile[(kr + 32 * rr) * 65 + c4 + 3] = v[3]; }
        { const int tn = t + gridDim.x; if (tn < ntiles) { const int k1 = (tn % nkt) * 64, n1 = (tn / nkt) * 64;
#pragma unroll
            for (int rr = 0; rr < 2; ++rr) pv[rr] = *(const f32x4*)(src + (size_t)(k1 + kr + 32 * rr) * ld + c0 + n1 + c4); } }
        __syncthreads();
        { const int n = tid >> 3, k8 = (tid & 7) * 8; float v[8];
#pragma unroll
          for (int i = 0; i < 8; ++i) v[i] = tile[(k8 + i) * 65 + n];
          const int c = c0 + n0 + n; int drow;
          if (rowmode == 0) drow = drow0 + c; else drow = 256 * (c >> 7) + (c & 127) + (rowmode == 2 ? 128 : 0);
          u32x4 w;
          if (gk) {
              const f32x4 g0 = *(const f32x4*)(gk + k0 + k8), g1 = *(const f32x4*)(gk + k0 + k8 + 4), b0 = *(const f32x4*)(bk + k0 + k8), b1 = *(const f32x4*)(bk + k0 + k8 + 4);
              float s2 = 0.f;
#pragma unroll
              for (int i = 0; i < 4; ++i) { s2 += b0[i] * v[i] + b1[i] * v[4 + i]; v[i] *= g0[i]; v[4 + i] *= g1[i]; }
              w.x = pk2(v[0], v[1]); w.y = pk2(v[2], v[3]); w.z = pk2(v[4], v[5]); w.w = pk2(v[6], v[7]);
              float s1 = 0.f;
#pragma unroll
              for (int i = 0; i < 4; ++i) s1 += bflo(w[i]) + bfhi(w[i]);
              s1 += __shfl_xor(s1, 1); s1 += __shfl_xor(s1, 2); s1 += __shfl_xor(s1, 4);
              s2 += __shfl_xor(s2, 1); s2 += __shfl_xor(s2, 2); s2 += __shfl_xor(s2, 4);
              if ((tid & 7) == 0) { atomicAdd(c1 + drow, s1); atomicAdd(c2 + drow, s2); }
          } else { w.x = pk2(v[0], v[1]); w.y = pk2(v[2], v[3]); w.z = pk2(v[4], v[5]); w.w = pk2(v[6], v[7]); }
          *(u32x4*)(dst + (size_t)drow * K + k0 + k8) = w; }
        __syncthreads();
    }
}
__device__ __forceinline__ void convert_job(const float* src, bf16_t* dst, float* dstf, size_t n) {
    const size_t nv = n / 8, stride = (size_t)gridDim.x * NTHR;
    for (size_t i = (size_t)lbid() * NTHR + ltid(); i < nv; i += 2 * stride) {
        const size_t i2 = i + stride; const bool two = i2 < nv;
        const f32x4 a = *(const f32x4*)(src + i * 8), b = *(const f32x4*)(src + i * 8 + 4);
        f32x4 c = a, d = b; if (two) { c = *(const f32x4*)(src + i2 * 8); d = *(const f32x4*)(src + i2 * 8 + 4); }
        u32x4 w; w.x = pk2(a[0], a[1]); w.y = pk2(a[2], a[3]); w.z = pk2(b[0], b[1]); w.w = pk2(b[2], b[3]);
        *(u32x4*)(dst + i * 8) = w;
        if (dstf) { *(f32x4*)(dstf + i * 8) = a; *(f32x4*)(dstf + i * 8 + 4) = b; }
        if (two) { w.x = pk2(c[0], c[1]); w.y = pk2(c[2], c[3]); w.z = pk2(d[0], d[1]); w.w = pk2(d[2], d[3]);
            *(u32x4*)(dst + i2 * 8) = w;
            if (dstf) { *(f32x4*)(dstf + i2 * 8) = c; *(f32x4*)(dstf + i2 * 8 + 4) = d; } }
    }
}
__device__ __forceinline__ void prep_phase(LAS unsigned char* lds, const Params& p) {
    unsigned char* ws = p.ws;
    for (int jb = 0; jb < 52; ++jb) {
        const float* src; int ld, K, c0, ncols, rowmode, drow0; bf16_t* dst; int li = -1; float* cv = nullptr; int cvn = 0;
        if (jb < 24) { const int lf = jb / 3, t = jb % 3;
            if (t < 2) { src = (t == 0 ? p.in[7] : p.in[8]) + (size_t)lf * 1024 * FF; ld = FF; K = 1024; c0 = 0; ncols = FF; dst = (bf16_t*)(ws + WS_WGU) + (size_t)lf * 5632 * 1024; rowmode = 1 + t; drow0 = 0;
                if (lf > 0) { li = (lf & 1) ? 3 * (lf >> 1) + 1 : 3 * (lf >> 1) - 1; cv = (float*)(ws + WS_CV_WGU) + (size_t)lf * 2 * 5632; cvn = 5632; } }
            else { src = p.in[9] + (size_t)lf * FF * 1024; ld = 1024; K = FF; c0 = 0; ncols = 1024; dst = (bf16_t*)(ws + WS_WD) + (size_t)lf * 1024 * FF; rowmode = 0; drow0 = 0; }
        } else if (jb < 44) { const int j = (jb - 24) / 10, t = (jb - 24) % 10; rowmode = 0; K = 1024;
            if (t < 4) {
                src = p.in[12] + (size_t)j * 1024 * 4608; ld = 4608; dst = (bf16_t*)(ws + WS_HWIN) + (size_t)j * 4608 * 1024;
                c0 = t == 0 ? 0 : (t == 1 ? 3072 : (t == 2 ? 2048 : 4096)); ncols = t == 0 ? 2048 : (t == 3 ? 512 : 1024); drow0 = (t == 0 ? 0 : (t == 1 ? 2048 : (t == 2 ? 3072 : 4096))) - c0;
                li = 3 * (2 * j); cv = (float*)(ws + WS_CV_HWIN) + (size_t)j * 2 * 4608; cvn = 4608;
            } else if (t < 8) {
                src = p.in[16] + (size_t)j * 1024 * 3600; ld = 3600; dst = (bf16_t*)(ws + WS_GWIN) + (size_t)j * 4096 * 1024; const int u = t - 4;
                c0 = u == 0 ? 0 : (u == 1 ? 2048 : (u == 2 ? 1024 : 3088)); ncols = u == 3 ? 512 : 1024; drow0 = (u == 0 ? 0 : (u == 1 ? 1536 : (u == 2 ? 2560 : 3584))) - c0;
                li = 3 * (2 * j + 1); cv = (float*)(ws + WS_CV_GWIN) + (size_t)j * 2 * 4096; cvn = 4096;
            } else { src = (t == 8 ? p.in[15] : p.in[20]) + (size_t)j * 1536 * 1024; ld = 1024; K = 1536; c0 = 0; ncols = 1024; dst = (bf16_t*)(ws + WS_WOUT) + (size_t)(2 * j + (t - 8)) * 1024 * 1536; drow0 = 0; }
        } else { const int l = (jb - 44) >> 1, kv = (jb - 44) & 1; src = (kv ? p.in[22] : p.in[21]) + (size_t)l * 1024 * 512; ld = 512; K = 1024; c0 = 0; ncols = 512; dst = (bf16_t*)(ws + WS_MEMW); rowmode = 0; drow0 = l * 1024 + kv * 512; }
        const float* gk = li >= 0 ? p.in[10] + li * 1024 : nullptr; const float* bk = li >= 0 ? p.in[11] + li * 1024 : nullptr;
        transpose_job(lds, src, ld, K, c0, ncols, dst, rowmode, drow0, gk, bk, cv, cv + cvn);
    }
    for (int j = 0; j < 2; ++j) {
        const float* gs = p.in[16] + (size_t)j * 1024 * 3600; bf16_t* gd = (bf16_t*)(ws + WS_GWIN) + (size_t)j * 4096 * 1024;
        const float* w2 = p.in[17] + (size_t)j * 16 * 512;
        const int li = 3 * (2 * j + 1); const float* gk = p.in[10] + li * 1024; const float* bk = p.in[11] + li * 1024;
        float* c1 = (float*)(ws + WS_CV_GWIN) + (size_t)j * 2 * 4096; float* c2 = c1 + 4096;
        for (int i = lbid() * NTHR + ltid(); i < 512 * 1024; i += gridDim.x * NTHR) {
            const int c = i >> 10, kk = i & 1023; float sacc = 0.f;
#pragma unroll
            for (int r = 0; r < 16; ++r) sacc += gs[(size_t)kk * 3600 + 3072 + r] * w2[r * 512 + c];
            const bf16_t hv = f2bf(sacc * gk[kk]);
            gd[(size_t)(1024 + c) * 1024 + kk] = hv;
            float s1 = __uint_as_float(((unsigned)hv) << 16), s2 = sacc * bk[kk];
#pragma unroll
            for (int o = 32; o >= 1; o >>= 1) { s1 += __shfl_xor(s1, o); s2 += __shfl_xor(s2, o); }
            if ((kk & 63) == 0) { atomicAdd(c1 + 1024 + c, s1); atomicAdd(c2 + 1024 + c, s2); }
        }
    }
    { float* idst = (float*)(ws + WS_IDST);
      for (int i = lbid() * NTHR + ltid(); i < MROWS + 1024; i += gridDim.x * NTHR) {
          if (i < MROWS) *(f32x2*)(idst + 2 * (size_t)i) = (f32x2){0.f, 1024.0f * (1.0f - 1e-5f)}; else ((float*)(ws + WS_ONES))[i - MROWS] = 1.0f; } }
    for (int jb = 0; jb < 5; ++jb) {
        const float* src; bf16_t* dst; float* dstf = nullptr; size_t n;
        if (jb == 0) { src = p.in[0]; dst = (bf16_t*)(ws + WS_XN); dstf = p.out + O_Y; n = (size_t)MP * D; }
        else if (jb == 1) { src = p.in[1]; dst = (bf16_t*)(ws + WS_XN) + (size_t)MP * D; dstf = p.out + O_Y + (size_t)MP * D; n = (size_t)MS * D; }
        else if (jb == 2) { src = p.in[2]; dst = (bf16_t*)(ws + WS_MEMP); n = (size_t)2048 * 1024; }
        else if (jb == 3) { src = p.in[3]; dst = (bf16_t*)(ws + WS_CKB); n = (size_t)4 * 4096 * 512; }
        else { src = p.in[4]; dst = (bf16_t*)(ws + WS_CVB); n = (size_t)4 * 4096 * 512; }
        convert_job(src, dst, dstf, n);
    }
}

__device__ __forceinline__ void ln_phase(float* x, bf16_t* xn, const float* gain, const float* bias) {
    int tid_ = threadIdx.x; asm volatile("" : "+v"(tid_));
    const int lane = tid_ & 63, wv = tid_ >> 6;
    f32x4 g[4], b[4];
#pragma unroll
    for (int i = 0; i < 4; ++i) { g[i] = *(const f32x4*)(gain + 4 * lane + 256 * i); b[i] = *(const f32x4*)(bias + 4 * lane + 256 * i); }
    const int rstep = gridDim.x * 8;
    int row = lbid() * 8 + wv;
    f32x4 nv[4];
    if (row < MROWS) {
#pragma unroll
        for (int i = 0; i < 4; ++i) nv[i] = *(const f32x4*)(x + (size_t)row * D + 4 * lane + 256 * i); }
    for (; row < MROWS; row += rstep) {
        float* xr = x + (size_t)row * D; f32x4 v[4]; float s = 0.f;
#pragma unroll
        for (int i = 0; i < 4; ++i) { v[i] = nv[i]; s += (v[i][0] + v[i][1]) + (v[i][2] + v[i][3]); }
        if (row + rstep < MROWS) {
#pragma unroll
            for (int i = 0; i < 4; ++i) nv[i] = *(const f32x4*)(x + (size_t)(row + rstep) * D + 4 * lane + 256 * i); }
#pragma unroll
        for (int o = 32; o >= 1; o >>= 1) s += __shfl_xor(s, o);
        const float mu = s * (1.0f / 1024.0f); float q = 0.f;
#pragma unroll
        for (int i = 0; i < 4; ++i) { const f32x4 d = v[i] - mu; q += (d[0] * d[0] + d[1] * d[1]) + (d[2] * d[2] + d[3] * d[3]); }
#pragma unroll
        for (int o = 32; o >= 1; o >>= 1) q += __shfl_xor(q, o);
        const float rs = 1.0f / sqrtf(q * (1.0f / 1024.0f) + 1e-5f);
#pragma unroll
        for (int i = 0; i < 4; ++i) { const f32x4 o = (v[i] - mu) * rs * g[i] + b[i]; *(f32x4*)(xr + 4 * lane + 256 * i) = o;
            if (xn) { u32x2 w; w.x = pk2(o[0], o[1]); w.y = pk2(o[2], o[3]); *(u32x2*)(xn + (size_t)row * D + 4 * lane + 256 * i) = w; } }
    }
}

__device__ __forceinline__ void headnorm_phase(bf16_t* proj, int ld, int ocol, int gcol, int lanes_per_head  , const float* gain) {
    int tid_ = threadIdx.x; asm volatile("" : "+v"(tid_));
    const int lane = tid_ & 63, wv = tid_ >> 6;
    float gn[2][8];
#pragma unroll
    for (int hh = 0; hh < 2; ++hh)
#pragma unroll
        for (int i = 0; i < 8; ++i) gn[hh][i] = gain[hh * 512 + 8 * lane + i];
    const float invn = lanes_per_head == 16 ? (1.0f / 128.0f) : (1.0f / 256.0f);
    const int rstep = gridDim.x * 8;
    int row = lbid() * 8 + wv;
    u32x4 nov[2], ngv[2];
    if (row < MROWS) { const bf16_t* pr = proj + (size_t)row * ld;
#pragma unroll
        for (int hh = 0; hh < 2; ++hh) { nov[hh] = *(const u32x4*)(pr + ocol + hh * 512 + 8 * lane); ngv[hh] = *(const u32x4*)(pr + gcol + hh * 512 + 8 * lane); } }
    for (; row < MROWS; row += rstep) {
        bf16_t* pr = proj + (size_t)row * ld;
        u32x4 cov[2], cgv[2];
#pragma unroll
        for (int hh = 0; hh < 2; ++hh) { cov[hh] = nov[hh]; cgv[hh] = ngv[hh]; }
        if (row + rstep < MROWS) { const bf16_t* pn = proj + (size_t)(row + rstep) * ld;
#pragma unroll
            for (int hh = 0; hh < 2; ++hh) { nov[hh] = *(const u32x4*)(pn + ocol + hh * 512 + 8 * lane); ngv[hh] = *(const u32x4*)(pn + gcol + hh * 512 + 8 * lane); } }
#pragma unroll
        for (int hh = 0; hh < 2; ++hh) {
            const u32x4 ov = cov[hh], gv = cgv[hh];
            float o[8], g[8];
#pragma unroll
            for (int i = 0; i < 4; ++i) { o[2 * i] = bflo(ov[i]); o[2 * i + 1] = bfhi(ov[i]); g[2 * i] = bflo(gv[i]); g[2 * i + 1] = bfhi(gv[i]); }
            float s = 0.f;
#pragma unroll
            for (int i = 0; i < 8; ++i) s += o[i] * o[i];
            s += __shfl_xor(s, 1); s += __shfl_xor(s, 2); s += __shfl_xor(s, 4); s += __shfl_xor(s, 8);
            if (lanes_per_head == 32) s += __shfl_xor(s, 16);
            const float rs = __builtin_amdgcn_rsqf(s * invn + 1e-6f);
            float r[8];
#pragma unroll
            for (int i = 0; i < 8; ++i) r[i] = o[i] * rs * gn[hh][i] * g[i] * sigmoidf_(g[i]);
            u32x4 w; w.x = pk2(r[0], r[1]); w.y = pk2(r[2], r[3]); w.z = pk2(r[4], r[5]); w.w = pk2(r[6], r[7]);
            *(u32x4*)(pr + ocol + hh * 512 + 8 * lane) = w;
        }
    }
}

constexpr int MP_G = 0, MP_T = 32768, MP_KTT = 34816, MP_QT = MP_KTT + 128 * 72 * 2, MP_KT = MP_QT + 64 * 136 * 2, MP_END = MP_KT + 64 * 136 * 2;
static_assert(MP_END <= 131072, "prepass LDS");

__device__ __forceinline__ void mixprep_loop(LAS unsigned char* lds, bf16_t* proj, int ld, int qcol, int kcol, int gcol, int gla, const float* lb0, const float* lb1, int lbj, const float* bgate,
                                             bf16_t* ktb_h, int nh, float* vec_h, int ci0, int cstep) {
    int tid_ = threadIdx.x; asm volatile("" : "+v"(tid_));
    const int tid = tid_, wid = __builtin_amdgcn_readfirstlane(tid >> 6), lane = tid & 63, fr = lane & 15, fq = lane >> 4;
    LAS float* G = (LAS float*)(lds + MP_G); LAS float* T = (LAS float*)(lds + MP_T); LAS bf16_t* KTT = (LAS bf16_t*)(lds + MP_KTT);
    LAS bf16_t* QT = (LAS bf16_t*)(lds + MP_QT); LAS bf16_t* KT = (LAS bf16_t*)(lds + MP_KT);
    const int t0 = tid >> 4, cv = tid & 15, c8 = cv * 8;
    float cA[8], cB[8];
#pragma unroll
    for (int i = 0; i < 8; ++i) {
        if (gla) { cA[i] = bgate[c8 + i]; cB[i] = 0.f; }
        else { float lb = 0.f; if (lbj == 1) lb = sigmoidf_(lb1[c8 + i] - lb0[c8 + i]); cA[i] = lb; cB[i] = 1.0f - lb; }
    }
    const float qscale = 0.08838834764831845f;
    u32x4 rq[2], rk[2], rg[2];
    rg[0] = rg[1] = (u32x4){0u, 0u, 0u, 0u};
    auto issue_loads = [&](int ci) {
        const bf16_t* base = proj + (size_t)ci * 64 * ld;
#pragma unroll
        for (int rr = 0; rr < 2; ++rr) { const bf16_t* rp = base + (size_t)(t0 + 32 * rr) * ld + c8; rq[rr] = *(const u32x4*)(rp + qcol); rk[rr] = *(const u32x4*)(rp + kcol); if (gla) rg[rr] = *(const u32x4*)(rp + gcol); }
    };
    if (ci0 < NCHUNK) issue_loads(ci0);
    for (int ci = ci0; ci < NCHUNK; ci += cstep) {
        bf16_t* base = proj + (size_t)ci * 64 * ld;
        float qv[2][8], kv[2][8], gvv[2][8];
        constexpr float L2E = 1.4426950408889634f, CLAMP2 = 80.0f * 1.4426950408889634f;
        if (gla) {
#pragma unroll
            for (int rr = 0; rr < 2; ++rr)
#pragma unroll
                for (int i = 0; i < 8; ++i) {
                    const unsigned uq = rq[rr][i >> 1], uk = rk[rr][i >> 1], ug = rg[rr][i >> 1];
                    const float q = (i & 1) ? bfhi(uq) : bflo(uq), k = (i & 1) ? bfhi(uk) : bflo(uk);
                    const float g = ((i & 1) ? bfhi(ug) : bflo(ug)) + cA[i];
                    qv[rr][i] = q * qscale; kv[rr][i] = k;
                    gvv[rr][i] = (L2E * fminf(g, 0.f) - __builtin_amdgcn_logf(1.0f + __builtin_amdgcn_exp2f(-L2E * fabsf(g)))) * (1.0f / 16.0f);
                }
        } else {
#pragma unroll
            for (int rr = 0; rr < 2; ++rr)
#pragma unroll
                for (int i = 0; i < 8; ++i) {
                    const unsigned uq = rq[rr][i >> 1], uk = rk[rr][i >> 1];
                    const float q = (i & 1) ? bfhi(uq) : bflo(uq), k = (i & 1) ? bfhi(uk) : bflo(uk);
                    qv[rr][i] = q * qscale * __builtin_amdgcn_rcpf(1.0f + __builtin_amdgcn_exp2f(-L2E * q));
                    const float e = __builtin_amdgcn_exp2f(-L2E * k), r = __builtin_amdgcn_rcpf(1.0f + e);
                    kv[rr][i] = cB[i] * e * r;
                    gvv[rr][i] = __builtin_amdgcn_logf(fmaxf(cA[i] + cB[i] * r, 1e-6f));
                }
        }
#pragma unroll
        for (int rr = 0; rr < 2; ++rr) {
            LAS float* gp = G + (t0 + 32 * rr) * 128 + c8;
            *(LAS f32x4*)gp = (f32x4){gvv[rr][0], gvv[rr][1], gvv[rr][2], gvv[rr][3]}; *(LAS f32x4*)(gp + 4) = (f32x4){gvv[rr][4], gvv[rr][5], gvv[rr][6], gvv[rr][7]};
        }
        if (ci + cstep < NCHUNK) issue_loads(ci + cstep);
        __syncthreads();
        { const int k = tid & 127, sg = tid >> 7; float run = 0.f;
#pragma unroll
          for (int i = 0; i < 16; ++i) { run += G[(16 * sg + i) * 128 + k]; G[(16 * sg + i) * 128 + k] = run; }
          T[sg * 128 + k] = run; }
        __syncthreads();
        {
            float tA[8], tB[8], tC[8], bmid[8], blast[8];
            { const f32x4 x0 = *(const LAS f32x4*)(T + c8), x1 = *(const LAS f32x4*)(T + c8 + 4), y0 = *(const LAS f32x4*)(T + 128 + c8), y1 = *(const LAS f32x4*)(T + 128 + c8 + 4),
                  z0 = *(const LAS f32x4*)(T + 256 + c8), z1 = *(const LAS f32x4*)(T + 256 + c8 + 4);
              const f32x4 m0 = *(const LAS f32x4*)(G + 31 * 128 + c8), m1 = *(const LAS f32x4*)(G + 31 * 128 + c8 + 4), l0 = *(const LAS f32x4*)(G + 63 * 128 + c8), l1 = *(const LAS f32x4*)(G + 63 * 128 + c8 + 4);
#pragma unroll
              for (int i = 0; i < 4; ++i) { tA[i] = x0[i]; tA[4 + i] = x1[i]; tB[i] = x0[i] + y0[i]; tB[4 + i] = x1[i] + y1[i]; tC[i] = tB[i] + z0[i]; tC[4 + i] = tB[4 + i] + z1[i];
                  bmid[i] = m0[i] + tA[i]; bmid[4 + i] = m1[i] + tA[4 + i]; blast[i] = l0[i] + tC[i]; blast[4 + i] = l1[i] + tC[4 + i]; } }
#pragma unroll
            for (int rr = 0; rr < 2; ++rr) {
                const int t = t0 + 32 * rr, sg = t >> 4;
                const f32x4 g0 = *(const LAS f32x4*)(G + t * 128 + c8), g1 = *(const LAS f32x4*)(G + t * 128 + c8 + 4);
                float qt[8], kt[8];
#pragma unroll
                for (int i = 0; i < 8; ++i) {
                    const float off = sg == 0 ? 0.f : (sg == 1 ? tA[i] : (sg == 2 ? tB[i] : tC[i]));
                    const float b = (i < 4 ? g0[i & 3] : g1[i & 3]) + off;
                    qt[i] = qv[rr][i] * __builtin_amdgcn_exp2f(fminf(b - bmid[i], CLAMP2));
                    kt[i] = kv[rr][i] * __builtin_amdgcn_exp2f(fminf(bmid[i] - b, CLAMP2));
                }
                bf16_t* rp = base + (size_t)t * ld + c8;
                u32x4 w;
                w.x = pk2(qt[0], qt[1]); w.y = pk2(qt[2], qt[3]); w.z = pk2(qt[4], qt[5]); w.w = pk2(qt[6], qt[7]); *(u32x4*)(rp + qcol) = w; *(LAS u32x4*)(QT + t * 136 + c8) = w;
                w.x = pk2(kt[0], kt[1]); w.y = pk2(kt[2], kt[3]); w.z = pk2(kt[4], kt[5]); w.w = pk2(kt[6], kt[7]); *(LAS u32x4*)(KT + t * 136 + c8) = w;
#pragma unroll
                for (int i = 0; i < 4; ++i) { KTT[(c8 + 2 * i) * 72 + t] = (bf16_t)(w[i] & 0xffffu); KTT[(c8 + 2 * i + 1) * 72 + t] = (bf16_t)(w[i] >> 16); }
            }
            if (t0 == 0) {
                float* em = vec_h + (size_t)ci * 1024; float* el = em + (size_t)NCHUNK * 1024; float* elm = el + (size_t)NCHUNK * 1024;
                f32x4 v0, v1;
#pragma unroll
                for (int i = 0; i < 4; ++i) { v0[i] = __builtin_amdgcn_exp2f(bmid[i]); v1[i] = __builtin_amdgcn_exp2f(bmid[4 + i]); }
                *(f32x4*)(em + c8) = v0; *(f32x4*)(em + c8 + 4) = v1;
#pragma unroll
                for (int i = 0; i < 4; ++i) { v0[i] = __builtin_amdgcn_exp2f(blast[i]); v1[i] = __builtin_amdgcn_exp2f(blast[4 + i]); }
                *(f32x4*)(el + c8) = v0; *(f32x4*)(el + c8 + 4) = v1;
#pragma unroll
                for (int i = 0; i < 4; ++i) { v0[i] = __builtin_amdgcn_exp2f(blast[i] - bmid[i]); v1[i] = __builtin_amdgcn_exp2f(blast[4 + i] - bmid[4 + i]); }
                *(f32x4*)(elm + c8) = v0; *(f32x4*)(elm + c8 + 4) = v1;
            }
        }
        __syncthreads();
        { const int k = tid >> 2, j = tid & 3; bf16_t* ktb = ktb_h + (size_t)ci * nh * 8192;
          const u32x4 w0 = *(const LAS u32x4*)(KTT + k * 72 + 16 * j), w1 = *(const LAS u32x4*)(KTT + k * 72 + 16 * j + 8);
          *(u32x4*)(ktb + k * 64 + 16 * j) = w0; *(u32x4*)(ktb + k * 64 + 16 * j + 8) = w1; }
        { const int ti = wid >> 1;
#pragma unroll
          for (int sh = 0; sh < 2; ++sh) { const int si = 2 * (wid & 1) + sh; f32x4 pa = {0.f, 0.f, 0.f, 0.f};
              if (si <= ti) {
#pragma unroll
                  for (int kk = 0; kk < 4; ++kk) { const bf16x8 A = *(const LAS bf16x8*)(KT + (16 * si + fr) * 136 + 32 * kk + 8 * fq), B = *(const LAS bf16x8*)(QT + (16 * ti + fr) * 136 + 32 * kk + 8 * fq); pa = MFMA16(A, B, pa); }
                  if (si == ti) {
#pragma unroll
                      for (int j = 0; j < 4; ++j) if (4 * fq + j > fr) pa[j] = 0.f; }
              }
              u32x2 w; w.x = pk2(pa[0], pa[1]); w.y = pk2(pa[2], pa[3]); *(u32x2*)(base + (size_t)(16 * ti + fr) * ld + kcol + 16 * si + 4 * fq) = w; } }
    }
    __syncthreads();
}

constexpr int MXB = 49664, MXB_QT = 0, MXB_KTT = 17408, MXB_VT = 35840, MXB_PP = 40448, MX_ST = 2 * MXB, MX_END = MX_ST + 2 * 8704;
static_assert(MX_END <= LDS_ST_OFF, "mixer LDS");

struct ChainArgs {
    bf16_t* proj; int ld; size_t row0; int nchunks;
    int qcol, kcol, vcol;
    const bf16_t* ktb;
    size_t ktb_stride;
    const float* em; const float* el; const float* elm; int vec_stride;
    const float* s0; float* sout; int sstride;
};

__device__ __forceinline__ void mixer_chain(LAS unsigned char* lds, const ChainArgs& a) {
    int tid_ = threadIdx.x; asm volatile("" : "+v"(tid_));
    const int tid = tid_, wid = __builtin_amdgcn_readfirstlane(tid >> 6), lane = tid & 63, fr = lane & 15, fq = lane >> 4;
    const int t0 = tid >> 4, c8 = (tid & 15) * 8;
    f32x4 Sacc[2];
#pragma unroll
    for (int vi = 0; vi < 2; ++vi)
#pragma unroll
        for (int j = 0; j < 4; ++j) Sacc[vi][j] = a.s0 ? a.s0[(size_t)(16 * wid + 4 * fq + j) * a.sstride + 16 * vi + fr] : 0.f;
    struct Regs { u32x4 rq[2], rkt[2], rp, rv; f32x4 vem, vel, velm; };
    Regs R0, R1;
    R0.rv = (u32x4){0u, 0u, 0u, 0u}; R1.rv = (u32x4){0u, 0u, 0u, 0u};
    auto issue_loads = [&](Regs& R, int c) {
        const bf16_t* base = a.proj + (a.row0 + (size_t)c * 64) * a.ld;
#pragma unroll
        for (int rr = 0; rr < 2; ++rr) R.rq[rr] = *(const u32x4*)(base + (size_t)(t0 + 32 * rr) * a.ld + c8 + a.qcol);
        R.rp = *(const u32x4*)(base + (size_t)(tid >> 3) * a.ld + a.kcol + 8 * (tid & 7));
        const bf16_t* kp = a.ktb + (size_t)c * a.ktb_stride + (tid >> 2) * 64 + 16 * (tid & 3);
        R.rkt[0] = *(const u32x4*)kp; R.rkt[1] = *(const u32x4*)(kp + 8);
        if (tid < 256) R.rv = *(const u32x4*)(base + (size_t)(tid >> 2) * a.ld + a.vcol + 8 * (tid & 3));
        const size_t vo = (size_t)c * a.vec_stride + 16 * wid + 4 * fq;
        R.vem = *(const f32x4*)(a.em + vo); R.vel = *(const f32x4*)(a.el + vo); R.velm = *(const f32x4*)(a.elm + vo);
    };
    f32x4 cel, celm;
    auto fill = [&](int b, const Regs& R) {
        LAS bf16_t* QT = (LAS bf16_t*)(lds + b * MXB + MXB_QT); LAS bf16_t* KTT = (LAS bf16_t*)(lds + b * MXB + MXB_KTT);
        LAS bf16_t* VT = (LAS bf16_t*)(lds + b * MXB + MXB_VT); LAS bf16_t* PP = (LAS bf16_t*)(lds + b * MXB + MXB_PP); LAS bf16_t* ST = (LAS bf16_t*)(lds + MX_ST + b * 8704);
#pragma unroll
        for (int rr = 0; rr < 2; ++rr) *(LAS u32x4*)(QT + (t0 + 32 * rr) * 136 + c8) = R.rq[rr];
        *(LAS u32x4*)(PP + (tid >> 3) * 72 + 8 * (tid & 7)) = R.rp;
        { LAS bf16_t* kp = KTT + (tid >> 2) * 72 + 16 * (tid & 3); *(LAS u32x4*)kp = R.rkt[0]; *(LAS u32x4*)(kp + 8) = R.rkt[1]; }
        if (tid < 256) { const int tv = tid >> 2, v8 = (tid & 3) * 8;
#pragma unroll
            for (int i = 0; i < 8; ++i) VT[(v8 + i) * 72 + tv] = (bf16_t)((i & 1) ? (R.rv[i >> 1] >> 16) : (R.rv[i >> 1] & 0xffffu)); }
#pragma unroll
        for (int vi = 0; vi < 2; ++vi) { u32x2 w; w.x = pk2(Sacc[vi][0] * R.vem[0], Sacc[vi][1] * R.vem[1]); w.y = pk2(Sacc[vi][2] * R.vem[2], Sacc[vi][3] * R.vem[3]); *(LAS u32x2*)(ST + (16 * vi + fr) * 136 + 16 * wid + 4 * fq) = w; }
        cel = R.vel; celm = R.velm;
    };
    auto compute = [&](int b, int c) {
        const LAS bf16_t* QT = (const LAS bf16_t*)(lds + b * MXB + MXB_QT); const LAS bf16_t* KTT = (const LAS bf16_t*)(lds + b * MXB + MXB_KTT);
        const LAS bf16_t* VT = (const LAS bf16_t*)(lds + b * MXB + MXB_VT); const LAS bf16_t* PP = (const LAS bf16_t*)(lds + b * MXB + MXB_PP); const LAS bf16_t* ST = (const LAS bf16_t*)(lds + MX_ST + b * 8704);
        { const int ti = wid >> 1, vi = wid & 1; f32x4 o = {0.f, 0.f, 0.f, 0.f};
#pragma unroll
          for (int kk = 0; kk < 2; ++kk) { const bf16x8 A = *(const LAS bf16x8*)(VT + (16 * vi + fr) * 72 + 32 * kk + 8 * fq), B = *(const LAS bf16x8*)(PP + (16 * ti + fr) * 72 + 32 * kk + 8 * fq); o = MFMA16(A, B, o); }
#pragma unroll
          for (int kk = 0; kk < 4; ++kk) { const bf16x8 A = *(const LAS bf16x8*)(ST + (16 * vi + fr) * 136 + 32 * kk + 8 * fq), B = *(const LAS bf16x8*)(QT + (16 * ti + fr) * 136 + 32 * kk + 8 * fq); o = MFMA16(A, B, o); }
          u32x2 w; w.x = pk2(o[0], o[1]); w.y = pk2(o[2], o[3]);
          *(u32x2*)(a.proj + (a.row0 + (size_t)c * 64 + 16 * ti + fr) * a.ld + a.vcol + 16 * vi + 4 * fq) = w; }
#pragma unroll
        for (int vi = 0; vi < 2; ++vi) { f32x4 u = {0.f, 0.f, 0.f, 0.f};
#pragma unroll
            for (int kk = 0; kk < 2; ++kk) { const bf16x8 A = *(const LAS bf16x8*)(KTT + (16 * wid + fr) * 72 + 32 * kk + 8 * fq), B = *(const LAS bf16x8*)(VT + (16 * vi + fr) * 72 + 32 * kk + 8 * fq); u = MFMA16(A, B, u); }
            Sacc[vi] = Sacc[vi] * cel + u * celm; }
    };
    const int n = a.nchunks;
    issue_loads(R0, 0);
    if (n > 1) issue_loads(R1, 1);
    fill(0, R0);
    if (n > 2) issue_loads(R0, 2);
    for (int c = 0; c < n; c += 2) {
        __syncthreads();
        compute(0, c);
        if (c + 1 < n) { fill(1, R1); if (c + 3 < n) issue_loads(R1, c + 3); }
        if (c + 1 < n) {
            __syncthreads();
            compute(1, c + 1);
            if (c + 2 < n) { fill(0, R0); if (c + 4 < n) issue_loads(R0, c + 4); }
        }
    }
#pragma unroll
    for (int vi = 0; vi < 2; ++vi)
#pragma unroll
        for (int j = 0; j < 4; ++j) a.sout[(size_t)(16 * wid + 4 * fq + j) * a.sstride + 16 * vi + fr] = Sacc[vi][j];
    __syncthreads();
}

constexpr int AT_PITCH = 264, AT_KOFF = 128 * AT_PITCH * 2, AT_KP = 136;
static_assert(AT_KOFF + 256 * AT_KP * 2 <= LDS_ST_OFF, "attention LDS");
__device__ __forceinline__ void mem_attn(LAS unsigned char* lds, const bf16_t* Kb, const bf16_t* Vb, bf16_t* Q, int ld, int nrows) {
    int tid_ = threadIdx.x; asm volatile("" : "+v"(tid_));
    const int tid = tid_, wid = __builtin_amdgcn_readfirstlane(tid >> 6), lane = tid & 63, fr = lane & 15, fq = lane >> 4;
    LAS bf16_t* VT = (LAS bf16_t*)lds;
    LAS bf16_t* KS = (LAS bf16_t*)(lds + AT_KOFF);
#pragma unroll
    for (int it = 0; it < 8; ++it) { const int idx = tid + NTHR * it, key = idx >> 4, v8 = (idx & 15) * 8; const u32x4 v = *(const u32x4*)(Vb + (size_t)key * 512 + v8), kx = *(const u32x4*)(Kb + (size_t)key * 512 + v8);
        *(LAS u32x4*)(KS + key * AT_KP + v8) = kx;
#pragma unroll
        for (int i = 0; i < 8; ++i) VT[(v8 + i) * AT_PITCH + key] = (bf16_t)((i & 1) ? (v[i >> 1] >> 16) : (v[i >> 1] & 0xffffu)); }
    __syncthreads();
    const float sc2 = 0.08838834764831845f * 1.4426950408889634f;
    for (int q0 = wid * 16; q0 < nrows; q0 += 128) {
        bf16x8 Qf0, Qf1, Qf2, Qf3;
        { const bf16_t* qp = Q + (size_t)(q0 + fr) * ld + 8 * fq; Qf0 = *(const bf16x8*)(qp); Qf1 = *(const bf16x8*)(qp + 32); Qf2 = *(const bf16x8*)(qp + 64); Qf3 = *(const bf16x8*)(qp + 96); }
        f32x4 s[16];
#pragma unroll
        for (int a = 0; a < 16; ++a) {
            const LAS bf16_t* kp = KS + (16 * a + fr) * AT_KP + 8 * fq;
            f32x4 t = {0.f, 0.f, 0.f, 0.f};
            t = MFMA16(*(const LAS bf16x8*)(kp), Qf0, t); t = MFMA16(*(const LAS bf16x8*)(kp + 32), Qf1, t); t = MFMA16(*(const LAS bf16x8*)(kp + 64), Qf2, t); t = MFMA16(*(const LAS bf16x8*)(kp + 96), Qf3, t);
            s[a] = t;
            if ((a & 3) == 3) asm volatile("" ::: "memory");
        }
        float mx = -3.0e38f;
#pragma unroll
        for (int a = 0; a < 16; ++a) mx = fmaxf(fmaxf(mx, fmaxf(s[a][0], s[a][1])), fmaxf(s[a][2], s[a][3]));
        mx = fmaxf(mx, __shfl_xor(mx, 16)); mx = fmaxf(mx, __shfl_xor(mx, 32));
        float sum = 0.f; u32x2 pk[16];
#pragma unroll
        for (int a = 0; a < 16; ++a) { const float e0 = __builtin_amdgcn_exp2f((s[a][0] - mx) * sc2), e1 = __builtin_amdgcn_exp2f((s[a][1] - mx) * sc2), e2 = __builtin_amdgcn_exp2f((s[a][2] - mx) * sc2), e3 = __builtin_amdgcn_exp2f((s[a][3] - mx) * sc2);
            sum += (e0 + e1) + (e2 + e3); pk[a].x = pk2(e0, e1); pk[a].y = pk2(e2, e3); }
        sum += __shfl_xor(sum, 16); sum += __shfl_xor(sum, 32);
        const float inv = 1.0f / sum;
        f32x4 o[8];
#pragma unroll
        for (int dt = 0; dt < 8; ++dt) o[dt] = (f32x4){0.f, 0.f, 0.f, 0.f};
#pragma unroll
        for (int ap = 0; ap < 8; ++ap) {
            const u32x4 bv = {pk[2 * ap].x, pk[2 * ap].y, pk[2 * ap + 1].x, pk[2 * ap + 1].y};
            const bf16x8 B = __builtin_bit_cast(bf16x8, bv);
#pragma unroll
            for (int dt = 0; dt < 8; ++dt) {
                const u32x2 lo = *(const LAS u32x2*)(VT + (16 * dt + fr) * AT_PITCH + 32 * ap + 4 * fq), hi = *(const LAS u32x2*)(VT + (16 * dt + fr) * AT_PITCH + 32 * ap + 16 + 4 * fq);
                const u32x4 av = {lo.x, lo.y, hi.x, hi.y};
                o[dt] = MFMA16(__builtin_bit_cast(bf16x8, av), B, o[dt]);
            }
        }
#pragma unroll
        for (int dt = 0; dt < 8; ++dt) { u32x2 w; w.x = pk2(o[dt][0] * inv, o[dt][1] * inv); w.y = pk2(o[dt][2] * inv, o[dt][3] * inv);
            *(u32x2*)(Q + (size_t)(q0 + fr) * ld + 16 * dt + 4 * fq) = w; }
    }
    __syncthreads();
}

__device__ __forceinline__ void mixprep_phase(LAS unsigned char* lds, const Params& p, int layer) {
    const int j = layer >> 1, gla = layer & 1, w = lbid(), G = gridDim.x;
    bf16_t* proj = (bf16_t*)(p.ws + WS_PROJ);
    const int ld = gla ? GL_LD : HG_LD, nh = gla ? 4 : 8;
    bf16_t* ktb = (bf16_t*)(p.ws + WS_XN);
    float* vec = (float*)(p.ws + WS_VEC);
    const int xq = gla ? 3584 : 4096;
    for (int it = w; it < 256 + 64; it += G) {
        const bf16_t* Kb; const bf16_t* Vb; bf16_t* Qp; int nrows;
        if (it < 256) { const int bh = it >> 3, grp = it & 7, b = bh >> 2, h = bh & 3;
            Kb = (const bf16_t*)(p.ws + WS_MKB) + ((size_t)layer * 2048 + b * 256) * 512 + h * 128;
            Vb = (const bf16_t*)(p.ws + WS_MVB) + ((size_t)layer * 2048 + b * 256) * 512 + h * 128;
            Qp = proj + ((size_t)b * 8192 + grp * 1024) * ld + xq + h * 128; nrows = 1024;
        } else { const int bh = it - 256, b = bh >> 2, h = bh & 3;
            Kb = (const bf16_t*)(p.ws + WS_CKB) + ((size_t)layer * 4096 + b * 256) * 512 + h * 128;
            Vb = (const bf16_t*)(p.ws + WS_CVB) + ((size_t)layer * 4096 + b * 256) * 512 + h * 128;
            Qp = proj + ((size_t)MP + b * 64) * ld + xq + h * 128; nrows = 64;
        }
        mem_attn(lds, Kb, Vb, Qp, ld, nrows);
    }
    { const int h = w % nh;
      mixprep_loop(lds, proj, ld, h * 128, (gla ? 512 : 1024) + h * 128, gla ? 1024 + h * 128 : 0, gla,
                   gla ? nullptr : p.in[13] + h * 128, gla ? nullptr : p.in[13] + 1024 + h * 128, j, gla ? p.in[18] + j * 512 + h * 128 : nullptr,
                   ktb + (size_t)h * 8192, nh, vec + h * 128, w / nh, G / nh); }
}
__device__ __forceinline__ void chain_phase(LAS unsigned char* lds, const Params& p, int layer) {
    const int j = layer >> 1, gla = layer & 1, w = lbid(), G = gridDim.x;
    bf16_t* proj = (bf16_t*)(p.ws + WS_PROJ);
    const int ld = gla ? GL_LD : HG_LD;
    const int nvs = gla ? 8 : 4, nh = gla ? 4 : 8, vdim = gla ? 256 : 128;
    const bf16_t* ktb = (const bf16_t*)(p.ws + WS_XN);
    const float* vec = (const float*)(p.ws + WS_VEC);
    const int n_prompt = 8 * nh * nvs  , n_sample = 16 * nh * nvs  ;
    for (int it = w; it < n_prompt + n_sample; it += G) {
        const bool smp = it >= n_prompt; const int id = smp ? it - n_prompt : it;
        const int lo = id & 7, rest = id >> 3, vs = rest % nvs, hi = rest / nvs, bh = lo + 8 * hi, b = bh / nh, h = bh % nh;
        ChainArgs a;
        a.proj = proj; a.ld = ld;
        a.row0 = smp ? (size_t)MP + (size_t)b * 64 : (size_t)b * 8192; a.nchunks = smp ? 1 : 128;
        const int ci0 = smp ? 1024 + b : b * 128;
        if (gla) { a.qcol = h * 128; a.kcol = 512 + h * 128; a.vcol = 2560 + h * 256 + 32 * vs; }
        else { a.qcol = h * 128; a.kcol = 1024 + h * 128; a.vcol = 3072 + h * 128 + 32 * vs; }
        a.ktb = ktb + ((size_t)ci0 * nh + h) * 8192; a.ktb_stride = (size_t)nh * 8192;
        a.em = vec + (size_t)ci0 * 1024 + h * 128; a.el = a.em + (size_t)NCHUNK * 1024; a.elm = a.el + (size_t)NCHUNK * 1024; a.vec_stride = 1024;
        const size_t per_b = (size_t)nh * 128 * vdim, so = ((size_t)b * nh + h) * 128 * vdim + 32 * vs;
        if (smp) { a.s0 = (gla ? p.in[6] : p.in[5]) + (size_t)j * 16 * per_b + so; a.sout = p.out + (gla ? O_SGS : O_SHS) + (size_t)j * 16 * per_b + so; }
        else { a.s0 = nullptr; a.sout = p.out + (gla ? O_SGP : O_SHP) + (size_t)j * 8 * per_b + so; }
        a.sstride = vdim;
        mixer_chain(lds, a);
    }
}

#define XB_TMO      128
#define XB_XCNT(j)  (256  + 64 * (j))
#define XB_XSUB(j)  (1280 + 64 * (j))
#define XB_XGEN(j)  (2304 + 64 * (j))
#define XB_TOP      3328
#define XB_TOPGEN   3392
#define XCD_BAR_WORDS 3456
#define XB_SPIN_CAP (1u << 22)
__device__ __forceinline__ unsigned xb_ld(unsigned* p)              { return __hip_atomic_load(p, __ATOMIC_RELAXED, __HIP_MEMORY_SCOPE_AGENT); }
__device__ __forceinline__ unsigned xb_add(unsigned* p, unsigned v) { return __hip_atomic_fetch_add(p, v, __ATOMIC_RELAXED, __HIP_MEMORY_SCOPE_AGENT); }
__device__ __forceinline__ unsigned xb_xcc_id() { return (unsigned)__builtin_amdgcn_s_getreg((3 << 11) | 20) & 0xFu; }
#define XB_SPIN(cond, bar) do { unsigned _sp = 0; while (cond) { __builtin_amdgcn_s_sleep(1); \
    if ((++_sp & 255u) == 0u) { if (xb_ld(&(bar)[XB_TMO])) break; if (_sp > XB_SPIN_CAP) { atomicAdd(&(bar)[XB_TMO], 1u); break; } } } } while (0)
struct XcdBarrier { unsigned* bar; unsigned x; volatile LAS unsigned* st; };
__device__ __forceinline__ XcdBarrier xcd_barrier_post(unsigned* bar, volatile LAS unsigned* st) {
    XcdBarrier b; b.bar = bar; b.x = xb_xcc_id(); b.st = st;
    if (threadIdx.x == 0) (void)xb_add(&bar[XB_XCNT(b.x)], 1u);
    return b;
}
__device__ __forceinline__ void xcd_barrier_complete(unsigned* bar, unsigned x, unsigned& nloc, unsigned& nx) {
    const unsigned G = gridDim.x * gridDim.y * gridDim.z;
    unsigned sum, cnt, mine, sp = 0u;
    for (;;) {
        sum = 0u; cnt = 0u; mine = 0u;
#pragma unroll
        for (unsigned j = 0; j < 16; ++j) { const unsigned c = xb_ld(&bar[XB_XCNT(j)]); sum += c; cnt += (c > 0u) ? 1u : 0u; mine = (j == x) ? c : mine; }
        if (sum == G) break;
        __builtin_amdgcn_s_sleep(1);
        if ((++sp & 255u) == 0u) { if (xb_ld(&bar[XB_TMO])) break; if (sp > XB_SPIN_CAP) { atomicAdd(&bar[XB_TMO], 1u); break; } }
    }
    nloc = mine > 0u ? mine : 1u; nx = cnt > 0u ? cnt : 1u;
}
__device__ __forceinline__ void xcd_barrier(const XcdBarrier& b) {
    asm volatile("s_waitcnt vmcnt(0)" ::: "memory");
    __syncthreads();
    if (threadIdx.x == 0) {
        unsigned* bar = b.bar;
        __builtin_amdgcn_s_waitcnt(0);
        unsigned nloc = b.st[0], nx = b.st[1];
        if (nloc == 0u) { xcd_barrier_complete(bar, b.x, nloc, nx); b.st[0] = nloc; b.st[1] = nx; }
        const unsigned old = xb_add(&bar[XB_XSUB(b.x)], 1u);
        const unsigned gen = old / nloc;
        if (old + 1u == (gen + 1u) * nloc) {
            __builtin_amdgcn_fence(__ATOMIC_RELEASE, "agent");
            asm volatile("s_waitcnt vmcnt(0)" ::: "memory");
            const unsigned og = xb_add(&bar[XB_TOP], 1u);
            const unsigned tg = og / nx;
            if (og + 1u == (tg + 1u) * nx) xb_add(&bar[XB_TOPGEN], 1u);
            else XB_SPIN(xb_ld(&bar[XB_TOPGEN]) == tg, bar);
            __builtin_amdgcn_fence(__ATOMIC_ACQUIRE, "agent");
            xb_add(&bar[XB_XGEN(b.x)], 1u);
            asm volatile("s_waitcnt vmcnt(0)" ::: "memory");
        } else {
            XB_SPIN(xb_ld(&bar[XB_XGEN(b.x)]) == gen, bar);
            __builtin_amdgcn_fence(__ATOMIC_ACQUIRE, "agent");
            asm volatile("s_waitcnt vmcnt(0)" ::: "memory");
        }
    }
    __syncthreads();
}

constexpr int PPL = 9;
constexpr int NPHASE = 2 + 4 * PPL + 1;
#define WSB(off) ((bf16_t*)(p.ws + (off)))
#define STATS(li) ((float*)(p.ws + WS_STATS) + (size_t)(li) * MROWS * 2)
__global__ void __launch_bounds__(NTHR, 2) trunk_fwd(Params p) {
    extern __shared__ __attribute__((aligned(16))) unsigned char lds_raw[];
    LAS unsigned char* lds = (LAS unsigned char*)lds_raw;
    if (p.ph_hi - p.ph_lo > 1) {
        if (threadIdx.x < 4) ((LAS unsigned*)(lds + LDS_ST_OFF))[threadIdx.x] = 0u;
        __syncthreads();
        (void)xcd_barrier_post((unsigned*)(p.ws + WS_BAR), (volatile LAS unsigned*)(lds + LDS_ST_OFF));
    }
    for (int ph = p.ph_lo; ph < p.ph_hi; ++ph) {
        if (ph == 0) prep_phase(lds, p);
        else if (ph == 1) { }
        else if (false) { Epi E{EPI_MEMKV, nullptr, 0, nullptr, 0.f, p.out + O_MK, p.out + O_MV, WSB(WS_MKB), WSB(WS_MVB), nullptr, nullptr, nullptr, nullptr, nullptr};
            gemm_phase<EPI_MEMKV>(lds, WSB(WS_MEMP), 1024, WSB(WS_MEMW), 2048, 4096, 1024, E); }
        else if (ph == NPHASE - 1) ln_phase(p.out + O_Y, nullptr, p.in[10] + 11 * 1024, p.in[11] + 11 * 1024);
        else {
            const int layer = (ph - 2) / PPL, s = (ph - 2) % PPL, gla = layer & 1, j = layer >> 1;
            if (s == 0 || s == 7) {
                const int lf = layer * 2 + (s == 7), li = (s == 7) ? 3 * layer + 1 : 3 * layer - 1;
                const float* cv = (const float*)(p.ws + WS_CV_WGU) + (size_t)lf * 2 * 5632;
                Epi E{EPI_SWIGLU, WSB(WS_PROJ), FF, nullptr, 0.f, nullptr, nullptr, nullptr, nullptr, li >= 0 ? STATS(li) : (const float*)(p.ws + WS_IDST), cv, cv + 5632, nullptr, nullptr};
                gemm_phase<EPI_SWIGLU>(lds, WSB(WS_XN), 1024, WSB(WS_WGU) + (size_t)lf * 5632 * 1024, MROWS, 5632, 1024, E);
                if (ph == 2) { Epi Em{EPI_MEMKV, nullptr, 0, nullptr, 0.f, p.out + O_MK, p.out + O_MV, WSB(WS_MKB), WSB(WS_MVB), nullptr, nullptr, nullptr, nullptr, nullptr};
                    gemm_phase<EPI_MEMKV>(lds, WSB(WS_MEMP), 1024, WSB(WS_MEMW), 2048, 4096, 1024, Em); } }
            else if (s == 1 || s == 8) {
                const int lf = layer * 2 + (s == 8), li_in = (s == 8) ? 3 * layer + 1 : 3 * layer - 1, li_out = (s == 8) ? 3 * layer + 2 : 3 * layer;
                Epi E{EPI_RES, nullptr, 0, p.out + O_Y, 0.5f, nullptr, nullptr, nullptr, nullptr, li_in >= 0 ? STATS(li_in) : (const float*)(p.ws + WS_IDST),
                      li_in >= 0 ? p.in[10] + li_in * 1024 : (const float*)(p.ws + WS_ONES), li_in >= 0 ? p.in[11] + li_in * 1024 : (const float*)(p.ws + WS_CV_WGU), STATS(li_out), WSB(WS_XN)};
                gemm_phase<EPI_RES>(lds, WSB(WS_PROJ), FF, WSB(WS_WD) + (size_t)lf * 1024 * FF, MP, 1024, FF, E);
                gemm_phase<EPI_RES, true>(lds, WSB(WS_PROJ), FF, WSB(WS_WD) + (size_t)lf * 1024 * FF, MP, 1024, FF, E); }

            else if (s == 2) {
                const int li = 3 * layer;
                const float* cv = gla ? (const float*)(p.ws + WS_CV_GWIN) + (size_t)j * 2 * 4096 : (const float*)(p.ws + WS_CV_HWIN) + (size_t)j * 2 * 4608;
                Epi E{EPI_BF16, WSB(WS_PROJ), gla ? GL_LD : HG_LD, nullptr, 0.f, nullptr, nullptr, nullptr, nullptr, STATS(li), cv, cv + (gla ? 4096 : 4608), nullptr, nullptr};
                if (gla) gemm_phase<EPI_BF16>(lds, WSB(WS_XN), 1024, WSB(WS_GWIN) + (size_t)j * 4096 * 1024, MROWS, 4096, 1024, E);
                else gemm_phase<EPI_BF16>(lds, WSB(WS_XN), 1024, WSB(WS_HWIN) + (size_t)j * 4608 * 1024, MROWS, 4608, 1024, E); }
            else if (s == 3) mixprep_phase(lds, p, layer);
            else if (s == 4) chain_phase(lds, p, layer);
            else if (s == 5) { if (gla) headnorm_phase(WSB(WS_PROJ), GL_LD, 2560, 1536, 32, p.in[19] + j * 1024); else headnorm_phase(WSB(WS_PROJ), HG_LD, 3072, 2048, 16, p.in[14] + j * 1024); }
            else if (s == 6) {
                const int li_in = 3 * layer;
                Epi E{EPI_RES, nullptr, 0, p.out + O_Y, 1.0f, nullptr, nullptr, nullptr, nullptr, STATS(li_in), p.in[10] + li_in * 1024, p.in[11] + li_in * 1024, STATS(li_in + 1), WSB(WS_XN)};
                gemm_phase<EPI_RES>(lds, WSB(WS_PROJ) + (gla ? 2560 : 3072), gla ? GL_LD : HG_LD, WSB(WS_WOUT) + (size_t)layer * 1024 * 1536, MP, 1024, 1536, E);
                gemm_phase<EPI_RES, true>(lds, WSB(WS_PROJ) + (gla ? 2560 : 3072), gla ? GL_LD : HG_LD, WSB(WS_WOUT) + (size_t)layer * 1024 * 1536, MP, 1024, 1536, E); }

        }
        if (ph + 1 < p.ph_hi && ph != 1) {
            if (ph == 0) cg::this_grid().sync();
            else { XcdBarrier bar; bar.bar = (unsigned*)(p.ws + WS_BAR); bar.x = xb_xcc_id(); bar.st = (volatile LAS unsigned*)(lds + LDS_ST_OFF); xcd_barrier(bar); }
        }
    }
}
#undef WSB
#undef STATS

extern "C" void kernel_launch(void* const* d_in, const int* in_sizes, int n_in, void* d_out, int out_size, void* d_ws, size_t ws_size, hipStream_t stream) {
    static int grid = 0;
    if (grid == 0) {
        if (n_in != 23 || ws_size < WS_END) { fprintf(stderr, "kernel_launch: need 23 inputs and %zu bytes of workspace; got %d, %zu\n", (size_t)WS_END, n_in, ws_size); grid = -1; return; }
        if (hipFuncSetAttribute((const void*)trunk_fwd, hipFuncAttributeMaxDynamicSharedMemorySize, LDS_BYTES) != hipSuccess) { fprintf(stderr, "kernel_launch: hipFuncSetAttribute failed\n"); grid = -1; return; }
        int dev = 0, cus = 0, per_cu = 0;
        (void)hipGetDevice(&dev); (void)hipDeviceGetAttribute(&cus, hipDeviceAttributeMultiprocessorCount, dev);
        (void)hipOccupancyMaxActiveBlocksPerMultiprocessor(&per_cu, (const void*)trunk_fwd, NTHR, LDS_BYTES);
        if (per_cu < 1) { fprintf(stderr, "kernel_launch: occupancy query says %d blocks per CU\n", per_cu); per_cu = 1; }
        (void)hipGetLastError();
        grid = cus;
    }
    if (grid < 0) return;
    Params p{};
    for (int i = 0; i < 23; ++i) p.in[i] = (const float*)d_in[i];
    p.out = (float*)d_out; p.ws = (unsigned char*)d_ws;
#if ONE_LAUNCH
    (void)hipMemsetAsync((unsigned char*)d_ws + WS_BAR, 0, WS_ZERO_END - WS_BAR, stream);
    p.ph_lo = 0; p.ph_hi = NPHASE;
    void* args[] = {&p};
    hipError_t e = hipLaunchCooperativeKernel((const void*)trunk_fwd, dim3(grid), dim3(NTHR), args, LDS_BYTES, stream);
    if (e != hipSuccess) fprintf(stderr, "cooperative launch failed: %s (grid %d)\n", hipGetErrorString(e), grid);
#else
    (void)hipMemsetAsync((unsigned char*)d_ws + WS_BAR, 0, WS_ZERO_END - WS_BAR, stream);
    for (int ph = 0; ph < NPHASE; ++ph) {
        p.ph_lo = ph; p.ph_hi = ph + 1;
        hipLaunchKernelGGL(trunk_fwd, dim3(grid), dim3(NTHR), LDS_BYTES, stream, p);
    }
#endif
}
```

```cpp
#include <hip/hip_runtime.h>
#include <hip/hip_cooperative_groups.h>
#include <cstdio>
namespace cg = cooperative_groups;

#ifndef ONE_LAUNCH
#define ONE_LAUNCH 1
#endif

#define LAS __attribute__((address_space(3)))
typedef unsigned short bf16_t;
typedef short bf16x8 __attribute__((ext_vector_type(8)));
typedef float f32x4 __attribute__((ext_vector_type(4)));
typedef float f32x2 __attribute__((ext_vector_type(2)));
typedef unsigned u32x4 __attribute__((ext_vector_type(4)));
typedef unsigned u32x2 __attribute__((ext_vector_type(2)));
typedef __bf16 nbf2 __attribute__((ext_vector_type(2)));

constexpr int D = 1024, MP = 65536, MS = 1024, MROWS = MP + MS, FF = 2816;
constexpr int HG_LD = 4608, GL_LD = 4096;
constexpr float ALPHA = 1.6817928305074292f;
constexpr int NTHR = 512;
constexpr int LDS_BYTES = 144 * 1024;
constexpr int LDS_ST_OFF = 143360;
constexpr int NCHUNK = MROWS / 64;
constexpr int LDS_X = 131072;

constexpr size_t O_Y = 0;
constexpr size_t O_SHP = (size_t)MROWS * D;
constexpr size_t O_SGP = O_SHP + 2u * 8 * 8 * 128 * 128;
constexpr size_t O_MK = O_SGP + 2u * 8 * 4 * 128 * 256;
constexpr size_t O_MV = O_MK + 4u * 2048 * 512;
constexpr size_t O_SHS = O_MV + 4u * 2048 * 512;
constexpr size_t O_SGS = O_SHS + 2u * 16 * 8 * 128 * 128;

constexpr size_t WS_WGU = 0;
constexpr size_t WS_WD = WS_WGU + 8ull * 5632 * 1024 * 2;
constexpr size_t WS_HWIN = WS_WD + 8ull * 1024 * 2816 * 2;
constexpr size_t WS_GWIN = WS_HWIN + 2ull * 4608 * 1024 * 2;
constexpr size_t WS_WOUT = WS_GWIN + 2ull * 4096 * 1024 * 2;
constexpr size_t WS_MEMW = WS_WOUT + 4ull * 1024 * 1536 * 2;
constexpr size_t WS_MEMP = WS_MEMW + 4096ull * 1024 * 2;
constexpr size_t WS_MKB = WS_MEMP + 2048ull * 1024 * 2;
constexpr size_t WS_MVB = WS_MKB + 4ull * 2048 * 512 * 2;
constexpr size_t WS_CKB = WS_MVB + 4ull * 2048 * 512 * 2;
constexpr size_t WS_CVB = WS_CKB + 4ull * 4096 * 512 * 2;
constexpr size_t WS_XN = WS_CVB + 4ull * 4096 * 512 * 2;
constexpr size_t WS_PROJ = WS_XN + (size_t)MROWS * 1024 * 2;
constexpr size_t WS_VEC = WS_PROJ + (size_t)MROWS * 4608 * 2;
constexpr size_t WS_BAR = WS_VEC + 3ull * (MROWS / 64) * 1024 * 4;
constexpr size_t WS_STATS = WS_BAR + 16384;
constexpr size_t WS_CV_WGU = WS_STATS + 12ull * MROWS * 8;
constexpr size_t WS_CV_HWIN = WS_CV_WGU + 8ull * 2 * 5632 * 4;
constexpr size_t WS_CV_GWIN = WS_CV_HWIN + 2ull * 2 * 4608 * 4;
constexpr size_t WS_ZERO_END = WS_CV_GWIN + 2ull * 2 * 4096 * 4;
constexpr size_t WS_IDST = WS_ZERO_END;
constexpr size_t WS_ONES = WS_IDST + (size_t)MROWS * 8;
constexpr size_t WS_END = WS_ONES + 4096;

struct Params {
    const float* in[23];
    float* out;
    unsigned char* ws;
    int ph_lo, ph_hi;
};

__device__ __forceinline__ unsigned pk2(float lo, float hi) { f32x2 v = {lo, hi}; nbf2 b = __builtin_convertvector(v, nbf2); return __builtin_bit_cast(unsigned, b); }
__device__ __forceinline__ float bflo(unsigned u) { return __uint_as_float(u << 16); }
__device__ __forceinline__ float bfhi(unsigned u) { return __uint_as_float(u & 0xffff0000u); }
__device__ __forceinline__ bf16_t f2bf(float f) { unsigned u = pk2(f, 0.f); return (bf16_t)(u & 0xffffu); }
__device__ __forceinline__ float sigmoidf_(float x) { return __builtin_amdgcn_rcpf(1.0f + __builtin_amdgcn_exp2f(-1.4426950408889634f * x)); }
__device__ __forceinline__ int ltid() { int t = threadIdx.x; asm volatile("" : "+v"(t)); return t; }
__device__ __forceinline__ int lbid() { int t = blockIdx.x; asm volatile("" : "+s"(t)); return t; }
#define MFMA16(a, b, c) __builtin_amdgcn_mfma_f32_16x16x32_bf16((a), (b), (c), 0, 0, 0)

constexpr int BM = 256, BK = 64, HALF = 128, HTB = HALF * BK * 2, NXCD = 8, WGM = 8;
__device__ __forceinline__ int lds_byte(int r, int c) { const int st = (r >> 4) * 2 + (c >> 5), rr = r & 15, cc = c & 31, ob = rr * 64 + cc * 2; return st * 1024 + (ob ^ (((ob >> 9) & 1) << 5)); }
__device__ __forceinline__ void stage_rc(int b, int& R, int& C) { const int st = b / 1024, sb = b % 1024, swz = sb ^ (((sb >> 9) & 1) << 5); R = (st >> 1) * 16 + swz / 64; C = (st & 1) * 32 + (swz % 64) / 2; }
__device__ __forceinline__ int perm32(int rho) { const int n = rho >> 4, i = rho & 15; return 8 * (i >> 2) + 4 * n + (i & 3); }

struct Unit { int pm, pn; };
struct StaticOrder {
    int nM, nN, nwg, G, c; bool rev;
    __device__ __forceinline__ void init(int M, int N, int G_, int c_, bool rev_ = false) { nM = M / BM; nN = N / BM; nwg = nM * nN; G = G_; c = c_; rev = rev_; }
    __device__ __forceinline__ bool next(int i, Unit& u) const {
        const long L = (long)i * G + c; if (L >= nwg) return false;
        int wgid = (int)L; { const int q = nwg / NXCD, r = nwg % NXCD, xcd = wgid % NXCD, off = wgid / NXCD; wgid = (xcd < r ? xcd * (q + 1) : r * (q + 1) + (xcd - r) * q) + off; }
        const int nig = WGM * nN, gid = wgid / nig, fm = gid * WGM, gsz = (nM - fm) < WGM ? (nM - fm) : WGM;
        u.pm = fm + ((wgid % nig) % gsz); u.pn = (wgid % nig) / gsz; if (rev) u.pm = nM - 1 - u.pm; return true;
    }
};

enum { EPI_SWIGLU = 0, EPI_BF16 = 1, EPI_RES = 2, EPI_MEMKV = 3 };
struct Epi { int mode; bf16_t* ob; int ldo; float* xf; float scale; float* mk_out; float* mv_out; bf16_t* mkb; bf16_t* mvb;
             const float* st_in; const float* v1; const float* v2; float* st_out; bf16_t* ybf; };
__device__ __forceinline__ void row_mu_rstd(const LAS float* XS, int rl, float& mu, float& rstd) {
    const f32x2 q = *(const LAS f32x2*)(XS + 2 * rl); mu = q.x * (1.0f / 1024.0f); rstd = __builtin_amdgcn_rsqf(fmaxf(q.y * (1.0f / 1024.0f) - mu * mu, 0.f) + 1e-5f);
}

template <int MODE, bool HALFM> __device__ __forceinline__ void gemm_epilogue(const f32x4 (&acc)[2][2][4][2], const Unit& u, int rb, int wr, int wc, int fr, int fq, const Epi& E, LAS unsigned char* lds) {
    const int row0 = rb + wr * 64 + fr;
    const LAS float* XS = (const LAS float*)(lds + LDS_X); const int rl0 = wr * 64 + fr;
    if constexpr (MODE == EPI_SWIGLU) {
        const int col0 = u.pn * 128 + wc * 32 + 8 * fq;
        const int cl = wc * 32 + 8 * fq;
        f32x4 c1g[2], c2g[2], c1u[2], c2u[2];
#pragma unroll
        for (int n = 0; n < 2; ++n) {
            c1g[n] = *(const LAS f32x4*)(XS + 512 + cl + 4 * n); c2g[n] = *(const LAS f32x4*)(XS + 768 + cl + 4 * n); c1u[n] = *(const LAS f32x4*)(XS + 512 + cl + 128 + 4 * n); c2u[n] = *(const LAS f32x4*)(XS + 768 + cl + 128 + 4 * n);
        }
        float mus[2][4], rstds[2][4];
#pragma unroll
        for (int ai = 0; ai < 2; ++ai)
#pragma unroll
            for (int m = 0; m < 4; ++m) row_mu_rstd(XS, rl0 + ai * HALF + m * 16, mus[ai][m], rstds[ai][m]);
#pragma unroll
        for (int ai = 0; ai < 2; ++ai)
#pragma unroll
            for (int m = 0; m < 4; ++m) {
                const int row = row0 + ai * HALF + m * 16;
                const float mu = mus[ai][m], rstd = rstds[ai][m];
                bf16_t* rowp = E.ob + (size_t)row * E.ldo + col0;
                float h[8];
#pragma unroll
                for (int n = 0; n < 2; ++n)
#pragma unroll
                    for (int j = 0; j < 4; ++j) { const float g = rstd * (acc[ai][0][m][n][j] - mu * c1g[n][j]) + c2g[n][j], up = rstd * (acc[ai][1][m][n][j] - mu * c1u[n][j]) + c2u[n][j];
                        h[n * 4 + j] = g * up * __builtin_amdgcn_rcpf(1.0f + __builtin_amdgcn_exp2f(-1.4426950408889634f * g)); }
                u32x4 w; w.x = pk2(h[0], h[1]); w.y = pk2(h[2], h[3]); w.z = pk2(h[4], h[5]); w.w = pk2(h[6], h[7]);
                *(u32x4*)rowp = w;
            }
    } else if constexpr (MODE == EPI_BF16) {
        const int col0 = u.pn * BM + wc * 32 + 8 * fq, cl = wc * 32 + 8 * fq;
        f32x4 c1[2][2], c2[2][2];
#pragma unroll
        for (int bj = 0; bj < 2; ++bj)
#pragma unroll
            for (int n = 0; n < 2; ++n) { c1[bj][n] = *(const LAS f32x4*)(XS + 512 + cl + bj * HALF + 4 * n); c2[bj][n] = *(const LAS f32x4*)(XS + 768 + cl + bj * HALF + 4 * n); }
#pragma unroll
        for (int ai = 0; ai < 2; ++ai)
#pragma unroll
            for (int m = 0; m < 4; ++m) {
                const int row = row0 + ai * HALF + m * 16;
                float mu, rstd; row_mu_rstd(XS, rl0 + ai * HALF + m * 16, mu, rstd);
                bf16_t* rowp = E.ob + (size_t)row * E.ldo + col0;
#pragma unroll
                for (int bj = 0; bj < 2; ++bj) {
                    const f32x4 v0 = (acc[ai][bj][m][0] - c1[bj][0] * mu) * rstd + c2[bj][0], v1 = (acc[ai][bj][m][1] - c1[bj][1] * mu) * rstd + c2[bj][1];
                    u32x4 w; w.x = pk2(v0[0], v0[1]); w.y = pk2(v0[2], v0[3]); w.z = pk2(v1[0], v1[1]); w.w = pk2(v1[2], v1[3]);
                    *(u32x4*)(rowp + bj * HALF) = w;
                }
            }
    } else if constexpr (MODE == EPI_RES) {
        const int col0 = u.pn * BM + wc * 32 + 4 * fq, cl = wc * 32 + 4 * fq;
        const unsigned eo0 = (unsigned)row0 * D + (unsigned)col0;
        float* const xb = E.xf; bf16_t* const yb = E.ybf;
        constexpr int NG = HALFM ? 4 : 8;
#pragma unroll
        for (int bt = 0; bt < NG / 4; ++bt) {
            const int g0 = bt * 4;
            f32x4 xv[4][2][2];
#pragma unroll
            for (int gi = 0; gi < 4; ++gi) { const int g = g0 + gi, ai = g >> 2, m = g & 3; const unsigned eo = eo0 + (unsigned)((ai * HALF + m * 16) * D);
#pragma unroll
                for (int bj = 0; bj < 2; ++bj)
#pragma unroll
                    for (int n = 0; n < 2; ++n) xv[gi][bj][n] = *(const f32x4*)(xb + eo + bj * HALF + n * 16); }
#pragma unroll
            for (int gi = 0; gi < 4; ++gi) {
                const int g = g0 + gi, ai = g >> 2, m = g & 3;
                const int row = row0 + ai * HALF + m * 16; const unsigned eo = eo0 + (unsigned)((ai * HALF + m * 16) * D);
                float mu, rstd; row_mu_rstd(XS, rl0 + ai * HALF + m * 16, mu, rstd);
                float s1 = 0.f, s2 = 0.f;
#pragma unroll
                for (int bj = 0; bj < 2; ++bj)
#pragma unroll
                    for (int n = 0; n < 2; ++n) { f32x4 x = xv[gi][bj][n];
                        { const f32x4 gp = *(const LAS f32x4*)(XS + 512 + cl + bj * HALF + n * 16), bp = *(const LAS f32x4*)(XS + 768 + cl + bj * HALF + n * 16); x = (x - mu) * rstd * gp + bp; }
                        x = x * ALPHA + acc[ai][bj][m][n] * E.scale;
                        *(f32x4*)(xb + eo + bj * HALF + n * 16) = x;
                        u32x2 w; w.x = pk2(x[0], x[1]); w.y = pk2(x[2], x[3]); *(u32x2*)(yb + eo + bj * HALF + n * 16) = w;
                        s1 += (x[0] + x[1]) + (x[2] + x[3]); s2 += (x[0] * x[0] + x[1] * x[1]) + (x[2] * x[2] + x[3] * x[3]); }
                s1 += __shfl_xor(s1, 16); s1 += __shfl_xor(s1, 32); s2 += __shfl_xor(s2, 16); s2 += __shfl_xor(s2, 32);
                if (fq == 0) { atomicAdd(E.st_out + 2 * (size_t)row, s1); atomicAdd(E.st_out + 2 * (size_t)row + 1, s2); }
            }
            asm volatile("" ::: "memory");
        }
    } else {
        const int colt = u.pn * BM; const int l = colt >> 10, kv = (colt >> 9) & 1, cc0 = (colt & 511) + wc * 32 + 4 * fq;
        float* of = (kv ? E.mv_out : E.mk_out) + (size_t)l * 2048 * 512;
        bf16_t* ob = (kv ? E.mvb : E.mkb) + (size_t)l * 2048 * 512;
#pragma unroll
        for (int ai = 0; ai < 2; ++ai)
#pragma unroll
            for (int m = 0; m < 4; ++m) {
                const size_t ro = (size_t)(row0 + ai * HALF + m * 16) * 512 + cc0;
#pragma unroll
                for (int bj = 0; bj < 2; ++bj)
#pragma unroll
                    for (int n = 0; n < 2; ++n) { const f32x4 v = acc[ai][bj][m][n]; *(f32x4*)(of + ro + bj * HALF + n * 16) = v; u32x2 w; w.x = pk2(v[0], v[1]); w.y = pk2(v[2], v[3]); *(u32x2*)(ob + ro + bj * HALF + n * 16) = w; }
            }
    }
}

template <int MODE, bool HALFM = false> __device__ __forceinline__ void gemm_phase(LAS unsigned char* lds, const bf16_t* Ag, int lda, const bf16_t* Btg, int M, int N, int K, const Epi& E) {
    int tid_ = threadIdx.x; asm volatile("" : "+v"(tid_));
    const int tid = tid_, wid = __builtin_amdgcn_readfirstlane(tid >> 6), lane = tid & 63, wr = wid >> 2, wc = wid & 3, fr = lane & 15, fq = lane >> 4;
    const int nt = K / BK;
    constexpr bool PERM = (MODE == EPI_SWIGLU || MODE == EPI_BF16);
    StaticOrder S; { const int G_ = (int)gridDim.x; int c_ = lbid(); if (MODE == EPI_MEMKV) c_ = (c_ + G_ / 2) % G_; S.init(M, N, G_, c_, MODE == EPI_RES); }
    unsigned voffA[2], voffB[2];
#pragma unroll
    for (int i = 0; i < 2; ++i) { int R, C; stage_rc(tid * 16 + i * 8192, R, C); const int Rb = PERM ? ((R & ~31) + perm32(R & 31)) : R;
        voffA[i] = (unsigned)(R * lda + C) * 2u; voffB[i] = (unsigned)(Rb * K + C) * 2u; }
    const size_t kstep = (size_t)(BK * 2);
    const size_t hstepA = (size_t)HALF * lda * 2, hstepB = (size_t)HALF * K * 2;
    const size_t tstepA = 2 * hstepA, tstepB = 2 * hstepB;
    const size_t hA1 = HALFM ? 0 : hstepA;
    const unsigned ldsw = (unsigned)wid * 1024u;
    const int aoff = lds_byte(wr * 64 + fr, fq * 8), boff = lds_byte(wc * 32 + fr, fq * 8);
#define PG8_SA(b, h) (((b) * 2 + (h)) * HTB)
#define PG8_SB(b, h) ((4 + (b) * 2 + (h)) * HTB)
#define PG8_STAGE(bufoff, gbase, voff) do { _Pragma("unroll") for (int _i = 0; _i < 2; ++_i) \
        __builtin_amdgcn_global_load_lds((const unsigned*)((const char*)(gbase) + (voff)[_i]), (LAS unsigned*)(lds + (bufoff) + ldsw + _i * 8192), 16, 0, 0); } while (0)
#define PG8_LDA(dst, b, h) do { _Pragma("unroll") for (int m = 0; m < 4; ++m) _Pragma("unroll") for (int k = 0; k < 2; ++k) dst[m][k] = *(const LAS bf16x8*)(lds + PG8_SA(b, h) + aoff + m * 2048 + k * 1024); } while (0)
#define PG8_LDB(dst, b, h) do { _Pragma("unroll") for (int n = 0; n < 2; ++n) _Pragma("unroll") for (int k = 0; k < 2; ++k) dst[n][k] = *(const LAS bf16x8*)(lds + PG8_SB(b, h) + boff + n * 2048 + k * 1024); } while (0)
#define PG8_MMA(ai, bj, At, Bt) do { __builtin_amdgcn_s_setprio(1); _Pragma("unroll") for (int m = 0; m < 4; ++m) _Pragma("unroll") for (int n = 0; n < 2; ++n) _Pragma("unroll") for (int k = 0; k < 2; ++k) \
        acc[ai][bj][m][n] = __builtin_amdgcn_mfma_f32_16x16x32_bf16(Bt[n][k], At[m][k], acc[ai][bj][m][n], 0, 0, 0); __builtin_amdgcn_s_setprio(0); } while (0)
#define PG8_WAIT_V(n) asm volatile("s_waitcnt vmcnt(" #n ")" ::: "memory")
#define PG8_WAIT_L(n) asm volatile("s_waitcnt lgkmcnt(" #n ")" ::: "memory")
#define PG8_BAR __builtin_amdgcn_s_barrier()
#define PG8_SCHED __builtin_amdgcn_sched_barrier(0)
    Unit cur, nxt; int ui = 0; int rb;
    if constexpr (HALFM) { const int c_ = S.c; if (c_ >= 8 * (N / BM)) return; cur.pm = M / 128 + (c_ & 7); cur.pn = c_ >> 3; rb = cur.pm * 128; }
    else { if (!S.next(0, cur)) return; rb = cur.pm * BM; }
    f32x4 acc[2][2][4][2];
#pragma unroll
    for (int a = 0; a < 2; ++a)
#pragma unroll
        for (int b = 0; b < 2; ++b)
#pragma unroll
            for (int m = 0; m < 4; ++m)
#pragma unroll
                for (int n = 0; n < 2; ++n) acc[a][b][m][n] = (f32x4){0.f, 0.f, 0.f, 0.f};
    bf16x8 At[4][2], B0[2][2], B1[2][2];
    const char* cA = (const char*)Ag + (size_t)cur.pm * (HALFM ? hstepA : tstepA); const char* cB = (const char*)Btg + (size_t)cur.pn * tstepB;
    PG8_STAGE(PG8_SB(0, 0), cB, voffB); PG8_STAGE(PG8_SA(0, 0), cA, voffA); PG8_STAGE(PG8_SB(0, 1), cB + hstepB, voffB); PG8_STAGE(PG8_SA(0, 1), cA + hA1, voffA);
    if (wr == 1) PG8_BAR;
    PG8_WAIT_V(4); PG8_BAR;
    PG8_STAGE(PG8_SB(1, 0), cB + kstep, voffB); PG8_STAGE(PG8_SA(1, 0), cA + kstep, voffA); PG8_STAGE(PG8_SB(1, 1), cB + hstepB + kstep, voffB);
    PG8_WAIT_V(6); PG8_BAR;
    for (;;) {
        const bool has_next = HALFM ? false : S.next(ui + 1, nxt);
        const char* nA = has_next ? (const char*)Ag + (size_t)nxt.pm * tstepA : cA; const char* nB = has_next ? (const char*)Btg + (size_t)nxt.pn * tstepB : cB;
        for (int t = 0; t < nt; t += 2) {
            const bool last = (t == nt - 2);
            if (MODE != EPI_MEMKV && t == nt - 4 && wid < 4) {
                const char* gsrc = wid < 2 ? (const char*)(E.st_in + 2 * ((size_t)rb + (HALFM ? 0 : wid * 128))) : (const char*)((wid == 2 ? E.v1 : E.v2) + cur.pn * BM);
                __builtin_amdgcn_global_load_lds((const unsigned*)(gsrc + lane * 16), (LAS unsigned*)(lds + LDS_X + wid * 1024), 16, 0, 0);
            }
            const char* a1 = cA + (size_t)(t + 1) * kstep;
            const char* a2 = last ? nA : cA + (size_t)(t + 2) * kstep; const char* b2 = last ? nB : cB + (size_t)(t + 2) * kstep;
            const char* a3 = a2 + kstep; const char* b3 = b2 + kstep;
            PG8_LDB(B0, 0, 0); PG8_SCHED; PG8_LDA(At, 0, 0); PG8_STAGE(PG8_SA(1, 1), a1 + hA1, voffA);
            PG8_WAIT_L(8); PG8_BAR; PG8_WAIT_L(0); PG8_MMA(0, 0, At, B0); PG8_BAR; PG8_SCHED;
            PG8_LDB(B1, 0, 1); PG8_STAGE(PG8_SB(0, 0), b2, voffB);
            PG8_BAR; PG8_WAIT_L(0); PG8_MMA(0, 1, At, B1); PG8_BAR;
            if constexpr (!HALFM) PG8_LDA(At, 0, 1); PG8_STAGE(PG8_SA(0, 0), a2, voffA);
            PG8_BAR; PG8_WAIT_L(0); if constexpr (!HALFM) PG8_MMA(1, 0, At, B0); PG8_BAR; PG8_SCHED;
            PG8_STAGE(PG8_SB(0, 1), b2 + hstepB, voffB);
            PG8_WAIT_V(6); PG8_BAR; if constexpr (!HALFM) PG8_MMA(1, 1, At, B1); PG8_BAR;
            PG8_LDB(B0, 1, 0); PG8_SCHED; PG8_LDA(At, 1, 0); PG8_STAGE(PG8_SA(0, 1), a2 + hA1, voffA);
            PG8_WAIT_L(8); PG8_BAR; PG8_WAIT_L(0); PG8_MMA(0, 0, At, B0); PG8_BAR; PG8_SCHED;
            PG8_LDB(B1, 1, 1); PG8_STAGE(PG8_SB(1, 0), b3, voffB);
            PG8_BAR; PG8_WAIT_L(0); PG8_MMA(0, 1, At, B1); PG8_BAR;
            if constexpr (!HALFM) PG8_LDA(At, 1, 1); PG8_STAGE(PG8_SA(1, 0), a3, voffA);
            PG8_BAR; PG8_WAIT_L(0); if constexpr (!HALFM) PG8_MMA(1, 0, At, B0); PG8_BAR; PG8_SCHED;
            PG8_STAGE(PG8_SB(1, 1), b3 + hstepB, voffB);
            PG8_WAIT_V(6); PG8_BAR; if constexpr (!HALFM) PG8_MMA(1, 1, At, B1); PG8_BAR;
        }
        gemm_epilogue<MODE, HALFM>(acc, cur, rb, wr, wc, fr, fq, E, lds);
        if (!has_next) break;
#pragma unroll
        for (int a = 0; a < 2; ++a)
#pragma unroll
            for (int b = 0; b < 2; ++b)
#pragma unroll
                for (int m = 0; m < 4; ++m)
#pragma unroll
                    for (int n = 0; n < 2; ++n) acc[a][b][m][n] = (f32x4){0.f, 0.f, 0.f, 0.f};
        cur = nxt; cA = nA; cB = nB; ++ui; rb = cur.pm * BM;
    }
    PG8_WAIT_V(0);
    if (wr == 0) PG8_BAR;
    PG8_BAR;
#undef PG8_SA
#undef PG8_SB
#undef PG8_STAGE
#undef PG8_LDA
#undef PG8_LDB
#undef PG8_MMA
#undef PG8_WAIT_V
#undef PG8_WAIT_L
#undef PG8_BAR
#undef PG8_SCHED
}

__device__ __forceinline__ void transpose_job(LAS unsigned char* lds, const float* src, int ld, int K, int c0, int ncols, bf16_t* dst, int rowmode, int drow0,
                                              const float* gk, const float* bk, float* c1, float* c2) {
    LAS float* tile = (LAS float*)lds;
    int tid_ = threadIdx.x; asm volatile("" : "+v"(tid_)); const int tid = tid_;
    const int nkt = K / 64, nct = ncols / 64, ntiles = nkt * nct;
    const int kr = tid >> 4, c4 = (tid & 15) * 4;
    f32x4 pv[2];
    { const int t = lbid(); if (t < ntiles) { const int k0 = (t % nkt) * 64, n0 = (t / nkt) * 64;
#pragma unroll
        for (int rr = 0; rr < 2; ++rr) pv[rr] = *(const f32x4*)(src + (size_t)(k0 + kr + 32 * rr) * ld + c0 + n0 + c4); } }
    for (int t = lbid(); t < ntiles; t += gridDim.x) {
        const int kt = t % nkt, ct = t / nkt;
        const int k0 = kt * 64, n0 = ct * 64;
#pragma unroll
        for (int rr = 0; rr < 2; ++rr) { const f32x4 v = pv[rr];
            tile[(kr + 32 * rr) * 65 + c4 + 0] = v[0]; tile[(kr + 32 * rr) * 65 + c4 + 1] = v[1]; tile[(kr + 32 * rr) * 65 + c4 + 2] = v[2]; tile[(kr + 32 * rr) * 65 + c4 + 3] = v[3]; }
        { const int tn = t + gridDim.x; if (tn < ntiles) { const int k1 = (tn % nkt) * 64, n1 = (tn / nkt) * 64;
#pragma unroll
            for (int rr = 0; rr < 2; ++rr) pv[rr] = *(const f32x4*)(src + (size_t)(k1 + kr + 32 * rr) * ld + c0 + n1 + c4); } }
        __syncthreads();
        { const int n = tid >> 3, k8 = (tid & 7) * 8; float v[8];
#pragma unroll
          for (int i = 0; i < 8; ++i) v[i] = tile[(k8 + i) * 65 + n];
          const int c = c0 + n0 + n; int drow;
          if (rowmode == 0) drow = drow0 + c; else drow = 256 * (c >> 7) + (c & 127) + (rowmode == 2 ? 128 : 0);
          u32x4 w;
          if (gk) {
              const f32x4 g0 = *(const f32x4*)(gk + k0 + k8), g1 = *(const f32x4*)(gk + k0 + k8 + 4), b0 = *(const f32x4*)(bk + k0 + k8), b1 = *(const f32x4*)(bk + k0 + k8 + 4);
              float s2 = 0.f;
#pragma unroll
              for (int i = 0; i < 4; ++i) { s2 += b0[i] * v[i] + b1[i] * v[4 + i]; v[i] *= g0[i]; v[4 + i] *= g1[i]; }
              w.x = pk2(v[0], v[1]); w.y = pk2(v[2], v[3]); w.z = pk2(v[4], v[5]); w.w = pk2(v[6], v[7]);
              float s1 = 0.f;
#pragma unroll
              for (int i = 0; i < 4; ++i) s1 += bflo(w[i]) + bfhi(w[i]);
              s1 += __shfl_xor(s1, 1); s1 += __shfl_xor(s1, 2); s1 += __shfl_xor(s1, 4);
              s2 += __shfl_xor(s2, 1); s2 += __shfl_xor(s2, 2); s2 += __shfl_xor(s2, 4);
              if ((tid & 7) == 0) { atomicAdd(c1 + drow, s1); atomicAdd(c2 + drow, s2); }
          } else { w.x = pk2(v[0], v[1]); w.y = pk2(v[2], v[3]); w.z = pk2(v[4], v[5]); w.w = pk2(v[6], v[7]); }
          *(u32x4*)(dst + (size_t)drow * K + k0 + k8) = w; }
        __syncthreads();
    }
}
__device__ __forceinline__ void convert_job(const float* src, bf16_t* dst, float* dstf, size_t n) {
    const size_t nv = n / 8, stride = (size_t)gridDim.x * NTHR;
    for (size_t i = (size_t)lbid() * NTHR + ltid(); i < nv; i += 2 * stride) {
        const size_t i2 = i + stride; const bool two = i2 < nv;
        const f32x4 a = *(const f32x4*)(src + i * 8), b = *(const f32x4*)(src + i * 8 + 4);
        f32x4 c = a, d = b; if (two) { c = *(const f32x4*)(src + i2 * 8); d = *(const f32x4*)(src + i2 * 8 + 4); }
        u32x4 w; w.x = pk2(a[0], a[1]); w.y = pk2(a[2], a[3]); w.z = pk2(b[0], b[1]); w.w = pk2(b[2], b[3]);
        *(u32x4*)(dst + i * 8) = w;
        if (dstf) { *(f32x4*)(dstf + i * 8) = a; *(f32x4*)(dstf + i * 8 + 4) = b; }
        if (two) { w.x = pk2(c[0], c[1]); w.y = pk2(c[2], c[3]); w.z = pk2(d[0], d[1]); w.w = pk2(d[2], d[3]);
            *(u32x4*)(dst + i2 * 8) = w;
            if (dstf) { *(f32x4*)(dstf + i2 * 8) = c; *(f32x4*)(dstf + i2 * 8 + 4) = d; } }
    }
}
__device__ __forceinline__ void prep_phase(LAS unsigned char* lds, const Params& p) {
    unsigned char* ws = p.ws;
    for (int jb = 0; jb < 52; ++jb) {
        const float* src; int ld, K, c0, ncols, rowmode, drow0; bf16_t* dst; int li = -1; float* cv = nullptr; int cvn = 0;
        if (jb < 24) { const int lf = jb / 3, t = jb % 3;
            if (t < 2) { src = (t == 0 ? p.in[7] : p.in[8]) + (size_t)lf * 1024 * FF; ld = FF; K = 1024; c0 = 0; ncols = FF; dst = (bf16_t*)(ws + WS_WGU) + (size_t)lf * 5632 * 1024; rowmode = 1 + t; drow0 = 0;
                if (lf > 0) { li = (lf & 1) ? 3 * (lf >> 1) + 1 : 3 * (lf >> 1) - 1; cv = (float*)(ws + WS_CV_WGU) + (size_t)lf * 2 * 5632; cvn = 5632; } }
            else { src = p.in[9] + (size_t)lf * FF * 1024; ld = 1024; K = FF; c0 = 0; ncols = 1024; dst = (bf16_t*)(ws + WS_WD) + (size_t)lf * 1024 * FF; rowmode = 0; drow0 = 0; }
        } else if (jb < 44) { const int j = (jb - 24) / 10, t = (jb - 24) % 10; rowmode = 0; K = 1024;
            if (t < 4) {
                src = p.in[12] + (size_t)j * 1024 * 4608; ld = 4608; dst = (bf16_t*)(ws + WS_HWIN) + (size_t)j * 4608 * 1024;
                c0 = t == 0 ? 0 : (t == 1 ? 3072 : (t == 2 ? 2048 : 4096)); ncols = t == 0 ? 2048 : (t == 3 ? 512 : 1024); drow0 = (t == 0 ? 0 : (t == 1 ? 2048 : (t == 2 ? 3072 : 4096))) - c0;
                li = 3 * (2 * j); cv = (float*)(ws + WS_CV_HWIN) + (size_t)j * 2 * 4608; cvn = 4608;
            } else if (t < 8) {
                src = p.in[16] + (size_t)j * 1024 * 3600; ld = 3600; dst = (bf16_t*)(ws + WS_GWIN) + (size_t)j * 4096 * 1024; const int u = t - 4;
                c0 = u == 0 ? 0 : (u == 1 ? 2048 : (u == 2 ? 1024 : 3088)); ncols = u == 3 ? 512 : 1024; drow0 = (u == 0 ? 0 : (u == 1 ? 1536 : (u == 2 ? 2560 : 3584))) - c0;
                li = 3 * (2 * j + 1); cv = (float*)(ws + WS_CV_GWIN) + (size_t)j * 2 * 4096; cvn = 4096;
            } else { src = (t == 8 ? p.in[15] : p.in[20]) + (size_t)j * 1536 * 1024; ld = 1024; K = 1536; c0 = 0; ncols = 1024; dst = (bf16_t*)(ws + WS_WOUT) + (size_t)(2 * j + (t - 8)) * 1024 * 1536; drow0 = 0; }
        } else { const int l = (jb - 44) >> 1, kv = (jb - 44) & 1; src = (kv ? p.in[22] : p.in[21]) + (size_t)l * 1024 * 512; ld = 512; K = 1024; c0 = 0; ncols = 512; dst = (bf16_t*)(ws + WS_MEMW); rowmode = 0; drow0 = l * 1024 + kv * 512; }
        const float* gk = li >= 0 ? p.in[10] + li * 1024 : nullptr; const float* bk = li >= 0 ? p.in[11] + li * 1024 : nullptr;
        transpose_job(lds, src, ld, K, c0, ncols, dst, rowmode, drow0, gk, bk, cv, cv + cvn);
    }
    for (int j = 0; j < 2; ++j) {
        const float* gs = p.in[16] + (size_t)j * 1024 * 3600; bf16_t* gd = (bf16_t*)(ws + WS_GWIN) + (size_t)j * 4096 * 1024;
        const float* w2 = p.in[17] + (size_t)j * 16 * 512;
        const int li = 3 * (2 * j + 1); const float* gk = p.in[10] + li * 1024; const float* bk = p.in[11] + li * 1024;
        float* c1 = (float*)(ws + WS_CV_GWIN) + (size_t)j * 2 * 4096; float* c2 = c1 + 4096;
        for (int i = lbid() * NTHR + ltid(); i < 512 * 1024; i += gridDim.x * NTHR) {
            const int c = i >> 10, kk = i & 1023; float sacc = 0.f;
#pragma unroll
            for (int r = 0; r < 16; ++r) sacc += gs[(size_t)kk * 3600 + 3072 + r] * w2[r * 512 + c];
            const bf16_t hv = f2bf(sacc * gk[kk]);
            gd[(size_t)(1024 + c) * 1024 + kk] = hv;
            float s1 = __uint_as_float(((unsigned)hv) << 16), s2 = sacc * bk[kk];
#pragma unroll
            for (int o = 32; o >= 1; o >>= 1) { s1 += __shfl_xor(s1, o); s2 += __shfl_xor(s2, o); }
            if ((kk & 63) == 0) { atomicAdd(c1 + 1024 + c, s1); atomicAdd(c2 + 1024 + c, s2); }
        }
    }
    { float* idst = (float*)(ws + WS_IDST);
      for (int i = lbid() * NTHR + ltid(); i < MROWS + 1024; i += gridDim.x * NTHR) {
          if (i < MROWS) *(f32x2*)(idst + 2 * (size_t)i) = (f32x2){0.f, 1024.0f * (1.0f - 1e-5f)}; else ((float*)(ws + WS_ONES))[i - MROWS] = 1.0f; } }
    for (int jb = 0; jb < 5; ++jb) {
        const float* src; bf16_t* dst; float* dstf = nullptr; size_t n;
        if (jb == 0) { src = p.in[0]; dst = (bf16_t*)(ws + WS_XN); dstf = p.out + O_Y; n = (size_t)MP * D; }
        else if (jb == 1) { src = p.in[1]; dst = (bf16_t*)(ws + WS_XN) + (size_t)MP * D; dstf = p.out + O_Y + (size_t)MP * D; n = (size_t)MS * D; }
        else if (jb == 2) { src = p.in[2]; dst = (bf16_t*)(ws + WS_MEMP); n = (size_t)2048 * 1024; }
        else if (jb == 3) { src = p.in[3]; dst = (bf16_t*)(ws + WS_CKB); n = (size_t)4 * 4096 * 512; }
        else { src = p.in[4]; dst = (bf16_t*)(ws + WS_CVB); n = (size_t)4 * 4096 * 512; }
        convert_job(src, dst, dstf, n);
    }
}

__device__ __forceinline__ void ln_phase(float* x, bf16_t* xn, const float* gain, const float* bias) {
    int tid_ = threadIdx.x; asm volatile("" : "+v"(tid_));
    const int lane = tid_ & 63, wv = tid_ >> 6;
    f32x4 g[4], b[4];
#pragma unroll
    for (int i = 0; i < 4; ++i) { g[i] = *(const f32x4*)(gain + 4 * lane + 256 * i); b[i] = *(const f32x4*)(bias + 4 * lane + 256 * i); }
    const int rstep = gridDim.x * 8;
    int row = lbid() * 8 + wv;
    f32x4 nv[4];
    if (row < MROWS) {
#pragma unroll
        for (int i = 0; i < 4; ++i) nv[i] = *(const f32x4*)(x + (size_t)row * D + 4 * lane + 256 * i); }
    for (; row < MROWS; row += rstep) {
        float* xr = x + (size_t)row * D; f32x4 v[4]; float s = 0.f;
#pragma unroll
        for (int i = 0; i < 4; ++i) { v[i] = nv[i]; s += (v[i][0] + v[i][1]) + (v[i][2] + v[i][3]); }
        if (row + rstep < MROWS) {
#pragma unroll
            for (int i = 0; i < 4; ++i) nv[i] = *(const f32x4*)(x + (size_t)(row + rstep) * D + 4 * lane + 256 * i); }
#pragma unroll
        for (int o = 32; o >= 1; o >>= 1) s += __shfl_xor(s, o);
        const float mu = s * (1.0f / 1024.0f); float q = 0.f;
#pragma unroll
        for (int i = 0; i < 4; ++i) { const f32x4 d = v[i] - mu; q += (d[0] * d[0] + d[1] * d[1]) + (d[2] * d[2] + d[3] * d[3]); }
#pragma unroll
        for (int o = 32; o >= 1; o >>= 1) q += __shfl_xor(q, o);
        const float rs = 1.0f / sqrtf(q * (1.0f / 1024.0f) + 1e-5f);
#pragma unroll
        for (int i = 0; i < 4; ++i) { const f32x4 o = (v[i] - mu) * rs * g[i] + b[i]; *(f32x4*)(xr + 4 * lane + 256 * i) = o;
            if (xn) { u32x2 w; w.x = pk2(o[0], o[1]); w.y = pk2(o[2], o[3]); *(u32x2*)(xn + (size_t)row * D + 4 * lane + 256 * i) = w; } }
    }
}

__device__ __forceinline__ void headnorm_phase(bf16_t* proj, int ld, int ocol, int gcol, int lanes_per_head  , const float* gain) {
    int tid_ = threadIdx.x; asm volatile("" : "+v"(tid_));
    const int lane = tid_ & 63, wv = tid_ >> 6;
    float gn[2][8];
#pragma unroll
    for (int hh = 0; hh < 2; ++hh)
#pragma unroll
        for (int i = 0; i < 8; ++i) gn[hh][i] = gain[hh * 512 + 8 * lane + i];
    const float invn = lanes_per_head == 16 ? (1.0f / 128.0f) : (1.0f / 256.0f);
    const int rstep = gridDim.x * 8;
    int row = lbid() * 8 + wv;
    u32x4 nov[2], ngv[2];
    if (row < MROWS) { const bf16_t* pr = proj + (size_t)row * ld;
#pragma unroll
        for (int hh = 0; hh < 2; ++hh) { nov[hh] = *(const u32x4*)(pr + ocol + hh * 512 + 8 * lane); ngv[hh] = *(const u32x4*)(pr + gcol + hh * 512 + 8 * lane); } }
    for (; row < MROWS; row += rstep) {
        bf16_t* pr = proj + (size_t)row * ld;
        u32x4 cov[2], cgv[2];
#pragma unroll
        for (int hh = 0; hh < 2; ++hh) { cov[hh] = nov[hh]; cgv[hh] = ngv[hh]; }
        if (row + rstep < MROWS) { const bf16_t* pn = proj + (size_t)(row + rstep) * ld;
#pragma unroll
            for (int hh = 0; hh < 2; ++hh) { nov[hh] = *(const u32x4*)(pn + ocol + hh * 512 + 8 * lane); ngv[hh] = *(const u32x4*)(pn + gcol + hh * 512 + 8 * lane); } }
#pragma unroll
        for (int hh = 0; hh < 2; ++hh) {
            const u32x4 ov = cov[hh], gv = cgv[hh];
            float o[8], g[8];
#pragma unroll
            for (int i = 0; i < 4; ++i) { o[2 * i] = bflo(ov[i]); o[2 * i + 1] = bfhi(ov[i]); g[2 * i] = bflo(gv[i]); g[2 * i + 1] = bfhi(gv[i]); }
            float s = 0.f;
#pragma unroll
            for (int i = 0; i < 8; ++i) s += o[i] * o[i];
            s += __shfl_xor(s, 1); s += __shfl_xor(s, 2); s += __shfl_xor(s, 4); s += __shfl_xor(s, 8);
            if (lanes_per_head == 32) s += __shfl_xor(s, 16);
            const float rs = __builtin_amdgcn_rsqf(s * invn + 1e-6f);
            float r[8];
#pragma unroll
            for (int i = 0; i < 8; ++i) r[i] = o[i] * rs * gn[hh][i] * g[i] * sigmoidf_(g[i]);
            u32x4 w; w.x = pk2(r[0], r[1]); w.y = pk2(r[2], r[3]); w.z = pk2(r[4], r[5]); w.w = pk2(r[6], r[7]);
            *(u32x4*)(pr + ocol + hh * 512 + 8 * lane) = w;
        }
    }
}

constexpr int MP_G = 0, MP_T = 32768, MP_KTT = 34816, MP_QT = MP_KTT + 128 * 72 * 2, MP_KT = MP_QT + 64 * 136 * 2, MP_END = MP_KT + 64 * 136 * 2;
static_assert(MP_END <= 131072, "prepass LDS");

__device__ __forceinline__ void mixprep_loop(LAS unsigned char* lds, bf16_t* proj, int ld, int qcol, int kcol, int gcol, int gla, const float* lb0, const float* lb1, int lbj, const float* bgate,
                                             bf16_t* ktb_h, int nh, float* vec_h, int ci0, int cstep) {
    int tid_ = threadIdx.x; asm volatile("" : "+v"(tid_));
    const int tid = tid_, wid = __builtin_amdgcn_readfirstlane(tid >> 6), lane = tid & 63, fr = lane & 15, fq = lane >> 4;
    LAS float* G = (LAS float*)(lds + MP_G); LAS float* T = (LAS float*)(lds + MP_T); LAS bf16_t* KTT = (LAS bf16_t*)(lds + MP_KTT);
    LAS bf16_t* QT = (LAS bf16_t*)(lds + MP_QT); LAS bf16_t* KT = (LAS bf16_t*)(lds + MP_KT);
    const int t0 = tid >> 4, cv = tid & 15, c8 = cv * 8;
    float cA[8], cB[8];
#pragma unroll
    for (int i = 0; i < 8; ++i) {
        if (gla) { cA[i] = bgate[c8 + i]; cB[i] = 0.f; }
        else { float lb = 0.f; if (lbj == 1) lb = sigmoidf_(lb1[c8 + i] - lb0[c8 + i]); cA[i] = lb; cB[i] = 1.0f - lb; }
    }
    const float qscale = 0.08838834764831845f;
    u32x4 rq[2], rk[2], rg[2];
    rg[0] = rg[1] = (u32x4){0u, 0u, 0u, 0u};
    auto issue_loads = [&](int ci) {
        const bf16_t* base = proj + (size_t)ci * 64 * ld;
#pragma unroll
        for (int rr = 0; rr < 2; ++rr) { const bf16_t* rp = base + (size_t)(t0 + 32 * rr) * ld + c8; rq[rr] = *(const u32x4*)(rp + qcol); rk[rr] = *(const u32x4*)(rp + kcol); if (gla) rg[rr] = *(const u32x4*)(rp + gcol); }
    };
    if (ci0 < NCHUNK) issue_loads(ci0);
    for (int ci = ci0; ci < NCHUNK; ci += cstep) {
        bf16_t* base = proj + (size_t)ci * 64 * ld;
        float qv[2][8], kv[2][8], gvv[2][8];
        constexpr float L2E = 1.4426950408889634f, CLAMP2 = 80.0f * 1.4426950408889634f;
        if (gla) {
#pragma unroll
            for (int rr = 0; rr < 2; ++rr)
#pragma unroll
                for (int i = 0; i < 8; ++i) {
                    const unsigned uq = rq[rr][i >> 1], uk = rk[rr][i >> 1], ug = rg[rr][i >> 1];
                    const float q = (i & 1) ? bfhi(uq) : bflo(uq), k = (i & 1) ? bfhi(uk) : bflo(uk);
                    const float g = ((i & 1) ? bfhi(ug) : bflo(ug)) + cA[i];
                    qv[rr][i] = q * qscale; kv[rr][i] = k;
                    gvv[rr][i] = (L2E * fminf(g, 0.f) - __builtin_amdgcn_logf(1.0f + __builtin_amdgcn_exp2f(-L2E * fabsf(g)))) * (1.0f / 16.0f);
                }
        } else {
#pragma unroll
            for (int rr = 0; rr < 2; ++rr)
#pragma unroll
                for (int i = 0; i < 8; ++i) {
                    const unsigned uq = rq[rr][i >> 1], uk = rk[rr][i >> 1];
                    const float q = (i & 1) ? bfhi(uq) : bflo(uq), k = (i & 1) ? bfhi(uk) : bflo(uk);
                    qv[rr][i] = q * qscale * __builtin_amdgcn_rcpf(1.0f + __builtin_amdgcn_exp2f(-L2E * q));
                    const float e = __builtin_amdgcn_exp2f(-L2E * k), r = __builtin_amdgcn_rcpf(1.0f + e);
                    kv[rr][i] = cB[i] * e * r;
                    gvv[rr][i] = __builtin_amdgcn_logf(fmaxf(cA[i] + cB[i] * r, 1e-6f));
                }
        }
#pragma unroll
        for (int rr = 0; rr < 2; ++rr) {
            LAS float* gp = G + (t0 + 32 * rr) * 128 + c8;
            *(LAS f32x4*)gp = (f32x4){gvv[rr][0], gvv[rr][1], gvv[rr][2], gvv[rr][3]}; *(LAS f32x4*)(gp + 4) = (f32x4){gvv[rr][4], gvv[rr][5], gvv[rr][6], gvv[rr][7]};
        }
        if (ci + cstep < NCHUNK) issue_loads(ci + cstep);
        __syncthreads();
        { const int k = tid & 127, sg = tid >> 7; float run = 0.f;
#pragma unroll
          for (int i = 0; i < 16; ++i) { run += G[(16 * sg + i) * 128 + k]; G[(16 * sg + i) * 128 + k] = run; }
          T[sg * 128 + k] = run; }
        __syncthreads();
        {
            float tA[8], tB[8], tC[8], bmid[8], blast[8];
            { const f32x4 x0 = *(const LAS f32x4*)(T + c8), x1 = *(const LAS f32x4*)(T + c8 + 4), y0 = *(const LAS f32x4*)(T + 128 + c8), y1 = *(const LAS f32x4*)(T + 128 + c8 + 4),
                  z0 = *(const LAS f32x4*)(T + 256 + c8), z1 = *(const LAS f32x4*)(T + 256 + c8 + 4);
              const f32x4 m0 = *(const LAS f32x4*)(G + 31 * 128 + c8), m1 = *(const LAS f32x4*)(G + 31 * 128 + c8 + 4), l0 = *(const LAS f32x4*)(G + 63 * 128 + c8), l1 = *(const LAS f32x4*)(G + 63 * 128 + c8 + 4);
#pragma unroll
              for (int i = 0; i < 4; ++i) { tA[i] = x0[i]; tA[4 + i] = x1[i]; tB[i] = x0[i] + y0[i]; tB[4 + i] = x1[i] + y1[i]; tC[i] = tB[i] + z0[i]; tC[4 + i] = tB[4 + i] + z1[i];
                  bmid[i] = m0[i] + tA[i]; bmid[4 + i] = m1[i] + tA[4 + i]; blast[i] = l0[i] + tC[i]; blast[4 + i] = l1[i] + tC[4 + i]; } }
#pragma unroll
            for (int rr = 0; rr < 2; ++rr) {
                const int t = t0 + 32 * rr; const bool hi16 = t0 >= 16;
                const f32x4 g0 = *(const LAS f32x4*)(G + t * 128 + c8), g1 = *(const LAS f32x4*)(G + t * 128 + c8 + 4);
                float qt[8], kt[8];
#pragma unroll
                for (int i = 0; i < 8; ++i) {
                    const float off = rr == 0 ? (hi16 ? tA[i] : 0.f) : (hi16 ? tC[i] : tB[i]);
                    const float b = (i < 4 ? g0[i & 3] : g1[i & 3]) + off;
                    qt[i] = qv[rr][i] * __builtin_amdgcn_exp2f(fminf(b - bmid[i], CLAMP2));
                    kt[i] = kv[rr][i] * __builtin_amdgcn_exp2f(fminf(bmid[i] - b, CLAMP2));
                }
                bf16_t* rp = base + (size_t)t * ld + c8;
                u32x4 w;
                w.x = pk2(qt[0], qt[1]); w.y = pk2(qt[2], qt[3]); w.z = pk2(qt[4], qt[5]); w.w = pk2(qt[6], qt[7]); *(u32x4*)(rp + qcol) = w; *(LAS u32x4*)(QT + t * 136 + c8) = w;
                w.x = pk2(kt[0], kt[1]); w.y = pk2(kt[2], kt[3]); w.z = pk2(kt[4], kt[5]); w.w = pk2(kt[6], kt[7]); *(LAS u32x4*)(KT + t * 136 + c8) = w;
#pragma unroll
                for (int i = 0; i < 4; ++i) { KTT[(c8 + 2 * i) * 72 + t] = (bf16_t)(w[i] & 0xffffu); KTT[(c8 + 2 * i + 1) * 72 + t] = (bf16_t)(w[i] >> 16); }
            }
            if (t0 == 0) {
                float* em = vec_h + (size_t)ci * 1024; float* el = em + (size_t)NCHUNK * 1024; float* elm = el + (size_t)NCHUNK * 1024;
                f32x4 v0, v1;
#pragma unroll
                for (int i = 0; i < 4; ++i) { v0[i] = __builtin_amdgcn_exp2f(bmid[i]); v1[i] = __builtin_amdgcn_exp2f(bmid[4 + i]); }
                *(f32x4*)(em + c8) = v0; *(f32x4*)(em + c8 + 4) = v1;
#pragma unroll
                for (int i = 0; i < 4; ++i) { v0[i] = __builtin_amdgcn_exp2f(blast[i]); v1[i] = __builtin_amdgcn_exp2f(blast[4 + i]); }
                *(f32x4*)(el + c8) = v0; *(f32x4*)(el + c8 + 4) = v1;
#pragma unroll
                for (int i = 0; i < 4; ++i) { v0[i] = __builtin_amdgcn_exp2f(blast[i] - bmid[i]); v1[i] = __builtin_amdgcn_exp2f(blast[4 + i] - bmid[4 + i]); }
                *(f32x4*)(elm + c8) = v0; *(f32x4*)(elm + c8 + 4) = v1;
            }
        }
        __syncthreads();
        { const int k = tid >> 2, j = tid & 3; bf16_t* ktb = ktb_h + (size_t)ci * nh * 8192;
          const u32x4 w0 = *(const LAS u32x4*)(KTT + k * 72 + 16 * j), w1 = *(const LAS u32x4*)(KTT + k * 72 + 16 * j + 8);
          *(u32x4*)(ktb + k * 64 + 16 * j) = w0; *(u32x4*)(ktb + k * 64 + 16 * j + 8) = w1; }
        { const int ti = wid >> 1;
#pragma unroll
          for (int sh = 0; sh < 2; ++sh) { const int si = 2 * (wid & 1) + sh; f32x4 pa = {0.f, 0.f, 0.f, 0.f};
              if (si <= ti) {
#pragma unroll
                  for (int kk = 0; kk < 4; ++kk) { const bf16x8 A = *(const LAS bf16x8*)(KT + (16 * si + fr) * 136 + 32 * kk + 8 * fq), B = *(const LAS bf16x8*)(QT + (16 * ti + fr) * 136 + 32 * kk + 8 * fq); pa = MFMA16(A, B, pa); }
                  if (si == ti) {
#pragma unroll
                      for (int j = 0; j < 4; ++j) if (4 * fq + j > fr) pa[j] = 0.f; }
              }
              u32x2 w; w.x = pk2(pa[0], pa[1]); w.y = pk2(pa[2], pa[3]); *(u32x2*)(base + (size_t)(16 * ti + fr) * ld + kcol + 16 * si + 4 * fq) = w; } }
    }
    __syncthreads();
}

constexpr int MXB = 49664, MXB_QT = 0, MXB_KTT = 17408, MXB_VT = 35840, MXB_PP = 40448, MX_ST = 2 * MXB, MX_END = MX_ST + 2 * 8704;
static_assert(MX_END <= LDS_ST_OFF, "mixer LDS");

struct ChainArgs {
    bf16_t* proj; int ld; size_t row0; int nchunks;
    int qcol, kcol, vcol;
    const bf16_t* ktb;
    size_t ktb_stride;
    const float* em; const float* el; const float* elm; int vec_stride;
    const float* s0; float* sout; int sstride;
};

__device__ __forceinline__ void mixer_chain(LAS unsigned char* lds, const ChainArgs& a) {
    int tid_ = threadIdx.x; asm volatile("" : "+v"(tid_));
    const int tid = tid_, wid = __builtin_amdgcn_readfirstlane(tid >> 6), lane = tid & 63, fr = lane & 15, fq = lane >> 4;
    const int t0 = tid >> 4, c8 = (tid & 15) * 8;
    f32x4 Sacc[2];
#pragma unroll
    for (int vi = 0; vi < 2; ++vi)
#pragma unroll
        for (int j = 0; j < 4; ++j) Sacc[vi][j] = a.s0 ? a.s0[(size_t)(16 * wid + 4 * fq + j) * a.sstride + 16 * vi + fr] : 0.f;
    struct Regs { u32x4 rq[2], rkt[2], rp, rv; f32x4 vem, vel, velm; };
    Regs R0, R1;
    R0.rv = (u32x4){0u, 0u, 0u, 0u}; R1.rv = (u32x4){0u, 0u, 0u, 0u};
    auto issue_loads = [&](Regs& R, int c) {
        const bf16_t* base = a.proj + (a.row0 + (size_t)c * 64) * a.ld;
#pragma unroll
        for (int rr = 0; rr < 2; ++rr) R.rq[rr] = *(const u32x4*)(base + (size_t)(t0 + 32 * rr) * a.ld + c8 + a.qcol);
        R.rp = *(const u32x4*)(base + (size_t)(tid >> 3) * a.ld + a.kcol + 8 * (tid & 7));
        const bf16_t* kp = a.ktb + (size_t)c * a.ktb_stride + (tid >> 2) * 64 + 16 * (tid & 3);
        R.rkt[0] = *(const u32x4*)kp; R.rkt[1] = *(const u32x4*)(kp + 8);
        if (tid < 256) R.rv = *(const u32x4*)(base + (size_t)(tid >> 2) * a.ld + a.vcol + 8 * (tid & 3));
        const size_t vo = (size_t)c * a.vec_stride + 16 * wid + 4 * fq;
        R.vem = *(const f32x4*)(a.em + vo); R.vel = *(const f32x4*)(a.el + vo); R.velm = *(const f32x4*)(a.elm + vo);
    };
    f32x4 cel, celm;
    auto fill = [&](int b, const Regs& R) {
        LAS bf16_t* QT = (LAS bf16_t*)(lds + b * MXB + MXB_QT); LAS bf16_t* KTT = (LAS bf16_t*)(lds + b * MXB + MXB_KTT);
        LAS bf16_t* VT = (LAS bf16_t*)(lds + b * MXB + MXB_VT); LAS bf16_t* PP = (LAS bf16_t*)(lds + b * MXB + MXB_PP); LAS bf16_t* ST = (LAS bf16_t*)(lds + MX_ST + b * 8704);
#pragma unroll
        for (int rr = 0; rr < 2; ++rr) *(LAS u32x4*)(QT + (t0 + 32 * rr) * 136 + c8) = R.rq[rr];
        *(LAS u32x4*)(PP + (tid >> 3) * 72 + 8 * (tid & 7)) = R.rp;
        { LAS bf16_t* kp = KTT + (tid >> 2) * 72 + 16 * (tid & 3); *(LAS u32x4*)kp = R.rkt[0]; *(LAS u32x4*)(kp + 8) = R.rkt[1]; }
        if (tid < 256) { const int tv = tid >> 2, v8 = (tid & 3) * 8;
#pragma unroll
            for (int i = 0; i < 8; ++i) VT[(v8 + i) * 72 + tv] = (bf16_t)((i & 1) ? (R.rv[i >> 1] >> 16) : (R.rv[i >> 1] & 0xffffu)); }
#pragma unroll
        for (int vi = 0; vi < 2; ++vi) { u32x2 w; w.x = pk2(Sacc[vi][0] * R.vem[0], Sacc[vi][1] * R.vem[1]); w.y = pk2(Sacc[vi][2] * R.vem[2], Sacc[vi][3] * R.vem[3]); *(LAS u32x2*)(ST + (16 * vi + fr) * 136 + 16 * wid + 4 * fq) = w; }
        cel = R.vel; celm = R.velm;
    };
    auto compute = [&](int b, int c) {
        const LAS bf16_t* QT = (const LAS bf16_t*)(lds + b * MXB + MXB_QT); const LAS bf16_t* KTT = (const LAS bf16_t*)(lds + b * MXB + MXB_KTT);
        const LAS bf16_t* VT = (const LAS bf16_t*)(lds + b * MXB + MXB_VT); const LAS bf16_t* PP = (const LAS bf16_t*)(lds + b * MXB + MXB_PP); const LAS bf16_t* ST = (const LAS bf16_t*)(lds + MX_ST + b * 8704);
        { const int ti = wid >> 1, vi = wid & 1; f32x4 o = {0.f, 0.f, 0.f, 0.f};
#pragma unroll
          for (int kk = 0; kk < 2; ++kk) { const bf16x8 A = *(const LAS bf16x8*)(VT + (16 * vi + fr) * 72 + 32 * kk + 8 * fq), B = *(const LAS bf16x8*)(PP + (16 * ti + fr) * 72 + 32 * kk + 8 * fq); o = MFMA16(A, B, o); }
#pragma unroll
          for (int kk = 0; kk < 4; ++kk) { const bf16x8 A = *(const LAS bf16x8*)(ST + (16 * vi + fr) * 136 + 32 * kk + 8 * fq), B = *(const LAS bf16x8*)(QT + (16 * ti + fr) * 136 + 32 * kk + 8 * fq); o = MFMA16(A, B, o); }
          u32x2 w; w.x = pk2(o[0], o[1]); w.y = pk2(o[2], o[3]);
          *(u32x2*)(a.proj + (a.row0 + (size_t)c * 64 + 16 * ti + fr) * a.ld + a.vcol + 16 * vi + 4 * fq) = w; }
#pragma unroll
        for (int vi = 0; vi < 2; ++vi) { f32x4 u = {0.f, 0.f, 0.f, 0.f};
#pragma unroll
            for (int kk = 0; kk < 2; ++kk) { const bf16x8 A = *(const LAS bf16x8*)(KTT + (16 * wid + fr) * 72 + 32 * kk + 8 * fq), B = *(const LAS bf16x8*)(VT + (16 * vi + fr) * 72 + 32 * kk + 8 * fq); u = MFMA16(A, B, u); }
            Sacc[vi] = Sacc[vi] * cel + u * celm; }
    };
    const int n = a.nchunks;
    issue_loads(R0, 0);
    if (n > 1) issue_loads(R1, 1);
    fill(0, R0);
    if (n > 2) issue_loads(R0, 2);
    for (int c = 0; c < n; c += 2) {
        __syncthreads();
        compute(0, c);
        if (c + 1 < n) { fill(1, R1); if (c + 3 < n) issue_loads(R1, c + 3); }
        if (c + 1 < n) {
            __syncthreads();
            compute(1, c + 1);
            if (c + 2 < n) { fill(0, R0); if (c + 4 < n) issue_loads(R0, c + 4); }
        }
    }
#pragma unroll
    for (int vi = 0; vi < 2; ++vi)
#pragma unroll
        for (int j = 0; j < 4; ++j) a.sout[(size_t)(16 * wid + 4 * fq + j) * a.sstride + 16 * vi + fr] = Sacc[vi][j];
    __syncthreads();
}

constexpr int AT_PITCH = 264, AT_KOFF = 128 * AT_PITCH * 2, AT_KP = 136;
static_assert(AT_KOFF + 256 * AT_KP * 2 <= LDS_ST_OFF, "attention LDS");
__device__ __forceinline__ void mem_attn(LAS unsigned char* lds, const bf16_t* Kb, const bf16_t* Vb, bf16_t* Q, int ld, int nrows) {
    int tid_ = threadIdx.x; asm volatile("" : "+v"(tid_));
    const int tid = tid_, wid = __builtin_amdgcn_readfirstlane(tid >> 6), lane = tid & 63, fr = lane & 15, fq = lane >> 4;
    LAS bf16_t* VT = (LAS bf16_t*)lds;
    LAS bf16_t* KS = (LAS bf16_t*)(lds + AT_KOFF);
#pragma unroll
    for (int it = 0; it < 8; ++it) { const int idx = tid + NTHR * it, key = idx >> 4, v8 = (idx & 15) * 8; const u32x4 v = *(const u32x4*)(Vb + (size_t)key * 512 + v8), kx = *(const u32x4*)(Kb + (size_t)key * 512 + v8);
        *(LAS u32x4*)(KS + key * AT_KP + v8) = kx;
#pragma unroll
        for (int i = 0; i < 8; ++i) VT[(v8 + i) * AT_PITCH + key] = (bf16_t)((i & 1) ? (v[i >> 1] >> 16) : (v[i >> 1] & 0xffffu)); }
    __syncthreads();
    const float sc2 = 0.08838834764831845f * 1.4426950408889634f;
    for (int q0 = wid * 16; q0 < nrows; q0 += 128) {
        bf16x8 Qf0, Qf1, Qf2, Qf3;
        { const bf16_t* qp = Q + (size_t)(q0 + fr) * ld + 8 * fq; Qf0 = *(const bf16x8*)(qp); Qf1 = *(const bf16x8*)(qp + 32); Qf2 = *(const bf16x8*)(qp + 64); Qf3 = *(const bf16x8*)(qp + 96); }
        f32x4 s[16];
#pragma unroll
        for (int a = 0; a < 16; ++a) {
            const LAS bf16_t* kp = KS + (16 * a + fr) * AT_KP + 8 * fq;
            f32x4 t = {0.f, 0.f, 0.f, 0.f};
            t = MFMA16(*(const LAS bf16x8*)(kp), Qf0, t); t = MFMA16(*(const LAS bf16x8*)(kp + 32), Qf1, t); t = MFMA16(*(const LAS bf16x8*)(kp + 64), Qf2, t); t = MFMA16(*(const LAS bf16x8*)(kp + 96), Qf3, t);
            s[a] = t;
            if ((a & 3) == 3) asm volatile("" ::: "memory");
        }
        float mx = -3.0e38f;
#pragma unroll
        for (int a = 0; a < 16; ++a) mx = fmaxf(fmaxf(mx, fmaxf(s[a][0], s[a][1])), fmaxf(s[a][2], s[a][3]));
        mx = fmaxf(mx, __shfl_xor(mx, 16)); mx = fmaxf(mx, __shfl_xor(mx, 32));
        float sum = 0.f; u32x2 pk[16];
#pragma unroll
        for (int a = 0; a < 16; ++a) { const float e0 = __builtin_amdgcn_exp2f((s[a][0] - mx) * sc2), e1 = __builtin_amdgcn_exp2f((s[a][1] - mx) * sc2), e2 = __builtin_amdgcn_exp2f((s[a][2] - mx) * sc2), e3 = __builtin_amdgcn_exp2f((s[a][3] - mx) * sc2);
            sum += (e0 + e1) + (e2 + e3); pk[a].x = pk2(e0, e1); pk[a].y = pk2(e2, e3); }
        sum += __shfl_xor(sum, 16); sum += __shfl_xor(sum, 32);
        const float inv = 1.0f / sum;
        f32x4 o[8];
#pragma unroll
        for (int dt = 0; dt < 8; ++dt) o[dt] = (f32x4){0.f, 0.f, 0.f, 0.f};
#pragma unroll
        for (int ap = 0; ap < 8; ++ap) {
            const u32x4 bv = {pk[2 * ap].x, pk[2 * ap].y, pk[2 * ap + 1].x, pk[2 * ap + 1].y};
            const bf16x8 B = __builtin_bit_cast(bf16x8, bv);
#pragma unroll
            for (int dt = 0; dt < 8; ++dt) {
                const u32x2 lo = *(const LAS u32x2*)(VT + (16 * dt + fr) * AT_PITCH + 32 * ap + 4 * fq), hi = *(const LAS u32x2*)(VT + (16 * dt + fr) * AT_PITCH + 32 * ap + 16 + 4 * fq);
                const u32x4 av = {lo.x, lo.y, hi.x, hi.y};
                o[dt] = MFMA16(__builtin_bit_cast(bf16x8, av), B, o[dt]);
            }
        }
#pragma unroll
        for (int dt = 0; dt < 8; ++dt) { u32x2 w; w.x = pk2(o[dt][0] * inv, o[dt][1] * inv); w.y = pk2(o[dt][2] * inv, o[dt][3] * inv);
            *(u32x2*)(Q + (size_t)(q0 + fr) * ld + 16 * dt + 4 * fq) = w; }
    }
    __syncthreads();
}

__device__ __forceinline__ void mixprep_phase(LAS unsigned char* lds, const Params& p, int layer) {
    const int j = layer >> 1, gla = layer & 1, w = lbid(), G = gridDim.x;
    bf16_t* proj = (bf16_t*)(p.ws + WS_PROJ);
    const int ld = gla ? GL_LD : HG_LD, nh = gla ? 4 : 8;
    bf16_t* ktb = (bf16_t*)(p.ws + WS_XN);
    float* vec = (float*)(p.ws + WS_VEC);
    const int xq = gla ? 3584 : 4096;
    for (int it = w; it < 256 + 64; it += G) {
        const bf16_t* Kb; const bf16_t* Vb; bf16_t* Qp; int nrows;
        if (it < 256) { const int bh = it >> 3, grp = it & 7, b = bh >> 2, h = bh & 3;
            Kb = (const bf16_t*)(p.ws + WS_MKB) + ((size_t)layer * 2048 + b * 256) * 512 + h * 128;
            Vb = (const bf16_t*)(p.ws + WS_MVB) + ((size_t)layer * 2048 + b * 256) * 512 + h * 128;
            Qp = proj + ((size_t)b * 8192 + grp * 1024) * ld + xq + h * 128; nrows = 1024;
        } else { const int bh = it - 256, b = bh >> 2, h = bh & 3;
            Kb = (const bf16_t*)(p.ws + WS_CKB) + ((size_t)layer * 4096 + b * 256) * 512 + h * 128;
            Vb = (const bf16_t*)(p.ws + WS_CVB) + ((size_t)layer * 4096 + b * 256) * 512 + h * 128;
            Qp = proj + ((size_t)MP + b * 64) * ld + xq + h * 128; nrows = 64;
        }
        mem_attn(lds, Kb, Vb, Qp, ld, nrows);
    }
    { const int h = w % nh;
      mixprep_loop(lds, proj, ld, h * 128, (gla ? 512 : 1024) + h * 128, gla ? 1024 + h * 128 : 0, gla,
                   gla ? nullptr : p.in[13] + h * 128, gla ? nullptr : p.in[13] + 1024 + h * 128, j, gla ? p.in[18] + j * 512 + h * 128 : nullptr,
                   ktb + (size_t)h * 8192, nh, vec + h * 128, w / nh, G / nh); }
}
__device__ __forceinline__ void chain_phase(LAS unsigned char* lds, const Params& p, int layer) {
    const int j = layer >> 1, gla = layer & 1, w = lbid(), G = gridDim.x;
    bf16_t* proj = (bf16_t*)(p.ws + WS_PROJ);
    const int ld = gla ? GL_LD : HG_LD;
    const int nvs = gla ? 8 : 4, nh = gla ? 4 : 8, vdim = gla ? 256 : 128;
    const bf16_t* ktb = (const bf16_t*)(p.ws + WS_XN);
    const float* vec = (const float*)(p.ws + WS_VEC);
    const int n_prompt = 8 * nh * nvs  , n_sample = 16 * nh * nvs  ;
    for (int it = w; it < n_prompt + n_sample; it += G) {
        const bool smp = it >= n_prompt; const int id = smp ? it - n_prompt : it;
        const int lo = id & 7, rest = id >> 3, vs = rest % nvs, hi = rest / nvs, bh = lo + 8 * hi, b = bh / nh, h = bh % nh;
        ChainArgs a;
        a.proj = proj; a.ld = ld;
        a.row0 = smp ? (size_t)MP + (size_t)b * 64 : (size_t)b * 8192; a.nchunks = smp ? 1 : 128;
        const int ci0 = smp ? 1024 + b : b * 128;
        if (gla) { a.qcol = h * 128; a.kcol = 512 + h * 128; a.vcol = 2560 + h * 256 + 32 * vs; }
        else { a.qcol = h * 128; a.kcol = 1024 + h * 128; a.vcol = 3072 + h * 128 + 32 * vs; }
        a.ktb = ktb + ((size_t)ci0 * nh + h) * 8192; a.ktb_stride = (size_t)nh * 8192;
        a.em = vec + (size_t)ci0 * 1024 + h * 128; a.el = a.em + (size_t)NCHUNK * 1024; a.elm = a.el + (size_t)NCHUNK * 1024; a.vec_stride = 1024;
        const size_t per_b = (size_t)nh * 128 * vdim, so = ((size_t)b * nh + h) * 128 * vdim + 32 * vs;
        if (smp) { a.s0 = (gla ? p.in[6] : p.in[5]) + (size_t)j * 16 * per_b + so; a.sout = p.out + (gla ? O_SGS : O_SHS) + (size_t)j * 16 * per_b + so; }
        else { a.s0 = nullptr; a.sout = p.out + (gla ? O_SGP : O_SHP) + (size_t)j * 8 * per_b + so; }
        a.sstride = vdim;
        mixer_chain(lds, a);
    }
}

#define XB_TMO      128
#define XB_XCNT(j)  (256  + 64 * (j))
#define XB_XSUB(j)  (1280 + 64 * (j))
#define XB_XGEN(j)  (2304 + 64 * (j))
#define XB_TOP      3328
#define XB_TOPGEN   3392
#define XCD_BAR_WORDS 3456
#define XB_SPIN_CAP (1u << 22)
__device__ __forceinline__ unsigned xb_ld(unsigned* p)              { return __hip_atomic_load(p, __ATOMIC_RELAXED, __HIP_MEMORY_SCOPE_AGENT); }
__device__ __forceinline__ unsigned xb_add(unsigned* p, unsigned v) { return __hip_atomic_fetch_add(p, v, __ATOMIC_RELAXED, __HIP_MEMORY_SCOPE_AGENT); }
__device__ __forceinline__ unsigned xb_xcc_id() { return (unsigned)__builtin_amdgcn_s_getreg((3 << 11) | 20) & 0xFu; }
#define XB_SPIN(cond, bar) do { unsigned _sp = 0; while (cond) { __builtin_amdgcn_s_sleep(1); \
    if ((++_sp & 255u) == 0u) { if (xb_ld(&(bar)[XB_TMO])) break; if (_sp > XB_SPIN_CAP) { atomicAdd(&(bar)[XB_TMO], 1u); break; } } } } while (0)
struct XcdBarrier { unsigned* bar; unsigned x; volatile LAS unsigned* st; };
__device__ __forceinline__ XcdBarrier xcd_barrier_post(unsigned* bar, volatile LAS unsigned* st) {
    XcdBarrier b; b.bar = bar; b.x = xb_xcc_id(); b.st = st;
    if (threadIdx.x == 0) (void)xb_add(&bar[XB_XCNT(b.x)], 1u);
    return b;
}
__device__ __forceinline__ void xcd_barrier_complete(unsigned* bar, unsigned x, unsigned& nloc, unsigned& nx) {
    const unsigned G = gridDim.x * gridDim.y * gridDim.z;
    unsigned sum, cnt, mine, sp = 0u;
    for (;;) {
        sum = 0u; cnt = 0u; mine = 0u;
#pragma unroll
        for (unsigned j = 0; j < 16; ++j) { const unsigned c = xb_ld(&bar[XB_XCNT(j)]); sum += c; cnt += (c > 0u) ? 1u : 0u; mine = (j == x) ? c : mine; }
        if (sum == G) break;
        __builtin_amdgcn_s_sleep(1);
        if ((++sp & 255u) == 0u) { if (xb_ld(&bar[XB_TMO])) break; if (sp > XB_SPIN_CAP) { atomicAdd(&bar[XB_TMO], 1u); break; } }
    }
    nloc = mine > 0u ? mine : 1u; nx = cnt > 0u ? cnt : 1u;
}
__device__ __forceinline__ void xcd_barrier(const XcdBarrier& b) {
    asm volatile("s_waitcnt vmcnt(0)" ::: "memory");
    __syncthreads();
    if (threadIdx.x == 0) {
        unsigned* bar = b.bar;
        __builtin_amdgcn_s_waitcnt(0);
        unsigned nloc = b.st[0], nx = b.st[1];
        if (nloc == 0u) { xcd_barrier_complete(bar, b.x, nloc, nx); b.st[0] = nloc; b.st[1] = nx; }
        const unsigned old = xb_add(&bar[XB_XSUB(b.x)], 1u);
        const unsigned gen = old / nloc;
        if (old + 1u == (gen + 1u) * nloc) {
            __builtin_amdgcn_fence(__ATOMIC_RELEASE, "agent");
            asm volatile("s_waitcnt vmcnt(0)" ::: "memory");
            const unsigned og = xb_add(&bar[XB_TOP], 1u);
            const unsigned tg = og / nx;
            if (og + 1u == (tg + 1u) * nx) xb_add(&bar[XB_TOPGEN], 1u);
            else XB_SPIN(xb_ld(&bar[XB_TOPGEN]) == tg, bar);
            __builtin_amdgcn_fence(__ATOMIC_ACQUIRE, "agent");
            xb_add(&bar[XB_XGEN(b.x)], 1u);
            asm volatile("s_waitcnt vmcnt(0)" ::: "memory");
        } else {
            XB_SPIN(xb_ld(&bar[XB_XGEN(b.x)]) == gen, bar);
            __builtin_amdgcn_fence(__ATOMIC_ACQUIRE, "agent");
            asm volatile("s_waitcnt vmcnt(0)" ::: "memory");
        }
    }
    __syncthreads();
}

constexpr int PPL = 9;
constexpr int NPHASE = 2 + 4 * PPL + 1;
#define WSB(off) ((bf16_t*)(p.ws + (off)))
#define STATS(li) ((float*)(p.ws + WS_STATS) + (size_t)(li) * MROWS * 2)
__global__ void __launch_bounds__(NTHR, 2) trunk_fwd(Params p) {
    extern __shared__ __attribute__((aligned(16))) unsigned char lds_raw[];
    LAS unsigned char* lds = (LAS unsigned char*)lds_raw;
    if (p.ph_hi - p.ph_lo > 1) {
        if (threadIdx.x < 4) ((LAS unsigned*)(lds + LDS_ST_OFF))[threadIdx.x] = 0u;
        __syncthreads();
        (void)xcd_barrier_post((unsigned*)(p.ws + WS_BAR), (volatile LAS unsigned*)(lds + LDS_ST_OFF));
    }
    for (int ph = p.ph_lo; ph < p.ph_hi; ++ph) {
        if (ph == 0) prep_phase(lds, p);
        else if (ph == 1) { }
        else if (false) { Epi E{EPI_MEMKV, nullptr, 0, nullptr, 0.f, p.out + O_MK, p.out + O_MV, WSB(WS_MKB), WSB(WS_MVB), nullptr, nullptr, nullptr, nullptr, nullptr};
            gemm_phase<EPI_MEMKV>(lds, WSB(WS_MEMP), 1024, WSB(WS_MEMW), 2048, 4096, 1024, E); }
        else if (ph == NPHASE - 1) ln_phase(p.out + O_Y, nullptr, p.in[10] + 11 * 1024, p.in[11] + 11 * 1024);
        else {
            const int layer = (ph - 2) / PPL, s = (ph - 2) % PPL, gla = layer & 1, j = layer >> 1;
            if (s == 0 || s == 7) {
                const int lf = layer * 2 + (s == 7), li = (s == 7) ? 3 * layer + 1 : 3 * layer - 1;
                const float* cv = (const float*)(p.ws + WS_CV_WGU) + (size_t)lf * 2 * 5632;
                Epi E{EPI_SWIGLU, WSB(WS_PROJ), FF, nullptr, 0.f, nullptr, nullptr, nullptr, nullptr, li >= 0 ? STATS(li) : (const float*)(p.ws + WS_IDST), cv, cv + 5632, nullptr, nullptr};
                gemm_phase<EPI_SWIGLU>(lds, WSB(WS_XN), 1024, WSB(WS_WGU) + (size_t)lf * 5632 * 1024, MROWS, 5632, 1024, E);
                if (ph == 2) { Epi Em{EPI_MEMKV, nullptr, 0, nullptr, 0.f, p.out + O_MK, p.out + O_MV, WSB(WS_MKB), WSB(WS_MVB), nullptr, nullptr, nullptr, nullptr, nullptr};
                    gemm_phase<EPI_MEMKV>(lds, WSB(WS_MEMP), 1024, WSB(WS_MEMW), 2048, 4096, 1024, Em); } }
            else if (s == 1 || s == 8) {
                const int lf = layer * 2 + (s == 8), li_in = (s == 8) ? 3 * layer + 1 : 3 * layer - 1, li_out = (s == 8) ? 3 * layer + 2 : 3 * layer;
                Epi E{EPI_RES, nullptr, 0, p.out + O_Y, 0.5f, nullptr, nullptr, nullptr, nullptr, li_in >= 0 ? STATS(li_in) : (const float*)(p.ws + WS_IDST),
                      li_in >= 0 ? p.in[10] + li_in * 1024 : (const float*)(p.ws + WS_ONES), li_in >= 0 ? p.in[11] + li_in * 1024 : (const float*)(p.ws + WS_CV_WGU), STATS(li_out), WSB(WS_XN)};
                gemm_phase<EPI_RES>(lds, WSB(WS_PROJ), FF, WSB(WS_WD) + (size_t)lf * 1024 * FF, MP, 1024, FF, E);
                gemm_phase<EPI_RES, true>(lds, WSB(WS_PROJ), FF, WSB(WS_WD) + (size_t)lf * 1024 * FF, MP, 1024, FF, E); }

            else if (s == 2) {
                const int li = 3 * layer;
                const float* cv = gla ? (const float*)(p.ws + WS_CV_GWIN) + (size_t)j * 2 * 4096 : (const float*)(p.ws + WS_CV_HWIN) + (size_t)j * 2 * 4608;
                Epi E{EPI_BF16, WSB(WS_PROJ), gla ? GL_LD : HG_LD, nullptr, 0.f, nullptr, nullptr, nullptr, nullptr, STATS(li), cv, cv + (gla ? 4096 : 4608), nullptr, nullptr};
                if (gla) gemm_phase<EPI_BF16>(lds, WSB(WS_XN), 1024, WSB(WS_GWIN) + (size_t)j * 4096 * 1024, MROWS, 4096, 1024, E);
                else gemm_phase<EPI_BF16>(lds, WSB(WS_XN), 1024, WSB(WS_HWIN) + (size_t)j * 4608 * 1024, MROWS, 4608, 1024, E); }
            else if (s == 3) mixprep_phase(lds, p, layer);
            else if (s == 4) chain_phase(lds, p, layer);
            else if (s == 5) { if (gla) headnorm_phase(WSB(WS_PROJ), GL_LD, 2560, 1536, 32, p.in[19] + j * 1024); else headnorm_phase(WSB(WS_PROJ), HG_LD, 3072, 2048, 16, p.in[14] + j * 1024); }
            else if (s == 6) {
                const int li_in = 3 * layer;
                Epi E{EPI_RES, nullptr, 0, p.out + O_Y, 1.0f, nullptr, nullptr, nullptr, nullptr, STATS(li_in), p.in[10] + li_in * 1024, p.in[11] + li_in * 1024, STATS(li_in + 1), WSB(WS_XN)};
                gemm_phase<EPI_RES>(lds, WSB(WS_PROJ) + (gla ? 2560 : 3072), gla ? GL_LD : HG_LD, WSB(WS_WOUT) + (size_t)layer * 1024 * 1536, MP, 1024, 1536, E);
                gemm_phase<EPI_RES, true>(lds, WSB(WS_PROJ) + (gla ? 2560 : 3072), gla ? GL_LD : HG_LD, WSB(WS_WOUT) + (size_t)layer * 1024 * 1536, MP, 1024, 1536, E); }

        }
        if (ph + 1 < p.ph_hi && ph != 1) {
            if (ph == 0) cg::this_grid().sync();
            else { XcdBarrier bar; bar.bar = (unsigned*)(p.ws + WS_BAR); bar.x = xb_xcc_id(); bar.st = (volatile LAS unsigned*)(lds + LDS_ST_OFF); xcd_barrier(bar); }
        }
    }
}
#undef WSB
#undef STATS

extern "C" void kernel_launch(void* const* d_in, const int* in_sizes, int n_in, void* d_out, int out_size, void* d_ws, size_t ws_size, hipStream_t stream) {
    static int grid = 0;
    if (grid == 0) {
        if (n_in != 23 || ws_size < WS_END) { fprintf(stderr, "kernel_launch: need 23 inputs and %zu bytes of workspace; got %d, %zu\n", (size_t)WS_END, n_in, ws_size); grid = -1; return; }
        if (hipFuncSetAttribute((const void*)trunk_fwd, hipFuncAttributeMaxDynamicSharedMemorySize, LDS_BYTES) != hipSuccess) { fprintf(stderr, "kernel_launch: hipFuncSetAttribute failed\n"); grid = -1; return; }
        int dev = 0, cus = 0, per_cu = 0;
        (void)hipGetDevice(&dev); (void)hipDeviceGetAttribute(&cus, hipDeviceAttributeMultiprocessorCount, dev);
        (void)hipOccupancyMaxActiveBlocksPerMultiprocessor(&per_cu, (const void*)trunk_fwd, NTHR, LDS_BYTES);
        if (per_cu < 1) { fprintf(stderr, "kernel_launch: occupancy query says %d blocks per CU\n", per_cu); per_cu = 1; }
        (void)hipGetLastError();
        grid = cus;
    }
    if (grid < 0) return;
    Params p{};
    for (int i = 0; i < 23; ++i) p.in[i] = (const float*)d_in[i];
    p.out = (float*)d_out; p.ws = (unsigned char*)d_ws;
#if ONE_LAUNCH
    (void)hipMemsetAsync((unsigned char*)d_ws + WS_BAR, 0, WS_ZERO_END - WS_BAR, stream);
    p.ph_lo = 0; p.ph_hi = NPHASE;
    void* args[] = {&p};
    hipError_t e = hipLaunchCooperativeKernel((const void*)trunk_fwd, dim3(grid), dim3(NTHR), args, LDS_BYTES, stream);
    if (e != hipSuccess) fprintf(stderr, "cooperative launch failed: %s (grid %d)\n", hipGetErrorString(e), grid);
#else
    (void)hipMemsetAsync((unsigned char*)d_ws + WS_BAR, 0, WS_ZERO_END - WS_BAR, stream);
    for (int ph = 0; ph < NPHASE; ++ph) {
        p.ph_lo = ph; p.ph_hi = ph + 1;
        hipLaunchKernelGGL(trunk_fwd, dim3(grid), dim3(NTHR), LDS_BYTES, stream, p);
    }
#endif
}
```
